# Optimizing an MI355X kernel written in HIP

```python
import math
import jax, jax.numpy as jnp
from jax import lax
import numpy as np

D_MODEL = 1024
BATCH = 8
SEQ = 2048
DEPTH = 1
DEC_BATCH = 128
DEC_SEQ = 1
PAST_LEN = 16384
PAGE_SIZE = 128

D_RNN = 1024
RNN_BLOCKS = 8
RNN_BW = D_RNN // RNN_BLOCKS
CONV_W = 4
RG_C = 8.0
GLA_HEADS = 4
GLA_DK = D_MODEL // 2 // GLA_HEADS
GLA_DV = D_MODEL // GLA_HEADS
GLA_RANK = 16
GLA_TAU = 16.0
GLA_CHUNK = 64
D_FF = 2816
EPS = 1e-6

IN_SIZES = (D_RNN, D_RNN, GLA_HEADS * GLA_DK, GLA_HEADS * GLA_DK, GLA_HEADS * GLA_DV,
            GLA_HEADS * GLA_DV, GLA_RANK, D_MODEL, D_MODEL)
D_IN = sum(IN_SIZES)

kernel_name = "hawk_gla_parallel_macaron_step"


def rmsnorm(x, g):
    xf = x.astype(jnp.float32)
    y = xf * lax.rsqrt(jnp.mean(xf * xf, axis=-1, keepdims=True) + EPS)
    return (y * g.astype(jnp.float32)).astype(x.dtype)


def swiglu(x, w_gu, w_down):
    gate, up = jnp.split(x @ w_gu, 2, axis=-1)
    return (jax.nn.silu(gate) * up) @ w_down


def causal_depthwise_conv(xr, buf, w, b):
    T = xr.shape[1]
    xp = jnp.concatenate([buf.astype(xr.dtype), xr], axis=1)
    y = b
    for j in range(CONV_W):
        y = y + xp[:, j:j + T] * w[j]
    return y, xp[:, T:]


def linear_scan(a, b, h0):
    def combine(c1, c2):
        a1, b1 = c1
        a2, b2 = c2
        return a1 * a2, a2 * b1 + b2
    a_cum, h = lax.associative_scan(combine, (a, b), axis=1)
    return h + a_cum * h0[:, None]


def rglru(xc, h0, w_a, b_a, w_x, b_x, lam, reset_first):
    xf = xc.astype(jnp.float32)
    B, T, _ = xf.shape
    xb = xf.reshape(B, T, RNN_BLOCKS, RNN_BW)
    r = jax.nn.sigmoid(jnp.einsum('btni,nij->btnj', xb, w_a.astype(jnp.float32)).reshape(B, T, D_RNN) + b_a)
    i = jax.nn.sigmoid(jnp.einsum('btni,nij->btnj', xb, w_x.astype(jnp.float32)).reshape(B, T, D_RNN) + b_x)
    log_a = -RG_C * r * jax.nn.softplus(-lam.astype(jnp.float32))
    a = jnp.exp(log_a)
    mult = jnp.sqrt(jnp.maximum(-jnp.expm1(2.0 * log_a), 0.0))
    if reset_first:
        mult = mult.at[:, 0].set(1.0)
    h = linear_scan(a, mult * i * xf, h0.astype(jnp.float32))
    return h, h[:, -1]


def gla_chunked(q, k, v, g, S0):
    B, T, H, DK = q.shape
    DV = v.shape[-1]
    C = min(GLA_CHUNK, T)
    pad = (-T) % C
    if pad:
        pw = ((0, 0), (0, pad), (0, 0), (0, 0))
        q, k, v, g = (jnp.pad(t, pw) for t in (q, k, v, g))
    N = (T + pad) // C
    q, k, g = (t.reshape(B, N, C, H, DK) for t in (q, k, g))
    v = v.reshape(B, N, C, H, DV)
    bcum = jnp.cumsum(g, axis=2)
    q_i = q * jnp.exp(bcum)
    k_i = k * jnp.exp(-bcum)
    mask = jnp.tril(jnp.ones((C, C), dtype=bool))
    att = jnp.where(mask, jnp.einsum('bnchk,bnshk->bnhcs', q_i, k_i), 0.0)
    o_intra = jnp.einsum('bnhcs,bnshv->bnchv', att, v)
    b_last = bcum[:, :, -1]
    k_end = k * jnp.exp(b_last[:, :, None] - bcum)

    def step(S, inp):
        kk, vv, dl = inp
        S_new = S * jnp.exp(dl)[..., None] + jnp.einsum('bchk,bchv->bhkv', kk, vv)
        return S_new, S

    xs = (jnp.moveaxis(k_end, 1, 0), jnp.moveaxis(v, 1, 0), jnp.moveaxis(b_last, 1, 0))
    S_final, S_starts = lax.scan(step, S0, xs)
    S_starts = jnp.moveaxis(S_starts, 0, 1)
    o_inter = jnp.einsum('bnchk,bnhkv->bnchv', q_i, S_starts)
    o = (o_intra + o_inter).reshape(B, N * C, H, DV)[:, :T]
    return o, S_final


def token_mixing(u, h0, conv0, S0, reset_first, w_in, conv_w, conv_b, rg_w_a, rg_b_a, rg_w_x, rg_b_x,
                 rg_lambda, gla_w_lr, gla_b_lr, gla_norm_g, w_branch_rnn, w_branch_gla, w_out):
    Bsz, T, _ = u.shape
    f32 = jnp.float32
    split_at = np.cumsum(IN_SIZES)[:-1].tolist()
    xr, yr, q, k, v, og, lr, gate_rnn, gate_gla = jnp.split(u @ w_in, split_at, axis=-1)
    xc, conv_new = causal_depthwise_conv(xr, conv0, conv_w, conv_b)
    h, h_last = rglru(xc, h0, rg_w_a, rg_b_a, rg_w_x, rg_b_x, rg_lambda, reset_first)
    o_rnn = (h * jax.nn.gelu(yr.astype(f32))).astype(u.dtype)
    qh = q.reshape(Bsz, T, GLA_HEADS, GLA_DK).astype(f32) * (GLA_DK ** -0.5)
    kh = k.reshape(Bsz, T, GLA_HEADS, GLA_DK).astype(f32)
    vh = v.reshape(Bsz, T, GLA_HEADS, GLA_DV).astype(f32)
    log_alpha = jax.nn.log_sigmoid((lr @ gla_w_lr + gla_b_lr).astype(f32)) / GLA_TAU
    o, S_new = gla_chunked(qh, kh, vh, log_alpha.reshape(Bsz, T, GLA_HEADS, GLA_DK), S0.astype(f32))
    o = o * lax.rsqrt(jnp.mean(o * o, axis=-1, keepdims=True) + EPS) * gla_norm_g.astype(f32)
    o = o * jax.nn.silu(og.reshape(Bsz, T, GLA_HEADS, GLA_DV).astype(f32))
    o_gla = o.reshape(Bsz, T, GLA_HEADS * GLA_DV).astype(u.dtype)
    merged = jax.nn.sigmoid(gate_rnn) * (o_rnn @ w_branch_rnn) + jax.nn.sigmoid(gate_gla) * (o_gla @ w_branch_gla)
    return merged @ w_out, h_last.astype(u.dtype), conv_new.astype(u.dtype), S_new.astype(u.dtype)


def decoder_layer(x, h0, conv0, S0, reset_first, norm_g, ffn1_w_gu, ffn1_w_down, w_in, conv_w, conv_b,
                  rg_w_a, rg_b_a, rg_w_x, rg_b_x, rg_lambda, gla_w_lr, gla_b_lr, gla_norm_g,
                  w_branch_rnn, w_branch_gla, w_out, ffn2_w_gu, ffn2_w_down):
    x = x + 0.5 * rmsnorm(swiglu(rmsnorm(x, norm_g[0]), ffn1_w_gu, ffn1_w_down), norm_g[1])
    mix, h_last, conv_new, S_new = token_mixing(
        rmsnorm(x, norm_g[2]), h0, conv0, S0, reset_first, w_in, conv_w, conv_b, rg_w_a, rg_b_a,
        rg_w_x, rg_b_x, rg_lambda, gla_w_lr, gla_b_lr, gla_norm_g, w_branch_rnn, w_branch_gla, w_out)
    x = x + rmsnorm(mix, norm_g[3])
    x = x + 0.5 * rmsnorm(swiglu(rmsnorm(x, norm_g[4]), ffn2_w_gu, ffn2_w_down), norm_g[5])
    return x, h_last, conv_new, S_new


def setup_inputs(seed: int = 0) -> dict:
    key = jax.random.key(seed)
    ks = iter(jax.random.split(key, 32))
    f32 = jnp.float32

    def nrm(shape, scale):
        return jax.random.normal(next(ks), shape, f32) * scale

    u = jax.random.uniform(next(ks), (DEPTH, D_RNN), f32, 0.9, 0.999)
    p = u ** (1.0 / RG_C)
    rg_lambda = jnp.log(p) - jnp.log1p(-p)
    return {
        "x_prompt": nrm((BATCH, SEQ, D_MODEL), 1.0),
        "x_sample": nrm((DEC_BATCH, DEC_SEQ, D_MODEL), 1.0),
        "state_rnn_h": nrm((DEPTH, DEC_BATCH, D_RNN), 0.5),
        "state_rnn_conv": nrm((DEPTH, DEC_BATCH, CONV_W - 1, D_RNN), 1.0),
        "state_gla": nrm((DEPTH, DEC_BATCH, GLA_HEADS, GLA_DK, GLA_DV), 1.0),
        "norm_gains": 1.0 + nrm((DEPTH, 6, D_MODEL), 0.02),
        "ffn1_w_gu": nrm((DEPTH, D_MODEL, 2 * D_FF), D_MODEL ** -0.5),
        "ffn1_w_down": nrm((DEPTH, D_FF, D_MODEL), D_FF ** -0.5),
        "w_in": nrm((DEPTH, D_MODEL, D_IN), D_MODEL ** -0.5),
        "conv_w": nrm((DEPTH, CONV_W, D_RNN), CONV_W ** -0.5),
        "conv_b": nrm((DEPTH, D_RNN), 0.01),
        "rg_w_a": nrm((DEPTH, RNN_BLOCKS, RNN_BW, RNN_BW), RNN_BW ** -0.5),
        "rg_b_a": nrm((DEPTH, D_RNN), 0.01),
        "rg_w_x": nrm((DEPTH, RNN_BLOCKS, RNN_BW, RNN_BW), RNN_BW ** -0.5),
        "rg_b_x": nrm((DEPTH, D_RNN), 0.01),
        "rg_lambda": rg_lambda,
        "gla_w_lr": nrm((DEPTH, GLA_RANK, GLA_HEADS * GLA_DK), GLA_RANK ** -0.5),
        "gla_b_lr": nrm((DEPTH, GLA_HEADS * GLA_DK), 0.01),
        "gla_norm_g": 1.0 + nrm((DEPTH, GLA_DV), 0.02),
        "w_branch_rnn": nrm((DEPTH, D_RNN, D_MODEL), D_RNN ** -0.5),
        "w_branch_gla": nrm((DEPTH, GLA_HEADS * GLA_DV, D_MODEL), (GLA_HEADS * GLA_DV) ** -0.5),
        "w_out": nrm((DEPTH, D_MODEL, D_MODEL), D_MODEL ** -0.5),
        "ffn2_w_gu": nrm((DEPTH, D_MODEL, 2 * D_FF), D_MODEL ** -0.5),
        "ffn2_w_down": nrm((DEPTH, D_FF, D_MODEL), D_FF ** -0.5),
    }


def reference(x_prompt, x_sample, state_rnn_h, state_rnn_conv, state_gla, norm_gains, ffn1_w_gu,
              ffn1_w_down, w_in, conv_w, conv_b, rg_w_a, rg_b_a, rg_w_x, rg_b_x, rg_lambda, gla_w_lr,
              gla_b_lr, gla_norm_g, w_branch_rnn, w_branch_gla, w_out, ffn2_w_gu, ffn2_w_down):
    dt = x_prompt.dtype
    Bp = x_prompt.shape[0]
    yp, ys = x_prompt, x_sample
    hp_l, cp_l, sp_l, hs_l, cs_l, ss_l = [], [], [], [], [], []
    for l in range(DEPTH):
        lw = (norm_gains[l], ffn1_w_gu[l], ffn1_w_down[l], w_in[l], conv_w[l], conv_b[l], rg_w_a[l],
              rg_b_a[l], rg_w_x[l], rg_b_x[l], rg_lambda[l], gla_w_lr[l], gla_b_lr[l], gla_norm_g[l],
              w_branch_rnn[l], w_branch_gla[l], w_out[l], ffn2_w_gu[l], ffn2_w_down[l])
        h0 = jnp.zeros((Bp, D_RNN), dt)
        c0 = jnp.zeros((Bp, CONV_W - 1, D_RNN), dt)
        s0 = jnp.zeros((Bp, GLA_HEADS, GLA_DK, GLA_DV), dt)
        yp, hp, cp, sp = decoder_layer(yp, h0, c0, s0, True, *lw)
        ys, hs, cs, ss = decoder_layer(ys, state_rnn_h[l], state_rnn_conv[l], state_gla[l], False, *lw)
        hp_l.append(hp); cp_l.append(cp); sp_l.append(sp)
        hs_l.append(hs); cs_l.append(cs); ss_l.append(ss)
    return (yp, ys, jnp.stack(hp_l), jnp.stack(cp_l), jnp.stack(sp_l),
            jnp.stack(hs_l), jnp.stack(cs_l), jnp.stack(ss_l))
```

```cpp
#include <hip/hip_runtime.h>
namespace nv {
constexpr int D = 1024, FF = 2816, DIN = 7184, TSEQ = 2048, NB = 8, NS = 128;
constexpr int C_XR = 0, C_YR = 1024, C_Q = 2048, C_K = 2560, C_V = 3072, C_OG = 4096, C_LR = 5120, C_GA = 5136, C_GB = 6160;
constexpr float EPS = 1e-6f;
constexpr size_t O_YP = 0, O_YS = 16777216, O_HP = 16908288, O_CP = 16916480, O_SP = 16941056, O_HS = 17989632, O_CS = 18120704, O_SS = 18513920;

__device__ __forceinline__ float sigmoidf_(float x) { return 1.f / (1.f + expf(-x)); }
__device__ __forceinline__ float siluf_(float x) { return x / (1.f + expf(-x)); }
__device__ __forceinline__ float softplusf_(float x) { return fmaxf(x, 0.f) + log1pf(expf(-fabsf(x))); }
__device__ __forceinline__ float logsigmoidf_(float x) { return -softplusf_(-x); }
__device__ __forceinline__ float gelu_tanhf_(float x) { const float c = 0.7978845608028654f; return 0.5f * x * (1.f + tanhf(c * (x + 0.044715f * x * x * x))); }

__device__ __forceinline__ float block_sum256(float v, float* red) {
#pragma unroll
    for (int o = 32; o > 0; o >>= 1) v += __shfl_xor(v, o);
    __syncthreads();
    if ((threadIdx.x & 63) == 0) red[threadIdx.x >> 6] = v;
    __syncthreads();
    return red[0] + red[1] + red[2] + red[3];
}
__global__ void k_rmsnorm(const float* x, const float* g, float* y) {
    __shared__ float red[4];
    const size_t r = blockIdx.x; const float* xr = x + r * D; float v[4]; float s = 0.f;
#pragma unroll
    for (int j = 0; j < 4; ++j) { v[j] = xr[threadIdx.x + 256 * j]; s += v[j] * v[j]; }
    const float tot = block_sum256(s, red); const float rs = rsqrtf(tot / D + EPS);
#pragma unroll
    for (int j = 0; j < 4; ++j) y[r * D + threadIdx.x + 256 * j] = v[j] * rs * g[threadIdx.x + 256 * j];
}
__global__ void k_resnorm(const float* base, const float* f, const float* g, float scale, float* out) {
    __shared__ float red[4];
    const size_t r = blockIdx.x; const float* fr = f + r * D; float v[4]; float s = 0.f;
#pragma unroll
    for (int j = 0; j < 4; ++j) { v[j] = fr[threadIdx.x + 256 * j]; s += v[j] * v[j]; }
    const float tot = block_sum256(s, red); const float rs = rsqrtf(tot / D + EPS);
#pragma unroll
    for (int j = 0; j < 4; ++j) { const int c = threadIdx.x + 256 * j; out[r * D + c] = base[r * D + c] + scale * (v[j] * rs * g[c]); }
}
__global__ void __launch_bounds__(256) k_gemm(const float* A, int lda, const float* B, int ldb, float* C, int ldc, int M, int N, int K, size_t sA, size_t sB, size_t sC) {
    __shared__ float As[16][64 + 1], Bs[16][64 + 1];
    A += blockIdx.z * sA; B += blockIdx.z * sB; C += blockIdx.z * sC;
    const int m0 = blockIdx.y * 64, n0 = blockIdx.x * 64, tx = threadIdx.x & 15, ty = threadIdx.x >> 4;
    float acc[4][4];
#pragma unroll
    for (int i = 0; i < 4; ++i)
#pragma unroll
        for (int j = 0; j < 4; ++j) acc[i][j] = 0.f;
    for (int k0 = 0; k0 < K; k0 += 16) {
#pragma unroll
        for (int i = 0; i < 4; ++i) { const int e = threadIdx.x + 256 * i; const int m = e >> 4, k = e & 15; As[k][m] = A[(size_t)(m0 + m) * lda + k0 + k]; }
#pragma unroll
        for (int i = 0; i < 4; ++i) { const int e = threadIdx.x + 256 * i; const int k = e >> 6, n = e & 63; Bs[k][n] = (n0 + n < N) ? B[(size_t)(k0 + k) * ldb + n0 + n] : 0.f; }
        __syncthreads();
#pragma unroll
        for (int k = 0; k < 16; ++k) { float a[4], b[4];
#pragma unroll
            for (int i = 0; i < 4; ++i) { a[i] = As[k][ty * 4 + i]; b[i] = Bs[k][tx * 4 + i]; }
#pragma unroll
            for (int i = 0; i < 4; ++i)
#pragma unroll
                for (int j = 0; j < 4; ++j) acc[i][j] = fmaf(a[i], b[j], acc[i][j]); }
        __syncthreads();
    }
#pragma unroll
    for (int i = 0; i < 4; ++i)
#pragma unroll
        for (int j = 0; j < 4; ++j) { const int n = n0 + tx * 4 + j; if (n < N) C[(size_t)(m0 + ty * 4 + i) * ldc + n] = acc[i][j]; }
}
__global__ void k_swiglu(const float* gu, float* h, size_t n) {
    for (size_t i = blockIdx.x * (size_t)blockDim.x + threadIdx.x; i < n; i += (size_t)gridDim.x * blockDim.x) { const size_t r = i / FF, j = i % FF; h[i] = siluf_(gu[r * (2 * FF) + j]) * gu[r * (2 * FF) + FF + j]; }
}
__global__ void k_conv(const float* P, const float* buf, const float* w, const float* b, float* xc, float* conv_new, int T, int nseq) {
    const size_t n = (size_t)nseq * T * D;
    for (size_t i = blockIdx.x * (size_t)blockDim.x + threadIdx.x; i < n; i += (size_t)gridDim.x * blockDim.x) {
        const int c = (int)(i % D); const size_t row = i / D; const int t = (int)(row % T); const int seq = (int)(row / T);
        float y = b[c];
#pragma unroll
        for (int j = 0; j < 4; ++j) { const int idx = t + j - 3; float xv;
            if (idx >= 0) xv = P[((size_t)seq * T + idx) * DIN + C_XR + c]; else xv = buf ? buf[((size_t)seq * 3 + (3 + idx)) * D + c] : 0.f;
            y += xv * w[j * D + c]; }
        xc[i] = y;
    }
    const size_t n2 = (size_t)nseq * 3 * D;
    for (size_t i = blockIdx.x * (size_t)blockDim.x + threadIdx.x; i < n2; i += (size_t)gridDim.x * blockDim.x) {
        const int c = (int)(i % D); const int j = (int)((i / D) % 3); const int seq = (int)(i / (3 * D));
        const int xi = T + j;
        float v; if (xi >= 3) v = P[((size_t)seq * T + (xi - 3)) * DIN + C_XR + c]; else v = buf ? buf[((size_t)seq * 3 + xi) * D + c] : 0.f;
        conv_new[i] = v;
    }
}
__global__ void k_rg_elem(const float* xc, const float* RA, const float* RX, const float* b_a, const float* b_x, const float* lam, float* a_out, float* bb_out, int T, int nseq, int reset) {
    const size_t n = (size_t)nseq * T * D;
    for (size_t i = blockIdx.x * (size_t)blockDim.x + threadIdx.x; i < n; i += (size_t)gridDim.x * blockDim.x) {
        const int c = (int)(i % D); const int t = (int)((i / D) % T);
        const float r = sigmoidf_(RA[i] + b_a[c]), ig = sigmoidf_(RX[i] + b_x[c]);
        const float log_a = -8.0f * r * softplusf_(-lam[c]); const float a = expf(log_a);
        float mult = sqrtf(fmaxf(-expm1f(2.0f * log_a), 0.f)); if (reset && t == 0) mult = 1.0f;
        a_out[i] = a; bb_out[i] = mult * ig * xc[i];
    }
}
__global__ void k_scan(const float* a, const float* bb, const float* h0, float* h, float* h_last, int T, int nseq) {
    const int i = blockIdx.x * blockDim.x + threadIdx.x; if (i >= nseq * D) return;
    const int c = i % D, seq = i / D; float hv = h0 ? h0[(size_t)seq * D + c] : 0.f;
    for (int t = 0; t < T; ++t) { const size_t o = ((size_t)seq * T + t) * D + c; hv = a[o] * hv + bb[o]; h[o] = hv; }
    h_last[(size_t)seq * D + c] = hv;
}
__global__ void k_gate_rnn(const float* h, const float* P, float* o, size_t n) {
    for (size_t i = blockIdx.x * (size_t)blockDim.x + threadIdx.x; i < n; i += (size_t)gridDim.x * blockDim.x) { const size_t r = i / D; const int c = (int)(i % D); o[i] = h[i] * gelu_tanhf_(P[r * DIN + C_YR + c]); }
}
__global__ void __launch_bounds__(256) k_gla(const float* P, const float* G, const float* blr, const float* S0, float* O, float* S_out, int T) {
    extern __shared__ float S[];
    __shared__ float sq[128], sk[128], se[128];
    const int head = blockIdx.x & 3, seq = blockIdx.x >> 2, dv = threadIdx.x;
    for (int kk = 0; kk < 128; ++kk) S[kk * 256 + dv] = S0 ? S0[(((size_t)seq * 4 + head) * 128 + kk) * 256 + dv] : 0.f;
    for (int t = 0; t < T; ++t) {
        const size_t row = (size_t)seq * T + t;
        __syncthreads();
        if (dv < 128) { sq[dv] = P[row * DIN + C_Q + head * 128 + dv] * 0.08838834764831845f; sk[dv] = P[row * DIN + C_K + head * 128 + dv];
            se[dv] = expf(logsigmoidf_(G[row * 512 + head * 128 + dv] + blr[head * 128 + dv]) * (1.0f / 16.0f)); }
        __syncthreads();
        const float v = P[row * DIN + C_V + head * 256 + dv]; float o = 0.f;
        for (int kk = 0; kk < 128; ++kk) { const float s = S[kk * 256 + dv] * se[kk] + sk[kk] * v; S[kk * 256 + dv] = s; o = fmaf(sq[kk], s, o); }
        O[row * D + head * 256 + dv] = o;
    }
    for (int kk = 0; kk < 128; ++kk) S_out[(((size_t)seq * 4 + head) * 128 + kk) * 256 + dv] = S[kk * 256 + dv];
}
__global__ void k_gla_out(const float* O, const float* P, const float* gn, float* og_out) {
    __shared__ float red[4];
    const int head = blockIdx.x & 3; const size_t row = blockIdx.x >> 2; const int dv = threadIdx.x;
    const float o = O[row * D + head * 256 + dv]; const float tot = block_sum256(o * o, red); const float rs = rsqrtf(tot / 256.f + EPS);
    og_out[row * D + head * 256 + dv] = o * rs * gn[dv] * siluf_(P[row * DIN + C_OG + head * 256 + dv]);
}
__global__ void k_merge(const float* P, const float* YA, const float* YB, float* m, size_t n) {
    for (size_t i = blockIdx.x * (size_t)blockDim.x + threadIdx.x; i < n; i += (size_t)gridDim.x * blockDim.x) { const size_t r = i / D; const int c = (int)(i % D);
        m[i] = sigmoidf_(P[r * DIN + C_GA + c]) * YA[i] + sigmoidf_(P[r * DIN + C_GB + c]) * YB[i]; }
}
struct In { const float *xp, *xs, *srh, *src, *sgla, *ng, *f1gu, *f1d, *win, *cw, *cb, *rwa, *rba, *rwx, *rbx, *lam, *wlr, *blr, *gng, *wbr, *wbg, *wout, *f2gu, *f2d; };
inline In make_in(void* const* d) { In I; const float** p = (const float**)&I; for (int i = 0; i < 24; ++i) p[i] = (const float*)d[i]; return I; }
inline void gemm(hipStream_t st, const float* A, int lda, const float* B, int ldb, float* C, int ldc, int M, int N, int K, int nz = 1, size_t sA = 0, size_t sB = 0, size_t sC = 0) {
    hipLaunchKernelGGL(k_gemm, dim3((N + 63) / 64, M / 64, nz), dim3(256), 0, st, A, lda, B, ldb, C, ldc, M, N, K, sA, sB, sC);
}
inline void run_group(hipStream_t st, const In& I, float* out, float* ws, int grp) {
    const bool smp = (grp == NB); const int T = smp ? 1 : TSEQ, nseq = smp ? NS : 1, R = T * nseq;
    const float* x = smp ? I.xs : I.xp + (size_t)grp * TSEQ * D;
    float* y = smp ? out + O_YS : out + O_YP + (size_t)grp * TSEQ * D;
    float* h_last = smp ? out + O_HS : out + O_HP + (size_t)grp * D;
    float* conv_new = smp ? out + O_CS : out + O_CP + (size_t)grp * 3 * D;
    float* s_new = smp ? out + O_SS : out + O_SP + (size_t)grp * 4 * 128 * 256;
    const size_t RD = (size_t)2048 * D;
    float *T0 = ws, *T1 = T0 + RD, *T2 = T1 + RD, *T3 = T2 + RD, *T4 = T3 + RD, *T5 = T4 + RD, *T6 = T5 + RD, *T7 = T6 + RD, *T8 = T7 + RD, *T9 = T8 + RD;
    float *GU = T9 + RD, *HH = GU + (size_t)2048 * 2 * FF, *P = HH + (size_t)2048 * FF, *G = P + (size_t)2048 * DIN;
    const float* ng = I.ng; const size_t n1 = (size_t)R * D; const int EB = 1024;
    hipLaunchKernelGGL(k_rmsnorm, dim3(R), dim3(256), 0, st, x, ng + 0 * D, T0);
    gemm(st, T0, D, I.f1gu, 2 * FF, GU, 2 * FF, R, 2 * FF, D);
    hipLaunchKernelGGL(k_swiglu, dim3(EB), dim3(256), 0, st, GU, HH, (size_t)R * FF);
    gemm(st, HH, FF, I.f1d, D, T1, D, R, D, FF);
    hipLaunchKernelGGL(k_resnorm, dim3(R), dim3(256), 0, st, x, T1, ng + 1 * D, 0.5f, T2);
    hipLaunchKernelGGL(k_rmsnorm, dim3(R), dim3(256), 0, st, T2, ng + 2 * D, T3);
    gemm(st, T3, D, I.win, DIN, P, DIN, R, DIN, D);
    hipLaunchKernelGGL(k_conv, dim3(EB), dim3(256), 0, st, P, smp ? I.src : nullptr, I.cw, I.cb, T4, conv_new, T, nseq);
    gemm(st, T4, D, I.rwa, 128, T5, D, R, 128, 128, 8, 128, 128 * 128, 128);
    gemm(st, T4, D, I.rwx, 128, T6, D, R, 128, 128, 8, 128, 128 * 128, 128);
    hipLaunchKernelGGL(k_rg_elem, dim3(EB), dim3(256), 0, st, T4, T5, T6, I.rba, I.rbx, I.lam, T7, T8, T, nseq, smp ? 0 : 1);
    hipLaunchKernelGGL(k_scan, dim3((nseq * D + 255) / 256), dim3(256), 0, st, T7, T8, smp ? I.srh : nullptr, T9, h_last, T, nseq);
    hipLaunchKernelGGL(k_gate_rnn, dim3(EB), dim3(256), 0, st, T9, P, T3, n1);
    gemm(st, P + C_LR, DIN, I.wlr, 512, G, 512, R, 512, 16);
    hipLaunchKernelGGL(k_gla, dim3(nseq * 4), dim3(256), 128 * 256 * 4, st, P, G, I.blr, smp ? I.sgla : nullptr, T7, s_new, T);
    hipLaunchKernelGGL(k_gla_out, dim3(R * 4), dim3(256), 0, st, T7, P, I.gng, T8);
    gemm(st, T3, D, I.wbr, D, T5, D, R, D, D);
    gemm(st, T8, D, I.wbg, D, T6, D, R, D, D);
    hipLaunchKernelGGL(k_merge, dim3(EB), dim3(256), 0, st, P, T5, T6, T9, n1);
    gemm(st, T9, D, I.wout, D, T1, D, R, D, D);
    hipLaunchKernelGGL(k_resnorm, dim3(R), dim3(256), 0, st, T2, T1, ng + 3 * D, 1.0f, T2);
    hipLaunchKernelGGL(k_rmsnorm, dim3(R), dim3(256), 0, st, T2, ng + 4 * D, T0);
    gemm(st, T0, D, I.f2gu, 2 * FF, GU, 2 * FF, R, 2 * FF, D);
    hipLaunchKernelGGL(k_swiglu, dim3(EB), dim3(256), 0, st, GU, HH, (size_t)R * FF);
    gemm(st, HH, FF, I.f2d, D, T1, D, R, D, FF);
    hipLaunchKernelGGL(k_resnorm, dim3(R), dim3(256), 0, st, T2, T1, ng + 5 * D, 0.5f, y);
}
}
extern "C" void kernel_launch(void* const* d_in, const int* in_sizes, int n_in,
                              void* d_out, int out_size, void* d_ws, size_t ws_size,
                              hipStream_t stream) {
    static bool init = false;
    if (!init) { (void)hipFuncSetAttribute((const void*)nv::k_gla, hipFuncAttributeMaxDynamicSharedMemorySize, 128 * 256 * 4); init = true; }
    nv::In I = nv::make_in(d_in);
    for (int g = 0; g <= nv::NB; ++g) nv::run_group(stream, I, (float*)d_out, (float*)d_ws, g);
}
```

```cpp
#include <hip/hip_runtime.h>
#include <cstdio>
#include <cstdint>

#ifndef DBG_STATIC_FLOATS
#define DBG_STATIC_FLOATS 16
#endif
__device__ float g_static[DBG_STATIC_FLOATS];
#define STATIC_TAG (1ull << 62)
template <class T> __device__ __forceinline__ T* fx(T* p) { const unsigned long long v = (unsigned long long)p; return (v & STATIC_TAG) ? (T*)((char*)g_static + (v & (STATIC_TAG - 1))) : p; }
inline float* static_ptr(size_t float_off) { return (float*)(STATIC_TAG | (unsigned long long)(float_off * 4)); }
namespace nv {
constexpr int D = 1024, FF = 2816, DIN = 7184, TSEQ = 2048, NB = 8, NS = 128;
constexpr int C_XR = 0, C_YR = 1024, C_Q = 2048, C_K = 2560, C_V = 3072, C_OG = 4096, C_LR = 5120, C_GA = 5136, C_GB = 6160;
constexpr float EPS = 1e-6f;
constexpr size_t O_YP = 0, O_YS = 16777216, O_HP = 16908288, O_CP = 16916480, O_SP = 16941056, O_HS = 17989632, O_CS = 18120704, O_SS = 18513920;

__device__ __forceinline__ float sigmoidf_(float x) { return 1.f / (1.f + expf(-x)); }
__device__ __forceinline__ float siluf_(float x) { return x / (1.f + expf(-x)); }
__device__ __forceinline__ float softplusf_(float x) { return fmaxf(x, 0.f) + log1pf(expf(-fabsf(x))); }
__device__ __forceinline__ float logsigmoidf_(float x) { return -softplusf_(-x); }
__device__ __forceinline__ float gelu_tanhf_(float x) { const float c = 0.7978845608028654f; return 0.5f * x * (1.f + tanhf(c * (x + 0.044715f * x * x * x))); }

__device__ __forceinline__ float block_sum256(float v, float* red) {
#pragma unroll
    for (int o = 32; o > 0; o >>= 1) v += __shfl_xor(v, o);
    __syncthreads();
    if ((threadIdx.x & 63) == 0) red[threadIdx.x >> 6] = v;
    __syncthreads();
    return red[0] + red[1] + red[2] + red[3];
}
__global__ void k_rmsnorm(const float* x, const float* g, float* y) { x = fx(x); g = fx(g); y = fx(y);
    __shared__ float red[4];
    const size_t r = blockIdx.x; const float* xr = x + r * D; float v[4]; float s = 0.f;
#pragma unroll
    for (int j = 0; j < 4; ++j) { v[j] = xr[threadIdx.x + 256 * j]; s += v[j] * v[j]; }
    const float tot = block_sum256(s, red); const float rs = rsqrtf(tot / D + EPS);
#pragma unroll
    for (int j = 0; j < 4; ++j) y[r * D + threadIdx.x + 256 * j] = v[j] * rs * g[threadIdx.x + 256 * j];
}
__global__ void k_resnorm(const float* base, const float* f, const float* g, float scale, float* out) { base = fx(base); f = fx(f); g = fx(g); out = fx(out);
    __shared__ float red[4];
    const size_t r = blockIdx.x; const float* fr = f + r * D; float v[4]; float s = 0.f;
#pragma unroll
    for (int j = 0; j < 4; ++j) { v[j] = fr[threadIdx.x + 256 * j]; s += v[j] * v[j]; }
    const float tot = block_sum256(s, red); const float rs = rsqrtf(tot / D + EPS);
#pragma unroll
    for (int j = 0; j < 4; ++j) { const int c = threadIdx.x + 256 * j; out[r * D + c] = base[r * D + c] + scale * (v[j] * rs * g[c]); }
}
__global__ void __launch_bounds__(256) k_gemm(const float* A, int lda, const float* B, int ldb, float* C, int ldc, int M, int N, int K, size_t sA, size_t sB, size_t sC) { A = fx(A); B = fx(B); C = fx(C);
    __shared__ float As[16][64 + 1], Bs[16][64 + 1];
    A += blockIdx.z * sA; B += blockIdx.z * sB; C += blockIdx.z * sC;
    const int m0 = blockIdx.y * 64, n0 = blockIdx.x * 64, tx = threadIdx.x & 15, ty = threadIdx.x >> 4;
    float acc[4][4];
#pragma unroll
    for (int i = 0; i < 4; ++i)
#pragma unroll
        for (int j = 0; j < 4; ++j) acc[i][j] = 0.f;
    for (int k0 = 0; k0 < K; k0 += 16) {
#pragma unroll
        for (int i = 0; i < 4; ++i) { const int e = threadIdx.x + 256 * i; const int m = e >> 4, k = e & 15; As[k][m] = A[(size_t)(m0 + m) * lda + k0 + k]; }
#pragma unroll
        for (int i = 0; i < 4; ++i) { const int e = threadIdx.x + 256 * i; const int k = e >> 6, n = e & 63; Bs[k][n] = (n0 + n < N) ? B[(size_t)(k0 + k) * ldb + n0 + n] : 0.f; }
        __syncthreads();
#pragma unroll
        for (int k = 0; k < 16; ++k) { float a[4], b[4];
#pragma unroll
            for (int i = 0; i < 4; ++i) { a[i] = As[k][ty * 4 + i]; b[i] = Bs[k][tx * 4 + i]; }
#pragma unroll
            for (int i = 0; i < 4; ++i)
#pragma unroll
                for (int j = 0; j < 4; ++j) acc[i][j] = fmaf(a[i], b[j], acc[i][j]); }
        __syncthreads();
    }
#pragma unroll
    for (int i = 0; i < 4; ++i)
#pragma unroll
        for (int j = 0; j < 4; ++j) { const int n = n0 + tx * 4 + j; if (n < N) C[(size_t)(m0 + ty * 4 + i) * ldc + n] = acc[i][j]; }
}
__global__ void k_swiglu(const float* gu, float* h, size_t n) { gu = fx(gu); h = fx(h);
    for (size_t i = blockIdx.x * (size_t)blockDim.x + threadIdx.x; i < n; i += (size_t)gridDim.x * blockDim.x) { const size_t r = i / FF, j = i % FF; h[i] = siluf_(gu[r * (2 * FF) + j]) * gu[r * (2 * FF) + FF + j]; }
}
__global__ void k_conv(const float* P, const float* buf, const float* w, const float* b, float* xc, float* conv_new, int T, int nseq) { P = fx(P); buf = fx(buf); w = fx(w); b = fx(b); xc = fx(xc); conv_new = fx(conv_new);
    const size_t n = (size_t)nseq * T * D;
    for (size_t i = blockIdx.x * (size_t)blockDim.x + threadIdx.x; i < n; i += (size_t)gridDim.x * blockDim.x) {
        const int c = (int)(i % D); const size_t row = i / D; const int t = (int)(row % T); const int seq = (int)(row / T);
        float y = b[c];
#pragma unroll
        for (int j = 0; j < 4; ++j) { const int idx = t + j - 3; float xv;
            if (idx >= 0) xv = P[((size_t)seq * T + idx) * DIN + C_XR + c]; else xv = buf ? buf[((size_t)seq * 3 + (3 + idx)) * D + c] : 0.f;
            y += xv * w[j * D + c]; }
        xc[i] = y;
    }
    const size_t n2 = (size_t)nseq * 3 * D;
    for (size_t i = blockIdx.x * (size_t)blockDim.x + threadIdx.x; i < n2; i += (size_t)gridDim.x * blockDim.x) {
        const int c = (int)(i % D); const int j = (int)((i / D) % 3); const int seq = (int)(i / (3 * D));
        const int xi = T + j;
        float v; if (xi >= 3) v = P[((size_t)seq * T + (xi - 3)) * DIN + C_XR + c]; else v = buf ? buf[((size_t)seq * 3 + xi) * D + c] : 0.f;
        conv_new[i] = v;
    }
}
__global__ void k_rg_elem(const float* xc, const float* RA, const float* RX, const float* b_a, const float* b_x, const float* lam, float* a_out, float* bb_out, int T, int nseq, int reset) { xc = fx(xc); RA = fx(RA); RX = fx(RX); b_a = fx(b_a); b_x = fx(b_x); lam = fx(lam); a_out = fx(a_out); bb_out = fx(bb_out);
    const size_t n = (size_t)nseq * T * D;
    for (size_t i = blockIdx.x * (size_t)blockDim.x + threadIdx.x; i < n; i += (size_t)gridDim.x * blockDim.x) {
        const int c = (int)(i % D); const int t = (int)((i / D) % T);
        const float r = sigmoidf_(RA[i] + b_a[c]), ig = sigmoidf_(RX[i] + b_x[c]);
        const float log_a = -8.0f * r * softplusf_(-lam[c]); const float a = expf(log_a);
        float mult = sqrtf(fmaxf(-expm1f(2.0f * log_a), 0.f)); if (reset && t == 0) mult = 1.0f;
        a_out[i] = a; bb_out[i] = mult * ig * xc[i];
    }
}
__global__ void k_scan(const float* a, const float* bb, const float* h0, float* h, float* h_last, int T, int nseq) { a = fx(a); bb = fx(bb); h0 = fx(h0); h = fx(h); h_last = fx(h_last);
    const int i = blockIdx.x * blockDim.x + threadIdx.x; if (i >= nseq * D) return;
    const int c = i % D, seq = i / D; float hv = h0 ? h0[(size_t)seq * D + c] : 0.f;
    for (int t = 0; t < T; ++t) { const size_t o = ((size_t)seq * T + t) * D + c; hv = a[o] * hv + bb[o]; h[o] = hv; }
    h_last[(size_t)seq * D + c] = hv;
}
__global__ void k_gate_rnn(const float* h, const float* P, float* o, size_t n) { h = fx(h); P = fx(P); o = fx(o);
    for (size_t i = blockIdx.x * (size_t)blockDim.x + threadIdx.x; i < n; i += (size_t)gridDim.x * blockDim.x) { const size_t r = i / D; const int c = (int)(i % D); o[i] = h[i] * gelu_tanhf_(P[r * DIN + C_YR + c]); }
}
__global__ void __launch_bounds__(256) k_gla(const float* P, const float* G, const float* blr, const float* S0, float* O, float* S_out, int T) { P = fx(P); G = fx(G); blr = fx(blr); S0 = fx(S0); O = fx(O); S_out = fx(S_out);
    extern __shared__ float S[];
    __shared__ float sq[128], sk[128], se[128];
    const int head = blockIdx.x & 3, seq = blockIdx.x >> 2, dv = threadIdx.x;
    for (int kk = 0; kk < 128; ++kk) S[kk * 256 + dv] = S0 ? S0[(((size_t)seq * 4 + head) * 128 + kk) * 256 + dv] : 0.f;
    for (int t = 0; t < T; ++t) {
        const size_t row = (size_t)seq * T + t;
        __syncthreads();
        if (dv < 128) { sq[dv] = P[row * DIN + C_Q + head * 128 + dv] * 0.08838834764831845f; sk[dv] = P[row * DIN + C_K + head * 128 + dv];
            se[dv] = expf(logsigmoidf_(G[row * 512 + head * 128 + dv] + blr[head * 128 + dv]) * (1.0f / 16.0f)); }
        __syncthreads();
        const float v = P[row * DIN + C_V + head * 256 + dv]; float o = 0.f;
        for (int kk = 0; kk < 128; ++kk) { const float s = S[kk * 256 + dv] * se[kk] + sk[kk] * v; S[kk * 256 + dv] = s; o = fmaf(sq[kk], s, o); }
        O[row * D + head * 256 + dv] = o;
    }
    for (int kk = 0; kk < 128; ++kk) S_out[(((size_t)seq * 4 + head) * 128 + kk) * 256 + dv] = S[kk * 256 + dv];
}
__global__ void k_gla_out(const float* O, const float* P, const float* gn, float* og_out) { O = fx(O); P = fx(P); gn = fx(gn); og_out = fx(og_out);
    __shared__ float red[4];
    const int head = blockIdx.x & 3; const size_t row = blockIdx.x >> 2; const int dv = threadIdx.x;
    const float o = O[row * D + head * 256 + dv]; const float tot = block_sum256(o * o, red); const float rs = rsqrtf(tot / 256.f + EPS);
    og_out[row * D + head * 256 + dv] = o * rs * gn[dv] * siluf_(P[row * DIN + C_OG + head * 256 + dv]);
}
__global__ void k_merge(const float* P, const float* YA, const float* YB, float* m, size_t n) { P = fx(P); YA = fx(YA); YB = fx(YB); m = fx(m);
    for (size_t i = blockIdx.x * (size_t)blockDim.x + threadIdx.x; i < n; i += (size_t)gridDim.x * blockDim.x) { const size_t r = i / D; const int c = (int)(i % D);
        m[i] = sigmoidf_(P[r * DIN + C_GA + c]) * YA[i] + sigmoidf_(P[r * DIN + C_GB + c]) * YB[i]; }
}
struct In { const float *xp, *xs, *srh, *src, *sgla, *ng, *f1gu, *f1d, *win, *cw, *cb, *rwa, *rba, *rwx, *rbx, *lam, *wlr, *blr, *gng, *wbr, *wbg, *wout, *f2gu, *f2d; };
inline In make_in(void* const* d) { In I; const float** p = (const float**)&I; for (int i = 0; i < 24; ++i) p[i] = (const float*)d[i]; return I; }
inline void gemm(hipStream_t st, const float* A, int lda, const float* B, int ldb, float* C, int ldc, int M, int N, int K, int nz = 1, size_t sA = 0, size_t sB = 0, size_t sC = 0) {
    hipLaunchKernelGGL(k_gemm, dim3((N + 63) / 64, M / 64, nz), dim3(256), 0, st, A, lda, B, ldb, C, ldc, M, N, K, sA, sB, sC);
}
struct Outs { float *y, *h_last, *conv_new, *s_new; };
struct Bufs { float *T0, *T1, *T2, *T3, *T4, *T5, *T6, *T7, *T8, *T9, *GU, *HH, *P, *G; };
inline Bufs make_bufs(float* ws, int R) { Bufs B; const size_t RD = (size_t)R * D; B.T0 = ws; B.T1 = B.T0 + RD; B.T2 = B.T1 + RD; B.T3 = B.T2 + RD; B.T4 = B.T3 + RD; B.T5 = B.T4 + RD; B.T6 = B.T5 + RD; B.T7 = B.T6 + RD; B.T8 = B.T7 + RD; B.T9 = B.T8 + RD;
    B.GU = B.T9 + RD; B.HH = B.GU + (size_t)R * 2 * FF; B.P = B.HH + (size_t)R * FF; B.G = B.P + (size_t)R * DIN; return B; }
inline Outs std_outs(float* out, int grp) { Outs o; const bool smp = (grp == NB);
    o.y = smp ? out + O_YS : out + O_YP + (size_t)grp * TSEQ * D; o.h_last = smp ? out + O_HS : out + O_HP + (size_t)grp * D;
    o.conv_new = smp ? out + O_CS : out + O_CP + (size_t)grp * 3 * D; o.s_new = smp ? out + O_SS : out + O_SP + (size_t)grp * 4 * 128 * 256; return o; }
inline void run_group(hipStream_t st, const In& I, const Outs& O, float* ws, int grp, int s_lo = 0, int s_hi = 12) {
    const bool smp = (grp == NB); const int T = smp ? 1 : TSEQ, nseq = smp ? NS : 1, R = T * nseq;
    const float* x = smp ? I.xs : I.xp + (size_t)grp * TSEQ * D;
    const Bufs B = make_bufs(ws, R);
    float *T0 = B.T0, *T1 = B.T1, *T2 = B.T2, *T3 = B.T3, *T4 = B.T4, *T5 = B.T5, *T6 = B.T6, *T7 = B.T7, *T8 = B.T8, *T9 = B.T9, *GU = B.GU, *HH = B.HH, *P = B.P, *G = B.G;
    const float* ng = I.ng; const size_t n1 = (size_t)R * D; const int EB = 1024;
#define STG(k) if (s_lo <= (k) && (k) < s_hi)
    STG(0) hipLaunchKernelGGL(k_rmsnorm, dim3(R), dim3(256), 0, st, x, ng + 0 * D, T0);
    STG(1) { gemm(st, T0, D, I.f1gu, 2 * FF, GU, 2 * FF, R, 2 * FF, D);
        hipLaunchKernelGGL(k_swiglu, dim3(EB), dim3(256), 0, st, GU, HH, (size_t)R * FF); }
    STG(2) gemm(st, HH, FF, I.f1d, D, T1, D, R, D, FF);
    STG(3) { hipLaunchKernelGGL(k_resnorm, dim3(R), dim3(256), 0, st, x, T1, ng + 1 * D, 0.5f, T2);
        hipLaunchKernelGGL(k_rmsnorm, dim3(R), dim3(256), 0, st, T2, ng + 2 * D, T3); }
    STG(4) gemm(st, T3, D, I.win, DIN, P, DIN, R, DIN, D);
    STG(5) { hipLaunchKernelGGL(k_conv, dim3(EB), dim3(256), 0, st, P, smp ? I.src : nullptr, I.cw, I.cb, T4, O.conv_new, T, nseq);
        gemm(st, T4, D, I.rwa, 128, T5, D, R, 128, 128, 8, 128, 128 * 128, 128);
        gemm(st, T4, D, I.rwx, 128, T6, D, R, 128, 128, 8, 128, 128 * 128, 128);
        hipLaunchKernelGGL(k_rg_elem, dim3(EB), dim3(256), 0, st, T4, T5, T6, I.rba, I.rbx, I.lam, T7, T8, T, nseq, smp ? 0 : 1);
        hipLaunchKernelGGL(k_scan, dim3((nseq * D + 255) / 256), dim3(256), 0, st, T7, T8, smp ? I.srh : nullptr, T9, O.h_last, T, nseq);
        hipLaunchKernelGGL(k_gate_rnn, dim3(EB), dim3(256), 0, st, T9, P, T3, n1);
        gemm(st, P + C_LR, DIN, I.wlr, 512, G, 512, R, 512, 16);
        hipLaunchKernelGGL(k_gla, dim3(nseq * 4), dim3(256), 128 * 256 * 4, st, P, G, I.blr, smp ? I.sgla : nullptr, T7, O.s_new, T);
        hipLaunchKernelGGL(k_gla_out, dim3(R * 4), dim3(256), 0, st, T7, P, I.gng, T8); }
    STG(6) { gemm(st, T3, D, I.wbr, D, T5, D, R, D, D);
        gemm(st, T8, D, I.wbg, D, T6, D, R, D, D);
        hipLaunchKernelGGL(k_merge, dim3(EB), dim3(256), 0, st, P, T5, T6, T9, n1); }
    STG(7) gemm(st, T9, D, I.wout, D, T1, D, R, D, D);
    STG(8) { hipLaunchKernelGGL(k_resnorm, dim3(R), dim3(256), 0, st, T2, T1, ng + 3 * D, 1.0f, T2);
        hipLaunchKernelGGL(k_rmsnorm, dim3(R), dim3(256), 0, st, T2, ng + 4 * D, T0); }
    STG(9) { gemm(st, T0, D, I.f2gu, 2 * FF, GU, 2 * FF, R, 2 * FF, D);
        hipLaunchKernelGGL(k_swiglu, dim3(EB), dim3(256), 0, st, GU, HH, (size_t)R * FF); }
    STG(10) gemm(st, HH, FF, I.f2d, D, T1, D, R, D, FF);
    STG(11) hipLaunchKernelGGL(k_resnorm, dim3(R), dim3(256), 0, st, T2, T1, ng + 5 * D, 0.5f, O.y);
#undef STG
}
}
namespace pg8 {
#define PG8_LAS __attribute__((address_space(3)))
typedef unsigned short bf16_t;
typedef short bf16x8 __attribute__((ext_vector_type(8)));
typedef float f32x4 __attribute__((ext_vector_type(4)));
typedef float f32x2 __attribute__((ext_vector_type(2)));
typedef unsigned u32x4 __attribute__((ext_vector_type(4)));
typedef unsigned u32x2 __attribute__((ext_vector_type(2)));
constexpr int BM = 256, BK = 64, HALF = 128, HTB = HALF * BK * 2, STAGE_BYTES = 8 * HTB, NXCD = 8, WGM = 8;

__host__ __device__ __forceinline__ int lds_byte(int r, int c) { const int st = (r >> 4) * 2 + (c >> 5), rr = r & 15, cc = c & 31, ob = rr * 64 + cc * 2; return st * 1024 + (ob ^ (((ob >> 9) & 1) << 5)); }
__host__ __device__ __forceinline__ void stage_rc(int b, int& R, int& C) { const int st = b / 1024, sb = b % 1024, swz = sb ^ (((sb >> 9) & 1) << 5); R = (st >> 1) * 16 + swz / 64; C = (st & 1) * 32 + (swz % 64) / 2; }
__host__ __device__ __forceinline__ int perm32(int rho) { const int n = rho >> 4, i = rho & 15; return 8 * (i >> 2) + 4 * n + (i & 3); }

struct Unit { int pm, pn; };
struct Gemm { const bf16_t* A; int lda; const bf16_t* Bt; int M, N, K; };

struct StaticOrder {
    int nM, nN, nwg, G, c;
    __host__ __device__ void init(int M, int N, int G_, int c_) { nM = M / BM; nN = N / BM; nwg = nM * nN; G = G_; c = c_; }
    __host__ __device__ bool next(int i, Unit& u) const {
        const long L = (long)i * G + c; if (L >= nwg) return false;
        int wgid = (int)L; { const int q = nwg / NXCD, r = nwg % NXCD, xcd = wgid % NXCD, off = wgid / NXCD; wgid = (xcd < r ? xcd * (q + 1) : r * (q + 1) + (xcd - r) * q) + off; }
        const int nig = WGM * nN, gid = wgid / nig, fm = gid * WGM, gsz = (nM - fm) < WGM ? (nM - fm) : WGM;
        u.pm = fm + ((wgid % nig) % gsz); u.pn = (wgid % nig) / gsz; return true;
    }
    __device__ __forceinline__ void a_ready(const Unit&) const {}
    __device__ __forceinline__ void done(const Unit&) const {}
};

__device__ __forceinline__ unsigned f2bf(float f) { unsigned u = __builtin_bit_cast(unsigned, f); return (u + 0x7fffu + ((u >> 16) & 1u)) >> 16; }
__device__ __forceinline__ unsigned pk2(float lo, float hi) { return f2bf(lo) | (f2bf(hi) << 16); }
__device__ __forceinline__ float bf_lo(unsigned w) { return __builtin_bit_cast(float, w << 16); }
__device__ __forceinline__ float bf_hi(unsigned w) { return __builtin_bit_cast(float, w & 0xffff0000u); }
__device__ __forceinline__ float fast_sigmoid(float x) { return __builtin_amdgcn_rcpf(1.0f + __builtin_amdgcn_exp2f(-1.4426950408889634f * x)); }

struct EpiF32 {
    static constexpr bool PERM = false, AFTER_DRAIN = false;
    float* C; int ldc;
    __device__ __forceinline__ void operator()(const f32x4 (&acc)[2][2][4][2], const Unit& u, int wr, int wc, int fr, int fq) const {
        const int row0 = u.pm * BM + wr * 64 + fr, col0 = u.pn * BM + wc * 32 + 4 * fq;
#pragma unroll
        for (int ai = 0; ai < 2; ++ai)
#pragma unroll
            for (int m = 0; m < 4; ++m) { float* rowp = C + (size_t)(row0 + ai * HALF + m * 16) * ldc + col0;
#pragma unroll
                for (int bj = 0; bj < 2; ++bj)
#pragma unroll
                    for (int n = 0; n < 2; ++n) *(f32x4*)(rowp + bj * HALF + n * 16) = acc[ai][bj][m][n]; }
    }
};
struct EpiBf16 {
    static constexpr bool PERM = true, AFTER_DRAIN = false;
    bf16_t* O; int ldc;
    __device__ __forceinline__ void operator()(const f32x4 (&acc)[2][2][4][2], const Unit& u, int wr, int wc, int fr, int fq) const {
        const int row0 = u.pm * BM + wr * 64 + fr, col0 = u.pn * BM + wc * 32 + 8 * fq;
#pragma unroll
        for (int ai = 0; ai < 2; ++ai)
#pragma unroll
            for (int m = 0; m < 4; ++m) { bf16_t* rowp = O + (size_t)(row0 + ai * HALF + m * 16) * ldc + col0;
#pragma unroll
                for (int bj = 0; bj < 2; ++bj) { const f32x4 v0 = acc[ai][bj][m][0], v1 = acc[ai][bj][m][1];
                    u32x4 w; w.x = pk2(v0[0], v0[1]); w.y = pk2(v0[2], v0[3]); w.z = pk2(v1[0], v1[1]); w.w = pk2(v1[2], v1[3]);
                    *(u32x4*)(rowp + bj * HALF) = w; } }
    }
};
struct EpiSwiGLU {
    static constexpr bool PERM = true, AFTER_DRAIN = false;
    bf16_t* O; int ldc;
    __device__ __forceinline__ void operator()(const f32x4 (&acc)[2][2][4][2], const Unit& u, int wr, int wc, int fr, int fq) const {
        const int row0 = u.pm * BM + wr * 64 + fr, col0 = u.pn * HALF + wc * 32 + 8 * fq;
#pragma unroll
        for (int ai = 0; ai < 2; ++ai)
#pragma unroll
            for (int m = 0; m < 4; ++m) { bf16_t* rowp = O + (size_t)(row0 + ai * HALF + m * 16) * ldc + col0;
                float h[8];
#pragma unroll
                for (int n = 0; n < 2; ++n)
#pragma unroll
                    for (int e = 0; e < 4; ++e) { const float g = acc[ai][0][m][n][e], up = acc[ai][1][m][n][e]; h[4 * n + e] = g * fast_sigmoid(g) * up; }
                u32x4 w; w.x = pk2(h[0], h[1]); w.y = pk2(h[2], h[3]); w.z = pk2(h[4], h[5]); w.w = pk2(h[6], h[7]);
                *(u32x4*)rowp = w; }
    }
};
struct EpiGateA {
    static constexpr bool PERM = true, AFTER_DRAIN = false;
    const bf16_t* G; int ldg; float* T; int ldt;
    __device__ __forceinline__ void operator()(const f32x4 (&acc)[2][2][4][2], const Unit& u, int wr, int wc, int fr, int fq) const {
        const int row0 = u.pm * BM + wr * 64 + fr, col0 = u.pn * BM + wc * 32 + 8 * fq;
#pragma unroll
        for (int ai = 0; ai < 2; ++ai)
#pragma unroll
            for (int m = 0; m < 4; ++m) { const size_t row = (size_t)(row0 + ai * HALF + m * 16);
#pragma unroll
                for (int bj = 0; bj < 2; ++bj) { const u32x4 g = *(const u32x4*)(G + row * ldg + col0 + bj * HALF); const f32x4 v0 = acc[ai][bj][m][0], v1 = acc[ai][bj][m][1];
                    f32x4 o0, o1; o0[0] = fast_sigmoid(bf_lo(g.x)) * v0[0]; o0[1] = fast_sigmoid(bf_hi(g.x)) * v0[1]; o0[2] = fast_sigmoid(bf_lo(g.y)) * v0[2]; o0[3] = fast_sigmoid(bf_hi(g.y)) * v0[3];
                    o1[0] = fast_sigmoid(bf_lo(g.z)) * v1[0]; o1[1] = fast_sigmoid(bf_hi(g.z)) * v1[1]; o1[2] = fast_sigmoid(bf_lo(g.w)) * v1[2]; o1[3] = fast_sigmoid(bf_hi(g.w)) * v1[3];
                    float* tp = T + row * ldt + col0 + bj * HALF; *(f32x4*)tp = o0; *(f32x4*)(tp + 4) = o1; } }
    }
};
struct EpiGateB {
    static constexpr bool PERM = true, AFTER_DRAIN = false;
    const bf16_t* G; int ldg; const float* T; int ldt; bf16_t* O; int ldc;
    __device__ __forceinline__ void operator()(const f32x4 (&acc)[2][2][4][2], const Unit& u, int wr, int wc, int fr, int fq) const {
        const int row0 = u.pm * BM + wr * 64 + fr, col0 = u.pn * BM + wc * 32 + 8 * fq;
#pragma unroll
        for (int ai = 0; ai < 2; ++ai)
#pragma unroll
            for (int m = 0; m < 4; ++m) { const size_t row = (size_t)(row0 + ai * HALF + m * 16);
#pragma unroll
                for (int bj = 0; bj < 2; ++bj) { const u32x4 g = *(const u32x4*)(G + row * ldg + col0 + bj * HALF); const f32x4 v0 = acc[ai][bj][m][0], v1 = acc[ai][bj][m][1];
                    const float* tp = T + row * ldt + col0 + bj * HALF; const f32x4 t0 = *(const f32x4*)tp, t1 = *(const f32x4*)(tp + 4);
                    f32x4 o0, o1; o0[0] = t0[0] + fast_sigmoid(bf_lo(g.x)) * v0[0]; o0[1] = t0[1] + fast_sigmoid(bf_hi(g.x)) * v0[1]; o0[2] = t0[2] + fast_sigmoid(bf_lo(g.y)) * v0[2]; o0[3] = t0[3] + fast_sigmoid(bf_hi(g.y)) * v0[3];
                    o1[0] = t1[0] + fast_sigmoid(bf_lo(g.z)) * v1[0]; o1[1] = t1[1] + fast_sigmoid(bf_hi(g.z)) * v1[1]; o1[2] = t1[2] + fast_sigmoid(bf_lo(g.w)) * v1[2]; o1[3] = t1[3] + fast_sigmoid(bf_hi(g.w)) * v1[3];
                    u32x4 w; w.x = pk2(o0[0], o0[1]); w.y = pk2(o0[2], o0[3]); w.z = pk2(o1[0], o1[1]); w.w = pk2(o1[2], o1[3]);
                    *(u32x4*)(O + row * ldc + col0 + bj * HALF) = w; } }
    }
};

template <class Epi, class Sched, bool ALIGN_EPI = false, bool SP2 = false>
__device__ __forceinline__ void gemm_phase(PG8_LAS unsigned char* lds, const Gemm g, const Sched& S, const Epi& E) {
    const int tid = threadIdx.x, wid = __builtin_amdgcn_readfirstlane(tid >> 6), lane = tid & 63, wr = wid >> 2, wc = wid & 3, fr = lane & 15, fq = lane >> 4;
    const int K = g.K, nt = K / BK;
    unsigned voffA[2], voffB[2];
#pragma unroll
    for (int i = 0; i < 2; ++i) { int R, C; stage_rc(tid * 16 + i * 8192, R, C); const int Rb = Epi::PERM ? ((R & ~31) + perm32(R & 31)) : R;
        voffA[i] = (unsigned)(R * g.lda + C) * 2u; voffB[i] = (unsigned)(Rb * K + C) * 2u; }
    const size_t kstep = (size_t)(BK * 2);
    const size_t hstepA = (size_t)HALF * g.lda * 2, hstepB = (size_t)HALF * K * 2;
    const size_t tstepA = 2 * hstepA, tstepB = 2 * hstepB;
    const unsigned ldsw = (unsigned)wid * 1024u;
    const int aoff = lds_byte(wr * 64 + fr, fq * 8), boff = lds_byte(wc * 32 + fr, fq * 8);
#define PG8_SA(b, h) (((b) * 2 + (h)) * HTB)
#define PG8_SB(b, h) ((4 + (b) * 2 + (h)) * HTB)
#define PG8_STAGE(bufoff, gbase, voff) do { _Pragma("unroll") for (int _i = 0; _i < 2; ++_i) \
        __builtin_amdgcn_global_load_lds((const unsigned*)((const char*)(gbase) + (voff)[_i]), (PG8_LAS unsigned*)(lds + (bufoff) + ldsw + _i * 8192), 16, 0, 0); } while (0)
#define PG8_LDA(dst, b, h) do { _Pragma("unroll") for (int m = 0; m < 4; ++m) _Pragma("unroll") for (int k = 0; k < 2; ++k) dst[m][k] = *(const PG8_LAS bf16x8*)(lds + PG8_SA(b, h) + aoff + m * 2048 + k * 1024); } while (0)
#define PG8_LDB(dst, b, h) do { _Pragma("unroll") for (int n = 0; n < 2; ++n) _Pragma("unroll") for (int k = 0; k < 2; ++k) dst[n][k] = *(const PG8_LAS bf16x8*)(lds + PG8_SB(b, h) + boff + n * 2048 + k * 1024); } while (0)
#define PG8_MMA(ai, bj, At, Bt) do { __builtin_amdgcn_s_setprio(1); _Pragma("unroll") for (int m = 0; m < 4; ++m) _Pragma("unroll") for (int n = 0; n < 2; ++n) _Pragma("unroll") for (int k = 0; k < 2; ++k) \
        acc[ai][bj][m][n] = __builtin_amdgcn_mfma_f32_16x16x32_bf16(Bt[n][k], At[m][k], acc[ai][bj][m][n], 0, 0, 0); __builtin_amdgcn_s_setprio(0); } while (0)
#define PG8_WAIT_V(n) asm volatile("s_waitcnt vmcnt(" #n ")" ::: "memory")
#define PG8_WAIT_L(n) asm volatile("s_waitcnt lgkmcnt(" #n ")" ::: "memory")
#define PG8_BAR __builtin_amdgcn_s_barrier()
#define PG8_SCHED __builtin_amdgcn_sched_barrier(0)
    Unit cur, nxt; int ui = 0;
    if (!S.next(0, cur)) return;
    f32x4 acc[2][2][4][2];
#pragma unroll
    for (int a = 0; a < 2; ++a)
#pragma unroll
        for (int b = 0; b < 2; ++b)
#pragma unroll
            for (int m = 0; m < 4; ++m)
#pragma unroll
                for (int n = 0; n < 2; ++n) acc[a][b][m][n] = (f32x4){0.f, 0.f, 0.f, 0.f};
    bf16x8 At[4][2], B0[2][2], B1[2][2];
    const char* cA = (const char*)g.A + (size_t)cur.pm * tstepA; const char* cB = (const char*)g.Bt + (size_t)cur.pn * tstepB;
    S.a_ready(cur);
    if constexpr (SP2) {
        PG8_STAGE(PG8_SB(0, 0), cB, voffB); PG8_STAGE(PG8_SB(0, 1), cB + hstepB, voffB); PG8_STAGE(PG8_SA(0, 0), cA, voffA); PG8_STAGE(PG8_SA(0, 1), cA + hstepA, voffA);
        if (wr == 1) PG8_BAR;
        PG8_WAIT_V(2); PG8_BAR;
        PG8_STAGE(PG8_SB(1, 0), cB + kstep, voffB); PG8_STAGE(PG8_SA(1, 0), cA + kstep, voffA); PG8_STAGE(PG8_SB(1, 1), cB + hstepB + kstep, voffB);
        PG8_WAIT_V(6); PG8_BAR;
    } else {
        PG8_STAGE(PG8_SB(0, 0), cB, voffB); PG8_STAGE(PG8_SA(0, 0), cA, voffA); PG8_STAGE(PG8_SB(0, 1), cB + hstepB, voffB); PG8_STAGE(PG8_SA(0, 1), cA + hstepA, voffA);
        if (wr == 1) PG8_BAR;
        PG8_WAIT_V(4); PG8_BAR;
        PG8_STAGE(PG8_SB(1, 0), cB + kstep, voffB); PG8_STAGE(PG8_SA(1, 0), cA + kstep, voffA); PG8_STAGE(PG8_SB(1, 1), cB + hstepB + kstep, voffB);
        PG8_WAIT_V(6); PG8_BAR;
    }
    for (;;) {
        const bool has_next = S.next(ui + 1, nxt);
        const char* nA = has_next ? (const char*)g.A + (size_t)nxt.pm * tstepA : cA; const char* nB = has_next ? (const char*)g.Bt + (size_t)nxt.pn * tstepB : cB;
        for (int t = 0; t < nt; t += 2) {
            const bool last = (t == nt - 2);
            const char* a1 = cA + (size_t)(t + 1) * kstep;
            const char* a2 = last ? nA : cA + (size_t)(t + 2) * kstep; const char* b2 = last ? nB : cB + (size_t)(t + 2) * kstep;
            const char* a3 = a2 + kstep; const char* b3 = b2 + kstep;
            if (last && has_next) S.a_ready(nxt);
            if constexpr (SP2) {
            PG8_LDB(B0, 0, 0); PG8_LDB(B1, 0, 1); PG8_SCHED; PG8_LDA(At, 0, 0); PG8_STAGE(PG8_SA(1, 1), a1 + hstepA, voffA);
            PG8_WAIT_V(8); PG8_WAIT_L(0); PG8_BAR; PG8_MMA(0, 0, At, B0); PG8_MMA(0, 1, At, B1); PG8_BAR; PG8_SCHED;
            PG8_LDA(At, 0, 1); PG8_STAGE(PG8_SB(0, 0), b2, voffB); PG8_STAGE(PG8_SB(0, 1), b2 + hstepB, voffB); PG8_STAGE(PG8_SA(0, 0), a2, voffA);
            PG8_WAIT_V(8); PG8_WAIT_L(0); PG8_BAR; PG8_MMA(1, 0, At, B0); PG8_MMA(1, 1, At, B1); PG8_BAR; PG8_SCHED;
            PG8_LDB(B0, 1, 0); PG8_LDB(B1, 1, 1); PG8_SCHED; PG8_LDA(At, 1, 0); PG8_STAGE(PG8_SA(0, 1), a2 + hstepA, voffA);
            PG8_WAIT_V(8); PG8_WAIT_L(0); PG8_BAR; PG8_MMA(0, 0, At, B0); PG8_MMA(0, 1, At, B1); PG8_BAR; PG8_SCHED;
            PG8_LDA(At, 1, 1); PG8_STAGE(PG8_SB(1, 0), b3, voffB); PG8_STAGE(PG8_SB(1, 1), b3 + hstepB, voffB); PG8_STAGE(PG8_SA(1, 0), a3, voffA);
            PG8_WAIT_V(8); PG8_WAIT_L(0); PG8_BAR; PG8_MMA(1, 0, At, B0); PG8_MMA(1, 1, At, B1); PG8_BAR; PG8_SCHED;
            } else {
            PG8_LDB(B0, 0, 0); PG8_SCHED; PG8_LDA(At, 0, 0); PG8_STAGE(PG8_SA(1, 1), a1 + hstepA, voffA);
            PG8_WAIT_L(8); PG8_BAR; PG8_WAIT_L(0); PG8_MMA(0, 0, At, B0); PG8_BAR; PG8_SCHED;
            PG8_LDB(B1, 0, 1); PG8_STAGE(PG8_SB(0, 0), b2, voffB);
            PG8_BAR; PG8_WAIT_L(0); PG8_MMA(0, 1, At, B1); PG8_BAR;
            PG8_LDA(At, 0, 1); PG8_STAGE(PG8_SA(0, 0), a2, voffA);
            PG8_BAR; PG8_WAIT_L(0); PG8_MMA(1, 0, At, B0); PG8_BAR; PG8_SCHED;
            PG8_STAGE(PG8_SB(0, 1), b2 + hstepB, voffB);
            PG8_WAIT_V(6); PG8_BAR; PG8_MMA(1, 1, At, B1); PG8_BAR;
            PG8_LDB(B0, 1, 0); PG8_SCHED; PG8_LDA(At, 1, 0); PG8_STAGE(PG8_SA(0, 1), a2 + hstepA, voffA);
            PG8_WAIT_L(8); PG8_BAR; PG8_WAIT_L(0); PG8_MMA(0, 0, At, B0); PG8_BAR; PG8_SCHED;
            PG8_LDB(B1, 1, 1); PG8_STAGE(PG8_SB(1, 0), b3, voffB);
            PG8_BAR; PG8_WAIT_L(0); PG8_MMA(0, 1, At, B1); PG8_BAR;
            PG8_LDA(At, 1, 1); PG8_STAGE(PG8_SA(1, 0), a3, voffA);
            PG8_BAR; PG8_WAIT_L(0); PG8_MMA(1, 0, At, B0); PG8_BAR; PG8_SCHED;
            PG8_STAGE(PG8_SB(1, 1), b3 + hstepB, voffB);
            PG8_WAIT_V(6); PG8_BAR; PG8_MMA(1, 1, At, B1); PG8_BAR;
            }
        }
        if constexpr (ALIGN_EPI) { if (wr == 0) PG8_BAR; }
        if constexpr (!Epi::AFTER_DRAIN) { E(acc, cur, wr, wc, fr, fq); S.done(cur); }
        if (!has_next) break;
#pragma unroll
        for (int a = 0; a < 2; ++a)
#pragma unroll
            for (int b = 0; b < 2; ++b)
#pragma unroll
                for (int m = 0; m < 4; ++m)
#pragma unroll
                    for (int n = 0; n < 2; ++n) acc[a][b][m][n] = (f32x4){0.f, 0.f, 0.f, 0.f};
        cur = nxt; cA = nA; cB = nB; ++ui;
        if constexpr (ALIGN_EPI) { if (wr == 1) PG8_BAR; }
    }
    PG8_WAIT_V(0);
    if constexpr (!ALIGN_EPI) { if (wr == 0) PG8_BAR; }
    PG8_BAR;
#undef PG8_SA
#undef PG8_SB
#undef PG8_STAGE
#undef PG8_LDA
#undef PG8_LDB
#undef PG8_MMA
#undef PG8_WAIT_V
#undef PG8_WAIT_L
#undef PG8_BAR
#undef PG8_SCHED
}
}
namespace mk {
using pg8::bf16_t; using pg8::bf16x8; using pg8::f32x4; using pg8::f32x2; using pg8::u32x4; using pg8::u32x2; using pg8::f2bf; using pg8::pk2; using pg8::bf_lo; using pg8::bf_hi;
#define LAS __attribute__((address_space(3)))
typedef float f32x16 __attribute__((ext_vector_type(16)));
constexpr int NWAVES = 8, NTHR = 512;
constexpr int D = 1024, FF = 2816, DIN = 7184, MP = 16384, MS = 128, MT = 16512, MPAD = 16640, TSEQ = 2048, NB = 8;
constexpr int PLD = 7424;
constexpr int PC_XR = 0, PC_YR = 1024, PC_OG = 2048, PC_Q = 3072, PC_K = 3584, PC_V = 4096, PC_GA = 5120, PC_GB = 6144, PC_LR = 7168;
constexpr int SC_XA = 0, SC_H = 1024, SC_T = 3072, SC_F = 5120;
constexpr float EPS = 1e-6f;
constexpr size_t O_YP = 0, O_YS = 16777216, O_HP = 16908288, O_CP = 16916480, O_SP = 16941056, O_HS = 17989632, O_CS = 18120704, O_SS = 18513920;
constexpr size_t MiB = 1u << 20;
constexpr size_t WS_CTL = 0, CTL_ZERO_BYTES = 64 * 1024;
constexpr size_t WS_P = 1 * MiB;
constexpr size_t WS_TAIL = 237 * MiB;
constexpr size_t WS_WRG = WS_TAIL, WS_WBR = WS_TAIL + MiB / 2, WS_WBG = WS_WBR + 2 * MiB, WS_WOUT = WS_WBG + 2 * MiB;
constexpr size_t WS_WGU2 = WS_TAIL, WS_WD2 = WS_TAIL + 11 * MiB;
static_assert(WS_P + (size_t)MPAD * PLD * 2 <= WS_TAIL && WS_WOUT + 2 * MiB <= 256 * MiB && WS_WD2 + (size_t)D * FF * 2 <= 256 * MiB, "d_ws map");
constexpr size_t SS_U = 0, SS_WIN = (size_t)MPAD * D * 2, SS_WGU1 = SS_WIN + (size_t)PLD * D * 2, SS_WD1 = SS_WGU1 + (size_t)2 * FF * D * 2;
static_assert(SS_WD1 + (size_t)D * FF * 2 <= 64 * MiB, "ss-region map");
constexpr int CW_BAR = 4096;
constexpr int LDS_BYTES = 163840, MISC_OFF = LDS_BYTES - 512;

#define RLX_AGENT __ATOMIC_RELAXED, __HIP_MEMORY_SCOPE_AGENT
#define LDS_WAIT() asm volatile("s_waitcnt lgkmcnt(0)" ::: "memory")
#define VM_WAIT() asm volatile("s_waitcnt vmcnt(0)" ::: "memory")

#define XB_TMO      128
#define XB_XCNT(j)  (256  + 64 * (j))
#define XB_XSUB(j)  (1280 + 64 * (j))
#define XB_XGEN(j)  (2304 + 64 * (j))
#define XB_TOP      3328
#define XB_TOPGEN   3392
#define XCD_BAR_WORDS 3456
#define XB_SPIN_CAP (1u << 18)
__device__ __forceinline__ unsigned xb_ld(unsigned* p)              { return __hip_atomic_load(p, __ATOMIC_RELAXED, __HIP_MEMORY_SCOPE_AGENT); }
__device__ __forceinline__ unsigned xb_add(unsigned* p, unsigned v) { return __hip_atomic_fetch_add(p, v, __ATOMIC_RELAXED, __HIP_MEMORY_SCOPE_AGENT); }
__device__ __forceinline__ unsigned xb_xcc_id() { return (unsigned)__builtin_amdgcn_s_getreg((3 << 11) | 20) & 0xFu; }
#define XB_SPIN(cond, bar) do { unsigned _sp = 0; while (cond) { __builtin_amdgcn_s_sleep(1); \
    if ((++_sp & 255u) == 0u) { if (xb_ld(&(bar)[XB_TMO])) break; if (_sp > XB_SPIN_CAP) { atomicAdd(&(bar)[XB_TMO], 1u); break; } } } } while (0)
struct XcdBarrier { unsigned* bar; unsigned x; volatile LAS unsigned* st; };
__device__ __forceinline__ XcdBarrier xcd_barrier_post(unsigned* bar, volatile LAS unsigned* st) {
    XcdBarrier b; b.bar = bar; b.x = xb_xcc_id(); b.st = st;
    if (threadIdx.x == 0) (void)xb_add(&bar[XB_XCNT(b.x)], 1u);
    return b;
}
__device__ __forceinline__ void xcd_barrier_complete(unsigned* bar, unsigned x, unsigned& nloc, unsigned& nx) {
    const unsigned G = gridDim.x * gridDim.y * gridDim.z;
    unsigned sum, cnt, mine, sp = 0u;
    for (;;) {
        sum = 0u; cnt = 0u; mine = 0u;
#pragma unroll
        for (unsigned j = 0; j < 16; ++j) { const unsigned c = xb_ld(&bar[XB_XCNT(j)]); sum += c; cnt += (c > 0u) ? 1u : 0u; mine = (j == x) ? c : mine; }
        if (sum == G) break;
        __builtin_amdgcn_s_sleep(1);
        if ((++sp & 255u) == 0u) { if (xb_ld(&bar[XB_TMO])) break; if (sp > XB_SPIN_CAP) { atomicAdd(&bar[XB_TMO], 1u); break; } }
    }
    nloc = mine > 0u ? mine : 1u; nx = cnt > 0u ? cnt : 1u;
}
__device__ __forceinline__ void xcd_barrier(const XcdBarrier& b) {
    asm volatile("s_waitcnt vmcnt(0)" ::: "memory");
    __syncthreads();
    if (threadIdx.x == 0) {
        unsigned* bar = b.bar;
        __builtin_amdgcn_s_waitcnt(0);
        unsigned nloc = b.st[0], nx = b.st[1];
        if (nloc == 0u) { xcd_barrier_complete(bar, b.x, nloc, nx); b.st[0] = nloc; b.st[1] = nx; }
        const unsigned old = xb_add(&bar[XB_XSUB(b.x)], 1u);
        const unsigned gen = old / nloc;
        if (old + 1u == (gen + 1u) * nloc) {
            __builtin_amdgcn_fence(__ATOMIC_RELEASE, "agent");
            asm volatile("s_waitcnt vmcnt(0)" ::: "memory");
            const unsigned og = xb_add(&bar[XB_TOP], 1u);
            const unsigned tg = og / nx;
            if (og + 1u == (tg + 1u) * nx) xb_add(&bar[XB_TOPGEN], 1u);
            else XB_SPIN(xb_ld(&bar[XB_TOPGEN]) == tg, bar);
            __builtin_amdgcn_fence(__ATOMIC_ACQUIRE, "agent");
            xb_add(&bar[XB_XGEN(b.x)], 1u);
            asm volatile("s_waitcnt vmcnt(0)" ::: "memory");
        } else {
            XB_SPIN(xb_ld(&bar[XB_XGEN(b.x)]) == gen, bar);
            __builtin_amdgcn_fence(__ATOMIC_ACQUIRE, "agent");
            asm volatile("s_waitcnt vmcnt(0)" ::: "memory");
        }
    }
    __syncthreads();
}

struct Args { const float* in[24]; float* out; unsigned char* ws; int ph_lo, ph_hi; };
struct Frame {
    LAS unsigned char* lds; int tid, lane, wave, vcu, G;
    const float* in[24]; float* out; unsigned char* ws;
    bf16_t* P; bf16_t* U; bf16_t* Win_t; bf16_t* Wgu1_t; bf16_t* Wd1_t; bf16_t* Wrg_t; bf16_t* Wbr_t; bf16_t* Wbg_t; bf16_t* Wout_t; bf16_t* Wgu2_t; bf16_t* Wd2_t;
};
enum { I_XP = 0, I_XS, I_SRH, I_SRC, I_SGLA, I_NG, I_F1GU, I_F1D, I_WIN, I_CW, I_CB, I_RWA, I_RBA, I_RWX, I_RBX, I_LAM, I_WLR, I_BLR, I_GNG, I_WBR, I_WBG, I_WOUT, I_F2GU, I_F2D };

__device__ __forceinline__ float wave_sum(float v) {
#pragma unroll
    for (int o = 1; o < 64; o <<= 1) v += __shfl_xor(v, o);
    return v;
}
__device__ __forceinline__ const float* xrow_ptr(const Frame& F, int row) { return row < MP ? F.in[I_XP] + (size_t)row * D : F.in[I_XS] + (size_t)(row - MP) * D; }
__device__ __forceinline__ void load_row16(const float* p, int lane, f32x4 (&v)[4]) {
#pragma unroll
    for (int j = 0; j < 4; ++j) v[j] = *(const f32x4*)(p + 4 * lane + 256 * j);
}
__device__ __forceinline__ float sumsq16(const f32x4 (&v)[4]) { float s = 0.f;
#pragma unroll
    for (int j = 0; j < 4; ++j) s += (v[j].x * v[j].x + v[j].y * v[j].y) + (v[j].z * v[j].z + v[j].w * v[j].w);
    return s; }
__device__ __forceinline__ void store_row16_bf16(bf16_t* p, int lane, const f32x4 (&v)[4]) {
#pragma unroll
    for (int j = 0; j < 4; ++j) { u32x2 w; w.x = pk2(v[j].x, v[j].y); w.y = pk2(v[j].z, v[j].w); *(u32x2*)(p + 4 * lane + 256 * j) = w; }
}
__device__ __forceinline__ void rowphase0(const Frame& F) {
    const int gw = F.vcu * NWAVES + F.wave, NGW = F.G * NWAVES; const float* g0 = F.in[I_NG];
    f32x4 g[4]; load_row16(g0, F.lane, g);
    for (int row = gw; row < MT; row += NGW) {
        f32x4 v[4]; load_row16(xrow_ptr(F, row), F.lane, v);
        const float rs = rsqrtf(wave_sum(sumsq16(v)) * (1.f / D) + EPS);
#pragma unroll
        for (int j = 0; j < 4; ++j) v[j] = v[j] * rs * g[j];
        store_row16_bf16(F.P + (size_t)row * PLD + SC_XA, F.lane, v);
    }
}
__device__ __forceinline__ void rowphase1(const Frame& F) {
    const int gw = F.vcu * NWAVES + F.wave, NGW = F.G * NWAVES; const float* ng = F.in[I_NG];
    f32x4 g1[4], g2[4]; load_row16(ng + 1 * D, F.lane, g1); load_row16(ng + 2 * D, F.lane, g2);
    for (int row = gw; row < MT; row += NGW) {
        f32x4 f[4], x[4]; load_row16((const float*)(F.P + (size_t)row * PLD + SC_F), F.lane, f); load_row16(xrow_ptr(F, row), F.lane, x);
        const float rs = rsqrtf(wave_sum(sumsq16(f)) * (1.f / D) + EPS);
#pragma unroll
        for (int j = 0; j < 4; ++j) x[j] = x[j] + 0.5f * (f[j] * rs * g1[j]);
        float* o = F.out + (size_t)row * D;
#pragma unroll
        for (int j = 0; j < 4; ++j) *(f32x4*)(o + 4 * F.lane + 256 * j) = x[j];
        const float rs2 = rsqrtf(wave_sum(sumsq16(x)) * (1.f / D) + EPS);
#pragma unroll
        for (int j = 0; j < 4; ++j) x[j] = x[j] * rs2 * g2[j];
        store_row16_bf16(F.U + (size_t)row * D, F.lane, x);
    }
}
__device__ __forceinline__ void rowphase2(const Frame& F) {
    const int gw = F.vcu * NWAVES + F.wave, NGW = F.G * NWAVES; const float* ng = F.in[I_NG];
    f32x4 g3[4], g4[4]; load_row16(ng + 3 * D, F.lane, g3); load_row16(ng + 4 * D, F.lane, g4);
    for (int row = gw; row < MT; row += NGW) {
        f32x4 f[4], x[4]; load_row16((const float*)(F.P + (size_t)row * PLD + SC_T), F.lane, f); float* o = F.out + (size_t)row * D; load_row16(o, F.lane, x);
        const float rs = rsqrtf(wave_sum(sumsq16(f)) * (1.f / D) + EPS);
#pragma unroll
        for (int j = 0; j < 4; ++j) x[j] = x[j] + f[j] * rs * g3[j];
#pragma unroll
        for (int j = 0; j < 4; ++j) *(f32x4*)(o + 4 * F.lane + 256 * j) = x[j];
        const float rs2 = rsqrtf(wave_sum(sumsq16(x)) * (1.f / D) + EPS);
#pragma unroll
        for (int j = 0; j < 4; ++j) x[j] = x[j] * rs2 * g4[j];
        store_row16_bf16(F.P + (size_t)row * PLD + SC_XA, F.lane, x);
    }
}
__device__ __forceinline__ void rowphase3(const Frame& F) {
    const int gw = F.vcu * NWAVES + F.wave, NGW = F.G * NWAVES; const float* ng = F.in[I_NG];
    f32x4 g5[4]; load_row16(ng + 5 * D, F.lane, g5);
    for (int row = gw; row < MT; row += NGW) {
        f32x4 f[4], x[4]; load_row16((const float*)(F.P + (size_t)row * PLD + SC_F), F.lane, f); float* o = F.out + (size_t)row * D; load_row16(o, F.lane, x);
        const float rs = rsqrtf(wave_sum(sumsq16(f)) * (1.f / D) + EPS);
#pragma unroll
        for (int j = 0; j < 4; ++j) *(f32x4*)(o + 4 * F.lane + 256 * j) = x[j] + 0.5f * (f[j] * rs * g5[j]);
    }
}

__device__ __forceinline__ void tr_item(const float* W, int ldw, int K, int k0, int scol0, int nvalid, bf16_t* WT, int drow0, LAS float* scr, int lane) {
    const bool ok = (lane & 31) < nvalid;
#pragma unroll 8
    for (int i = 0; i < 32; ++i) { const int kk = 2 * i + (lane >> 5); scr[kk * 33 + (lane & 31)] = ok ? W[(size_t)(k0 + kk) * ldw + scol0 + (lane & 31)] : 0.f; }
    LDS_WAIT(); asm volatile("" ::: "memory");
    const int c = lane & 7;
#pragma unroll
    for (int j = 0; j < 4; ++j) { const int n = (lane >> 3) + 8 * j; const LAS float* s = scr + (8 * c) * 33 + n;
        u32x4 o; o.x = pk2(s[0 * 33], s[1 * 33]); o.y = pk2(s[2 * 33], s[3 * 33]); o.z = pk2(s[4 * 33], s[5 * 33]); o.w = pk2(s[6 * 33], s[7 * 33]);
        *(u32x4*)(WT + (size_t)(drow0 + n) * K + k0 + 8 * c) = o; }
    LDS_WAIT(); asm volatile("" ::: "memory");
}
__device__ __forceinline__ void prep_wgu(const Frame& F, const float* W, bf16_t* WT, LAS float* scr, int gw, int NGW) {
    constexpr int KB = D / 64, RB = 2 * FF / 32;
    for (int it = gw; it < KB * RB; it += NGW) { const int kb = it / RB, rb = it % RB, n0 = 32 * rb, pn = n0 >> 8, bj = (n0 >> 7) & 1, j = n0 & 127;
        tr_item(W, 2 * FF, D, 64 * kb, bj * FF + 128 * pn + j, 32, WT, n0, scr, F.lane); }
}
__device__ __forceinline__ void prep_plain(const Frame& F, const float* W, int K, int N, bf16_t* WT, LAS float* scr, int gw, int NGW) {
    const int KB = K / 64, RB = N / 32;
    for (int it = gw; it < KB * RB; it += NGW) { const int kb = it / RB, rb = it % RB; tr_item(W, N, K, 64 * kb, 32 * rb, 32, WT, 32 * rb, scr, F.lane); }
}
__device__ __forceinline__ void prep_win(const Frame& F, LAS float* scr, int gw, int NGW) {
    constexpr int KB = D / 64, RB = PLD / 32;
    for (int it = gw; it < KB * RB; it += NGW) { const int kb = it / RB, rb = it % RB, n0 = 32 * rb; int sc, nv = 32;
        if (n0 < 2048) sc = n0;
        else if (n0 < 3072) sc = 4096 + (n0 - 2048);
        else if (n0 < 3584) sc = 2048 + (n0 - 3072);
        else if (n0 < 4096) sc = 2560 + (n0 - 3584);
        else if (n0 < 5120) sc = 3072 + (n0 - 4096);
        else if (n0 < 6144) sc = 5136 + (n0 - 5120);
        else if (n0 < 7168) sc = 6160 + (n0 - 6144);
        else if (n0 == 7168) { sc = 5120; nv = 16; }
        else { sc = 0; nv = 0; }
        tr_item(F.in[I_WIN], DIN, D, 64 * kb, sc, nv, F.Win_t, n0, scr, F.lane); }
}
__device__ __forceinline__ void prep_rg(const Frame& F, LAS float* scr, int gw, int NGW) {
    for (int it = gw; it < 2 * 8 * 8; it += NGW) { const int gate = it >> 6, n = (it >> 3) & 7, sub = it & 7, kb = sub >> 2, rb = sub & 3;
        tr_item(F.in[gate ? I_RWX : I_RWA] + (size_t)n * 16384, 128, 128, 64 * kb, 32 * rb, 32, F.Wrg_t + (size_t)(gate * 8 + n) * 16384, 32 * rb, scr, F.lane); }
}
}
namespace mk {
#define MFMA16(a, b, c) __builtin_amdgcn_mfma_f32_16x16x32_bf16((a), (b), (c), 0, 0, 0)
#define MFMA32(a, b, c) __builtin_amdgcn_mfma_f32_32x32x16_bf16((a), (b), (c), 0, 0, 0)
__device__ __forceinline__ float bf2f(bf16_t h) { return __builtin_bit_cast(float, (unsigned)h << 16); }
__device__ __forceinline__ float sigm(float x) { return 1.f / (1.f + __expf(-x)); }
__device__ __forceinline__ float softplus_(float x) { return fmaxf(x, 0.f) + log1pf(__expf(-fabsf(x))); }
__device__ __forceinline__ float gelu_tanh_(float x) { return x * sigm(1.5957691216057308f * (x + 0.044715f * x * x * x)); }
__device__ __forceinline__ float silu_(float x) { return x * sigm(x); }
__device__ __forceinline__ void unpack8(const u32x4 w, float (&f)[8]) { f[0] = bf_lo(w.x); f[1] = bf_hi(w.x); f[2] = bf_lo(w.y); f[3] = bf_hi(w.y); f[4] = bf_lo(w.z); f[5] = bf_hi(w.z); f[6] = bf_lo(w.w); f[7] = bf_hi(w.w); }
__device__ __forceinline__ u32x4 pack8(const float (&f)[8]) { u32x4 w; w.x = pk2(f[0], f[1]); w.y = pk2(f[2], f[3]); w.z = pk2(f[4], f[5]); w.w = pk2(f[6], f[7]); return w; }

template <bool SAMPLE>
__device__ __forceinline__ void rnn_item(const Frame& F, int item) {
    constexpr int XRAW_OFF = 0, XRAW_LD = 136, XCF_OFF = 18432, XCF_LD = 132, XCB_OFF = 52224, XCB_LD = 136, HB_OFF = 69632, CW_OFF = 103424;
    const int tid = F.tid, lane = F.lane, wid = F.wave;
    const int n = SAMPLE ? item : (item & 7), b = SAMPLE ? 0 : (item >> 3), ch0 = 128 * n;
    LAS bf16_t* XRAW = (LAS bf16_t*)(F.lds + XRAW_OFF); LAS float* XCF = (LAS float*)(F.lds + XCF_OFF); LAS bf16_t* XCB = (LAS bf16_t*)(F.lds + XCB_OFF);
    LAS float* HB = (LAS float*)(F.lds + HB_OFF); LAS float* CW = (LAS float*)(F.lds + CW_OFF);
    for (int i = tid; i < 5 * 128; i += NTHR) { const int j = i >> 7, c = i & 127; CW[i] = j < 4 ? F.in[I_CW][j * D + ch0 + c] : F.in[I_CB][ch0 + c]; }
    const int q = lane >> 4, cl = 16 * wid + (lane & 15);
    const float ba = F.in[I_RBA][ch0 + cl], bx = F.in[I_RBX][ch0 + cl], sp8 = 8.0f * softplus_(-F.in[I_LAM][ch0 + cl]);
    bf16x8 Bw[2][4];
#pragma unroll
    for (int g = 0; g < 2; ++g)
#pragma unroll
        for (int ks = 0; ks < 4; ++ks) Bw[g][ks] = *(const bf16x8*)(F.Wrg_t + ((size_t)(g * 8 + n) * 128 + cl) * 128 + 32 * ks + 8 * q);
    const int t5 = tid >> 3, c5 = 16 * (tid & 7);
    float carry = 0.f;
    const int ntiles = SAMPLE ? 2 : 32;
    __syncthreads();
    for (int tt = 0; tt < ntiles; ++tt) {
        const int t0 = 64 * tt;
        const size_t row5 = SAMPLE ? (size_t)(MP + t0 + t5) : (size_t)b * TSEQ + t0 + t5;
        bf16_t* yrp = F.P + row5 * PLD + PC_YR + ch0 + c5;
        const u32x4 y0 = *(const u32x4*)yrp, y1 = *(const u32x4*)(yrp + 8);
        if constexpr (!SAMPLE) {
            for (int e = tid; e < 67 * 16; e += NTHR) { const int i = e >> 4, chk = e & 15, t = t0 - 3 + i; u32x4 v = (u32x4){0u, 0u, 0u, 0u};
                if (t >= 0) v = *(const u32x4*)(F.P + ((size_t)b * TSEQ + t) * PLD + PC_XR + ch0 + 8 * chk);
                *(LAS u32x4*)(XRAW + i * XRAW_LD + 8 * chk) = v; }
            __syncthreads();
            const int c0 = 8 * (tid & 15);
            float w[4][8], cb8[8];
#pragma unroll
            for (int e = 0; e < 8; ++e) { cb8[e] = CW[4 * 128 + c0 + e];
#pragma unroll
                for (int j = 0; j < 4; ++j) w[j][e] = CW[j * 128 + c0 + e]; }
#pragma unroll
            for (int rr = 0; rr < 2; ++rr) { const int t = (tid >> 4) + 32 * rr; float xc[8];
#pragma unroll
                for (int e = 0; e < 8; ++e) xc[e] = cb8[e];
#pragma unroll
                for (int j = 0; j < 4; ++j) { float x[8]; unpack8(*(const LAS u32x4*)(XRAW + (t + j) * XRAW_LD + c0), x);
#pragma unroll
                    for (int e = 0; e < 8; ++e) xc[e] = fmaf(w[j][e], x[e], xc[e]); }
                *(LAS f32x4*)(XCF + t * XCF_LD + c0) = (f32x4){xc[0], xc[1], xc[2], xc[3]}; *(LAS f32x4*)(XCF + t * XCF_LD + c0 + 4) = (f32x4){xc[4], xc[5], xc[6], xc[7]};
                *(LAS u32x4*)(XCB + t * XCB_LD + c0) = pack8(xc); }
        } else {
            const int s = t0 + t5; const bf16_t* xrp = F.P + (size_t)(MP + s) * PLD + PC_XR + ch0 + c5;
            float xr[16]; { float a8[8], b8[8]; unpack8(*(const u32x4*)xrp, a8); unpack8(*(const u32x4*)(xrp + 8), b8);
#pragma unroll
                for (int e = 0; e < 8; ++e) { xr[e] = a8[e]; xr[8 + e] = b8[e]; } }
            const float* bufp = F.in[I_SRC] + (size_t)s * 3 * D + ch0 + c5; float* csp = F.out + O_CS + (size_t)s * 3 * D + ch0 + c5;
            float xc[16];
#pragma unroll
            for (int e = 0; e < 16; ++e) xc[e] = CW[4 * 128 + c5 + e] + CW[3 * 128 + c5 + e] * xr[e];
#pragma unroll
            for (int j = 0; j < 3; ++j)
#pragma unroll
                for (int v4 = 0; v4 < 4; ++v4) { const f32x4 bv = *(const f32x4*)(bufp + j * D + 4 * v4);
#pragma unroll
                    for (int e = 0; e < 4; ++e) xc[4 * v4 + e] = fmaf(CW[j * 128 + c5 + 4 * v4 + e], bv[e], xc[4 * v4 + e]);
                    if (j >= 1) *(f32x4*)(csp + (j - 1) * D + 4 * v4) = bv; }
#pragma unroll
            for (int v4 = 0; v4 < 4; ++v4) { *(f32x4*)(csp + 2 * D + 4 * v4) = (f32x4){xr[4 * v4], xr[4 * v4 + 1], xr[4 * v4 + 2], xr[4 * v4 + 3]};
                *(LAS f32x4*)(XCF + t5 * XCF_LD + c5 + 4 * v4) = (f32x4){xc[4 * v4], xc[4 * v4 + 1], xc[4 * v4 + 2], xc[4 * v4 + 3]}; }
            { float h8[8];
#pragma unroll
              for (int hf = 0; hf < 2; ++hf) {
#pragma unroll
                for (int e = 0; e < 8; ++e) h8[e] = xc[8 * hf + e];
                *(LAS u32x4*)(XCB + t5 * XCB_LD + c5 + 8 * hf) = pack8(h8); } }
        }
        __syncthreads();
        f32x4 acc[4][2];
#pragma unroll
        for (int m = 0; m < 4; ++m) { acc[m][0] = (f32x4){0.f, 0.f, 0.f, 0.f}; acc[m][1] = (f32x4){0.f, 0.f, 0.f, 0.f}; }
#pragma unroll
        for (int m = 0; m < 4; ++m)
#pragma unroll
            for (int ks = 0; ks < 4; ++ks) { const bf16x8 a = *(const LAS bf16x8*)(XCB + (16 * m + (lane & 15)) * XCB_LD + 32 * ks + 8 * q);
                acc[m][0] = MFMA16(a, Bw[0][ks], acc[m][0]); acc[m][1] = MFMA16(a, Bw[1][ks], acc[m][1]); }
#pragma unroll
        for (int m = 0; m < 4; ++m) {
            float av[4], bv[4];
#pragma unroll
            for (int reg = 0; reg < 4; ++reg) { const int t = 16 * m + 4 * q + reg; const float xcv = XCF[t * XCF_LD + cl];
                const float r = sigm(acc[m][0][reg] + ba), ig = sigm(acc[m][1][reg] + bx), log_a = -sp8 * r;
                float mult = sqrtf(fmaxf(-expm1f(2.0f * log_a), 0.f)); if (!SAMPLE && (t0 + t) == 0) mult = 1.0f;
                av[reg] = __expf(log_a); bv[reg] = mult * ig * xcv; }
            if constexpr (!SAMPLE) {
                float Al = 1.f, Hl = 0.f;
#pragma unroll
                for (int reg = 0; reg < 4; ++reg) { Hl = fmaf(av[reg], Hl, bv[reg]); Al *= av[reg]; }
                float hin = carry, cn = carry;
#pragma unroll
                for (int qq = 0; qq < 4; ++qq) { const float Ag = __shfl(Al, (lane & 15) + 16 * qq), Hg = __shfl(Hl, (lane & 15) + 16 * qq);
                    cn = fmaf(Ag, cn, Hg); hin = (qq < q) ? cn : hin; }
                carry = cn; float hv = hin;
#pragma unroll
                for (int reg = 0; reg < 4; ++reg) { hv = fmaf(av[reg], hv, bv[reg]); HB[(16 * m + 4 * q + reg) * XCF_LD + cl] = hv; }
            } else {
#pragma unroll
                for (int reg = 0; reg < 4; ++reg) { const int t = 16 * m + 4 * q + reg; const float h0 = F.in[I_SRH][(size_t)(t0 + t) * D + ch0 + cl];
                    HB[t * XCF_LD + cl] = fmaf(av[reg], h0, bv[reg]); }
            }
        }
        __syncthreads();
        { float h[16], yv[16], o8[8];
#pragma unroll
          for (int v4 = 0; v4 < 4; ++v4) { const f32x4 hv = *(const LAS f32x4*)(HB + t5 * XCF_LD + c5 + 4 * v4); h[4 * v4] = hv[0]; h[4 * v4 + 1] = hv[1]; h[4 * v4 + 2] = hv[2]; h[4 * v4 + 3] = hv[3]; }
          { float a8[8], b8[8]; unpack8(y0, a8); unpack8(y1, b8);
#pragma unroll
            for (int e = 0; e < 8; ++e) { yv[e] = a8[e]; yv[8 + e] = b8[e]; } }
          if constexpr (SAMPLE) { float* hsp = F.out + O_HS + (size_t)(t0 + t5) * D + ch0 + c5;
#pragma unroll
              for (int v4 = 0; v4 < 4; ++v4) *(f32x4*)(hsp + 4 * v4) = (f32x4){h[4 * v4], h[4 * v4 + 1], h[4 * v4 + 2], h[4 * v4 + 3]}; }
#pragma unroll
          for (int hf = 0; hf < 2; ++hf) {
#pragma unroll
              for (int e = 0; e < 8; ++e) o8[e] = h[8 * hf + e] * gelu_tanh_(yv[8 * hf + e]);
              *(u32x4*)(yrp + 8 * hf) = pack8(o8); }
          if constexpr (!SAMPLE) { if (tt == 31 && t5 >= 61) { float* cpp = F.out + O_CP + ((size_t)b * 3 + (t5 - 61)) * D + ch0 + c5;
#pragma unroll
              for (int e = 0; e < 16; ++e) cpp[e] = bf2f(XRAW[(t5 + 3) * XRAW_LD + c5 + e]); } }
        }
    }
    if constexpr (!SAMPLE) { if (q == 0) F.out[O_HP + (size_t)b * D + ch0 + cl] = carry; }
    __syncthreads();
}

__device__ __forceinline__ int crow(int reg, int h) { return (reg & 3) + 8 * (reg >> 2) + 4 * h; }
__device__ __forceinline__ bf16x8 pack_step(const f32x16& x, int s) {
    u32x4 p; p.x = pk2(x[8 * s], x[8 * s + 1]); p.y = pk2(x[8 * s + 2], x[8 * s + 3]); p.z = pk2(x[8 * s + 4], x[8 * s + 5]); p.w = pk2(x[8 * s + 6], x[8 * s + 7]);
    return __builtin_bit_cast(bf16x8, p);
}
__device__ __forceinline__ void gla_item(const Frame& F, int item) {
    constexpr int VRAW = 0, VRAW_LD = 264, LRS = 33792, QI = 37888, QK_LD = 136, KI = 55296, OBUF = 0, KET = 72704, T_LD = 72, VT = 91136, ATT = 128000, SEG = 137216, DEC = 139264;
    static_assert(DEC + 512 <= MISC_OFF, "GLA LDS map");
    const int tid = F.tid, lane = F.lane, w = F.wave;
    const int hh = item & 3, b = item >> 2; const size_t rowbase = (size_t)b * TSEQ;
    LAS bf16_t* sVRAW = (LAS bf16_t*)(F.lds + VRAW); LAS float* sLR = (LAS float*)(F.lds + LRS); LAS bf16_t* sQI = (LAS bf16_t*)(F.lds + QI); LAS bf16_t* sKI = (LAS bf16_t*)(F.lds + KI);
    LAS float* sO = (LAS float*)(F.lds + OBUF); LAS bf16_t* sKET = (LAS bf16_t*)(F.lds + KET); LAS bf16_t* sVT = (LAS bf16_t*)(F.lds + VT); LAS bf16_t* sATT = (LAS bf16_t*)(F.lds + ATT);
    LAS float* sSEG = (LAS float*)(F.lds + SEG); LAS float* sDEC = (LAS float*)(F.lds + DEC);
    const int kk = tid & 127, seg = tid >> 7;
    float wl[16];
#pragma unroll
    for (int r = 0; r < 16; ++r) wl[r] = F.in[I_WLR][r * 512 + hh * 128 + kk];
    const float bias = F.in[I_BLR][hh * 128 + kk];
    const int r32 = lane & 31, h = lane >> 5, q = lane >> 4;
    const f32x4 gn = *(const f32x4*)(F.in[I_GNG] + 4 * lane);
    f32x16 S[4];
#pragma unroll
    for (int kb = 0; kb < 4; ++kb)
#pragma unroll
        for (int i = 0; i < 16; ++i) S[kb][i] = 0.f;
    __syncthreads();
    for (int cn = 0; cn < 32; ++cn) {
        const size_t row0 = rowbase + 64 * cn;
#pragma unroll
        for (int i = 0; i < 4; ++i) { const int e = tid + NTHR * i, row = e >> 5, c16 = e & 31;
            *(LAS u32x4*)(sVRAW + row * VRAW_LD + 8 * c16) = *(const u32x4*)(F.P + (row0 + row) * PLD + PC_V + 256 * hh + 8 * c16); }
        if (tid < 128) { const int row = tid >> 1, hf = tid & 1; float f[8]; unpack8(*(const u32x4*)(F.P + (row0 + row) * PLD + PC_LR + 8 * hf), f);
            *(LAS f32x4*)(sLR + row * 16 + 8 * hf) = (f32x4){f[0], f[1], f[2], f[3]}; *(LAS f32x4*)(sLR + row * 16 + 8 * hf + 4) = (f32x4){f[4], f[5], f[6], f[7]}; }
        bf16_t qv[16], kv[16];
#pragma unroll
        for (int i = 0; i < 16; ++i) { const bf16_t* p = F.P + (row0 + 16 * seg + i) * PLD + 128 * hh + kk; qv[i] = p[PC_Q]; kv[i] = p[PC_K]; }
        u32x2 og[8];
#pragma unroll
        for (int j = 0; j < 8; ++j) og[j] = *(const u32x2*)(F.P + (row0 + 8 * w + j) * PLD + PC_OG + 256 * hh + 4 * lane);
        __syncthreads();
        float c[16]; float run = 0.f;
#pragma unroll
        for (int i = 0; i < 16; ++i) { const LAS float* lr = sLR + (16 * seg + i) * 16; float x = bias;
#pragma unroll
            for (int r4 = 0; r4 < 4; ++r4) { const f32x4 lv = *(const LAS f32x4*)(lr + 4 * r4); x = fmaf(lv[0], wl[4 * r4], x); x = fmaf(lv[1], wl[4 * r4 + 1], x); x = fmaf(lv[2], wl[4 * r4 + 2], x); x = fmaf(lv[3], wl[4 * r4 + 3], x); }
            run += -softplus_(-x) * (1.0f / 16.0f); c[i] = run; }
        sSEG[seg * 128 + kk] = run;
        { const int dv = tid & 255, hf = tid >> 8;
#pragma unroll
          for (int s8 = 0; s8 < 4; ++s8) { const int s = 32 * hf + 8 * s8; u32x4 wv; unsigned t[8];
#pragma unroll
              for (int j = 0; j < 8; ++j) t[j] = sVRAW[(s + j) * VRAW_LD + dv];
              wv.x = t[0] | (t[1] << 16); wv.y = t[2] | (t[3] << 16); wv.z = t[4] | (t[5] << 16); wv.w = t[6] | (t[7] << 16);
              *(LAS u32x4*)(sVT + dv * T_LD + s) = wv; } }
        __syncthreads();
        { float off = 0.f, tot = 0.f;
#pragma unroll
          for (int s2 = 0; s2 < 4; ++s2) { const float v = sSEG[s2 * 128 + kk]; tot += v; off += (s2 < seg) ? v : 0.f; }
          if (seg == 0) sDEC[kk] = __expf(tot);
          float ke[16];
#pragma unroll
          for (int i = 0; i < 16; ++i) { const int t = 16 * seg + i; const float bc = off + c[i]; const float qf = bf2f(qv[i]) * 0.08838834764831845f, kf = bf2f(kv[i]);
              sQI[t * QK_LD + kk] = (bf16_t)f2bf(qf * __expf(bc)); sKI[t * QK_LD + kk] = (bf16_t)f2bf(kf * __expf(-bc)); ke[i] = kf * __expf(tot - bc); }
          { float a8[8], b8[8];
#pragma unroll
            for (int e = 0; e < 8; ++e) { a8[e] = ke[e]; b8[e] = ke[8 + e]; }
            *(LAS u32x4*)(sKET + kk * T_LD + 16 * seg) = pack8(a8); *(LAS u32x4*)(sKET + kk * T_LD + 16 * seg + 8) = pack8(b8); } }
        __syncthreads();
#pragma unroll
        for (int u = 0; u < 2; ++u) { const int T = 2 * w + u, ti = T >> 2, si = T & 3; f32x4 cc = (f32x4){0.f, 0.f, 0.f, 0.f};
            if (si <= ti) {
#pragma unroll
                for (int ks = 0; ks < 4; ++ks) { const bf16x8 a = *(const LAS bf16x8*)(sKI + (16 * si + (lane & 15)) * QK_LD + 32 * ks + 8 * q), bq = *(const LAS bf16x8*)(sQI + (16 * ti + (lane & 15)) * QK_LD + 32 * ks + 8 * q);
                    cc = MFMA16(a, bq, cc); } }
            const int t = 16 * ti + (lane & 15), s0 = 16 * si + 4 * q; float v[4];
#pragma unroll
            for (int reg = 0; reg < 4; ++reg) v[reg] = (s0 + reg <= t) ? cc[reg] : 0.f;
            u32x2 wv; wv.x = pk2(v[0], v[1]); wv.y = pk2(v[2], v[3]); *(LAS u32x2*)(sATT + t * T_LD + s0) = wv; }
        __syncthreads();
        bf16x8 vf[4];
#pragma unroll
        for (int st = 0; st < 4; ++st) vf[st] = *(const LAS bf16x8*)(sVT + (32 * w + r32) * T_LD + 16 * st + 8 * h);
        f32x16 o[2];
#pragma unroll
        for (int i = 0; i < 16; ++i) { o[0][i] = 0.f; o[1][i] = 0.f; }
#pragma unroll
        for (int kb = 0; kb < 4; ++kb)
#pragma unroll
            for (int s2 = 0; s2 < 2; ++s2) { const bf16x8 Bf = pack_step(S[kb], s2);
#pragma unroll
                for (int tb = 0; tb < 2; ++tb) { const LAS bf16_t* qp = sQI + (32 * tb + r32) * QK_LD + 32 * kb + 16 * s2 + 4 * h; const u32x2 lo = *(const LAS u32x2*)qp, hi = *(const LAS u32x2*)(qp + 8);
                    const u32x4 af = (u32x4){lo.x, lo.y, hi.x, hi.y}; o[tb] = MFMA32(__builtin_bit_cast(bf16x8, af), Bf, o[tb]); } }
#pragma unroll
        for (int tb = 0; tb < 2; ++tb)
#pragma unroll
            for (int st = 0; st < 4; ++st) { if (tb == 0 && st >= 2) continue; const bf16x8 af = *(const LAS bf16x8*)(sATT + (32 * tb + r32) * T_LD + 16 * st + 8 * h); o[tb] = MFMA32(af, vf[st], o[tb]); }
#pragma unroll
        for (int kb = 0; kb < 4; ++kb) {
#pragma unroll
            for (int i = 0; i < 16; ++i) S[kb][i] *= sDEC[32 * kb + crow(i, h)];
#pragma unroll
            for (int st = 0; st < 4; ++st) { const bf16x8 af = *(const LAS bf16x8*)(sKET + (32 * kb + r32) * T_LD + 16 * st + 8 * h); S[kb] = MFMA32(af, vf[st], S[kb]); } }
        __syncthreads();
#pragma unroll
        for (int tb = 0; tb < 2; ++tb)
#pragma unroll
            for (int i = 0; i < 16; ++i) sO[(32 * tb + crow(i, h)) * 256 + 32 * w + r32] = o[tb][i];
        __syncthreads();
#pragma unroll
        for (int j = 0; j < 8; ++j) { const int t = 8 * w + j; const f32x4 v = *(const LAS f32x4*)(sO + t * 256 + 4 * lane);
            const float rs = rsqrtf(wave_sum((v[0] * v[0] + v[1] * v[1]) + (v[2] * v[2] + v[3] * v[3])) * (1.0f / 256.0f) + EPS);
            const float g0 = bf_lo(og[j].x), g1 = bf_hi(og[j].x), g2 = bf_lo(og[j].y), g3 = bf_hi(og[j].y);
            u32x2 wv; wv.x = pk2(v[0] * rs * gn[0] * silu_(g0), v[1] * rs * gn[1] * silu_(g1)); wv.y = pk2(v[2] * rs * gn[2] * silu_(g2), v[3] * rs * gn[3] * silu_(g3));
            *(u32x2*)(F.P + (row0 + t) * PLD + PC_OG + 256 * hh + 4 * lane) = wv; }
        __syncthreads();
    }
    float* sp = F.out + O_SP + (size_t)(b * 4 + hh) * 128 * 256;
#pragma unroll
    for (int kb = 0; kb < 4; ++kb)
#pragma unroll
        for (int i = 0; i < 16; ++i) sp[(size_t)(32 * kb + crow(i, h)) * 256 + 32 * w + r32] = S[kb][i];
}

__device__ __forceinline__ void gla_sample_item(const Frame& F, int item) {
    constexpr int SQ = 0, SK = 512, SE = 1024, RED = 2048;
    const int tid = F.tid, lane = F.lane, w = F.wave; const int hh = item & 3, s = item >> 2;
    LAS float* sq = (LAS float*)(F.lds + SQ); LAS float* sk = (LAS float*)(F.lds + SK); LAS float* se = (LAS float*)(F.lds + SE); LAS float* red = (LAS float*)(F.lds + RED);
    const bf16_t* Prow = F.P + (size_t)(MP + s) * PLD;
    if (tid < 128) { float x = F.in[I_BLR][hh * 128 + tid];
#pragma unroll
        for (int r = 0; r < 16; ++r) x = fmaf(bf2f(Prow[PC_LR + r]), F.in[I_WLR][r * 512 + hh * 128 + tid], x);
        se[tid] = __expf(-softplus_(-x) * (1.0f / 16.0f)); sq[tid] = bf2f(Prow[PC_Q + 128 * hh + tid]) * 0.08838834764831845f; sk[tid] = bf2f(Prow[PC_K + 128 * hh + tid]); }
    __syncthreads();
    const u32x2 vw = *(const u32x2*)(Prow + PC_V + 256 * hh + 4 * lane); const f32x4 v4 = (f32x4){bf_lo(vw.x), bf_hi(vw.x), bf_lo(vw.y), bf_hi(vw.y)};
    const float* S0 = F.in[I_SGLA] + ((size_t)(s * 4 + hh) * 128 + 16 * w) * 256 + 4 * lane; float* S1 = F.out + O_SS + ((size_t)(s * 4 + hh) * 128 + 16 * w) * 256 + 4 * lane;
    f32x4 o4 = (f32x4){0.f, 0.f, 0.f, 0.f};
#pragma unroll
    for (int j = 0; j < 16; ++j) { const int k = 16 * w + j; const f32x4 sn = *(const f32x4*)(S0 + j * 256) * se[k] + v4 * sk[k]; *(f32x4*)(S1 + j * 256) = sn; o4 = o4 + sn * sq[k]; }
    *(LAS f32x4*)(red + w * 256 + 4 * lane) = o4;
    __syncthreads();
    if (w == 0) { f32x4 o = (f32x4){0.f, 0.f, 0.f, 0.f};
#pragma unroll
        for (int ww = 0; ww < 8; ++ww) o = o + *(const LAS f32x4*)(red + ww * 256 + 4 * lane);
        const float rs = rsqrtf(wave_sum((o[0] * o[0] + o[1] * o[1]) + (o[2] * o[2] + o[3] * o[3])) * (1.0f / 256.0f) + EPS);
        const f32x4 gn = *(const f32x4*)(F.in[I_GNG] + 4 * lane); bf16_t* ogp = F.P + (size_t)(MP + s) * PLD + PC_OG + 256 * hh + 4 * lane; const u32x2 ogw = *(const u32x2*)ogp;
        u32x2 wv; wv.x = pk2(o[0] * rs * gn[0] * silu_(bf_lo(ogw.x)), o[1] * rs * gn[1] * silu_(bf_hi(ogw.x))); wv.y = pk2(o[2] * rs * gn[2] * silu_(bf_lo(ogw.y)), o[3] * rs * gn[3] * silu_(bf_hi(ogw.y)));
        *(u32x2*)ogp = wv; }
    __syncthreads();
}
}
namespace mk {
constexpr int N_PHASES = 12;
__global__ void __launch_bounds__(NTHR, 2) mega_fwd(Args args) {
    extern __shared__ __attribute__((aligned(16))) unsigned char lds_raw[];
    Frame F;
    F.lds = (LAS unsigned char*)lds_raw;
    F.tid = threadIdx.x; F.lane = F.tid & 63; F.wave = __builtin_amdgcn_readfirstlane(F.tid >> 6);
    F.G = gridDim.x; { const int bx = blockIdx.x; F.vcu = (F.G % 8 == 0) ? (bx % 8) * (F.G / 8) + bx / 8 : bx; }
#pragma unroll
    for (int i = 0; i < 24; ++i) F.in[i] = args.in[i];
    F.out = args.out; F.ws = args.ws;
    F.P = (bf16_t*)(args.ws + WS_P);
    unsigned char* ssr = (unsigned char*)(args.out + O_SS);
    F.U = (bf16_t*)(ssr + SS_U); F.Win_t = (bf16_t*)(ssr + SS_WIN); F.Wgu1_t = (bf16_t*)(ssr + SS_WGU1); F.Wd1_t = (bf16_t*)(ssr + SS_WD1);
    F.Wrg_t = (bf16_t*)(args.ws + WS_WRG); F.Wbr_t = (bf16_t*)(args.ws + WS_WBR); F.Wbg_t = (bf16_t*)(args.ws + WS_WBG); F.Wout_t = (bf16_t*)(args.ws + WS_WOUT);
    F.Wgu2_t = (bf16_t*)(args.ws + WS_WGU2); F.Wd2_t = (bf16_t*)(args.ws + WS_WD2);
    volatile LAS unsigned* MISC = (volatile LAS unsigned*)(F.lds + MISC_OFF);
    for (int u = F.tid; u < 128; u += NTHR) MISC[u] = 0u;
    __syncthreads();
    const int lo = args.ph_lo, hi = args.ph_hi;
    XcdBarrier bar; bar.bar = (unsigned*)(args.ws + WS_CTL) + CW_BAR; bar.x = 0; bar.st = nullptr;
    if (hi - lo > 1) bar = xcd_barrier_post((unsigned*)(args.ws + WS_CTL) + CW_BAR, MISC + 8);
#define IN(k) (lo <= (k) && (k) < hi)
#define SEAM(k) do { if (IN(k) && IN((k) + 1)) xcd_barrier(bar); } while (0)
    const int gw = F.vcu * NWAVES + F.wave, NGW = F.G * NWAVES;
    LAS float* scr = (LAS float*)(F.lds + F.wave * 16384);
    constexpr bool AL = true, SP = true;

    if (IN(0)) {
        prep_wgu(F, F.in[I_F1GU], F.Wgu1_t, scr, gw, NGW);
        prep_plain(F, F.in[I_F1D], FF, D, F.Wd1_t, scr, gw, NGW);
        prep_win(F, scr, gw, NGW);
        prep_rg(F, scr, gw, NGW);
        prep_plain(F, F.in[I_WBR], D, D, F.Wbr_t, scr, gw, NGW);
        prep_plain(F, F.in[I_WBG], D, D, F.Wbg_t, scr, gw, NGW);
        prep_plain(F, F.in[I_WOUT], D, D, F.Wout_t, scr, gw, NGW);
        rowphase0(F);
    }
    SEAM(0);
    if (IN(1)) {
        pg8::Gemm g{F.P + SC_XA, PLD, F.Wgu1_t, MPAD, 2 * FF, D}; pg8::StaticOrder S; S.init(MPAD, 2 * FF, F.G, (int)blockIdx.x);
        pg8::EpiSwiGLU E{F.P + SC_H, PLD};
        pg8::gemm_phase<pg8::EpiSwiGLU, pg8::StaticOrder, AL, SP>(F.lds, g, S, E);
    }
    SEAM(1);
    if (IN(2)) {
        pg8::Gemm g{F.P + SC_H, PLD, F.Wd1_t, MPAD, D, FF}; pg8::StaticOrder S; S.init(MPAD, D, F.G, (int)blockIdx.x);
        pg8::EpiF32 E{(float*)(F.P + SC_F), PLD / 2};
        pg8::gemm_phase<pg8::EpiF32, pg8::StaticOrder, AL, SP>(F.lds, g, S, E);
    }
    SEAM(2);
    if (IN(3)) rowphase1(F);
    SEAM(3);
    if (IN(4)) {
        pg8::Gemm g{F.U, D, F.Win_t, MPAD, PLD, D}; pg8::StaticOrder S; S.init(MPAD, PLD, F.G, (int)blockIdx.x);
        pg8::EpiBf16 E{F.P, PLD};
        pg8::gemm_phase<pg8::EpiBf16, pg8::StaticOrder, AL, SP>(F.lds, g, S, E);
    }
    SEAM(4);
    if (IN(5)) {
        const int c = F.vcu;
        if (c < 32) gla_item(F, c);
        else if (c < 96) rnn_item<false>(F, c - 32);
        else if (c < 104) rnn_item<true>(F, c - 96);
        if (c >= 32) for (int it = c - 32; it < 4 * MS; it += F.G - 32) gla_sample_item(F, it);
    }
    SEAM(5);
    if (IN(6)) {
        { pg8::Gemm g{F.P + PC_YR, PLD, F.Wbr_t, MPAD, D, D}; pg8::StaticOrder S; S.init(MPAD, D, F.G, (int)blockIdx.x);
          pg8::EpiGateA E{F.P + PC_GA, PLD, (float*)(F.P + SC_T), PLD / 2};
          pg8::gemm_phase<pg8::EpiGateA, pg8::StaticOrder, AL, SP>(F.lds, g, S, E); }
        { pg8::Gemm g{F.P + PC_OG, PLD, F.Wbg_t, MPAD, D, D}; pg8::StaticOrder S; S.init(MPAD, D, F.G, (int)blockIdx.x);
          pg8::EpiGateB E{F.P + PC_GB, PLD, (const float*)(F.P + SC_T), PLD / 2, F.P + SC_XA, PLD};
          pg8::gemm_phase<pg8::EpiGateB, pg8::StaticOrder, AL, SP>(F.lds, g, S, E); }
    }
    SEAM(6);
    if (IN(7)) {
        pg8::Gemm g{F.P + SC_XA, PLD, F.Wout_t, MPAD, D, D}; pg8::StaticOrder S; S.init(MPAD, D, F.G, (int)blockIdx.x);
        pg8::EpiF32 E{(float*)(F.P + SC_T), PLD / 2};
        pg8::gemm_phase<pg8::EpiF32, pg8::StaticOrder, AL, SP>(F.lds, g, S, E);
    }
    SEAM(7);
    if (IN(8)) {
        prep_wgu(F, F.in[I_F2GU], F.Wgu2_t, scr, gw, NGW);
        prep_plain(F, F.in[I_F2D], FF, D, F.Wd2_t, scr, gw, NGW);
        rowphase2(F);
    }
    SEAM(8);
    if (IN(9)) {
        pg8::Gemm g{F.P + SC_XA, PLD, F.Wgu2_t, MPAD, 2 * FF, D}; pg8::StaticOrder S; S.init(MPAD, 2 * FF, F.G, (int)blockIdx.x);
        pg8::EpiSwiGLU E{F.P + SC_H, PLD};
        pg8::gemm_phase<pg8::EpiSwiGLU, pg8::StaticOrder, AL, SP>(F.lds, g, S, E);
    }
    SEAM(9);
    if (IN(10)) {
        pg8::Gemm g{F.P + SC_H, PLD, F.Wd2_t, MPAD, D, FF}; pg8::StaticOrder S; S.init(MPAD, D, F.G, (int)blockIdx.x);
        pg8::EpiF32 E{(float*)(F.P + SC_F), PLD / 2};
        pg8::gemm_phase<pg8::EpiF32, pg8::StaticOrder, AL, SP>(F.lds, g, S, E);
    }
    SEAM(10);
    if (IN(11)) rowphase3(F);
#undef IN
#undef SEAM
}

inline int launch(void* const* d_in, void* d_out, void* d_ws, hipStream_t stream, int n_launches, int ph_lo = 0, int ph_hi = 0) {
    static int grid = 0;
    if (grid == 0) {
        int dev = 0, cus = 0, per_cu = 0;
        if (hipGetDevice(&dev) != hipSuccess || hipDeviceGetAttribute(&cus, hipDeviceAttributeMultiprocessorCount, dev) != hipSuccess) { grid = -1; return -1; }
        if (hipFuncSetAttribute((const void*)mega_fwd, hipFuncAttributeMaxDynamicSharedMemorySize, LDS_BYTES) != hipSuccess) { grid = -1; return -1; }
        if (hipOccupancyMaxActiveBlocksPerMultiprocessor(&per_cu, (const void*)mega_fwd, NTHR, LDS_BYTES) != hipSuccess || per_cu < 1) per_cu = 1;
        (void)hipGetLastError();
        grid = cus;
    }
    if (grid < 0) return -1;
    Args a{};
    for (int i = 0; i < 24; ++i) a.in[i] = (const float*)d_in[i];
    a.out = (float*)d_out; a.ws = (unsigned char*)d_ws;
    if (n_launches == 0) { a.ph_lo = ph_lo; a.ph_hi = ph_hi; hipLaunchKernelGGL(mega_fwd, dim3(grid), dim3(NTHR), LDS_BYTES, stream, a); return 0; }
    (void)hipMemsetAsync((char*)d_ws + WS_CTL, 0, CTL_ZERO_BYTES, stream);
    if (n_launches == 1) { a.ph_lo = 0; a.ph_hi = N_PHASES; hipLaunchKernelGGL(mega_fwd, dim3(grid), dim3(NTHR), LDS_BYTES, stream, a); }
    else for (int p = 0; p < N_PHASES; ++p) { a.ph_lo = p; a.ph_hi = p + 1; hipLaunchKernelGGL(mega_fwd, dim3(grid), dim3(NTHR), LDS_BYTES, stream, a); }
    return 0;
}
}
#ifndef MK_NL
#define MK_NL 1
#endif
extern "C" void kernel_launch(void* const* d_in, const int* in_sizes, int n_in,
                              void* d_out, int out_size, void* d_ws, size_t ws_size,
                              hipStream_t stream) {
    mk::launch(d_in, d_out, d_ws, stream, MK_NL);
}
```

```cpp
#include <hip/hip_runtime.h>
#include <cstdio>
#include <cstdint>

#ifndef DBG_STATIC_FLOATS
#define DBG_STATIC_FLOATS 16
#endif
__device__ float g_static[DBG_STATIC_FLOATS];
#define STATIC_TAG (1ull << 62)
template <class T> __device__ __forceinline__ T* fx(T* p) { const unsigned long long v = (unsigned long long)p; return (v & STATIC_TAG) ? (T*)((char*)g_static + (v & (STATIC_TAG - 1))) : p; }
inline float* static_ptr(size_t float_off) { return (float*)(STATIC_TAG | (unsigned long long)(float_off * 4)); }
namespace nv {
constexpr int D = 1024, FF = 2816, DIN = 7184, TSEQ = 2048, NB = 8, NS = 128;
constexpr int C_XR = 0, C_YR = 1024, C_Q = 2048, C_K = 2560, C_V = 3072, C_OG = 4096, C_LR = 5120, C_GA = 5136, C_GB = 6160;
constexpr float EPS = 1e-6f;
constexpr size_t O_YP = 0, O_YS = 16777216, O_HP = 16908288, O_CP = 16916480, O_SP = 16941056, O_HS = 17989632, O_CS = 18120704, O_SS = 18513920;

__device__ __forceinline__ float sigmoidf_(float x) { return 1.f / (1.f + expf(-x)); }
__device__ __forceinline__ float siluf_(float x) { return x / (1.f + expf(-x)); }
__device__ __forceinline__ float softplusf_(float x) { return fmaxf(x, 0.f) + log1pf(expf(-fabsf(x))); }
__device__ __forceinline__ float logsigmoidf_(float x) { return -softplusf_(-x); }
__device__ __forceinline__ float gelu_tanhf_(float x) { const float c = 0.7978845608028654f; return 0.5f * x * (1.f + tanhf(c * (x + 0.044715f * x * x * x))); }

__device__ __forceinline__ float block_sum256(float v, float* red) {
#pragma unroll
    for (int o = 32; o > 0; o >>= 1) v += __shfl_xor(v, o);
    __syncthreads();
    if ((threadIdx.x & 63) == 0) red[threadIdx.x >> 6] = v;
    __syncthreads();
    return red[0] + red[1] + red[2] + red[3];
}
__global__ void k_rmsnorm(const float* x, const float* g, float* y) { x = fx(x); g = fx(g); y = fx(y);
    __shared__ float red[4];
    const size_t r = blockIdx.x; const float* xr = x + r * D; float v[4]; float s = 0.f;
#pragma unroll
    for (int j = 0; j < 4; ++j) { v[j] = xr[threadIdx.x + 256 * j]; s += v[j] * v[j]; }
    const float tot = block_sum256(s, red); const float rs = rsqrtf(tot / D + EPS);
#pragma unroll
    for (int j = 0; j < 4; ++j) y[r * D + threadIdx.x + 256 * j] = v[j] * rs * g[threadIdx.x + 256 * j];
}
__global__ void k_resnorm(const float* base, const float* f, const float* g, float scale, float* out) { base = fx(base); f = fx(f); g = fx(g); out = fx(out);
    __shared__ float red[4];
    const size_t r = blockIdx.x; const float* fr = f + r * D; float v[4]; float s = 0.f;
#pragma unroll
    for (int j = 0; j < 4; ++j) { v[j] = fr[threadIdx.x + 256 * j]; s += v[j] * v[j]; }
    const float tot = block_sum256(s, red); const float rs = rsqrtf(tot / D + EPS);
#pragma unroll
    for (int j = 0; j < 4; ++j) { const int c = threadIdx.x + 256 * j; out[r * D + c] = base[r * D + c] + scale * (v[j] * rs * g[c]); }
}
__global__ void __launch_bounds__(256) k_gemm(const float* A, int lda, const float* B, int ldb, float* C, int ldc, int M, int N, int K, size_t sA, size_t sB, size_t sC) { A = fx(A); B = fx(B); C = fx(C);
    __shared__ float As[16][64 + 1], Bs[16][64 + 1];
    A += blockIdx.z * sA; B += blockIdx.z * sB; C += blockIdx.z * sC;
    const int m0 = blockIdx.y * 64, n0 = blockIdx.x * 64, tx = threadIdx.x & 15, ty = threadIdx.x >> 4;
    float acc[4][4];
#pragma unroll
    for (int i = 0; i < 4; ++i)
#pragma unroll
        for (int j = 0; j < 4; ++j) acc[i][j] = 0.f;
    for (int k0 = 0; k0 < K; k0 += 16) {
#pragma unroll
        for (int i = 0; i < 4; ++i) { const int e = threadIdx.x + 256 * i; const int m = e >> 4, k = e & 15; As[k][m] = A[(size_t)(m0 + m) * lda + k0 + k]; }
#pragma unroll
        for (int i = 0; i < 4; ++i) { const int e = threadIdx.x + 256 * i; const int k = e >> 6, n = e & 63; Bs[k][n] = (n0 + n < N) ? B[(size_t)(k0 + k) * ldb + n0 + n] : 0.f; }
        __syncthreads();
#pragma unroll
        for (int k = 0; k < 16; ++k) { float a[4], b[4];
#pragma unroll
            for (int i = 0; i < 4; ++i) { a[i] = As[k][ty * 4 + i]; b[i] = Bs[k][tx * 4 + i]; }
#pragma unroll
            for (int i = 0; i < 4; ++i)
#pragma unroll
                for (int j = 0; j < 4; ++j) acc[i][j] = fmaf(a[i], b[j], acc[i][j]); }
        __syncthreads();
    }
#pragma unroll
    for (int i = 0; i < 4; ++i)
#pragma unroll
        for (int j = 0; j < 4; ++j) { const int n = n0 + tx * 4 + j; if (n < N) C[(size_t)(m0 + ty * 4 + i) * ldc + n] = acc[i][j]; }
}
__global__ void k_swiglu(const float* gu, float* h, size_t n) { gu = fx(gu); h = fx(h);
    for (size_t i = blockIdx.x * (size_t)blockDim.x + threadIdx.x; i < n; i += (size_t)gridDim.x * blockDim.x) { const size_t r = i / FF, j = i % FF; h[i] = siluf_(gu[r * (2 * FF) + j]) * gu[r * (2 * FF) + FF + j]; }
}
__global__ void k_conv(const float* P, const float* buf, const float* w, const float* b, float* xc, float* conv_new, int T, int nseq) { P = fx(P); buf = fx(buf); w = fx(w); b = fx(b); xc = fx(xc); conv_new = fx(conv_new);
    const size_t n = (size_t)nseq * T * D;
    for (size_t i = blockIdx.x * (size_t)blockDim.x + threadIdx.x; i < n; i += (size_t)gridDim.x * blockDim.x) {
        const int c = (int)(i % D); const size_t row = i / D; const int t = (int)(row % T); const int seq = (int)(row / T);
        float y = b[c];
#pragma unroll
        for (int j = 0; j < 4; ++j) { const int idx = t + j - 3; float xv;
            if (idx >= 0) xv = P[((size_t)seq * T + idx) * DIN + C_XR + c]; else xv = buf ? buf[((size_t)seq * 3 + (3 + idx)) * D + c] : 0.f;
            y += xv * w[j * D + c]; }
        xc[i] = y;
    }
    const size_t n2 = (size_t)nseq * 3 * D;
    for (size_t i = blockIdx.x * (size_t)blockDim.x + threadIdx.x; i < n2; i += (size_t)gridDim.x * blockDim.x) {
        const int c = (int)(i % D); const int j = (int)((i / D) % 3); const int seq = (int)(i / (3 * D));
        const int xi = T + j;
        float v; if (xi >= 3) v = P[((size_t)seq * T + (xi - 3)) * DIN + C_XR + c]; else v = buf ? buf[((size_t)seq * 3 + xi) * D + c] : 0.f;
        conv_new[i] = v;
    }
}
__global__ void k_rg_elem(const float* xc, const float* RA, const float* RX, const float* b_a, const float* b_x, const float* lam, float* a_out, float* bb_out, int T, int nseq, int reset) { xc = fx(xc); RA = fx(RA); RX = fx(RX); b_a = fx(b_a); b_x = fx(b_x); lam = fx(lam); a_out = fx(a_out); bb_out = fx(bb_out);
    const size_t n = (size_t)nseq * T * D;
    for (size_t i = blockIdx.x * (size_t)blockDim.x + threadIdx.x; i < n; i += (size_t)gridDim.x * blockDim.x) {
        const int c = (int)(i % D); const int t = (int)((i / D) % T);
        const float r = sigmoidf_(RA[i] + b_a[c]), ig = sigmoidf_(RX[i] + b_x[c]);
        const float log_a = -8.0f * r * softplusf_(-lam[c]); const float a = expf(log_a);
        float mult = sqrtf(fmaxf(-expm1f(2.0f * log_a), 0.f)); if (reset && t == 0) mult = 1.0f;
        a_out[i] = a; bb_out[i] = mult * ig * xc[i];
    }
}
__global__ void k_scan(const float* a, const float* bb, const float* h0, float* h, float* h_last, int T, int nseq) { a = fx(a); bb = fx(bb); h0 = fx(h0); h = fx(h); h_last = fx(h_last);
    const int i = blockIdx.x * blockDim.x + threadIdx.x; if (i >= nseq * D) return;
    const int c = i % D, seq = i / D; float hv = h0 ? h0[(size_t)seq * D + c] : 0.f;
    for (int t = 0; t < T; ++t) { const size_t o = ((size_t)seq * T + t) * D + c; hv = a[o] * hv + bb[o]; h[o] = hv; }
    h_last[(size_t)seq * D + c] = hv;
}
__global__ void k_gate_rnn(const float* h, const float* P, float* o, size_t n) { h = fx(h); P = fx(P); o = fx(o);
    for (size_t i = blockIdx.x * (size_t)blockDim.x + threadIdx.x; i < n; i += (size_t)gridDim.x * blockDim.x) { const size_t r = i / D; const int c = (int)(i % D); o[i] = h[i] * gelu_tanhf_(P[r * DIN + C_YR + c]); }
}
__global__ void __launch_bounds__(256) k_gla(const float* P, const float* G, const float* blr, const float* S0, float* O, float* S_out, int T) { P = fx(P); G = fx(G); blr = fx(blr); S0 = fx(S0); O = fx(O); S_out = fx(S_out);
    extern __shared__ float S[];
    __shared__ float sq[128], sk[128], se[128];
    const int head = blockIdx.x & 3, seq = blockIdx.x >> 2, dv = threadIdx.x;
    for (int kk = 0; kk < 128; ++kk) S[kk * 256 + dv] = S0 ? S0[(((size_t)seq * 4 + head) * 128 + kk) * 256 + dv] : 0.f;
    for (int t = 0; t < T; ++t) {
        const size_t row = (size_t)seq * T + t;
        __syncthreads();
        if (dv < 128) { sq[dv] = P[row * DIN + C_Q + head * 128 + dv] * 0.08838834764831845f; sk[dv] = P[row * DIN + C_K + head * 128 + dv];
            se[dv] = expf(logsigmoidf_(G[row * 512 + head * 128 + dv] + blr[head * 128 + dv]) * (1.0f / 16.0f)); }
        __syncthreads();
        const float v = P[row * DIN + C_V + head * 256 + dv]; float o = 0.f;
        for (int kk = 0; kk < 128; ++kk) { const float s = S[kk * 256 + dv] * se[kk] + sk[kk] * v; S[kk * 256 + dv] = s; o = fmaf(sq[kk], s, o); }
        O[row * D + head * 256 + dv] = o;
    }
    for (int kk = 0; kk < 128; ++kk) S_out[(((size_t)seq * 4 + head) * 128 + kk) * 256 + dv] = S[kk * 256 + dv];
}
__global__ void k_gla_out(const float* O, const float* P, const float* gn, float* og_out) { O = fx(O); P = fx(P); gn = fx(gn); og_out = fx(og_out);
    __shared__ float red[4];
    const int head = blockIdx.x & 3; const size_t row = blockIdx.x >> 2; const int dv = threadIdx.x;
    const float o = O[row * D + head * 256 + dv]; const float tot = block_sum256(o * o, red); const float rs = rsqrtf(tot / 256.f + EPS);
    og_out[row * D + head * 256 + dv] = o * rs * gn[dv] * siluf_(P[row * DIN + C_OG + head * 256 + dv]);
}
__global__ void k_merge(const float* P, const float* YA, const float* YB, float* m, size_t n) { P = fx(P); YA = fx(YA); YB = fx(YB); m = fx(m);
    for (size_t i = blockIdx.x * (size_t)blockDim.x + threadIdx.x; i < n; i += (size_t)gridDim.x * blockDim.x) { const size_t r = i / D; const int c = (int)(i % D);
        m[i] = sigmoidf_(P[r * DIN + C_GA + c]) * YA[i] + sigmoidf_(P[r * DIN + C_GB + c]) * YB[i]; }
}
struct In { const float *xp, *xs, *srh, *src, *sgla, *ng, *f1gu, *f1d, *win, *cw, *cb, *rwa, *rba, *rwx, *rbx, *lam, *wlr, *blr, *gng, *wbr, *wbg, *wout, *f2gu, *f2d; };
inline In make_in(void* const* d) { In I; const float** p = (const float**)&I; for (int i = 0; i < 24; ++i) p[i] = (const float*)d[i]; return I; }
inline void gemm(hipStream_t st, const float* A, int lda, const float* B, int ldb, float* C, int ldc, int M, int N, int K, int nz = 1, size_t sA = 0, size_t sB = 0, size_t sC = 0) {
    hipLaunchKernelGGL(k_gemm, dim3((N + 63) / 64, M / 64, nz), dim3(256), 0, st, A, lda, B, ldb, C, ldc, M, N, K, sA, sB, sC);
}
struct Outs { float *y, *h_last, *conv_new, *s_new; };
struct Bufs { float *T0, *T1, *T2, *T3, *T4, *T5, *T6, *T7, *T8, *T9, *GU, *HH, *P, *G; };
inline Bufs make_bufs(float* ws, int R) { Bufs B; const size_t RD = (size_t)R * D; B.T0 = ws; B.T1 = B.T0 + RD; B.T2 = B.T1 + RD; B.T3 = B.T2 + RD; B.T4 = B.T3 + RD; B.T5 = B.T4 + RD; B.T6 = B.T5 + RD; B.T7 = B.T6 + RD; B.T8 = B.T7 + RD; B.T9 = B.T8 + RD;
    B.GU = B.T9 + RD; B.HH = B.GU + (size_t)R * 2 * FF; B.P = B.HH + (size_t)R * FF; B.G = B.P + (size_t)R * DIN; return B; }
inline Outs std_outs(float* out, int grp) { Outs o; const bool smp = (grp == NB);
    o.y = smp ? out + O_YS : out + O_YP + (size_t)grp * TSEQ * D; o.h_last = smp ? out + O_HS : out + O_HP + (size_t)grp * D;
    o.conv_new = smp ? out + O_CS : out + O_CP + (size_t)grp * 3 * D; o.s_new = smp ? out + O_SS : out + O_SP + (size_t)grp * 4 * 128 * 256; return o; }
inline void run_group(hipStream_t st, const In& I, const Outs& O, float* ws, int grp, int s_lo = 0, int s_hi = 12) {
    const bool smp = (grp == NB); const int T = smp ? 1 : TSEQ, nseq = smp ? NS : 1, R = T * nseq;
    const float* x = smp ? I.xs : I.xp + (size_t)grp * TSEQ * D;
    const Bufs B = make_bufs(ws, R);
    float *T0 = B.T0, *T1 = B.T1, *T2 = B.T2, *T3 = B.T3, *T4 = B.T4, *T5 = B.T5, *T6 = B.T6, *T7 = B.T7, *T8 = B.T8, *T9 = B.T9, *GU = B.GU, *HH = B.HH, *P = B.P, *G = B.G;
    const float* ng = I.ng; const size_t n1 = (size_t)R * D; const int EB = 1024;
#define STG(k) if (s_lo <= (k) && (k) < s_hi)
    STG(0) hipLaunchKernelGGL(k_rmsnorm, dim3(R), dim3(256), 0, st, x, ng + 0 * D, T0);
    STG(1) { gemm(st, T0, D, I.f1gu, 2 * FF, GU, 2 * FF, R, 2 * FF, D);
        hipLaunchKernelGGL(k_swiglu, dim3(EB), dim3(256), 0, st, GU, HH, (size_t)R * FF); }
    STG(2) gemm(st, HH, FF, I.f1d, D, T1, D, R, D, FF);
    STG(3) { hipLaunchKernelGGL(k_resnorm, dim3(R), dim3(256), 0, st, x, T1, ng + 1 * D, 0.5f, T2);
        hipLaunchKernelGGL(k_rmsnorm, dim3(R), dim3(256), 0, st, T2, ng + 2 * D, T3); }
    STG(4) gemm(st, T3, D, I.win, DIN, P, DIN, R, DIN, D);
    STG(5) { hipLaunchKernelGGL(k_conv, dim3(EB), dim3(256), 0, st, P, smp ? I.src : nullptr, I.cw, I.cb, T4, O.conv_new, T, nseq);
        gemm(st, T4, D, I.rwa, 128, T5, D, R, 128, 128, 8, 128, 128 * 128, 128);
        gemm(st, T4, D, I.rwx, 128, T6, D, R, 128, 128, 8, 128, 128 * 128, 128);
        hipLaunchKernelGGL(k_rg_elem, dim3(EB), dim3(256), 0, st, T4, T5, T6, I.rba, I.rbx, I.lam, T7, T8, T, nseq, smp ? 0 : 1);
        hipLaunchKernelGGL(k_scan, dim3((nseq * D + 255) / 256), dim3(256), 0, st, T7, T8, smp ? I.srh : nullptr, T9, O.h_last, T, nseq);
        hipLaunchKernelGGL(k_gate_rnn, dim3(EB), dim3(256), 0, st, T9, P, T3, n1);
        gemm(st, P + C_LR, DIN, I.wlr, 512, G, 512, R, 512, 16);
        hipLaunchKernelGGL(k_gla, dim3(nseq * 4), dim3(256), 128 * 256 * 4, st, P, G, I.blr, smp ? I.sgla : nullptr, T7, O.s_new, T);
        hipLaunchKernelGGL(k_gla_out, dim3(R * 4), dim3(256), 0, st, T7, P, I.gng, T8); }
    STG(6) { gemm(st, T3, D, I.wbr, D, T5, D, R, D, D);
        gemm(st, T8, D, I.wbg, D, T6, D, R, D, D);
        hipLaunchKernelGGL(k_merge, dim3(EB), dim3(256), 0, st, P, T5, T6, T9, n1); }
    STG(7) gemm(st, T9, D, I.wout, D, T1, D, R, D, D);
    STG(8) { hipLaunchKernelGGL(k_resnorm, dim3(R), dim3(256), 0, st, T2, T1, ng + 3 * D, 1.0f, T2);
        hipLaunchKernelGGL(k_rmsnorm, dim3(R), dim3(256), 0, st, T2, ng + 4 * D, T0); }
    STG(9) { gemm(st, T0, D, I.f2gu, 2 * FF, GU, 2 * FF, R, 2 * FF, D);
        hipLaunchKernelGGL(k_swiglu, dim3(EB), dim3(256), 0, st, GU, HH, (size_t)R * FF); }
    STG(10) gemm(st, HH, FF, I.f2d, D, T1, D, R, D, FF);
    STG(11) hipLaunchKernelGGL(k_resnorm, dim3(R), dim3(256), 0, st, T2, T1, ng + 5 * D, 0.5f, O.y);
#undef STG
}
}
namespace pg8 {
#define PG8_LAS __attribute__((address_space(3)))
typedef unsigned short bf16_t;
typedef short bf16x8 __attribute__((ext_vector_type(8)));
typedef float f32x4 __attribute__((ext_vector_type(4)));
typedef float f32x2 __attribute__((ext_vector_type(2)));
typedef unsigned u32x4 __attribute__((ext_vector_type(4)));
typedef unsigned u32x2 __attribute__((ext_vector_type(2)));
constexpr int BM = 256, BK = 64, HALF = 128, HTB = HALF * BK * 2, STAGE_BYTES = 8 * HTB, NXCD = 8, WGM = 8;

__host__ __device__ __forceinline__ int lds_byte(int r, int c) { const int st = (r >> 4) * 2 + (c >> 5), rr = r & 15, cc = c & 31, ob = rr * 64 + cc * 2; return st * 1024 + (ob ^ (((ob >> 9) & 1) << 5)); }
__host__ __device__ __forceinline__ void stage_rc(int b, int& R, int& C) { const int st = b / 1024, sb = b % 1024, swz = sb ^ (((sb >> 9) & 1) << 5); R = (st >> 1) * 16 + swz / 64; C = (st & 1) * 32 + (swz % 64) / 2; }
__host__ __device__ __forceinline__ int perm32(int rho) { const int n = rho >> 4, i = rho & 15; return 8 * (i >> 2) + 4 * n + (i & 3); }

struct Unit { int pm, pn; };
struct Gemm { const bf16_t* A; int lda; const bf16_t* Bt; int M, N, K; };

struct StaticOrder {
    int nM, nN, nwg, G, c;
    __host__ __device__ void init(int M, int N, int G_, int c_) { nM = M / BM; nN = N / BM; nwg = nM * nN; G = G_; c = c_; }
    __host__ __device__ bool next(int i, Unit& u) const {
        const long L = (long)i * G + c; if (L >= nwg) return false;
        int wgid = (int)L; { const int q = nwg / NXCD, r = nwg % NXCD, xcd = wgid % NXCD, off = wgid / NXCD; wgid = (xcd < r ? xcd * (q + 1) : r * (q + 1) + (xcd - r) * q) + off; }
        const int nig = WGM * nN, gid = wgid / nig, fm = gid * WGM, gsz = (nM - fm) < WGM ? (nM - fm) : WGM;
        u.pm = fm + ((wgid % nig) % gsz); u.pn = (wgid % nig) / gsz; return true;
    }
    __device__ __forceinline__ void a_ready(const Unit&) const {}
    __device__ __forceinline__ void done(const Unit&) const {}
};

__device__ __forceinline__ unsigned f2bf(float f) { unsigned u = __builtin_bit_cast(unsigned, f); return (u + 0x7fffu + ((u >> 16) & 1u)) >> 16; }
typedef __bf16 hwbf16x2 __attribute__((ext_vector_type(2)));
__device__ __forceinline__ unsigned pk2(float lo, float hi) { const f32x2 v = {lo, hi}; return __builtin_bit_cast(unsigned, __builtin_convertvector(v, hwbf16x2)); }
__device__ __forceinline__ float bf_lo(unsigned w) { return __builtin_bit_cast(float, w << 16); }
__device__ __forceinline__ float bf_hi(unsigned w) { return __builtin_bit_cast(float, w & 0xffff0000u); }
__device__ __forceinline__ float fast_sigmoid(float x) { return __builtin_amdgcn_rcpf(1.0f + __builtin_amdgcn_exp2f(-1.4426950408889634f * x)); }

struct EpiF32 {
    static constexpr bool PERM = false, AFTER_DRAIN = false;
    float* C; int ldc;
    __device__ __forceinline__ void operator()(const f32x4 (&acc)[2][2][4][2], const Unit& u, int wr, int wc, int fr, int fq) const {
        const int row0 = u.pm * BM + wr * 64 + fr, col0 = u.pn * BM + wc * 32 + 4 * fq;
#pragma unroll
        for (int ai = 0; ai < 2; ++ai)
#pragma unroll
            for (int m = 0; m < 4; ++m) { float* rowp = C + (size_t)(row0 + ai * HALF + m * 16) * ldc + col0;
#pragma unroll
                for (int bj = 0; bj < 2; ++bj)
#pragma unroll
                    for (int n = 0; n < 2; ++n) *(f32x4*)(rowp + bj * HALF + n * 16) = acc[ai][bj][m][n]; }
    }
};
struct EpiBf16 {
    static constexpr bool PERM = true, AFTER_DRAIN = false;
    bf16_t* O; int ldc;
    __device__ __forceinline__ void operator()(const f32x4 (&acc)[2][2][4][2], const Unit& u, int wr, int wc, int fr, int fq) const {
        const int row0 = u.pm * BM + wr * 64 + fr, col0 = u.pn * BM + wc * 32 + 8 * fq;
#pragma unroll
        for (int ai = 0; ai < 2; ++ai)
#pragma unroll
            for (int m = 0; m < 4; ++m) { bf16_t* rowp = O + (size_t)(row0 + ai * HALF + m * 16) * ldc + col0;
#pragma unroll
                for (int bj = 0; bj < 2; ++bj) { const f32x4 v0 = acc[ai][bj][m][0], v1 = acc[ai][bj][m][1];
                    u32x4 w; w.x = pk2(v0[0], v0[1]); w.y = pk2(v0[2], v0[3]); w.z = pk2(v1[0], v1[1]); w.w = pk2(v1[2], v1[3]);
                    *(u32x4*)(rowp + bj * HALF) = w; } }
    }
};
struct EpiSwiGLU {
    static constexpr bool PERM = true, AFTER_DRAIN = false;
    bf16_t* O; int ldc;
    __device__ __forceinline__ void operator()(const f32x4 (&acc)[2][2][4][2], const Unit& u, int wr, int wc, int fr, int fq) const {
        const int row0 = u.pm * BM + wr * 64 + fr, col0 = u.pn * HALF + wc * 32 + 8 * fq;
#pragma unroll
        for (int ai = 0; ai < 2; ++ai)
#pragma unroll
            for (int m = 0; m < 4; ++m) { bf16_t* rowp = O + (size_t)(row0 + ai * HALF + m * 16) * ldc + col0;
                float h[8];
#pragma unroll
                for (int n = 0; n < 2; ++n)
#pragma unroll
                    for (int e = 0; e < 4; ++e) { const float g = acc[ai][0][m][n][e], up = acc[ai][1][m][n][e]; h[4 * n + e] = g * fast_sigmoid(g) * up; }
                u32x4 w; w.x = pk2(h[0], h[1]); w.y = pk2(h[2], h[3]); w.z = pk2(h[4], h[5]); w.w = pk2(h[6], h[7]);
                *(u32x4*)rowp = w; }
    }
};
struct EpiGateA {
    static constexpr bool PERM = true, AFTER_DRAIN = false;
    const bf16_t* G; int ldg; float* T; int ldt;
    __device__ __forceinline__ void operator()(const f32x4 (&acc)[2][2][4][2], const Unit& u, int wr, int wc, int fr, int fq) const {
        const int row0 = u.pm * BM + wr * 64 + fr, col0 = u.pn * BM + wc * 32 + 8 * fq;
#pragma unroll
        for (int ai = 0; ai < 2; ++ai)
#pragma unroll
            for (int m = 0; m < 4; ++m) { const size_t row = (size_t)(row0 + ai * HALF + m * 16);
#pragma unroll
                for (int bj = 0; bj < 2; ++bj) { const u32x4 g = *(const u32x4*)(G + row * ldg + col0 + bj * HALF); const f32x4 v0 = acc[ai][bj][m][0], v1 = acc[ai][bj][m][1];
                    f32x4 o0, o1; o0[0] = fast_sigmoid(bf_lo(g.x)) * v0[0]; o0[1] = fast_sigmoid(bf_hi(g.x)) * v0[1]; o0[2] = fast_sigmoid(bf_lo(g.y)) * v0[2]; o0[3] = fast_sigmoid(bf_hi(g.y)) * v0[3];
                    o1[0] = fast_sigmoid(bf_lo(g.z)) * v1[0]; o1[1] = fast_sigmoid(bf_hi(g.z)) * v1[1]; o1[2] = fast_sigmoid(bf_lo(g.w)) * v1[2]; o1[3] = fast_sigmoid(bf_hi(g.w)) * v1[3];
                    float* tp = T + row * ldt + col0 + bj * HALF; *(f32x4*)tp = o0; *(f32x4*)(tp + 4) = o1; } }
    }
};
struct EpiGateB {
    static constexpr bool PERM = true, AFTER_DRAIN = false;
    const bf16_t* G; int ldg; const float* T; int ldt; bf16_t* O; int ldc;
    __device__ __forceinline__ void operator()(const f32x4 (&acc)[2][2][4][2], const Unit& u, int wr, int wc, int fr, int fq) const {
        const int row0 = u.pm * BM + wr * 64 + fr, col0 = u.pn * BM + wc * 32 + 8 * fq;
#pragma unroll
        for (int ai = 0; ai < 2; ++ai)
#pragma unroll
            for (int m = 0; m < 4; ++m) { const size_t row = (size_t)(row0 + ai * HALF + m * 16);
#pragma unroll
                for (int bj = 0; bj < 2; ++bj) { const u32x4 g = *(const u32x4*)(G + row * ldg + col0 + bj * HALF); const f32x4 v0 = acc[ai][bj][m][0], v1 = acc[ai][bj][m][1];
                    const float* tp = T + row * ldt + col0 + bj * HALF; const f32x4 t0 = *(const f32x4*)tp, t1 = *(const f32x4*)(tp + 4);
                    f32x4 o0, o1; o0[0] = t0[0] + fast_sigmoid(bf_lo(g.x)) * v0[0]; o0[1] = t0[1] + fast_sigmoid(bf_hi(g.x)) * v0[1]; o0[2] = t0[2] + fast_sigmoid(bf_lo(g.y)) * v0[2]; o0[3] = t0[3] + fast_sigmoid(bf_hi(g.y)) * v0[3];
                    o1[0] = t1[0] + fast_sigmoid(bf_lo(g.z)) * v1[0]; o1[1] = t1[1] + fast_sigmoid(bf_hi(g.z)) * v1[1]; o1[2] = t1[2] + fast_sigmoid(bf_lo(g.w)) * v1[2]; o1[3] = t1[3] + fast_sigmoid(bf_hi(g.w)) * v1[3];
                    u32x4 w; w.x = pk2(o0[0], o0[1]); w.y = pk2(o0[2], o0[3]); w.z = pk2(o1[0], o1[1]); w.w = pk2(o1[2], o1[3]);
                    *(u32x4*)(O + row * ldc + col0 + bj * HALF) = w; } }
    }
};

template <class Epi, class Sched, bool ALIGN_EPI = false, bool SP2 = false>
__device__ __forceinline__ void gemm_phase(PG8_LAS unsigned char* lds, const Gemm g, const Sched& S, const Epi& E) {
    const int tid = threadIdx.x, wid = __builtin_amdgcn_readfirstlane(tid >> 6), lane = tid & 63, wr = wid >> 2, wc = wid & 3, fr = lane & 15, fq = lane >> 4;
    const int K = g.K, nt = K / BK;
    unsigned voffA[2], voffB[2];
#pragma unroll
    for (int i = 0; i < 2; ++i) { int R, C; stage_rc(tid * 16 + i * 8192, R, C); const int Rb = Epi::PERM ? ((R & ~31) + perm32(R & 31)) : R;
        voffA[i] = (unsigned)(R * g.lda + C) * 2u; voffB[i] = (unsigned)(Rb * K + C) * 2u; }
    const size_t kstep = (size_t)(BK * 2);
    const size_t hstepA = (size_t)HALF * g.lda * 2, hstepB = (size_t)HALF * K * 2;
    const size_t tstepA = 2 * hstepA, tstepB = 2 * hstepB;
    const unsigned ldsw = (unsigned)wid * 1024u;
    const int aoff = lds_byte(wr * 64 + fr, fq * 8), boff = lds_byte(wc * 32 + fr, fq * 8);
#define PG8_SA(b, h) (((b) * 2 + (h)) * HTB)
#define PG8_SB(b, h) ((4 + (b) * 2 + (h)) * HTB)
#define PG8_STAGE(bufoff, gbase, voff) do { _Pragma("unroll") for (int _i = 0; _i < 2; ++_i) \
        __builtin_amdgcn_global_load_lds((const unsigned*)((const char*)(gbase) + (voff)[_i]), (PG8_LAS unsigned*)(lds + (bufoff) + ldsw + _i * 8192), 16, 0, 0); } while (0)
#define PG8_LDA(dst, b, h) do { _Pragma("unroll") for (int m = 0; m < 4; ++m) _Pragma("unroll") for (int k = 0; k < 2; ++k) dst[m][k] = *(const PG8_LAS bf16x8*)(lds + PG8_SA(b, h) + aoff + m * 2048 + k * 1024); } while (0)
#define PG8_LDB(dst, b, h) do { _Pragma("unroll") for (int n = 0; n < 2; ++n) _Pragma("unroll") for (int k = 0; k < 2; ++k) dst[n][k] = *(const PG8_LAS bf16x8*)(lds + PG8_SB(b, h) + boff + n * 2048 + k * 1024); } while (0)
#define PG8_MMA(ai, bj, At, Bt) do { __builtin_amdgcn_s_setprio(1); _Pragma("unroll") for (int m = 0; m < 4; ++m) _Pragma("unroll") for (int n = 0; n < 2; ++n) _Pragma("unroll") for (int k = 0; k < 2; ++k) \
        acc[ai][bj][m][n] = __builtin_amdgcn_mfma_f32_16x16x32_bf16(Bt[n][k], At[m][k], acc[ai][bj][m][n], 0, 0, 0); __builtin_amdgcn_s_setprio(0); } while (0)
#define PG8_WAIT_V(n) asm volatile("s_waitcnt vmcnt(" #n ")" ::: "memory")
#define PG8_WAIT_L(n) asm volatile("s_waitcnt lgkmcnt(" #n ")" ::: "memory")
#define PG8_BAR __builtin_amdgcn_s_barrier()
#define PG8_SCHED __builtin_amdgcn_sched_barrier(0)
    Unit cur, nxt; int ui = 0;
    if (!S.next(0, cur)) return;
    f32x4 acc[2][2][4][2];
#pragma unroll
    for (int a = 0; a < 2; ++a)
#pragma unroll
        for (int b = 0; b < 2; ++b)
#pragma unroll
            for (int m = 0; m < 4; ++m)
#pragma unroll
                for (int n = 0; n < 2; ++n) acc[a][b][m][n] = (f32x4){0.f, 0.f, 0.f, 0.f};
    bf16x8 At[4][2], B0[2][2], B1[2][2];
    const char* cA = (const char*)g.A + (size_t)cur.pm * tstepA; const char* cB = (const char*)g.Bt + (size_t)cur.pn * tstepB;
    S.a_ready(cur);
    if constexpr (SP2) {
        PG8_STAGE(PG8_SB(0, 0), cB, voffB); PG8_STAGE(PG8_SB(0, 1), cB + hstepB, voffB); PG8_STAGE(PG8_SA(0, 0), cA, voffA); PG8_STAGE(PG8_SA(0, 1), cA + hstepA, voffA);
        if (wr == 1) PG8_BAR;
        PG8_WAIT_V(2); PG8_BAR;
        PG8_STAGE(PG8_SB(1, 0), cB + kstep, voffB); PG8_STAGE(PG8_SA(1, 0), cA + kstep, voffA); PG8_STAGE(PG8_SB(1, 1), cB + hstepB + kstep, voffB);
        PG8_WAIT_V(6); PG8_BAR;
    } else {
        PG8_STAGE(PG8_SB(0, 0), cB, voffB); PG8_STAGE(PG8_SA(0, 0), cA, voffA); PG8_STAGE(PG8_SB(0, 1), cB + hstepB, voffB); PG8_STAGE(PG8_SA(0, 1), cA + hstepA, voffA);
        if (wr == 1) PG8_BAR;
        PG8_WAIT_V(4); PG8_BAR;
        PG8_STAGE(PG8_SB(1, 0), cB + kstep, voffB); PG8_STAGE(PG8_SA(1, 0), cA + kstep, voffA); PG8_STAGE(PG8_SB(1, 1), cB + hstepB + kstep, voffB);
        PG8_WAIT_V(6); PG8_BAR;
    }
    for (;;) {
        const bool has_next = S.next(ui + 1, nxt);
        const char* nA = has_next ? (const char*)g.A + (size_t)nxt.pm * tstepA : cA; const char* nB = has_next ? (const char*)g.Bt + (size_t)nxt.pn * tstepB : cB;
        for (int t = 0; t < nt; t += 2) {
            const bool last = (t == nt - 2);
            const char* a1 = cA + (size_t)(t + 1) * kstep;
            const char* a2 = last ? nA : cA + (size_t)(t + 2) * kstep; const char* b2 = last ? nB : cB + (size_t)(t + 2) * kstep;
            const char* a3 = a2 + kstep; const char* b3 = b2 + kstep;
            if (last && has_next) S.a_ready(nxt);
            if constexpr (SP2) {
            PG8_LDB(B0, 0, 0); PG8_LDB(B1, 0, 1); PG8_SCHED; PG8_LDA(At, 0, 0); PG8_STAGE(PG8_SA(1, 1), a1 + hstepA, voffA);
            PG8_WAIT_V(8); PG8_WAIT_L(0); PG8_BAR; PG8_MMA(0, 0, At, B0); PG8_MMA(0, 1, At, B1); PG8_BAR; PG8_SCHED;
            PG8_LDA(At, 0, 1); PG8_STAGE(PG8_SB(0, 0), b2, voffB); PG8_STAGE(PG8_SB(0, 1), b2 + hstepB, voffB); PG8_STAGE(PG8_SA(0, 0), a2, voffA);
            PG8_WAIT_V(8); PG8_WAIT_L(0); PG8_BAR; PG8_MMA(1, 0, At, B0); PG8_MMA(1, 1, At, B1); PG8_BAR; PG8_SCHED;
            PG8_LDB(B0, 1, 0); PG8_LDB(B1, 1, 1); PG8_SCHED; PG8_LDA(At, 1, 0); PG8_STAGE(PG8_SA(0, 1), a2 + hstepA, voffA);
            PG8_WAIT_V(8); PG8_WAIT_L(0); PG8_BAR; PG8_MMA(0, 0, At, B0); PG8_MMA(0, 1, At, B1); PG8_BAR; PG8_SCHED;
            PG8_LDA(At, 1, 1); PG8_STAGE(PG8_SB(1, 0), b3, voffB); PG8_STAGE(PG8_SB(1, 1), b3 + hstepB, voffB); PG8_STAGE(PG8_SA(1, 0), a3, voffA);
            PG8_WAIT_V(8); PG8_WAIT_L(0); PG8_BAR; PG8_MMA(1, 0, At, B0); PG8_MMA(1, 1, At, B1); PG8_BAR; PG8_SCHED;
            } else {
            PG8_LDB(B0, 0, 0); PG8_SCHED; PG8_LDA(At, 0, 0); PG8_STAGE(PG8_SA(1, 1), a1 + hstepA, voffA);
            PG8_WAIT_L(8); PG8_BAR; PG8_WAIT_L(0); PG8_MMA(0, 0, At, B0); PG8_BAR; PG8_SCHED;
            PG8_LDB(B1, 0, 1); PG8_STAGE(PG8_SB(0, 0), b2, voffB);
            PG8_BAR; PG8_WAIT_L(0); PG8_MMA(0, 1, At, B1); PG8_BAR;
            PG8_LDA(At, 0, 1); PG8_STAGE(PG8_SA(0, 0), a2, voffA);
            PG8_BAR; PG8_WAIT_L(0); PG8_MMA(1, 0, At, B0); PG8_BAR; PG8_SCHED;
            PG8_STAGE(PG8_SB(0, 1), b2 + hstepB, voffB);
            PG8_WAIT_V(6); PG8_BAR; PG8_MMA(1, 1, At, B1); PG8_BAR;
            PG8_LDB(B0, 1, 0); PG8_SCHED; PG8_LDA(At, 1, 0); PG8_STAGE(PG8_SA(0, 1), a2 + hstepA, voffA);
            PG8_WAIT_L(8); PG8_BAR; PG8_WAIT_L(0); PG8_MMA(0, 0, At, B0); PG8_BAR; PG8_SCHED;
            PG8_LDB(B1, 1, 1); PG8_STAGE(PG8_SB(1, 0), b3, voffB);
            PG8_BAR; PG8_WAIT_L(0); PG8_MMA(0, 1, At, B1); PG8_BAR;
            PG8_LDA(At, 1, 1); PG8_STAGE(PG8_SA(1, 0), a3, voffA);
            PG8_BAR; PG8_WAIT_L(0); PG8_MMA(1, 0, At, B0); PG8_BAR; PG8_SCHED;
            PG8_STAGE(PG8_SB(1, 1), b3 + hstepB, voffB);
            PG8_WAIT_V(6); PG8_BAR; PG8_MMA(1, 1, At, B1); PG8_BAR;
            }
        }
        if constexpr (ALIGN_EPI) { if (wr == 0) PG8_BAR; }
        if constexpr (!Epi::AFTER_DRAIN) { E(acc, cur, wr, wc, fr, fq); S.done(cur); }
        if (!has_next) break;
#pragma unroll
        for (int a = 0; a < 2; ++a)
#pragma unroll
            for (int b = 0; b < 2; ++b)
#pragma unroll
                for (int m = 0; m < 4; ++m)
#pragma unroll
                    for (int n = 0; n < 2; ++n) acc[a][b][m][n] = (f32x4){0.f, 0.f, 0.f, 0.f};
        cur = nxt; cA = nA; cB = nB; ++ui;
        if constexpr (ALIGN_EPI) { if (wr == 1) PG8_BAR; }
    }
    PG8_WAIT_V(0);
    if constexpr (!ALIGN_EPI) { if (wr == 0) PG8_BAR; }
    PG8_BAR;
#undef PG8_SA
#undef PG8_SB
#undef PG8_STAGE
#undef PG8_LDA
#undef PG8_LDB
#undef PG8_MMA
#undef PG8_WAIT_V
#undef PG8_WAIT_L
#undef PG8_BAR
#undef PG8_SCHED
}
}
namespace mk {
using pg8::bf16_t; using pg8::bf16x8; using pg8::f32x4; using pg8::f32x2; using pg8::u32x4; using pg8::u32x2; using pg8::f2bf; using pg8::pk2; using pg8::bf_lo; using pg8::bf_hi;
#define LAS __attribute__((address_space(3)))
typedef float f32x16 __attribute__((ext_vector_type(16)));
constexpr int NWAVES = 8, NTHR = 512;
constexpr int D = 1024, FF = 2816, DIN = 7184, MP = 16384, MS = 128, MT = 16512, MPAD = 16640, TSEQ = 2048, NB = 8;
constexpr int PLD = 7424;
constexpr int PC_XR = 0, PC_YR = 1024, PC_OG = 2048, PC_Q = 3072, PC_K = 3584, PC_V = 4096, PC_GA = 5120, PC_GB = 6144, PC_LR = 7168;
constexpr int SC_XA = 0, SC_H = 1024, SC_T = 3072, SC_F = 5120;
constexpr float EPS = 1e-6f;
constexpr size_t O_YP = 0, O_YS = 16777216, O_HP = 16908288, O_CP = 16916480, O_SP = 16941056, O_HS = 17989632, O_CS = 18120704, O_SS = 18513920;
constexpr size_t MiB = 1u << 20;
constexpr size_t WS_CTL = 0, CTL_ZERO_BYTES = 64 * 1024;
constexpr size_t WS_P = 1 * MiB;
constexpr size_t WS_TAIL = 237 * MiB;
constexpr size_t WS_WRG = WS_TAIL, WS_WBR = WS_TAIL + MiB / 2, WS_WBG = WS_WBR + 2 * MiB, WS_WOUT = WS_WBG + 2 * MiB;
constexpr size_t WS_WGU2 = WS_TAIL, WS_WD2 = WS_TAIL + 11 * MiB;
static_assert(WS_P + (size_t)MPAD * PLD * 2 <= WS_TAIL && WS_WOUT + 2 * MiB <= 256 * MiB && WS_WD2 + (size_t)D * FF * 2 <= 256 * MiB, "d_ws map");
constexpr size_t SS_U = 0, SS_WIN = (size_t)MPAD * D * 2, SS_WGU1 = SS_WIN + (size_t)PLD * D * 2, SS_WD1 = SS_WGU1 + (size_t)2 * FF * D * 2;
static_assert(SS_WD1 + (size_t)D * FF * 2 <= 64 * MiB, "ss-region map");
constexpr int CW_BAR = 4096;
constexpr int LDS_BYTES = 163840, MISC_OFF = LDS_BYTES - 512;

#define RLX_AGENT __ATOMIC_RELAXED, __HIP_MEMORY_SCOPE_AGENT
#define LDS_WAIT() asm volatile("s_waitcnt lgkmcnt(0)" ::: "memory")
#define VM_WAIT() asm volatile("s_waitcnt vmcnt(0)" ::: "memory")

#define XB_TMO      128
#define XB_XCNT(j)  (256  + 64 * (j))
#define XB_XSUB(j)  (1280 + 64 * (j))
#define XB_XGEN(j)  (2304 + 64 * (j))
#define XB_TOP      3328
#define XB_TOPGEN   3392
#define XCD_BAR_WORDS 3456
#define XB_SPIN_CAP (1u << 18)
__device__ __forceinline__ unsigned xb_ld(unsigned* p)              { return __hip_atomic_load(p, __ATOMIC_RELAXED, __HIP_MEMORY_SCOPE_AGENT); }
__device__ __forceinline__ unsigned xb_add(unsigned* p, unsigned v) { return __hip_atomic_fetch_add(p, v, __ATOMIC_RELAXED, __HIP_MEMORY_SCOPE_AGENT); }
__device__ __forceinline__ unsigned xb_xcc_id() { return (unsigned)__builtin_amdgcn_s_getreg((3 << 11) | 20) & 0xFu; }
#define XB_SPIN(cond, bar) do { unsigned _sp = 0; while (cond) { __builtin_amdgcn_s_sleep(1); \
    if ((++_sp & 255u) == 0u) { if (xb_ld(&(bar)[XB_TMO])) break; if (_sp > XB_SPIN_CAP) { atomicAdd(&(bar)[XB_TMO], 1u); break; } } } } while (0)
struct XcdBarrier { unsigned* bar; unsigned x; volatile LAS unsigned* st; };
__device__ __forceinline__ XcdBarrier xcd_barrier_post(unsigned* bar, volatile LAS unsigned* st) {
    XcdBarrier b; b.bar = bar; b.x = xb_xcc_id(); b.st = st;
    if (threadIdx.x == 0) (void)xb_add(&bar[XB_XCNT(b.x)], 1u);
    return b;
}
__device__ __forceinline__ void xcd_barrier_complete(unsigned* bar, unsigned x, unsigned& nloc, unsigned& nx) {
    const unsigned G = gridDim.x * gridDim.y * gridDim.z;
    unsigned sum, cnt, mine, sp = 0u;
    for (;;) {
        sum = 0u; cnt = 0u; mine = 0u;
#pragma unroll
        for (unsigned j = 0; j < 16; ++j) { const unsigned c = xb_ld(&bar[XB_XCNT(j)]); sum += c; cnt += (c > 0u) ? 1u : 0u; mine = (j == x) ? c : mine; }
        if (sum == G) break;
        __builtin_amdgcn_s_sleep(1);
        if ((++sp & 255u) == 0u) { if (xb_ld(&bar[XB_TMO])) break; if (sp > XB_SPIN_CAP) { atomicAdd(&bar[XB_TMO], 1u); break; } }
    }
    nloc = mine > 0u ? mine : 1u; nx = cnt > 0u ? cnt : 1u;
}
__device__ __forceinline__ void xcd_barrier(const XcdBarrier& b) {
    asm volatile("s_waitcnt vmcnt(0)" ::: "memory");
    __syncthreads();
    if (threadIdx.x == 0) {
        unsigned* bar = b.bar;
        __builtin_amdgcn_s_waitcnt(0);
        unsigned nloc = b.st[0], nx = b.st[1];
        if (nloc == 0u) { xcd_barrier_complete(bar, b.x, nloc, nx); b.st[0] = nloc; b.st[1] = nx; }
        const unsigned old = xb_add(&bar[XB_XSUB(b.x)], 1u);
        const unsigned gen = old / nloc;
        if (old + 1u == (gen + 1u) * nloc) {
            __builtin_amdgcn_fence(__ATOMIC_RELEASE, "agent");
            asm volatile("s_waitcnt vmcnt(0)" ::: "memory");
            const unsigned og = xb_add(&bar[XB_TOP], 1u);
            const unsigned tg = og / nx;
            if (og + 1u == (tg + 1u) * nx) xb_add(&bar[XB_TOPGEN], 1u);
            else XB_SPIN(xb_ld(&bar[XB_TOPGEN]) == tg, bar);
            __builtin_amdgcn_fence(__ATOMIC_ACQUIRE, "agent");
            xb_add(&bar[XB_XGEN(b.x)], 1u);
            asm volatile("s_waitcnt vmcnt(0)" ::: "memory");
        } else {
            XB_SPIN(xb_ld(&bar[XB_XGEN(b.x)]) == gen, bar);
            __builtin_amdgcn_fence(__ATOMIC_ACQUIRE, "agent");
            asm volatile("s_waitcnt vmcnt(0)" ::: "memory");
        }
    }
    __syncthreads();
}

struct Args { const float* in[24]; float* out; unsigned char* ws; int ph_lo, ph_hi; };
struct Frame {
    LAS unsigned char* lds; int tid, lane, wave, vcu, G;
    const float* in[24]; float* out; unsigned char* ws;
    bf16_t* P; bf16_t* U; bf16_t* Win_t; bf16_t* Wgu1_t; bf16_t* Wd1_t; bf16_t* Wrg_t; bf16_t* Wbr_t; bf16_t* Wbg_t; bf16_t* Wout_t; bf16_t* Wgu2_t; bf16_t* Wd2_t;
};
enum { I_XP = 0, I_XS, I_SRH, I_SRC, I_SGLA, I_NG, I_F1GU, I_F1D, I_WIN, I_CW, I_CB, I_RWA, I_RBA, I_RWX, I_RBX, I_LAM, I_WLR, I_BLR, I_GNG, I_WBR, I_WBG, I_WOUT, I_F2GU, I_F2D };

__device__ __forceinline__ float wave_sum(float v) {
#pragma unroll
    for (int o = 1; o < 64; o <<= 1) v += __shfl_xor(v, o);
    return v;
}
__device__ __forceinline__ const float* xrow_ptr(const Frame& F, int row) { return row < MP ? F.in[I_XP] + (size_t)row * D : F.in[I_XS] + (size_t)(row - MP) * D; }
__device__ __forceinline__ void load_row16(const float* p, int lane, f32x4 (&v)[4]) {
#pragma unroll
    for (int j = 0; j < 4; ++j) v[j] = *(const f32x4*)(p + 4 * lane + 256 * j);
}
__device__ __forceinline__ float sumsq16(const f32x4 (&v)[4]) { float s = 0.f;
#pragma unroll
    for (int j = 0; j < 4; ++j) s += (v[j].x * v[j].x + v[j].y * v[j].y) + (v[j].z * v[j].z + v[j].w * v[j].w);
    return s; }
__device__ __forceinline__ void store_row16_bf16(bf16_t* p, int lane, const f32x4 (&v)[4]) {
#pragma unroll
    for (int j = 0; j < 4; ++j) { u32x2 w; w.x = pk2(v[j].x, v[j].y); w.y = pk2(v[j].z, v[j].w); *(u32x2*)(p + 4 * lane + 256 * j) = w; }
}
__device__ __forceinline__ void rowphase0(const Frame& F) {
    const int gw = F.vcu * NWAVES + F.wave, NGW = F.G * NWAVES; const float* g0 = F.in[I_NG];
    f32x4 g[4]; load_row16(g0, F.lane, g);
    for (int row = gw; row < MT; row += NGW) {
        f32x4 v[4]; load_row16(xrow_ptr(F, row), F.lane, v);
        const float rs = rsqrtf(wave_sum(sumsq16(v)) * (1.f / D) + EPS);
#pragma unroll
        for (int j = 0; j < 4; ++j) v[j] = v[j] * rs * g[j];
        store_row16_bf16(F.P + (size_t)row * PLD + SC_XA, F.lane, v);
    }
}
__device__ __forceinline__ void rowphase1(const Frame& F) {
    const int gw = F.vcu * NWAVES + F.wave, NGW = F.G * NWAVES; const float* ng = F.in[I_NG];
    f32x4 g1[4], g2[4]; load_row16(ng + 1 * D, F.lane, g1); load_row16(ng + 2 * D, F.lane, g2);
    for (int row = gw; row < MT; row += NGW) {
        f32x4 f[4], x[4]; load_row16((const float*)(F.P + (size_t)row * PLD + SC_F), F.lane, f); load_row16(xrow_ptr(F, row), F.lane, x);
        const float rs = rsqrtf(wave_sum(sumsq16(f)) * (1.f / D) + EPS);
#pragma unroll
        for (int j = 0; j < 4; ++j) x[j] = x[j] + 0.5f * (f[j] * rs * g1[j]);
        float* o = F.out + (size_t)row * D;
#pragma unroll
        for (int j = 0; j < 4; ++j) *(f32x4*)(o + 4 * F.lane + 256 * j) = x[j];
        const float rs2 = rsqrtf(wave_sum(sumsq16(x)) * (1.f / D) + EPS);
#pragma unroll
        for (int j = 0; j < 4; ++j) x[j] = x[j] * rs2 * g2[j];
        store_row16_bf16(F.U + (size_t)row * D, F.lane, x);
    }
}
__device__ __forceinline__ void rowphase2(const Frame& F) {
    const int gw = F.vcu * NWAVES + F.wave, NGW = F.G * NWAVES; const float* ng = F.in[I_NG];
    f32x4 g3[4], g4[4]; load_row16(ng + 3 * D, F.lane, g3); load_row16(ng + 4 * D, F.lane, g4);
    for (int row = gw; row < MT; row += NGW) {
        f32x4 f[4], x[4]; load_row16((const float*)(F.P + (size_t)row * PLD + SC_T), F.lane, f); float* o = F.out + (size_t)row * D; load_row16(o, F.lane, x);
        const float rs = rsqrtf(wave_sum(sumsq16(f)) * (1.f / D) + EPS);
#pragma unroll
        for (int j = 0; j < 4; ++j) x[j] = x[j] + f[j] * rs * g3[j];
#pragma unroll
        for (int j = 0; j < 4; ++j) *(f32x4*)(o + 4 * F.lane + 256 * j) = x[j];
        const float rs2 = rsqrtf(wave_sum(sumsq16(x)) * (1.f / D) + EPS);
#pragma unroll
        for (int j = 0; j < 4; ++j) x[j] = x[j] * rs2 * g4[j];
        store_row16_bf16(F.P + (size_t)row * PLD + SC_XA, F.lane, x);
    }
}
__device__ __forceinline__ void rowphase3(const Frame& F) {
    const int gw = F.vcu * NWAVES + F.wave, NGW = F.G * NWAVES; const float* ng = F.in[I_NG];
    f32x4 g5[4]; load_row16(ng + 5 * D, F.lane, g5);
    for (int row = gw; row < MT; row += NGW) {
        f32x4 f[4], x[4]; load_row16((const float*)(F.P + (size_t)row * PLD + SC_F), F.lane, f); float* o = F.out + (size_t)row * D; load_row16(o, F.lane, x);
        const float rs = rsqrtf(wave_sum(sumsq16(f)) * (1.f / D) + EPS);
#pragma unroll
        for (int j = 0; j < 4; ++j) *(f32x4*)(o + 4 * F.lane + 256 * j) = x[j] + 0.5f * (f[j] * rs * g5[j]);
    }
}

__device__ __forceinline__ void tr_item(const float* W, int ldw, int K, int k0, int scol0, int nvalid, bf16_t* WT, int drow0, LAS float* scr, int lane) {
    const bool ok = (lane & 31) < nvalid;
#pragma unroll 8
    for (int i = 0; i < 32; ++i) { const int kk = 2 * i + (lane >> 5); scr[kk * 33 + (lane & 31)] = ok ? W[(size_t)(k0 + kk) * ldw + scol0 + (lane & 31)] : 0.f; }
    LDS_WAIT(); asm volatile("" ::: "memory");
    const int c = lane & 7;
#pragma unroll
    for (int j = 0; j < 4; ++j) { const int n = (lane >> 3) + 8 * j; const LAS float* s = scr + (8 * c) * 33 + n;
        u32x4 o; o.x = pk2(s[0 * 33], s[1 * 33]); o.y = pk2(s[2 * 33], s[3 * 33]); o.z = pk2(s[4 * 33], s[5 * 33]); o.w = pk2(s[6 * 33], s[7 * 33]);
        *(u32x4*)(WT + (size_t)(drow0 + n) * K + k0 + 8 * c) = o; }
    LDS_WAIT(); asm volatile("" ::: "memory");
}
__device__ __forceinline__ void prep_wgu(const Frame& F, const float* W, bf16_t* WT, LAS float* scr, int gw, int NGW) {
    constexpr int KB = D / 64, RB = 2 * FF / 32;
    for (int it = gw; it < KB * RB; it += NGW) { const int kb = it / RB, rb = it % RB, n0 = 32 * rb, pn = n0 >> 8, bj = (n0 >> 7) & 1, j = n0 & 127;
        tr_item(W, 2 * FF, D, 64 * kb, bj * FF + 128 * pn + j, 32, WT, n0, scr, F.lane); }
}
__device__ __forceinline__ void prep_plain(const Frame& F, const float* W, int K, int N, bf16_t* WT, LAS float* scr, int gw, int NGW) {
    const int KB = K / 64, RB = N / 32;
    for (int it = gw; it < KB * RB; it += NGW) { const int kb = it / RB, rb = it % RB; tr_item(W, N, K, 64 * kb, 32 * rb, 32, WT, 32 * rb, scr, F.lane); }
}
__device__ __forceinline__ void prep_win(const Frame& F, LAS float* scr, int gw, int NGW) {
    constexpr int KB = D / 64, RB = PLD / 32;
    for (int it = gw; it < KB * RB; it += NGW) { const int kb = it / RB, rb = it % RB, n0 = 32 * rb; int sc, nv = 32;
        if (n0 < 2048) sc = n0;
        else if (n0 < 3072) sc = 4096 + (n0 - 2048);
        else if (n0 < 3584) sc = 2048 + (n0 - 3072);
        else if (n0 < 4096) sc = 2560 + (n0 - 3584);
        else if (n0 < 5120) sc = 3072 + (n0 - 4096);
        else if (n0 < 6144) sc = 5136 + (n0 - 5120);
        else if (n0 < 7168) sc = 6160 + (n0 - 6144);
        else if (n0 == 7168) { sc = 5120; nv = 16; }
        else { sc = 0; nv = 0; }
        tr_item(F.in[I_WIN], DIN, D, 64 * kb, sc, nv, F.Win_t, n0, scr, F.lane); }
}
__device__ __forceinline__ void prep_rg(const Frame& F, LAS float* scr, int gw, int NGW) {
    for (int it = gw; it < 2 * 8 * 8; it += NGW) { const int gate = it >> 6, n = (it >> 3) & 7, sub = it & 7, kb = sub >> 2, rb = sub & 3;
        tr_item(F.in[gate ? I_RWX : I_RWA] + (size_t)n * 16384, 128, 128, 64 * kb, 32 * rb, 32, F.Wrg_t + (size_t)(gate * 8 + n) * 16384, 32 * rb, scr, F.lane); }
}
}
namespace mk {
#define MFMA16(a, b, c) __builtin_amdgcn_mfma_f32_16x16x32_bf16((a), (b), (c), 0, 0, 0)
#define MFMA32(a, b, c) __builtin_amdgcn_mfma_f32_32x32x16_bf16((a), (b), (c), 0, 0, 0)
constexpr float LOG2E = 1.4426950408889634f;
__device__ __forceinline__ float bf2f(bf16_t h) { return __builtin_bit_cast(float, (unsigned)h << 16); }
__device__ __forceinline__ float ex2(float x) { return __builtin_amdgcn_exp2f(x); }
__device__ __forceinline__ float sigm(float x) { return __builtin_amdgcn_rcpf(1.0f + ex2(-LOG2E * x)); }
__device__ __forceinline__ float softplus_(float x) { return fmaxf(x, 0.f) + log1pf(__expf(-fabsf(x))); }
__device__ __forceinline__ float gelu_tanh_(float x) { return x * sigm(1.5957691216057308f * (x + 0.044715f * x * x * x)); }
__device__ __forceinline__ float silu_(float x) { return x * sigm(x); }
__device__ __forceinline__ void unpack8(const u32x4 w, float (&f)[8]) { f[0] = bf_lo(w.x); f[1] = bf_hi(w.x); f[2] = bf_lo(w.y); f[3] = bf_hi(w.y); f[4] = bf_lo(w.z); f[5] = bf_hi(w.z); f[6] = bf_lo(w.w); f[7] = bf_hi(w.w); }
__device__ __forceinline__ u32x4 pack8(const float (&f)[8]) { u32x4 w; w.x = pk2(f[0], f[1]); w.y = pk2(f[2], f[3]); w.z = pk2(f[4], f[5]); w.w = pk2(f[6], f[7]); return w; }

constexpr size_t WS_GAGG = WS_WOUT + 2 * MiB, GAGG_FLOATS = 32768 + 128, WS_RAGG = 128 * 1024;
static_assert(WS_GAGG + (size_t)96 * GAGG_FLOATS * 4 <= 256 * MiB && WS_RAGG + 512 * 256 * 4 <= WS_P, "mixer scratch map");

template <bool SAMPLE, int MODE>
__device__ __forceinline__ void rnn_item(const Frame& F, int item) {
    constexpr int XRAW_OFF = 0, XRAW_LD = 136, XCF_OFF = 18432, XCF_LD = 132, XCB_OFF = 52224, XCB_LD = 136, HB_OFF = 69632, CW_OFF = 103424;
    constexpr bool FULL = SAMPLE || MODE == 3;
    const int tid = F.tid, lane = F.lane, wid = F.wave;
    const int seg = SAMPLE ? 0 : (item & 7), n = SAMPLE ? item : ((item >> 3) & 7), b = SAMPLE ? 0 : (item >> 6), ch0 = 128 * n;
    LAS bf16_t* XRAW = (LAS bf16_t*)(F.lds + XRAW_OFF); LAS float* XCF = (LAS float*)(F.lds + XCF_OFF); LAS bf16_t* XCB = (LAS bf16_t*)(F.lds + XCB_OFF);
    LAS float* HB = (LAS float*)(F.lds + HB_OFF); LAS float* CW = (LAS float*)(F.lds + CW_OFF);
    for (int i = tid; i < 5 * 128; i += NTHR) { const int j = i >> 7, c = i & 127; CW[i] = j < 4 ? F.in[I_CW][j * D + ch0 + c] : F.in[I_CB][ch0 + c]; }
    const int q = lane >> 4, cl = 16 * wid + (lane & 15);
    const float ba = F.in[I_RBA][ch0 + cl], bx = F.in[I_RBX][ch0 + cl], sp8 = 8.0f * softplus_(-F.in[I_LAM][ch0 + cl]), sp8l2 = sp8 * LOG2E;
    bf16x8 Bw[2][4];
#pragma unroll
    for (int g = 0; g < 2; ++g)
#pragma unroll
        for (int ks = 0; ks < 4; ++ks) Bw[g][ks] = *(const bf16x8*)(F.Wrg_t + ((size_t)(g * 8 + n) * 128 + cl) * 128 + 32 * ks + 8 * q);
    const int t5 = tid >> 3, c5 = 16 * (tid & 7);
    float* ragg = (float*)(F.ws + WS_RAGG);
    float carry = 0.f, aprod = 1.f;
    if constexpr (!SAMPLE && MODE == 3) {
        for (int s = 0; s < seg; ++s) { const float* ag = ragg + ((size_t)((b * 8 + n) * 8 + s)) * 256; carry = fmaf(ag[cl], carry, ag[128 + cl]); }
    }
    const int ntiles = SAMPLE ? 2 : 4, tile0 = SAMPLE ? 0 : 4 * seg;
    __syncthreads();
    for (int tt = 0; tt < ntiles; ++tt) {
        const int t0 = 64 * (tile0 + tt);
        const size_t row5 = SAMPLE ? (size_t)(MP + t0 + t5) : (size_t)b * TSEQ + t0 + t5;
        bf16_t* yrp = F.P + row5 * PLD + PC_YR + ch0 + c5;
        u32x4 y0 = (u32x4){0u, 0u, 0u, 0u}, y1 = y0;
        if constexpr (FULL) { y0 = *(const u32x4*)yrp; y1 = *(const u32x4*)(yrp + 8); }
        if constexpr (!SAMPLE) {
            for (int e = tid; e < 67 * 16; e += NTHR) { const int i = e >> 4, chk = e & 15, t = t0 - 3 + i; u32x4 v = (u32x4){0u, 0u, 0u, 0u};
                if (t >= 0) v = *(const u32x4*)(F.P + ((size_t)b * TSEQ + t) * PLD + PC_XR + ch0 + 8 * chk);
                *(LAS u32x4*)(XRAW + i * XRAW_LD + 8 * chk) = v; }
            __syncthreads();
            const int c0 = 8 * (tid & 15);
            float w[4][8], cb8[8];
#pragma unroll
            for (int e = 0; e < 8; ++e) { cb8[e] = CW[4 * 128 + c0 + e];
#pragma unroll
                for (int j = 0; j < 4; ++j) w[j][e] = CW[j * 128 + c0 + e]; }
#pragma unroll
            for (int rr = 0; rr < 2; ++rr) { const int t = (tid >> 4) + 32 * rr; float xc[8];
#pragma unroll
                for (int e = 0; e < 8; ++e) xc[e] = cb8[e];
#pragma unroll
                for (int j = 0; j < 4; ++j) { float x[8]; unpack8(*(const LAS u32x4*)(XRAW + (t + j) * XRAW_LD + c0), x);
#pragma unroll
                    for (int e = 0; e < 8; ++e) xc[e] = fmaf(w[j][e], x[e], xc[e]); }
                *(LAS f32x4*)(XCF + t * XCF_LD + c0) = (f32x4){xc[0], xc[1], xc[2], xc[3]}; *(LAS f32x4*)(XCF + t * XCF_LD + c0 + 4) = (f32x4){xc[4], xc[5], xc[6], xc[7]};
                *(LAS u32x4*)(XCB + t * XCB_LD + c0) = pack8(xc); }
        } else {
            const int s = t0 + t5; const bf16_t* xrp = F.P + (size_t)(MP + s) * PLD + PC_XR + ch0 + c5;
            float xr[16]; { float a8[8], b8[8]; unpack8(*(const u32x4*)xrp, a8); unpack8(*(const u32x4*)(xrp + 8), b8);
#pragma unroll
                for (int e = 0; e < 8; ++e) { xr[e] = a8[e]; xr[8 + e] = b8[e]; } }
            const float* bufp = F.in[I_SRC] + (size_t)s * 3 * D + ch0 + c5; float* csp = F.out + O_CS + (size_t)s * 3 * D + ch0 + c5;
            float xc[16];
#pragma unroll
            for (int e = 0; e < 16; ++e) xc[e] = CW[4 * 128 + c5 + e] + CW[3 * 128 + c5 + e] * xr[e];
#pragma unroll
            for (int j = 0; j < 3; ++j)
#pragma unroll
                for (int v4 = 0; v4 < 4; ++v4) { const f32x4 bv = *(const f32x4*)(bufp + j * D + 4 * v4);
#pragma unroll
                    for (int e = 0; e < 4; ++e) xc[4 * v4 + e] = fmaf(CW[j * 128 + c5 + 4 * v4 + e], bv[e], xc[4 * v4 + e]);
                    if (j >= 1) *(f32x4*)(csp + (j - 1) * D + 4 * v4) = bv; }
#pragma unroll
            for (int v4 = 0; v4 < 4; ++v4) { *(f32x4*)(csp + 2 * D + 4 * v4) = (f32x4){xr[4 * v4], xr[4 * v4 + 1], xr[4 * v4 + 2], xr[4 * v4 + 3]};
                *(LAS f32x4*)(XCF + t5 * XCF_LD + c5 + 4 * v4) = (f32x4){xc[4 * v4], xc[4 * v4 + 1], xc[4 * v4 + 2], xc[4 * v4 + 3]}; }
            { float h8[8];
#pragma unroll
              for (int hf = 0; hf < 2; ++hf) {
#pragma unroll
                for (int e = 0; e < 8; ++e) h8[e] = xc[8 * hf + e];
                *(LAS u32x4*)(XCB + t5 * XCB_LD + c5 + 8 * hf) = pack8(h8); } }
        }
        __syncthreads();
        f32x4 acc[4][2];
#pragma unroll
        for (int m = 0; m < 4; ++m) { acc[m][0] = (f32x4){0.f, 0.f, 0.f, 0.f}; acc[m][1] = (f32x4){0.f, 0.f, 0.f, 0.f}; }
#pragma unroll
        for (int m = 0; m < 4; ++m)
#pragma unroll
            for (int ks = 0; ks < 4; ++ks) { const bf16x8 a = *(const LAS bf16x8*)(XCB + (16 * m + (lane & 15)) * XCB_LD + 32 * ks + 8 * q);
                acc[m][0] = MFMA16(a, Bw[0][ks], acc[m][0]); acc[m][1] = MFMA16(a, Bw[1][ks], acc[m][1]); }
#pragma unroll
        for (int m = 0; m < 4; ++m) {
            float av[4], bv[4];
#pragma unroll
            for (int reg = 0; reg < 4; ++reg) { const int t = 16 * m + 4 * q + reg; const float xcv = XCF[t * XCF_LD + cl];
                const float r = sigm(acc[m][0][reg] + ba), ig = sigm(acc[m][1][reg] + bx);
                const float x2 = -2.0f * sp8 * r;
                const float em = -x2 * (1.0f + x2 * (0.5f + x2 * (0.16666667f + x2 * (0.041666668f + x2 * (0.0083333338f + x2 * (0.0013888889f + x2 * 0.00019841270f))))));
                float mult = __builtin_amdgcn_sqrtf(fmaxf(em, 0.f)); if (!SAMPLE && (t0 + t) == 0) mult = 1.0f;
                av[reg] = ex2(-sp8l2 * r); bv[reg] = mult * ig * xcv; }
            if constexpr (!SAMPLE) {
                float Al = 1.f, Hl = 0.f;
#pragma unroll
                for (int reg = 0; reg < 4; ++reg) { Hl = fmaf(av[reg], Hl, bv[reg]); Al *= av[reg]; }
                float hin = carry, cn = carry;
#pragma unroll
                for (int qq = 0; qq < 4; ++qq) { const float Ag = __shfl(Al, (lane & 15) + 16 * qq), Hg = __shfl(Hl, (lane & 15) + 16 * qq);
                    cn = fmaf(Ag, cn, Hg); hin = (qq < q) ? cn : hin; if (MODE == 1) aprod *= Ag; }
                carry = cn;
                if constexpr (MODE == 3) { float hv = hin;
#pragma unroll
                    for (int reg = 0; reg < 4; ++reg) { hv = fmaf(av[reg], hv, bv[reg]); HB[(16 * m + 4 * q + reg) * XCF_LD + cl] = hv; } }
            } else {
#pragma unroll
                for (int reg = 0; reg < 4; ++reg) { const int t = 16 * m + 4 * q + reg; const float h0 = F.in[I_SRH][(size_t)(t0 + t) * D + ch0 + cl];
                    HB[t * XCF_LD + cl] = fmaf(av[reg], h0, bv[reg]); }
            }
        }
        __syncthreads();
        if constexpr (FULL) {
            float h[16], yv[16], o8[8];
#pragma unroll
            for (int v4 = 0; v4 < 4; ++v4) { const f32x4 hv = *(const LAS f32x4*)(HB + t5 * XCF_LD + c5 + 4 * v4); h[4 * v4] = hv[0]; h[4 * v4 + 1] = hv[1]; h[4 * v4 + 2] = hv[2]; h[4 * v4 + 3] = hv[3]; }
            { float a8[8], b8[8]; unpack8(y0, a8); unpack8(y1, b8);
#pragma unroll
              for (int e = 0; e < 8; ++e) { yv[e] = a8[e]; yv[8 + e] = b8[e]; } }
            if constexpr (SAMPLE) { float* hsp = F.out + O_HS + (size_t)(t0 + t5) * D + ch0 + c5;
#pragma unroll
                for (int v4 = 0; v4 < 4; ++v4) *(f32x4*)(hsp + 4 * v4) = (f32x4){h[4 * v4], h[4 * v4 + 1], h[4 * v4 + 2], h[4 * v4 + 3]}; }
#pragma unroll
            for (int hf = 0; hf < 2; ++hf) {
#pragma unroll
                for (int e = 0; e < 8; ++e) o8[e] = h[8 * hf + e] * gelu_tanh_(yv[8 * hf + e]);
                *(u32x4*)(yrp + 8 * hf) = pack8(o8); }
            if constexpr (!SAMPLE) { if (tile0 + tt == 31 && t5 >= 61) { float* cpp = F.out + O_CP + ((size_t)b * 3 + (t5 - 61)) * D + ch0 + c5;
#pragma unroll
                for (int e = 0; e < 16; ++e) cpp[e] = bf2f(XRAW[(t5 + 3) * XRAW_LD + c5 + e]); } }
        }
    }
    if constexpr (!SAMPLE && MODE == 1) { if (q == 0) { float* ag = ragg + (size_t)item * 256; ag[cl] = aprod; ag[128 + cl] = carry; } }
    if constexpr (!SAMPLE && MODE == 3) { if (seg == 7 && q == 0) F.out[O_HP + (size_t)b * D + ch0 + cl] = carry; }
    __syncthreads();
}

__device__ __forceinline__ int crow(int reg, int h) { return (reg & 3) + 8 * (reg >> 2) + 4 * h; }
__device__ __forceinline__ bf16x8 pack_step(const f32x16& x, int s) {
    u32x4 p; p.x = pk2(x[8 * s], x[8 * s + 1]); p.y = pk2(x[8 * s + 2], x[8 * s + 3]); p.z = pk2(x[8 * s + 4], x[8 * s + 5]); p.w = pk2(x[8 * s + 6], x[8 * s + 7]);
    return __builtin_bit_cast(bf16x8, p);
}
template <int MODE>
__device__ __forceinline__ void gla_item(const Frame& F, int item) {
    constexpr int VRAW = 0, VRAW_LD = 264, LRS = 33792, QI = 37888, QK_LD = 136, KI = 55296, OBUF = 0, KET = 72704, T_LD = 72, VT = 91136, ATT = 128000, SEG = 137216, DEC = 139264;
    static_assert(DEC + 512 <= MISC_OFF, "GLA LDS map");
    constexpr bool FULL = (MODE == 3);
    const int tid = F.tid, lane = F.lane, w = F.wave;
    const int j = item & 3, hh = (item >> 2) & 3, b = item >> 4; const size_t rowbase = (size_t)b * TSEQ;
    LAS bf16_t* sVRAW = (LAS bf16_t*)(F.lds + VRAW); LAS float* sLR = (LAS float*)(F.lds + LRS); LAS bf16_t* sQI = (LAS bf16_t*)(F.lds + QI); LAS bf16_t* sKI = (LAS bf16_t*)(F.lds + KI);
    LAS float* sO = (LAS float*)(F.lds + OBUF); LAS bf16_t* sKET = (LAS bf16_t*)(F.lds + KET); LAS bf16_t* sVT = (LAS bf16_t*)(F.lds + VT); LAS bf16_t* sATT = (LAS bf16_t*)(F.lds + ATT);
    LAS float* sSEG = (LAS float*)(F.lds + SEG); LAS float* sDEC = (LAS float*)(F.lds + DEC);
    const int kk = tid & 127, seg = tid >> 7;
    float wl[16];
#pragma unroll
    for (int r = 0; r < 16; ++r) wl[r] = F.in[I_WLR][r * 512 + hh * 128 + kk];
    const float bias = F.in[I_BLR][hh * 128 + kk];
    const int r32 = lane & 31, h = lane >> 5, q = lane >> 4;
    const f32x4 gn = *(const f32x4*)(F.in[I_GNG] + 4 * lane);
    float* gagg = (float*)(F.ws + WS_GAGG);
    f32x16 S[4];
#pragma unroll
    for (int kb = 0; kb < 4; ++kb)
#pragma unroll
        for (int i = 0; i < 16; ++i) S[kb][i] = 0.f;
    float dsum = 0.f;
    if constexpr (FULL) {
        for (int s = 0; s < j; ++s) { const float* ag = gagg + (size_t)((b * 4 + hh) * 3 + s) * GAGG_FLOATS;
            __syncthreads();
            if (tid < 128) sDEC[tid] = ag[32768 + tid];
            __syncthreads();
#pragma unroll
            for (int kb = 0; kb < 4; ++kb)
#pragma unroll
                for (int g4 = 0; g4 < 4; ++g4) { const f32x4 kv = *(const f32x4*)(ag + ((size_t)((w * 4 + kb) * 4 + g4)) * 256 + 4 * lane); const f32x4 dd = *(const LAS f32x4*)(sDEC + 32 * kb + 8 * g4 + 4 * h);
#pragma unroll
                    for (int e = 0; e < 4; ++e) S[kb][4 * g4 + e] = fmaf(S[kb][4 * g4 + e], dd[e], kv[e]); } }
    }
    __syncthreads();
    for (int cn = 8 * j; cn < 8 * j + 8; ++cn) {
        const size_t row0 = rowbase + 64 * cn;
#pragma unroll
        for (int i = 0; i < 4; ++i) { const int e = tid + NTHR * i, row = e >> 5, c16 = e & 31;
            *(LAS u32x4*)(sVRAW + row * VRAW_LD + 8 * c16) = *(const u32x4*)(F.P + (row0 + row) * PLD + PC_V + 256 * hh + 8 * c16); }
        if (tid < 128) { const int row = tid >> 1, hf = tid & 1; float f[8]; unpack8(*(const u32x4*)(F.P + (row0 + row) * PLD + PC_LR + 8 * hf), f);
            *(LAS f32x4*)(sLR + row * 16 + 8 * hf) = (f32x4){f[0], f[1], f[2], f[3]}; *(LAS f32x4*)(sLR + row * 16 + 8 * hf + 4) = (f32x4){f[4], f[5], f[6], f[7]}; }
        bf16_t qv[16], kv[16];
#pragma unroll
        for (int i = 0; i < 16; ++i) { const bf16_t* p = F.P + (row0 + 16 * seg + i) * PLD + 128 * hh + kk; kv[i] = p[PC_K]; qv[i] = FULL ? p[PC_Q] : (bf16_t)0; }
        u32x2 og[8];
        if constexpr (FULL) {
#pragma unroll
            for (int jj = 0; jj < 8; ++jj) og[jj] = *(const u32x2*)(F.P + (row0 + 8 * w + jj) * PLD + PC_OG + 256 * hh + 4 * lane); }
        __syncthreads();
        float c[16]; float run = 0.f;
#pragma unroll
        for (int i = 0; i < 16; ++i) { const LAS float* lr = sLR + (16 * seg + i) * 16; float x = bias;
#pragma unroll
            for (int r4 = 0; r4 < 4; ++r4) { const f32x4 lv = *(const LAS f32x4*)(lr + 4 * r4); x = fmaf(lv[0], wl[4 * r4], x); x = fmaf(lv[1], wl[4 * r4 + 1], x); x = fmaf(lv[2], wl[4 * r4 + 2], x); x = fmaf(lv[3], wl[4 * r4 + 3], x); }
            x = fminf(fmaxf(x, -80.f), 80.f);
            run -= __builtin_amdgcn_logf(1.0f + ex2(-LOG2E * x)) * (1.0f / 16.0f);
            c[i] = run; }
        sSEG[seg * 128 + kk] = run;
        { const int dv = tid & 255, hf = tid >> 8;
#pragma unroll
          for (int s8 = 0; s8 < 4; ++s8) { const int s = 32 * hf + 8 * s8; u32x4 wv; unsigned t[8];
#pragma unroll
              for (int jj = 0; jj < 8; ++jj) t[jj] = sVRAW[(s + jj) * VRAW_LD + dv];
              wv.x = t[0] | (t[1] << 16); wv.y = t[2] | (t[3] << 16); wv.z = t[4] | (t[5] << 16); wv.w = t[6] | (t[7] << 16);
              *(LAS u32x4*)(sVT + dv * T_LD + s) = wv; } }
        __syncthreads();
        { float off = 0.f, tot = 0.f;
#pragma unroll
          for (int s2 = 0; s2 < 4; ++s2) { const float v = sSEG[s2 * 128 + kk]; tot += v; off += (s2 < seg) ? v : 0.f; }
          const float dec = ex2(tot);
          if (seg == 0) { sDEC[kk] = dec; dsum += tot; }
          float ke[16];
#pragma unroll
          for (int i = 0; i < 16; ++i) { const int t = 16 * seg + i; const float bc = off + c[i]; const float eb = ex2(bc), ei = __builtin_amdgcn_rcpf(eb); const float kf = bf2f(kv[i]) * ei;
              ke[i] = kf * dec;
              if constexpr (FULL) { sQI[t * QK_LD + kk] = (bf16_t)(pk2(bf2f(qv[i]) * 0.08838834764831845f * eb, 0.f) & 0xffffu); sKI[t * QK_LD + kk] = (bf16_t)(pk2(kf, 0.f) & 0xffffu); } }
          { float a8[8], b8[8];
#pragma unroll
            for (int e = 0; e < 8; ++e) { a8[e] = ke[e]; b8[e] = ke[8 + e]; }
            *(LAS u32x4*)(sKET + kk * T_LD + 16 * seg) = pack8(a8); *(LAS u32x4*)(sKET + kk * T_LD + 16 * seg + 8) = pack8(b8); } }
        __syncthreads();
        if constexpr (FULL) {
#pragma unroll
            for (int u = 0; u < 2; ++u) { const int T = 2 * w + u, ti = T >> 2, si = T & 3; f32x4 cc = (f32x4){0.f, 0.f, 0.f, 0.f};
                if (si <= ti) {
#pragma unroll
                    for (int ks = 0; ks < 4; ++ks) { const bf16x8 a = *(const LAS bf16x8*)(sKI + (16 * si + (lane & 15)) * QK_LD + 32 * ks + 8 * q), bq = *(const LAS bf16x8*)(sQI + (16 * ti + (lane & 15)) * QK_LD + 32 * ks + 8 * q);
                        cc = MFMA16(a, bq, cc); } }
                const int t = 16 * ti + (lane & 15), s0 = 16 * si + 4 * q; float v[4];
#pragma unroll
                for (int reg = 0; reg < 4; ++reg) v[reg] = (s0 + reg <= t) ? cc[reg] : 0.f;
                u32x2 wv; wv.x = pk2(v[0], v[1]); wv.y = pk2(v[2], v[3]); *(LAS u32x2*)(sATT + t * T_LD + s0) = wv; }
            __syncthreads();
        }
        bf16x8 vf[4];
#pragma unroll
        for (int st = 0; st < 4; ++st) vf[st] = *(const LAS bf16x8*)(sVT + (32 * w + r32) * T_LD + 16 * st + 8 * h);
        f32x16 o[2];
        if constexpr (FULL) {
#pragma unroll
            for (int i = 0; i < 16; ++i) { o[0][i] = 0.f; o[1][i] = 0.f; }
#pragma unroll
            for (int kb = 0; kb < 4; ++kb)
#pragma unroll
                for (int s2 = 0; s2 < 2; ++s2) { const bf16x8 Bf = pack_step(S[kb], s2);
#pragma unroll
                    for (int tb = 0; tb < 2; ++tb) { const LAS bf16_t* qp = sQI + (32 * tb + r32) * QK_LD + 32 * kb + 16 * s2 + 4 * h; const u32x2 lo = *(const LAS u32x2*)qp, hi = *(const LAS u32x2*)(qp + 8);
                        const u32x4 af = (u32x4){lo.x, lo.y, hi.x, hi.y}; o[tb] = MFMA32(__builtin_bit_cast(bf16x8, af), Bf, o[tb]); } }
#pragma unroll
            for (int tb = 0; tb < 2; ++tb)
#pragma unroll
                for (int st = 0; st < 4; ++st) { if (tb == 0 && st >= 2) continue; const bf16x8 af = *(const LAS bf16x8*)(sATT + (32 * tb + r32) * T_LD + 16 * st + 8 * h); o[tb] = MFMA32(af, vf[st], o[tb]); }
        }
#pragma unroll
        for (int kb = 0; kb < 4; ++kb) {
#pragma unroll
            for (int g4 = 0; g4 < 4; ++g4) { const f32x4 dd = *(const LAS f32x4*)(sDEC + 32 * kb + 8 * g4 + 4 * h);
#pragma unroll
                for (int e = 0; e < 4; ++e) S[kb][4 * g4 + e] *= dd[e]; }
#pragma unroll
            for (int st = 0; st < 4; ++st) { const bf16x8 af = *(const LAS bf16x8*)(sKET + (32 * kb + r32) * T_LD + 16 * st + 8 * h); S[kb] = MFMA32(af, vf[st], S[kb]); } }
        __syncthreads();
        if constexpr (FULL) {
#pragma unroll
            for (int tb = 0; tb < 2; ++tb)
#pragma unroll
                for (int i = 0; i < 16; ++i) sO[(32 * tb + crow(i, h)) * 256 + 32 * w + r32] = o[tb][i];
            __syncthreads();
#pragma unroll
            for (int jj = 0; jj < 8; ++jj) { const int t = 8 * w + jj; const f32x4 v = *(const LAS f32x4*)(sO + t * 256 + 4 * lane);
                const float rs = __builtin_amdgcn_rsqf(wave_sum((v[0] * v[0] + v[1] * v[1]) + (v[2] * v[2] + v[3] * v[3])) * (1.0f / 256.0f) + EPS);
                const float g0 = bf_lo(og[jj].x), g1 = bf_hi(og[jj].x), g2 = bf_lo(og[jj].y), g3 = bf_hi(og[jj].y);
                u32x2 wv; wv.x = pk2(v[0] * rs * gn[0] * silu_(g0), v[1] * rs * gn[1] * silu_(g1)); wv.y = pk2(v[2] * rs * gn[2] * silu_(g2), v[3] * rs * gn[3] * silu_(g3));
                *(u32x2*)(F.P + (row0 + t) * PLD + PC_OG + 256 * hh + 4 * lane) = wv; }
            __syncthreads();
        }
    }
    if constexpr (!FULL) {
        float* ag = gagg + (size_t)((b * 4 + hh) * 3 + j) * GAGG_FLOATS;
#pragma unroll
        for (int kb = 0; kb < 4; ++kb)
#pragma unroll
            for (int g4 = 0; g4 < 4; ++g4) *(f32x4*)(ag + ((size_t)((w * 4 + kb) * 4 + g4)) * 256 + 4 * lane) = (f32x4){S[kb][4 * g4], S[kb][4 * g4 + 1], S[kb][4 * g4 + 2], S[kb][4 * g4 + 3]};
        if (seg == 0) ag[32768 + kk] = ex2(dsum);
    } else if (j == 3) {
        float* sp = F.out + O_SP + (size_t)(b * 4 + hh) * 128 * 256;
#pragma unroll
        for (int kb = 0; kb < 4; ++kb)
#pragma unroll
            for (int i = 0; i < 16; ++i) sp[(size_t)(32 * kb + crow(i, h)) * 256 + 32 * w + r32] = S[kb][i];
    }
    __syncthreads();
}

__device__ __forceinline__ void gla_sample_item(const Frame& F, int item) {
    constexpr int SQ = 0, SK = 512, SE = 1024, RED = 2048;
    const int tid = F.tid, lane = F.lane, w = F.wave; const int hh = item & 3, s = item >> 2;
    LAS float* sq = (LAS float*)(F.lds + SQ); LAS float* sk = (LAS float*)(F.lds + SK); LAS float* se = (LAS float*)(F.lds + SE); LAS float* red = (LAS float*)(F.lds + RED);
    const bf16_t* Prow = F.P + (size_t)(MP + s) * PLD;
    if (tid < 128) { float x = F.in[I_BLR][hh * 128 + tid];
#pragma unroll
        for (int r = 0; r < 16; ++r) x = fmaf(bf2f(Prow[PC_LR + r]), F.in[I_WLR][r * 512 + hh * 128 + tid], x);
        se[tid] = __expf(-softplus_(-x) * (1.0f / 16.0f)); sq[tid] = bf2f(Prow[PC_Q + 128 * hh + tid]) * 0.08838834764831845f; sk[tid] = bf2f(Prow[PC_K + 128 * hh + tid]); }
    __syncthreads();
    const u32x2 vw = *(const u32x2*)(Prow + PC_V + 256 * hh + 4 * lane); const f32x4 v4 = (f32x4){bf_lo(vw.x), bf_hi(vw.x), bf_lo(vw.y), bf_hi(vw.y)};
    const float* S0 = F.in[I_SGLA] + ((size_t)(s * 4 + hh) * 128 + 16 * w) * 256 + 4 * lane; float* S1 = F.out + O_SS + ((size_t)(s * 4 + hh) * 128 + 16 * w) * 256 + 4 * lane;
    f32x4 o4 = (f32x4){0.f, 0.f, 0.f, 0.f};
    f32x4 sv[16];
#pragma unroll
    for (int jj = 0; jj < 16; ++jj) sv[jj] = __builtin_nontemporal_load((const f32x4*)(S0 + jj * 256));
#pragma unroll
    for (int jj = 0; jj < 16; ++jj) { const int k = 16 * w + jj; const f32x4 sn = sv[jj] * se[k] + v4 * sk[k]; __builtin_nontemporal_store(sn, (f32x4*)(S1 + jj * 256)); o4 = o4 + sn * sq[k]; }
    *(LAS f32x4*)(red + w * 256 + 4 * lane) = o4;
    __syncthreads();
    if (w == 0) { f32x4 o = (f32x4){0.f, 0.f, 0.f, 0.f};
#pragma unroll
        for (int ww = 0; ww < 8; ++ww) o = o + *(const LAS f32x4*)(red + ww * 256 + 4 * lane);
        const float rs = rsqrtf(wave_sum((o[0] * o[0] + o[1] * o[1]) + (o[2] * o[2] + o[3] * o[3])) * (1.0f / 256.0f) + EPS);
        const f32x4 gn = *(const f32x4*)(F.in[I_GNG] + 4 * lane); bf16_t* ogp = F.P + (size_t)(MP + s) * PLD + PC_OG + 256 * hh + 4 * lane; const u32x2 ogw = *(const u32x2*)ogp;
        u32x2 wv; wv.x = pk2(o[0] * rs * gn[0] * silu_(bf_lo(ogw.x)), o[1] * rs * gn[1] * silu_(bf_hi(ogw.x))); wv.y = pk2(o[2] * rs * gn[2] * silu_(bf_lo(ogw.y)), o[3] * rs * gn[3] * silu_(bf_hi(ogw.y)));
        *(u32x2*)ogp = wv; }
    __syncthreads();
}
}
namespace mk {
constexpr int N_PHASES = 13;
__global__ void __launch_bounds__(NTHR, 2) mega_fwd(Args args) {
    extern __shared__ __attribute__((aligned(16))) unsigned char lds_raw[];
    Frame F;
    F.lds = (LAS unsigned char*)lds_raw;
    F.tid = threadIdx.x; F.lane = F.tid & 63; F.wave = __builtin_amdgcn_readfirstlane(F.tid >> 6);
    F.G = gridDim.x; { const int bx = blockIdx.x; F.vcu = (F.G % 8 == 0) ? (bx % 8) * (F.G / 8) + bx / 8 : bx; }
#pragma unroll
    for (int i = 0; i < 24; ++i) F.in[i] = args.in[i];
    F.out = args.out; F.ws = args.ws;
    F.P = (bf16_t*)(args.ws + WS_P);
    unsigned char* ssr = (unsigned char*)(args.out + O_SS);
    F.U = (bf16_t*)(ssr + SS_U); F.Win_t = (bf16_t*)(ssr + SS_WIN); F.Wgu1_t = (bf16_t*)(ssr + SS_WGU1); F.Wd1_t = (bf16_t*)(ssr + SS_WD1);
    F.Wrg_t = (bf16_t*)(args.ws + WS_WRG); F.Wbr_t = (bf16_t*)(args.ws + WS_WBR); F.Wbg_t = (bf16_t*)(args.ws + WS_WBG); F.Wout_t = (bf16_t*)(args.ws + WS_WOUT);
    F.Wgu2_t = (bf16_t*)(args.ws + WS_WGU2); F.Wd2_t = (bf16_t*)(args.ws + WS_WD2);
    volatile LAS unsigned* MISC = (volatile LAS unsigned*)(F.lds + MISC_OFF);
    for (int u = F.tid; u < 128; u += NTHR) MISC[u] = 0u;
    __syncthreads();
    const int lo = args.ph_lo, hi = args.ph_hi;
    XcdBarrier bar; bar.bar = (unsigned*)(args.ws + WS_CTL) + CW_BAR; bar.x = 0; bar.st = nullptr;
    if (hi - lo > 1) bar = xcd_barrier_post((unsigned*)(args.ws + WS_CTL) + CW_BAR, MISC + 8);
#define IN(k) (lo <= (k) && (k) < hi)
#ifdef TIME_PHASE
    unsigned long long tp0 = 0, tp1 = 0;
#define SEAM(k) do { if (IN(k) && IN((k) + 1)) xcd_barrier(bar); if ((k) + 1 == TIME_PHASE) tp0 = __builtin_amdgcn_s_memrealtime(); if ((k) == TIME_PHASE) tp1 = __builtin_amdgcn_s_memrealtime(); } while (0)
#else
#define SEAM(k) do { if (IN(k) && IN((k) + 1)) xcd_barrier(bar); } while (0)
#endif
    const int gw = F.vcu * NWAVES + F.wave, NGW = F.G * NWAVES;
    LAS float* scr = (LAS float*)(F.lds + F.wave * 16384);
    constexpr bool AL = true, SP = true;

    if (IN(0)) {
        prep_wgu(F, F.in[I_F1GU], F.Wgu1_t, scr, gw, NGW);
        prep_plain(F, F.in[I_F1D], FF, D, F.Wd1_t, scr, gw, NGW);
        prep_win(F, scr, gw, NGW);
        prep_rg(F, scr, gw, NGW);
        prep_plain(F, F.in[I_WBR], D, D, F.Wbr_t, scr, gw, NGW);
        prep_plain(F, F.in[I_WBG], D, D, F.Wbg_t, scr, gw, NGW);
        prep_plain(F, F.in[I_WOUT], D, D, F.Wout_t, scr, gw, NGW);
        rowphase0(F);
    }
    SEAM(0);
    if (IN(1)) {
        pg8::Gemm g{F.P + SC_XA, PLD, F.Wgu1_t, MPAD, 2 * FF, D}; pg8::StaticOrder S; S.init(MPAD, 2 * FF, F.G, (int)blockIdx.x);
        pg8::EpiSwiGLU E{F.P + SC_H, PLD};
        pg8::gemm_phase<pg8::EpiSwiGLU, pg8::StaticOrder, AL, SP>(F.lds, g, S, E);
    }
    SEAM(1);
    if (IN(2)) {
        pg8::Gemm g{F.P + SC_H, PLD, F.Wd1_t, MPAD, D, FF}; pg8::StaticOrder S; S.init(MPAD, D, F.G, (int)blockIdx.x);
        pg8::EpiF32 E{(float*)(F.P + SC_F), PLD / 2};
        pg8::gemm_phase<pg8::EpiF32, pg8::StaticOrder, AL, SP>(F.lds, g, S, E);
    }
    SEAM(2);
    if (IN(3)) rowphase1(F);
    SEAM(3);
    if (IN(4)) {
        pg8::Gemm g{F.U, D, F.Win_t, MPAD, PLD, D}; pg8::StaticOrder S; S.init(MPAD, PLD, F.G, (int)blockIdx.x);
        pg8::EpiBf16 E{F.P, PLD};
        pg8::gemm_phase<pg8::EpiBf16, pg8::StaticOrder, AL, SP>(F.lds, g, S, E);
    }
    SEAM(4);
    if (IN(5)) {
        const int c = F.vcu;
        if (c < 96) gla_item<1>(F, (c / 3) * 4 + (c % 3));
        else {
            for (int i = c - 96; i < 448; i += F.G - 96) rnn_item<false, 1>(F, (i / 7) * 8 + (i % 7));
            for (int i = c - 96; i < 2 * MS; i += F.G - 96) gla_sample_item(F, i);
        }
    }
    SEAM(5);
    if (IN(6)) {
        const int c = F.vcu;
        if (c < 128) gla_item<3>(F, c);
        else {
            for (int i = c - 128; i < 512; i += F.G - 128) rnn_item<false, 3>(F, i);
            if (c < 136) rnn_item<true, 3>(F, c - 128);
            for (int i = 2 * MS + c - 128; i < 4 * MS; i += F.G - 128) gla_sample_item(F, i);
        }
    }
    SEAM(6);
    if (IN(7)) {
        { pg8::Gemm g{F.P + PC_YR, PLD, F.Wbr_t, MPAD, D, D}; pg8::StaticOrder S; S.init(MPAD, D, F.G, (int)blockIdx.x);
          pg8::EpiGateA E{F.P + PC_GA, PLD, (float*)(F.P + SC_T), PLD / 2};
          pg8::gemm_phase<pg8::EpiGateA, pg8::StaticOrder, AL, SP>(F.lds, g, S, E); }
        { pg8::Gemm g{F.P + PC_OG, PLD, F.Wbg_t, MPAD, D, D}; pg8::StaticOrder S; S.init(MPAD, D, F.G, (int)blockIdx.x);
          pg8::EpiGateB E{F.P + PC_GB, PLD, (const float*)(F.P + SC_T), PLD / 2, F.P + SC_XA, PLD};
          pg8::gemm_phase<pg8::EpiGateB, pg8::StaticOrder, AL, SP>(F.lds, g, S, E); }
    }
    SEAM(7);
    if (IN(8)) {
        pg8::Gemm g{F.P + SC_XA, PLD, F.Wout_t, MPAD, D, D}; pg8::StaticOrder S; S.init(MPAD, D, F.G, (int)blockIdx.x);
        pg8::EpiF32 E{(float*)(F.P + SC_T), PLD / 2};
        pg8::gemm_phase<pg8::EpiF32, pg8::StaticOrder, AL, SP>(F.lds, g, S, E);
    }
    SEAM(8);
    if (IN(9)) {
        prep_wgu(F, F.in[I_F2GU], F.Wgu2_t, scr, gw, NGW);
        prep_plain(F, F.in[I_F2D], FF, D, F.Wd2_t, scr, gw, NGW);
        rowphase2(F);
    }
    SEAM(9);
    if (IN(10)) {
        pg8::Gemm g{F.P + SC_XA, PLD, F.Wgu2_t, MPAD, 2 * FF, D}; pg8::StaticOrder S; S.init(MPAD, 2 * FF, F.G, (int)blockIdx.x);
        pg8::EpiSwiGLU E{F.P + SC_H, PLD};
        pg8::gemm_phase<pg8::EpiSwiGLU, pg8::StaticOrder, AL, SP>(F.lds, g, S, E);
    }
    SEAM(10);
    if (IN(11)) {
        pg8::Gemm g{F.P + SC_H, PLD, F.Wd2_t, MPAD, D, FF}; pg8::StaticOrder S; S.init(MPAD, D, F.G, (int)blockIdx.x);
        pg8::EpiF32 E{(float*)(F.P + SC_F), PLD / 2};
        pg8::gemm_phase<pg8::EpiF32, pg8::StaticOrder, AL, SP>(F.lds, g, S, E);
    }
    SEAM(11);
    if (IN(12)) rowphase3(F);
#ifdef TIME_PHASE
    if (blockIdx.x == 0) { const unsigned long long te = __builtin_amdgcn_s_memrealtime(), wait = (unsigned long long)(TIME_MULT) * (tp1 - tp0); while (__builtin_amdgcn_s_memrealtime() - te < wait) __builtin_amdgcn_s_sleep(8); }
#endif
#undef IN
#undef SEAM
}

inline int launch(void* const* d_in, void* d_out, void* d_ws, hipStream_t stream, int n_launches, int ph_lo = 0, int ph_hi = 0) {
    static int grid = 0;
    if (grid == 0) {
        int dev = 0, cus = 0, per_cu = 0;
        if (hipGetDevice(&dev) != hipSuccess || hipDeviceGetAttribute(&cus, hipDeviceAttributeMultiprocessorCount, dev) != hipSuccess) { grid = -1; return -1; }
        if (hipFuncSetAttribute((const void*)mega_fwd, hipFuncAttributeMaxDynamicSharedMemorySize, LDS_BYTES) != hipSuccess) { grid = -1; return -1; }
        if (hipOccupancyMaxActiveBlocksPerMultiprocessor(&per_cu, (const void*)mega_fwd, NTHR, LDS_BYTES) != hipSuccess || per_cu < 1) per_cu = 1;
        (void)hipGetLastError();
        grid = cus;
    }
    if (grid < 0) return -1;
    Args a{};
    for (int i = 0; i < 24; ++i) a.in[i] = (const float*)d_in[i];
    a.out = (float*)d_out; a.ws = (unsigned char*)d_ws;
    if (n_launches == 0) { a.ph_lo = ph_lo; a.ph_hi = ph_hi; hipLaunchKernelGGL(mega_fwd, dim3(grid), dim3(NTHR), LDS_BYTES, stream, a); return 0; }
    (void)hipMemsetAsync((char*)d_ws + WS_CTL, 0, CTL_ZERO_BYTES, stream);
    if (n_launches == 1) { a.ph_lo = 0; a.ph_hi = N_PHASES; hipLaunchKernelGGL(mega_fwd, dim3(grid), dim3(NTHR), LDS_BYTES, stream, a); }
    else for (int p = 0; p < N_PHASES; ++p) { a.ph_lo = p; a.ph_hi = p + 1; hipLaunchKernelGGL(mega_fwd, dim3(grid), dim3(NTHR), LDS_BYTES, stream, a); }
    return 0;
}
}
#ifndef MK_NL
#define MK_NL 1
#endif
extern "C" void kernel_launch(void* const* d_in, const int* in_sizes, int n_in,
                              void* d_out, int out_size, void* d_ws, size_t ws_size,
                              hipStream_t stream) {
    mk::launch(d_in, d_out, d_ws, stream, MK_NL);
}
```

```cpp
#include <hip/hip_runtime.h>
#include <cstdio>
#include <cstdint>

#ifndef DBG_STATIC_FLOATS
#define DBG_STATIC_FLOATS 16
#endif
__device__ float g_static[DBG_STATIC_FLOATS];
#define STATIC_TAG (1ull << 62)
template <class T> __device__ __forceinline__ T* fx(T* p) { const unsigned long long v = (unsigned long long)p; return (v & STATIC_TAG) ? (T*)((char*)g_static + (v & (STATIC_TAG - 1))) : p; }
inline float* static_ptr(size_t float_off) { return (float*)(STATIC_TAG | (unsigned long long)(float_off * 4)); }
namespace nv {
constexpr int D = 1024, FF = 2816, DIN = 7184, TSEQ = 2048, NB = 8, NS = 128;
constexpr int C_XR = 0, C_YR = 1024, C_Q = 2048, C_K = 2560, C_V = 3072, C_OG = 4096, C_LR = 5120, C_GA = 5136, C_GB = 6160;
constexpr float EPS = 1e-6f;
constexpr size_t O_YP = 0, O_YS = 16777216, O_HP = 16908288, O_CP = 16916480, O_SP = 16941056, O_HS = 17989632, O_CS = 18120704, O_SS = 18513920;

__device__ __forceinline__ float sigmoidf_(float x) { return 1.f / (1.f + expf(-x)); }
__device__ __forceinline__ float siluf_(float x) { return x / (1.f + expf(-x)); }
__device__ __forceinline__ float softplusf_(float x) { return fmaxf(x, 0.f) + log1pf(expf(-fabsf(x))); }
__device__ __forceinline__ float logsigmoidf_(float x) { return -softplusf_(-x); }
__device__ __forceinline__ float gelu_tanhf_(float x) { const float c = 0.7978845608028654f; return 0.5f * x * (1.f + tanhf(c * (x + 0.044715f * x * x * x))); }

__device__ __forceinline__ float block_sum256(float v, float* red) {
#pragma unroll
    for (int o = 32; o > 0; o >>= 1) v += __shfl_xor(v, o);
    __syncthreads();
    if ((threadIdx.x & 63) == 0) red[threadIdx.x >> 6] = v;
    __syncthreads();
    return red[0] + red[1] + red[2] + red[3];
}
__global__ void k_rmsnorm(const float* x, const float* g, float* y) { x = fx(x); g = fx(g); y = fx(y);
    __shared__ float red[4];
    const size_t r = blockIdx.x; const float* xr = x + r * D; float v[4]; float s = 0.f;
#pragma unroll
    for (int j = 0; j < 4; ++j) { v[j] = xr[threadIdx.x + 256 * j]; s += v[j] * v[j]; }
    const float tot = block_sum256(s, red); const float rs = rsqrtf(tot / D + EPS);
#pragma unroll
    for (int j = 0; j < 4; ++j) y[r * D + threadIdx.x + 256 * j] = v[j] * rs * g[threadIdx.x + 256 * j];
}
__global__ void k_resnorm(const float* base, const float* f, const float* g, float scale, float* out) { base = fx(base); f = fx(f); g = fx(g); out = fx(out);
    __shared__ float red[4];
    const size_t r = blockIdx.x; const float* fr = f + r * D; float v[4]; float s = 0.f;
#pragma unroll
    for (int j = 0; j < 4; ++j) { v[j] = fr[threadIdx.x + 256 * j]; s += v[j] * v[j]; }
    const float tot = block_sum256(s, red); const float rs = rsqrtf(tot / D + EPS);
#pragma unroll
    for (int j = 0; j < 4; ++j) { const int c = threadIdx.x + 256 * j; out[r * D + c] = base[r * D + c] + scale * (v[j] * rs * g[c]); }
}
__global__ void __launch_bounds__(256) k_gemm(const float* A, int lda, const float* B, int ldb, float* C, int ldc, int M, int N, int K, size_t sA, size_t sB, size_t sC) { A = fx(A); B = fx(B); C = fx(C);
    __shared__ float As[16][64 + 1], Bs[16][64 + 1];
    A += blockIdx.z * sA; B += blockIdx.z * sB; C += blockIdx.z * sC;
    const int m0 = blockIdx.y * 64, n0 = blockIdx.x * 64, tx = threadIdx.x & 15, ty = threadIdx.x >> 4;
    float acc[4][4];
#pragma unroll
    for (int i = 0; i < 4; ++i)
#pragma unroll
        for (int j = 0; j < 4; ++j) acc[i][j] = 0.f;
    for (int k0 = 0; k0 < K; k0 += 16) {
#pragma unroll
        for (int i = 0; i < 4; ++i) { const int e = threadIdx.x + 256 * i; const int m = e >> 4, k = e & 15; As[k][m] = A[(size_t)(m0 + m) * lda + k0 + k]; }
#pragma unroll
        for (int i = 0; i < 4; ++i) { const int e = threadIdx.x + 256 * i; const int k = e >> 6, n = e & 63; Bs[k][n] = (n0 + n < N) ? B[(size_t)(k0 + k) * ldb + n0 + n] : 0.f; }
        __syncthreads();
#pragma unroll
        for (int k = 0; k < 16; ++k) { float a[4], b[4];
#pragma unroll
            for (int i = 0; i < 4; ++i) { a[i] = As[k][ty * 4 + i]; b[i] = Bs[k][tx * 4 + i]; }
#pragma unroll
            for (int i = 0; i < 4; ++i)
#pragma unroll
                for (int j = 0; j < 4; ++j) acc[i][j] = fmaf(a[i], b[j], acc[i][j]); }
        __syncthreads();
    }
#pragma unroll
    for (int i = 0; i < 4; ++i)
#pragma unroll
        for (int j = 0; j < 4; ++j) { const int n = n0 + tx * 4 + j; if (n < N) C[(size_t)(m0 + ty * 4 + i) * ldc + n] = acc[i][j]; }
}
__global__ void k_swiglu(const float* gu, float* h, size_t n) { gu = fx(gu); h = fx(h);
    for (size_t i = blockIdx.x * (size_t)blockDim.x + threadIdx.x; i < n; i += (size_t)gridDim.x * blockDim.x) { const size_t r = i / FF, j = i % FF; h[i] = siluf_(gu[r * (2 * FF) + j]) * gu[r * (2 * FF) + FF + j]; }
}
__global__ void k_conv(const float* P, const float* buf, const float* w, const float* b, float* xc, float* conv_new, int T, int nseq) { P = fx(P); buf = fx(buf); w = fx(w); b = fx(b); xc = fx(xc); conv_new = fx(conv_new);
    const size_t n = (size_t)nseq * T * D;
    for (size_t i = blockIdx.x * (size_t)blockDim.x + threadIdx.x; i < n; i += (size_t)gridDim.x * blockDim.x) {
        const int c = (int)(i % D); const size_t row = i / D; const int t = (int)(row % T); const int seq = (int)(row / T);
        float y = b[c];
#pragma unroll
        for (int j = 0; j < 4; ++j) { const int idx = t + j - 3; float xv;
            if (idx >= 0) xv = P[((size_t)seq * T + idx) * DIN + C_XR + c]; else xv = buf ? buf[((size_t)seq * 3 + (3 + idx)) * D + c] : 0.f;
            y += xv * w[j * D + c]; }
        xc[i] = y;
    }
    const size_t n2 = (size_t)nseq * 3 * D;
    for (size_t i = blockIdx.x * (size_t)blockDim.x + threadIdx.x; i < n2; i += (size_t)gridDim.x * blockDim.x) {
        const int c = (int)(i % D); const int j = (int)((i / D) % 3); const int seq = (int)(i / (3 * D));
        const int xi = T + j;
        float v; if (xi >= 3) v = P[((size_t)seq * T + (xi - 3)) * DIN + C_XR + c]; else v = buf ? buf[((size_t)seq * 3 + xi) * D + c] : 0.f;
        conv_new[i] = v;
    }
}
__global__ void k_rg_elem(const float* xc, const float* RA, const float* RX, const float* b_a, const float* b_x, const float* lam, float* a_out, float* bb_out, int T, int nseq, int reset) { xc = fx(xc); RA = fx(RA); RX = fx(RX); b_a = fx(b_a); b_x = fx(b_x); lam = fx(lam); a_out = fx(a_out); bb_out = fx(bb_out);
    const size_t n = (size_t)nseq * T * D;
    for (size_t i = blockIdx.x * (size_t)blockDim.x + threadIdx.x; i < n; i += (size_t)gridDim.x * blockDim.x) {
        const int c = (int)(i % D); const int t = (int)((i / D) % T);
        const float r = sigmoidf_(RA[i] + b_a[c]), ig = sigmoidf_(RX[i] + b_x[c]);
        const float log_a = -8.0f * r * softplusf_(-lam[c]); const float a = expf(log_a);
        float mult = sqrtf(fmaxf(-expm1f(2.0f * log_a), 0.f)); if (reset && t == 0) mult = 1.0f;
        a_out[i] = a; bb_out[i] = mult * ig * xc[i];
    }
}
__global__ void k_scan(const float* a, const float* bb, const float* h0, float* h, float* h_last, int T, int nseq) { a = fx(a); bb = fx(bb); h0 = fx(h0); h = fx(h); h_last = fx(h_last);
    const int i = blockIdx.x * blockDim.x + threadIdx.x; if (i >= nseq * D) return;
    const int c = i % D, seq = i / D; float hv = h0 ? h0[(size_t)seq * D + c] : 0.f;
    for (int t = 0; t < T; ++t) { const size_t o = ((size_t)seq * T + t) * D + c; hv = a[o] * hv + bb[o]; h[o] = hv; }
    h_last[(size_t)seq * D + c] = hv;
}
__global__ void k_gate_rnn(const float* h, const float* P, float* o, size_t n) { h = fx(h); P = fx(P); o = fx(o);
    for (size_t i = blockIdx.x * (size_t)blockDim.x + threadIdx.x; i < n; i += (size_t)gridDim.x * blockDim.x) { const size_t r = i / D; const int c = (int)(i % D); o[i] = h[i] * gelu_tanhf_(P[r * DIN + C_YR + c]); }
}
__global__ void __launch_bounds__(256) k_gla(const float* P, const float* G, const float* blr, const float* S0, float* O, float* S_out, int T) { P = fx(P); G = fx(G); blr = fx(blr); S0 = fx(S0); O = fx(O); S_out = fx(S_out);
    extern __shared__ float S[];
    __shared__ float sq[128], sk[128], se[128];
    const int head = blockIdx.x & 3, seq = blockIdx.x >> 2, dv = threadIdx.x;
    for (int kk = 0; kk < 128; ++kk) S[kk * 256 + dv] = S0 ? S0[(((size_t)seq * 4 + head) * 128 + kk) * 256 + dv] : 0.f;
    for (int t = 0; t < T; ++t) {
        const size_t row = (size_t)seq * T + t;
        __syncthreads();
        if (dv < 128) { sq[dv] = P[row * DIN + C_Q + head * 128 + dv] * 0.08838834764831845f; sk[dv] = P[row * DIN + C_K + head * 128 + dv];
            se[dv] = expf(logsigmoidf_(G[row * 512 + head * 128 + dv] + blr[head * 128 + dv]) * (1.0f / 16.0f)); }
        __syncthreads();
        const float v = P[row * DIN + C_V + head * 256 + dv]; float o = 0.f;
        for (int kk = 0; kk < 128; ++kk) { const float s = S[kk * 256 + dv] * se[kk] + sk[kk] * v; S[kk * 256 + dv] = s; o = fmaf(sq[kk], s, o); }
        O[row * D + head * 256 + dv] = o;
    }
    for (int kk = 0; kk < 128; ++kk) S_out[(((size_t)seq * 4 + head) * 128 + kk) * 256 + dv] = S[kk * 256 + dv];
}
__global__ void k_gla_out(const float* O, const float* P, const float* gn, float* og_out) { O = fx(O); P = fx(P); gn = fx(gn); og_out = fx(og_out);
    __shared__ float red[4];
    const int head = blockIdx.x & 3; const size_t row = blockIdx.x >> 2; const int dv = threadIdx.x;
    const float o = O[row * D + head * 256 + dv]; const float tot = block_sum256(o * o, red); const float rs = rsqrtf(tot / 256.f + EPS);
    og_out[row * D + head * 256 + dv] = o * rs * gn[dv] * siluf_(P[row * DIN + C_OG + head * 256 + dv]);
}
__global__ void k_merge(const float* P, const float* YA, const float* YB, float* m, size_t n) { P = fx(P); YA = fx(YA); YB = fx(YB); m = fx(m);
    for (size_t i = blockIdx.x * (size_t)blockDim.x + threadIdx.x; i < n; i += (size_t)gridDim.x * blockDim.x) { const size_t r = i / D; const int c = (int)(i % D);
        m[i] = sigmoidf_(P[r * DIN + C_GA + c]) * YA[i] + sigmoidf_(P[r * DIN + C_GB + c]) * YB[i]; }
}
struct In { const float *xp, *xs, *srh, *src, *sgla, *ng, *f1gu, *f1d, *win, *cw, *cb, *rwa, *rba, *rwx, *rbx, *lam, *wlr, *blr, *gng, *wbr, *wbg, *wout, *f2gu, *f2d; };
inline In make_in(void* const* d) { In I; const float** p = (const float**)&I; for (int i = 0; i < 24; ++i) p[i] = (const float*)d[i]; return I; }
inline void gemm(hipStream_t st, const float* A, int lda, const float* B, int ldb, float* C, int ldc, int M, int N, int K, int nz = 1, size_t sA = 0, size_t sB = 0, size_t sC = 0) {
    hipLaunchKernelGGL(k_gemm, dim3((N + 63) / 64, M / 64, nz), dim3(256), 0, st, A, lda, B, ldb, C, ldc, M, N, K, sA, sB, sC);
}
struct Outs { float *y, *h_last, *conv_new, *s_new; };
struct Bufs { float *T0, *T1, *T2, *T3, *T4, *T5, *T6, *T7, *T8, *T9, *GU, *HH, *P, *G; };
inline Bufs make_bufs(float* ws, int R) { Bufs B; const size_t RD = (size_t)R * D; B.T0 = ws; B.T1 = B.T0 + RD; B.T2 = B.T1 + RD; B.T3 = B.T2 + RD; B.T4 = B.T3 + RD; B.T5 = B.T4 + RD; B.T6 = B.T5 + RD; B.T7 = B.T6 + RD; B.T8 = B.T7 + RD; B.T9 = B.T8 + RD;
    B.GU = B.T9 + RD; B.HH = B.GU + (size_t)R * 2 * FF; B.P = B.HH + (size_t)R * FF; B.G = B.P + (size_t)R * DIN; return B; }
inline Outs std_outs(float* out, int grp) { Outs o; const bool smp = (grp == NB);
    o.y = smp ? out + O_YS : out + O_YP + (size_t)grp * TSEQ * D; o.h_last = smp ? out + O_HS : out + O_HP + (size_t)grp * D;
    o.conv_new = smp ? out + O_CS : out + O_CP + (size_t)grp * 3 * D; o.s_new = smp ? out + O_SS : out + O_SP + (size_t)grp * 4 * 128 * 256; return o; }
inline void run_group(hipStream_t st, const In& I, const Outs& O, float* ws, int grp, int s_lo = 0, int s_hi = 12) {
    const bool smp = (grp == NB); const int T = smp ? 1 : TSEQ, nseq = smp ? NS : 1, R = T * nseq;
    const float* x = smp ? I.xs : I.xp + (size_t)grp * TSEQ * D;
    const Bufs B = make_bufs(ws, R);
    float *T0 = B.T0, *T1 = B.T1, *T2 = B.T2, *T3 = B.T3, *T4 = B.T4, *T5 = B.T5, *T6 = B.T6, *T7 = B.T7, *T8 = B.T8, *T9 = B.T9, *GU = B.GU, *HH = B.HH, *P = B.P, *G = B.G;
    const float* ng = I.ng; const size_t n1 = (size_t)R * D; const int EB = 1024;
#define STG(k) if (s_lo <= (k) && (k) < s_hi)
    STG(0) hipLaunchKernelGGL(k_rmsnorm, dim3(R), dim3(256), 0, st, x, ng + 0 * D, T0);
    STG(1) { gemm(st, T0, D, I.f1gu, 2 * FF, GU, 2 * FF, R, 2 * FF, D);
        hipLaunchKernelGGL(k_swiglu, dim3(EB), dim3(256), 0, st, GU, HH, (size_t)R * FF); }
    STG(2) gemm(st, HH, FF, I.f1d, D, T1, D, R, D, FF);
    STG(3) { hipLaunchKernelGGL(k_resnorm, dim3(R), dim3(256), 0, st, x, T1, ng + 1 * D, 0.5f, T2);
        hipLaunchKernelGGL(k_rmsnorm, dim3(R), dim3(256), 0, st, T2, ng + 2 * D, T3); }
    STG(4) gemm(st, T3, D, I.win, DIN, P, DIN, R, DIN, D);
    STG(5) { hipLaunchKernelGGL(k_conv, dim3(EB), dim3(256), 0, st, P, smp ? I.src : nullptr, I.cw, I.cb, T4, O.conv_new, T, nseq);
        gemm(st, T4, D, I.rwa, 128, T5, D, R, 128, 128, 8, 128, 128 * 128, 128);
        gemm(st, T4, D, I.rwx, 128, T6, D, R, 128, 128, 8, 128, 128 * 128, 128);
        hipLaunchKernelGGL(k_rg_elem, dim3(EB), dim3(256), 0, st, T4, T5, T6, I.rba, I.rbx, I.lam, T7, T8, T, nseq, smp ? 0 : 1);
        hipLaunchKernelGGL(k_scan, dim3((nseq * D + 255) / 256), dim3(256), 0, st, T7, T8, smp ? I.srh : nullptr, T9, O.h_last, T, nseq);
        hipLaunchKernelGGL(k_gate_rnn, dim3(EB), dim3(256), 0, st, T9, P, T3, n1);
        gemm(st, P + C_LR, DIN, I.wlr, 512, G, 512, R, 512, 16);
        hipLaunchKernelGGL(k_gla, dim3(nseq * 4), dim3(256), 128 * 256 * 4, st, P, G, I.blr, smp ? I.sgla : nullptr, T7, O.s_new, T);
        hipLaunchKernelGGL(k_gla_out, dim3(R * 4), dim3(256), 0, st, T7, P, I.gng, T8); }
    STG(6) { gemm(st, T3, D, I.wbr, D, T5, D, R, D, D);
        gemm(st, T8, D, I.wbg, D, T6, D, R, D, D);
        hipLaunchKernelGGL(k_merge, dim3(EB), dim3(256), 0, st, P, T5, T6, T9, n1); }
    STG(7) gemm(st, T9, D, I.wout, D, T1, D, R, D, D);
    STG(8) { hipLaunchKernelGGL(k_resnorm, dim3(R), dim3(256), 0, st, T2, T1, ng + 3 * D, 1.0f, T2);
        hipLaunchKernelGGL(k_rmsnorm, dim3(R), dim3(256), 0, st, T2, ng + 4 * D, T0); }
    STG(9) { gemm(st, T0, D, I.f2gu, 2 * FF, GU, 2 * FF, R, 2 * FF, D);
        hipLaunchKernelGGL(k_swiglu, dim3(EB), dim3(256), 0, st, GU, HH, (size_t)R * FF); }
    STG(10) gemm(st, HH, FF, I.f2d, D, T1, D, R, D, FF);
    STG(11) hipLaunchKernelGGL(k_resnorm, dim3(R), dim3(256), 0, st, T2, T1, ng + 5 * D, 0.5f, O.y);
#undef STG
}
}
namespace pg8 {
#define PG8_LAS __attribute__((address_space(3)))
typedef unsigned short bf16_t;
typedef short bf16x8 __attribute__((ext_vector_type(8)));
typedef float f32x4 __attribute__((ext_vector_type(4)));
typedef float f32x2 __attribute__((ext_vector_type(2)));
typedef unsigned u32x4 __attribute__((ext_vector_type(4)));
typedef unsigned u32x2 __attribute__((ext_vector_type(2)));
constexpr int BM = 256, BK = 64, HALF = 128, HTB = HALF * BK * 2, STAGE_BYTES = 8 * HTB, NXCD = 8, WGM = 8;

__host__ __device__ __forceinline__ int lds_byte(int r, int c) { const int st = (r >> 4) * 2 + (c >> 5), rr = r & 15, cc = c & 31, ob = rr * 64 + cc * 2; return st * 1024 + (ob ^ (((ob >> 9) & 1) << 5)); }
__host__ __device__ __forceinline__ void stage_rc(int b, int& R, int& C) { const int st = b / 1024, sb = b % 1024, swz = sb ^ (((sb >> 9) & 1) << 5); R = (st >> 1) * 16 + swz / 64; C = (st & 1) * 32 + (swz % 64) / 2; }
__host__ __device__ __forceinline__ int perm32(int rho) { const int n = rho >> 4, i = rho & 15; return 8 * (i >> 2) + 4 * n + (i & 3); }

struct Unit { int pm, pn; };
struct Gemm { const bf16_t* A; int lda; const bf16_t* Bt; int M, N, K; };

struct StaticOrder {
    int nM, nN, nwg, G, c;
    __host__ __device__ void init(int M, int N, int G_, int c_) { nM = M / BM; nN = N / BM; nwg = nM * nN; G = G_; c = c_; }
    __host__ __device__ bool next(int i, Unit& u) const {
        const long L = (long)i * G + c; if (L >= nwg) return false;
        int wgid = (int)L; { const int q = nwg / NXCD, r = nwg % NXCD, xcd = wgid % NXCD, off = wgid / NXCD; wgid = (xcd < r ? xcd * (q + 1) : r * (q + 1) + (xcd - r) * q) + off; }
        const int nig = WGM * nN, gid = wgid / nig, fm = gid * WGM, gsz = (nM - fm) < WGM ? (nM - fm) : WGM;
        u.pm = fm + ((wgid % nig) % gsz); u.pn = (wgid % nig) / gsz; return true;
    }
    __device__ __forceinline__ void a_ready(const Unit&) const {}
    __device__ __forceinline__ void done(const Unit&) const {}
};

__device__ __forceinline__ unsigned f2bf(float f) { unsigned u = __builtin_bit_cast(unsigned, f); return (u + 0x7fffu + ((u >> 16) & 1u)) >> 16; }
typedef __bf16 hwbf16x2 __attribute__((ext_vector_type(2)));
__device__ __forceinline__ unsigned pk2(float lo, float hi) { const f32x2 v = {lo, hi}; return __builtin_bit_cast(unsigned, __builtin_convertvector(v, hwbf16x2)); }
__device__ __forceinline__ float bf_lo(unsigned w) { return __builtin_bit_cast(float, w << 16); }
__device__ __forceinline__ float bf_hi(unsigned w) { return __builtin_bit_cast(float, w & 0xffff0000u); }
__device__ __forceinline__ float fast_sigmoid(float x) { return __builtin_amdgcn_rcpf(1.0f + __builtin_amdgcn_exp2f(-1.4426950408889634f * x)); }

struct EpiF32 {
    static constexpr bool PERM = false, AFTER_DRAIN = false;
    float* C; int ldc;
    __device__ __forceinline__ void operator()(const f32x4 (&acc)[2][2][4][2], const Unit& u, int wr, int wc, int fr, int fq) const {
        const int row0 = u.pm * BM + wr * 64 + fr, col0 = u.pn * BM + wc * 32 + 4 * fq;
#pragma unroll
        for (int ai = 0; ai < 2; ++ai)
#pragma unroll
            for (int m = 0; m < 4; ++m) { float* rowp = C + (size_t)(row0 + ai * HALF + m * 16) * ldc + col0;
#pragma unroll
                for (int bj = 0; bj < 2; ++bj)
#pragma unroll
                    for (int n = 0; n < 2; ++n) *(f32x4*)(rowp + bj * HALF + n * 16) = acc[ai][bj][m][n]; }
    }
};
struct EpiBf16 {
    static constexpr bool PERM = true, AFTER_DRAIN = false;
    bf16_t* O; int ldc;
    __device__ __forceinline__ void operator()(const f32x4 (&acc)[2][2][4][2], const Unit& u, int wr, int wc, int fr, int fq) const {
        const int row0 = u.pm * BM + wr * 64 + fr, col0 = u.pn * BM + wc * 32 + 8 * fq;
#pragma unroll
        for (int ai = 0; ai < 2; ++ai)
#pragma unroll
            for (int m = 0; m < 4; ++m) { bf16_t* rowp = O + (size_t)(row0 + ai * HALF + m * 16) * ldc + col0;
#pragma unroll
                for (int bj = 0; bj < 2; ++bj) { const f32x4 v0 = acc[ai][bj][m][0], v1 = acc[ai][bj][m][1];
                    u32x4 w; w.x = pk2(v0[0], v0[1]); w.y = pk2(v0[2], v0[3]); w.z = pk2(v1[0], v1[1]); w.w = pk2(v1[2], v1[3]);
                    *(u32x4*)(rowp + bj * HALF) = w; } }
    }
};
struct EpiSwiGLU {
    static constexpr bool PERM = true, AFTER_DRAIN = false;
    bf16_t* O; int ldc;
    __device__ __forceinline__ void operator()(const f32x4 (&acc)[2][2][4][2], const Unit& u, int wr, int wc, int fr, int fq) const {
        const int row0 = u.pm * BM + wr * 64 + fr, col0 = u.pn * HALF + wc * 32 + 8 * fq;
#pragma unroll
        for (int ai = 0; ai < 2; ++ai)
#pragma unroll
            for (int m = 0; m < 4; ++m) { bf16_t* rowp = O + (size_t)(row0 + ai * HALF + m * 16) * ldc + col0;
                float h[8];
#pragma unroll
                for (int n = 0; n < 2; ++n)
#pragma unroll
                    for (int e = 0; e < 4; ++e) { const float g = acc[ai][0][m][n][e], up = acc[ai][1][m][n][e]; h[4 * n + e] = g * fast_sigmoid(g) * up; }
                u32x4 w; w.x = pk2(h[0], h[1]); w.y = pk2(h[2], h[3]); w.z = pk2(h[4], h[5]); w.w = pk2(h[6], h[7]);
                *(u32x4*)rowp = w; }
    }
};
struct EpiGateA {
    static constexpr bool PERM = true, AFTER_DRAIN = false;
    const bf16_t* G; int ldg; float* T; int ldt;
    __device__ __forceinline__ void operator()(const f32x4 (&acc)[2][2][4][2], const Unit& u, int wr, int wc, int fr, int fq) const {
        const int row0 = u.pm * BM + wr * 64 + fr, col0 = u.pn * BM + wc * 32 + 8 * fq;
#pragma unroll
        for (int ai = 0; ai < 2; ++ai)
#pragma unroll
            for (int m = 0; m < 4; ++m) { const size_t row = (size_t)(row0 + ai * HALF + m * 16);
#pragma unroll
                for (int bj = 0; bj < 2; ++bj) { const u32x4 g = *(const u32x4*)(G + row * ldg + col0 + bj * HALF); const f32x4 v0 = acc[ai][bj][m][0], v1 = acc[ai][bj][m][1];
                    f32x4 o0, o1; o0[0] = fast_sigmoid(bf_lo(g.x)) * v0[0]; o0[1] = fast_sigmoid(bf_hi(g.x)) * v0[1]; o0[2] = fast_sigmoid(bf_lo(g.y)) * v0[2]; o0[3] = fast_sigmoid(bf_hi(g.y)) * v0[3];
                    o1[0] = fast_sigmoid(bf_lo(g.z)) * v1[0]; o1[1] = fast_sigmoid(bf_hi(g.z)) * v1[1]; o1[2] = fast_sigmoid(bf_lo(g.w)) * v1[2]; o1[3] = fast_sigmoid(bf_hi(g.w)) * v1[3];
                    float* tp = T + row * ldt + col0 + bj * HALF; *(f32x4*)tp = o0; *(f32x4*)(tp + 4) = o1; } }
    }
};
struct EpiGateB {
    static constexpr bool PERM = true, AFTER_DRAIN = false;
    const bf16_t* G; int ldg; const float* T; int ldt; bf16_t* O; int ldc;
    __device__ __forceinline__ void operator()(const f32x4 (&acc)[2][2][4][2], const Unit& u, int wr, int wc, int fr, int fq) const {
        const int row0 = u.pm * BM + wr * 64 + fr, col0 = u.pn * BM + wc * 32 + 8 * fq;
#pragma unroll
        for (int ai = 0; ai < 2; ++ai)
#pragma unroll
            for (int m = 0; m < 4; ++m) { const size_t row = (size_t)(row0 + ai * HALF + m * 16);
#pragma unroll
                for (int bj = 0; bj < 2; ++bj) { const u32x4 g = *(const u32x4*)(G + row * ldg + col0 + bj * HALF); const f32x4 v0 = acc[ai][bj][m][0], v1 = acc[ai][bj][m][1];
                    const float* tp = T + row * ldt + col0 + bj * HALF; const f32x4 t0 = *(const f32x4*)tp, t1 = *(const f32x4*)(tp + 4);
                    f32x4 o0, o1; o0[0] = t0[0] + fast_sigmoid(bf_lo(g.x)) * v0[0]; o0[1] = t0[1] + fast_sigmoid(bf_hi(g.x)) * v0[1]; o0[2] = t0[2] + fast_sigmoid(bf_lo(g.y)) * v0[2]; o0[3] = t0[3] + fast_sigmoid(bf_hi(g.y)) * v0[3];
                    o1[0] = t1[0] + fast_sigmoid(bf_lo(g.z)) * v1[0]; o1[1] = t1[1] + fast_sigmoid(bf_hi(g.z)) * v1[1]; o1[2] = t1[2] + fast_sigmoid(bf_lo(g.w)) * v1[2]; o1[3] = t1[3] + fast_sigmoid(bf_hi(g.w)) * v1[3];
                    u32x4 w; w.x = pk2(o0[0], o0[1]); w.y = pk2(o0[2], o0[3]); w.z = pk2(o1[0], o1[1]); w.w = pk2(o1[2], o1[3]);
                    *(u32x4*)(O + row * ldc + col0 + bj * HALF) = w; } }
    }
};

template <class Epi, class Sched, bool ALIGN_EPI = false, bool SP2 = false>
__device__ __forceinline__ void gemm_phase(PG8_LAS unsigned char* lds, const Gemm g, const Sched& S, const Epi& E) {
    const int tid = threadIdx.x, wid = __builtin_amdgcn_readfirstlane(tid >> 6), lane = tid & 63, wr = wid >> 2, wc = wid & 3, fr = lane & 15, fq = lane >> 4;
    const int K = g.K, nt = K / BK;
    unsigned voffA[2], voffB[2];
#pragma unroll
    for (int i = 0; i < 2; ++i) { int R, C; stage_rc(tid * 16 + i * 8192, R, C); const int Rb = Epi::PERM ? ((R & ~31) + perm32(R & 31)) : R;
        voffA[i] = (unsigned)(R * g.lda + C) * 2u; voffB[i] = (unsigned)(Rb * K + C) * 2u; }
    const size_t kstep = (size_t)(BK * 2);
    const size_t hstepA = (size_t)HALF * g.lda * 2, hstepB = (size_t)HALF * K * 2;
    const size_t tstepA = 2 * hstepA, tstepB = 2 * hstepB;
    const unsigned ldsw = (unsigned)wid * 1024u;
    const int aoff = lds_byte(wr * 64 + fr, fq * 8), boff = lds_byte(wc * 32 + fr, fq * 8);
#define PG8_SA(b, h) (((b) * 2 + (h)) * HTB)
#define PG8_SB(b, h) ((4 + (b) * 2 + (h)) * HTB)
#define PG8_STAGE(bufoff, gbase, voff) do { _Pragma("unroll") for (int _i = 0; _i < 2; ++_i) \
        __builtin_amdgcn_global_load_lds((const unsigned*)((const char*)(gbase) + (voff)[_i]), (PG8_LAS unsigned*)(lds + (bufoff) + ldsw + _i * 8192), 16, 0, 0); } while (0)
#define PG8_LDA(dst, b, h) do { _Pragma("unroll") for (int m = 0; m < 4; ++m) _Pragma("unroll") for (int k = 0; k < 2; ++k) dst[m][k] = *(const PG8_LAS bf16x8*)(lds + PG8_SA(b, h) + aoff + m * 2048 + k * 1024); } while (0)
#define PG8_LDB(dst, b, h) do { _Pragma("unroll") for (int n = 0; n < 2; ++n) _Pragma("unroll") for (int k = 0; k < 2; ++k) dst[n][k] = *(const PG8_LAS bf16x8*)(lds + PG8_SB(b, h) + boff + n * 2048 + k * 1024); } while (0)
#define PG8_MMA(ai, bj, At, Bt) do { __builtin_amdgcn_s_setprio(1); _Pragma("unroll") for (int m = 0; m < 4; ++m) _Pragma("unroll") for (int n = 0; n < 2; ++n) _Pragma("unroll") for (int k = 0; k < 2; ++k) \
        acc[ai][bj][m][n] = __builtin_amdgcn_mfma_f32_16x16x32_bf16(Bt[n][k], At[m][k], acc[ai][bj][m][n], 0, 0, 0); __builtin_amdgcn_s_setprio(0); } while (0)
#define PG8_WAIT_V(n) asm volatile("s_waitcnt vmcnt(" #n ")" ::: "memory")
#define PG8_WAIT_L(n) asm volatile("s_waitcnt lgkmcnt(" #n ")" ::: "memory")
#define PG8_BAR __builtin_amdgcn_s_barrier()
#define PG8_SCHED __builtin_amdgcn_sched_barrier(0)
    Unit cur, nxt; int ui = 0;
    if (!S.next(0, cur)) return;
    f32x4 acc[2][2][4][2];
#pragma unroll
    for (int a = 0; a < 2; ++a)
#pragma unroll
        for (int b = 0; b < 2; ++b)
#pragma unroll
            for (int m = 0; m < 4; ++m)
#pragma unroll
                for (int n = 0; n < 2; ++n) acc[a][b][m][n] = (f32x4){0.f, 0.f, 0.f, 0.f};
    bf16x8 At[4][2], B0[2][2], B1[2][2];
    const char* cA = (const char*)g.A + (size_t)cur.pm * tstepA; const char* cB = (const char*)g.Bt + (size_t)cur.pn * tstepB;
    S.a_ready(cur);
    if constexpr (SP2) {
        PG8_STAGE(PG8_SB(0, 0), cB, voffB); PG8_STAGE(PG8_SB(0, 1), cB + hstepB, voffB); PG8_STAGE(PG8_SA(0, 0), cA, voffA); PG8_STAGE(PG8_SA(0, 1), cA + hstepA, voffA);
        if (wr == 1) PG8_BAR;
        PG8_WAIT_V(2); PG8_BAR;
        PG8_STAGE(PG8_SB(1, 0), cB + kstep, voffB); PG8_STAGE(PG8_SA(1, 0), cA + kstep, voffA); PG8_STAGE(PG8_SB(1, 1), cB + hstepB + kstep, voffB);
        PG8_WAIT_V(6); PG8_BAR;
    } else {
        PG8_STAGE(PG8_SB(0, 0), cB, voffB); PG8_STAGE(PG8_SA(0, 0), cA, voffA); PG8_STAGE(PG8_SB(0, 1), cB + hstepB, voffB); PG8_STAGE(PG8_SA(0, 1), cA + hstepA, voffA);
        if (wr == 1) PG8_BAR;
        PG8_WAIT_V(4); PG8_BAR;
        PG8_STAGE(PG8_SB(1, 0), cB + kstep, voffB); PG8_STAGE(PG8_SA(1, 0), cA + kstep, voffA); PG8_STAGE(PG8_SB(1, 1), cB + hstepB + kstep, voffB);
        PG8_WAIT_V(6); PG8_BAR;
    }
    for (;;) {
        const bool has_next = S.next(ui + 1, nxt);
        const char* nA = has_next ? (const char*)g.A + (size_t)nxt.pm * tstepA : cA; const char* nB = has_next ? (const char*)g.Bt + (size_t)nxt.pn * tstepB : cB;
        for (int t = 0; t < nt; t += 2) {
            const bool last = (t == nt - 2);
            const char* a1 = cA + (size_t)(t + 1) * kstep;
            const char* a2 = last ? nA : cA + (size_t)(t + 2) * kstep; const char* b2 = last ? nB : cB + (size_t)(t + 2) * kstep;
            const char* a3 = a2 + kstep; const char* b3 = b2 + kstep;
            if (last && has_next) S.a_ready(nxt);
            if constexpr (SP2) {
            PG8_LDB(B0, 0, 0); PG8_LDB(B1, 0, 1); PG8_SCHED; PG8_LDA(At, 0, 0); PG8_STAGE(PG8_SA(1, 1), a1 + hstepA, voffA);
            PG8_WAIT_V(8); PG8_WAIT_L(0); PG8_BAR; PG8_MMA(0, 0, At, B0); PG8_MMA(0, 1, At, B1); PG8_BAR; PG8_SCHED;
            PG8_LDA(At, 0, 1); PG8_STAGE(PG8_SB(0, 0), b2, voffB); PG8_STAGE(PG8_SB(0, 1), b2 + hstepB, voffB); PG8_STAGE(PG8_SA(0, 0), a2, voffA);
            PG8_WAIT_V(8); PG8_WAIT_L(0); PG8_BAR; PG8_MMA(1, 0, At, B0); PG8_MMA(1, 1, At, B1); PG8_BAR; PG8_SCHED;
            PG8_LDB(B0, 1, 0); PG8_LDB(B1, 1, 1); PG8_SCHED; PG8_LDA(At, 1, 0); PG8_STAGE(PG8_SA(0, 1), a2 + hstepA, voffA);
            PG8_WAIT_V(8); PG8_WAIT_L(0); PG8_BAR; PG8_MMA(0, 0, At, B0); PG8_MMA(0, 1, At, B1); PG8_BAR; PG8_SCHED;
            PG8_LDA(At, 1, 1); PG8_STAGE(PG8_SB(1, 0), b3, voffB); PG8_STAGE(PG8_SB(1, 1), b3 + hstepB, voffB); PG8_STAGE(PG8_SA(1, 0), a3, voffA);
            PG8_WAIT_V(8); PG8_WAIT_L(0); PG8_BAR; PG8_MMA(1, 0, At, B0); PG8_MMA(1, 1, At, B1); PG8_BAR; PG8_SCHED;
            } else {
            PG8_LDB(B0, 0, 0); PG8_SCHED; PG8_LDA(At, 0, 0); PG8_STAGE(PG8_SA(1, 1), a1 + hstepA, voffA);
            PG8_WAIT_L(8); PG8_BAR; PG8_WAIT_L(0); PG8_MMA(0, 0, At, B0); PG8_BAR; PG8_SCHED;
            PG8_LDB(B1, 0, 1); PG8_STAGE(PG8_SB(0, 0), b2, voffB);
            PG8_BAR; PG8_WAIT_L(0); PG8_MMA(0, 1, At, B1); PG8_BAR;
            PG8_LDA(At, 0, 1); PG8_STAGE(PG8_SA(0, 0), a2, voffA);
            PG8_BAR; PG8_WAIT_L(0); PG8_MMA(1, 0, At, B0); PG8_BAR; PG8_SCHED;
            PG8_STAGE(PG8_SB(0, 1), b2 + hstepB, voffB);
            PG8_WAIT_V(6); PG8_BAR; PG8_MMA(1, 1, At, B1); PG8_BAR;
            PG8_LDB(B0, 1, 0); PG8_SCHED; PG8_LDA(At, 1, 0); PG8_STAGE(PG8_SA(0, 1), a2 + hstepA, voffA);
            PG8_WAIT_L(8); PG8_BAR; PG8_WAIT_L(0); PG8_MMA(0, 0, At, B0); PG8_BAR; PG8_SCHED;
            PG8_LDB(B1, 1, 1); PG8_STAGE(PG8_SB(1, 0), b3, voffB);
            PG8_BAR; PG8_WAIT_L(0); PG8_MMA(0, 1, At, B1); PG8_BAR;
            PG8_LDA(At, 1, 1); PG8_STAGE(PG8_SA(1, 0), a3, voffA);
            PG8_BAR; PG8_WAIT_L(0); PG8_MMA(1, 0, At, B0); PG8_BAR; PG8_SCHED;
            PG8_STAGE(PG8_SB(1, 1), b3 + hstepB, voffB);
            PG8_WAIT_V(6); PG8_BAR; PG8_MMA(1, 1, At, B1); PG8_BAR;
            }
        }
        if constexpr (ALIGN_EPI) { if (wr == 0) PG8_BAR; }
        if constexpr (!Epi::AFTER_DRAIN) { E(acc, cur, wr, wc, fr, fq); S.done(cur); }
        if (!has_next) break;
#pragma unroll
        for (int a = 0; a < 2; ++a)
#pragma unroll
            for (int b = 0; b < 2; ++b)
#pragma unroll
                for (int m = 0; m < 4; ++m)
#pragma unroll
                    for (int n = 0; n < 2; ++n) acc[a][b][m][n] = (f32x4){0.f, 0.f, 0.f, 0.f};
        cur = nxt; cA = nA; cB = nB; ++ui;
        if constexpr (ALIGN_EPI) { if (wr == 1) PG8_BAR; }
    }
    PG8_WAIT_V(0);
    if constexpr (!ALIGN_EPI) { if (wr == 0) PG8_BAR; }
    PG8_BAR;
#undef PG8_SA
#undef PG8_SB
#undef PG8_STAGE
#undef PG8_LDA
#undef PG8_LDB
#undef PG8_MMA
#undef PG8_WAIT_V
#undef PG8_WAIT_L
#undef PG8_BAR
#undef PG8_SCHED
}
}
namespace mk {
using pg8::bf16_t; using pg8::bf16x8; using pg8::f32x4; using pg8::f32x2; using pg8::u32x4; using pg8::u32x2; using pg8::f2bf; using pg8::pk2; using pg8::bf_lo; using pg8::bf_hi;
#define LAS __attribute__((address_space(3)))
typedef float f32x16 __attribute__((ext_vector_type(16)));
constexpr int NWAVES = 8, NTHR = 512;
constexpr int D = 1024, FF = 2816, DIN = 7184, MP = 16384, MS = 128, MT = 16512, MPAD = 16640, TSEQ = 2048, NB = 8;
constexpr int PLD = 7424;
constexpr int PC_XR = 0, PC_YR = 1024, PC_OG = 2048, PC_Q = 3072, PC_K = 3584, PC_V = 4096, PC_GA = 5120, PC_GB = 6144, PC_LR = 7168;
constexpr int SC_XA = 0, SC_H = 1024, SC_T = 3072, SC_F = 5120;
constexpr float EPS = 1e-6f;
constexpr size_t O_YP = 0, O_YS = 16777216, O_HP = 16908288, O_CP = 16916480, O_SP = 16941056, O_HS = 17989632, O_CS = 18120704, O_SS = 18513920;
constexpr size_t MiB = 1u << 20;
constexpr size_t WS_CTL = 0, CTL_ZERO_BYTES = 64 * 1024;
constexpr size_t WS_P = 1 * MiB;
constexpr size_t WS_TAIL = 237 * MiB;
constexpr size_t WS_WRG = WS_TAIL, WS_WBR = WS_TAIL + MiB / 2, WS_WBG = WS_WBR + 2 * MiB, WS_WOUT = WS_WBG + 2 * MiB;
constexpr size_t WS_WGU2 = WS_TAIL, WS_WD2 = WS_TAIL + 11 * MiB;
static_assert(WS_P + (size_t)MPAD * PLD * 2 <= WS_TAIL && WS_WOUT + 2 * MiB <= 256 * MiB && WS_WD2 + (size_t)D * FF * 2 <= 256 * MiB, "d_ws map");
constexpr size_t SS_U = 0, SS_WIN = (size_t)MPAD * D * 2, SS_WGU1 = SS_WIN + (size_t)PLD * D * 2, SS_WD1 = SS_WGU1 + (size_t)2 * FF * D * 2;
static_assert(SS_WD1 + (size_t)D * FF * 2 <= 64 * MiB, "ss-region map");
constexpr int CW_BAR = 4096;
constexpr int LDS_BYTES = 163840, MISC_OFF = LDS_BYTES - 512;

#define RLX_AGENT __ATOMIC_RELAXED, __HIP_MEMORY_SCOPE_AGENT
#define LDS_WAIT() asm volatile("s_waitcnt lgkmcnt(0)" ::: "memory")
#define VM_WAIT() asm volatile("s_waitcnt vmcnt(0)" ::: "memory")

#define XB_TMO      128
#define XB_XCNT(j)  (256  + 64 * (j))
#define XB_XSUB(j)  (1280 + 64 * (j))
#define XB_XGEN(j)  (2304 + 64 * (j))
#define XB_TOP      3328
#define XB_TOPGEN   3392
#define XCD_BAR_WORDS 3456
#define XB_SPIN_CAP (1u << 18)
__device__ __forceinline__ unsigned xb_ld(unsigned* p)              { return __hip_atomic_load(p, __ATOMIC_RELAXED, __HIP_MEMORY_SCOPE_AGENT); }
__device__ __forceinline__ unsigned xb_add(unsigned* p, unsigned v) { return __hip_atomic_fetch_add(p, v, __ATOMIC_RELAXED, __HIP_MEMORY_SCOPE_AGENT); }
__device__ __forceinline__ unsigned xb_xcc_id() { return (unsigned)__builtin_amdgcn_s_getreg((3 << 11) | 20) & 0xFu; }
#define XB_SPIN(cond, bar) do { unsigned _sp = 0; while (cond) { __builtin_amdgcn_s_sleep(1); \
    if ((++_sp & 255u) == 0u) { if (xb_ld(&(bar)[XB_TMO])) break; if (_sp > XB_SPIN_CAP) { atomicAdd(&(bar)[XB_TMO], 1u); break; } } } } while (0)
struct XcdBarrier { unsigned* bar; unsigned x; volatile LAS unsigned* st; };
__device__ __forceinline__ XcdBarrier xcd_barrier_post(unsigned* bar, volatile LAS unsigned* st) {
    XcdBarrier b; b.bar = bar; b.x = xb_xcc_id(); b.st = st;
    if (threadIdx.x == 0) (void)xb_add(&bar[XB_XCNT(b.x)], 1u);
    return b;
}
__device__ __forceinline__ void xcd_barrier_complete(unsigned* bar, unsigned x, unsigned& nloc, unsigned& nx) {
    const unsigned G = gridDim.x * gridDim.y * gridDim.z;
    unsigned sum, cnt, mine, sp = 0u;
    for (;;) {
        sum = 0u; cnt = 0u; mine = 0u;
#pragma unroll
        for (unsigned j = 0; j < 16; ++j) { const unsigned c = xb_ld(&bar[XB_XCNT(j)]); sum += c; cnt += (c > 0u) ? 1u : 0u; mine = (j == x) ? c : mine; }
        if (sum == G) break;
        __builtin_amdgcn_s_sleep(1);
        if ((++sp & 255u) == 0u) { if (xb_ld(&bar[XB_TMO])) break; if (sp > XB_SPIN_CAP) { atomicAdd(&bar[XB_TMO], 1u); break; } }
    }
    nloc = mine > 0u ? mine : 1u; nx = cnt > 0u ? cnt : 1u;
}
__device__ __forceinline__ void xcd_barrier(const XcdBarrier& b) {
    asm volatile("s_waitcnt vmcnt(0)" ::: "memory");
    __syncthreads();
    if (threadIdx.x == 0) {
        unsigned* bar = b.bar;
        __builtin_amdgcn_s_waitcnt(0);
        unsigned nloc = b.st[0], nx = b.st[1];
        if (nloc == 0u) { xcd_barrier_complete(bar, b.x, nloc, nx); b.st[0] = nloc; b.st[1] = nx; }
        const unsigned old = xb_add(&bar[XB_XSUB(b.x)], 1u);
        const unsigned gen = old / nloc;
        if (old + 1u == (gen + 1u) * nloc) {
            __builtin_amdgcn_fence(__ATOMIC_RELEASE, "agent");
            asm volatile("s_waitcnt vmcnt(0)" ::: "memory");
            const unsigned og = xb_add(&bar[XB_TOP], 1u);
            const unsigned tg = og / nx;
            if (og + 1u == (tg + 1u) * nx) xb_add(&bar[XB_TOPGEN], 1u);
            else XB_SPIN(xb_ld(&bar[XB_TOPGEN]) == tg, bar);
            __builtin_amdgcn_fence(__ATOMIC_ACQUIRE, "agent");
            xb_add(&bar[XB_XGEN(b.x)], 1u);
            asm volatile("s_waitcnt vmcnt(0)" ::: "memory");
        } else {
            XB_SPIN(xb_ld(&bar[XB_XGEN(b.x)]) == gen, bar);
            __builtin_amdgcn_fence(__ATOMIC_ACQUIRE, "agent");
            asm volatile("s_waitcnt vmcnt(0)" ::: "memory");
        }
    }
    __syncthreads();
}

struct Args { const float* in[24]; float* out; unsigned char* ws; int ph_lo, ph_hi; };
struct Frame {
    LAS unsigned char* lds; int tid, lane, wave, vcu, G;
    const float* in[24]; float* out; unsigned char* ws;
    bf16_t* P; bf16_t* U; bf16_t* Win_t; bf16_t* Wgu1_t; bf16_t* Wd1_t; bf16_t* Wrg_t; bf16_t* Wbr_t; bf16_t* Wbg_t; bf16_t* Wout_t; bf16_t* Wgu2_t; bf16_t* Wd2_t;
};
enum { I_XP = 0, I_XS, I_SRH, I_SRC, I_SGLA, I_NG, I_F1GU, I_F1D, I_WIN, I_CW, I_CB, I_RWA, I_RBA, I_RWX, I_RBX, I_LAM, I_WLR, I_BLR, I_GNG, I_WBR, I_WBG, I_WOUT, I_F2GU, I_F2D };

__device__ __forceinline__ float wave_sum(float v) {
#pragma unroll
    for (int o = 1; o < 64; o <<= 1) v += __shfl_xor(v, o);
    return v;
}
__device__ __forceinline__ const float* xrow_ptr(const Frame& F, int row) { return row < MP ? F.in[I_XP] + (size_t)row * D : F.in[I_XS] + (size_t)(row - MP) * D; }
__device__ __forceinline__ void load_row16(const float* p, int lane, f32x4 (&v)[4]) {
#pragma unroll
    for (int j = 0; j < 4; ++j) v[j] = *(const f32x4*)(p + 4 * lane + 256 * j);
}
__device__ __forceinline__ float sumsq16(const f32x4 (&v)[4]) { float s = 0.f;
#pragma unroll
    for (int j = 0; j < 4; ++j) s += (v[j].x * v[j].x + v[j].y * v[j].y) + (v[j].z * v[j].z + v[j].w * v[j].w);
    return s; }
__device__ __forceinline__ void store_row16_bf16(bf16_t* p, int lane, const f32x4 (&v)[4]) {
#pragma unroll
    for (int j = 0; j < 4; ++j) { u32x2 w; w.x = pk2(v[j].x, v[j].y); w.y = pk2(v[j].z, v[j].w); *(u32x2*)(p + 4 * lane + 256 * j) = w; }
}
struct SlabMap { int slot, logw; };
__device__ __forceinline__ float* slab_at(const Frame& F, const SlabMap m, int s, int r, int c) {
    return (float*)(F.P + (size_t)(((s * MS + r) << (10 - m.logw)) + (c >> m.logw)) * PLD + m.slot) + (c & ((1 << m.logw) - 1)); }
constexpr SlabMap SLAB_D = {SC_XA, 9};
constexpr SlabMap SLAB_B = {PC_LR, 7};
__device__ __forceinline__ void load_row16_f(const Frame& F, int row, int slot, const SlabMap m, int slab0, int ns, f32x4 (&v)[4]) {
    if (row < MP) { load_row16((const float*)(F.P + (size_t)row * PLD + slot), F.lane, v); return; }
#pragma unroll
    for (int j = 0; j < 4; ++j) v[j] = (f32x4){0.f, 0.f, 0.f, 0.f};
    for (int s = 0; s < ns; ++s) {
#pragma unroll
        for (int j = 0; j < 4; ++j) v[j] = v[j] + *(const f32x4*)slab_at(F, m, slab0 + s, row - MP, 4 * F.lane + 256 * j); }
}
__device__ __forceinline__ void rowphase0(const Frame& F) {
    const int gw = F.vcu * NWAVES + F.wave, NGW = F.G * NWAVES; const float* g0 = F.in[I_NG];
    f32x4 g[4]; load_row16(g0, F.lane, g);
    for (int row = gw; row < MT; row += NGW) {
        f32x4 v[4]; load_row16(xrow_ptr(F, row), F.lane, v);
        const float rs = rsqrtf(wave_sum(sumsq16(v)) * (1.f / D) + EPS);
#pragma unroll
        for (int j = 0; j < 4; ++j) v[j] = v[j] * rs * g[j];
        store_row16_bf16(F.P + (size_t)row * PLD + SC_XA, F.lane, v);
    }
}
__device__ __forceinline__ void rowphase1(const Frame& F) {
    const int gw = F.vcu * NWAVES + F.wave, NGW = F.G * NWAVES; const float* ng = F.in[I_NG];
    f32x4 g1[4], g2[4]; load_row16(ng + 1 * D, F.lane, g1); load_row16(ng + 2 * D, F.lane, g2);
    for (int row = gw; row < MT; row += NGW) {
        f32x4 f[4], x[4]; load_row16_f(F, row, SC_F, SLAB_D, 0, 22, f); load_row16(xrow_ptr(F, row), F.lane, x);
        const float rs = rsqrtf(wave_sum(sumsq16(f)) * (1.f / D) + EPS);
#pragma unroll
        for (int j = 0; j < 4; ++j) x[j] = x[j] + 0.5f * (f[j] * rs * g1[j]);
        float* o = F.out + (size_t)row * D;
#pragma unroll
        for (int j = 0; j < 4; ++j) *(f32x4*)(o + 4 * F.lane + 256 * j) = x[j];
        const float rs2 = rsqrtf(wave_sum(sumsq16(x)) * (1.f / D) + EPS);
#pragma unroll
        for (int j = 0; j < 4; ++j) x[j] = x[j] * rs2 * g2[j];
        store_row16_bf16(F.U + (size_t)row * D, F.lane, x);
    }
}
__device__ __forceinline__ void rowphase2(const Frame& F) {
    const int gw = F.vcu * NWAVES + F.wave, NGW = F.G * NWAVES; const float* ng = F.in[I_NG];
    f32x4 g3[4], g4[4]; load_row16(ng + 3 * D, F.lane, g3); load_row16(ng + 4 * D, F.lane, g4);
    for (int row = gw; row < MT; row += NGW) {
        f32x4 f[4], x[4]; load_row16_f(F, row, SC_T, SLAB_B, 4, 8, f); float* o = F.out + (size_t)row * D; load_row16(o, F.lane, x);
        const float rs = rsqrtf(wave_sum(sumsq16(f)) * (1.f / D) + EPS);
#pragma unroll
        for (int j = 0; j < 4; ++j) x[j] = x[j] + f[j] * rs * g3[j];
#pragma unroll
        for (int j = 0; j < 4; ++j) *(f32x4*)(o + 4 * F.lane + 256 * j) = x[j];
        const float rs2 = rsqrtf(wave_sum(sumsq16(x)) * (1.f / D) + EPS);
#pragma unroll
        for (int j = 0; j < 4; ++j) x[j] = x[j] * rs2 * g4[j];
        store_row16_bf16(F.P + (size_t)row * PLD + SC_XA, F.lane, x);
    }
}
__device__ __forceinline__ void rowphase3(const Frame& F) {
    const int gw = F.vcu * NWAVES + F.wave, NGW = F.G * NWAVES; const float* ng = F.in[I_NG];
    f32x4 g5[4]; load_row16(ng + 5 * D, F.lane, g5);
    for (int row = gw; row < MT; row += NGW) {
        f32x4 f[4], x[4]; load_row16_f(F, row, SC_F, SLAB_D, 0, 22, f); float* o = F.out + (size_t)row * D; load_row16(o, F.lane, x);
        const float rs = rsqrtf(wave_sum(sumsq16(f)) * (1.f / D) + EPS);
#pragma unroll
        for (int j = 0; j < 4; ++j) *(f32x4*)(o + 4 * F.lane + 256 * j) = x[j] + 0.5f * (f[j] * rs * g5[j]);
    }
}

__device__ __forceinline__ void tr_item(const float* W, int ldw, int K, int k0, int scol0, int nvalid, bf16_t* WT, int drow0, LAS float* scr, int lane) {
    const bool ok = (lane & 31) < nvalid;
#pragma unroll 8
    for (int i = 0; i < 32; ++i) { const int kk = 2 * i + (lane >> 5); scr[kk * 33 + (lane & 31)] = ok ? W[(size_t)(k0 + kk) * ldw + scol0 + (lane & 31)] : 0.f; }
    LDS_WAIT(); asm volatile("" ::: "memory");
    const int c = lane & 7;
#pragma unroll
    for (int j = 0; j < 4; ++j) { const int n = (lane >> 3) + 8 * j; const LAS float* s = scr + (8 * c) * 33 + n;
        u32x4 o; o.x = pk2(s[0 * 33], s[1 * 33]); o.y = pk2(s[2 * 33], s[3 * 33]); o.z = pk2(s[4 * 33], s[5 * 33]); o.w = pk2(s[6 * 33], s[7 * 33]);
        *(u32x4*)(WT + (size_t)(drow0 + n) * K + k0 + 8 * c) = o; }
    LDS_WAIT(); asm volatile("" ::: "memory");
}
__device__ __forceinline__ void prep_wgu(const Frame& F, const float* W, bf16_t* WT, LAS float* scr, int gw, int NGW) {
    constexpr int KB = D / 64, RB = 2 * FF / 32;
    for (int it = gw; it < KB * RB; it += NGW) { const int kb = it / RB, rb = it % RB, n0 = 32 * rb, pn = n0 >> 8, bj = (n0 >> 7) & 1, j = n0 & 127;
        tr_item(W, 2 * FF, D, 64 * kb, bj * FF + 128 * pn + j, 32, WT, n0, scr, F.lane); }
}
__device__ __forceinline__ void prep_plain(const Frame& F, const float* W, int K, int N, bf16_t* WT, LAS float* scr, int gw, int NGW) {
    const int KB = K / 64, RB = N / 32;
    for (int it = gw; it < KB * RB; it += NGW) { const int kb = it / RB, rb = it % RB; tr_item(W, N, K, 64 * kb, 32 * rb, 32, WT, 32 * rb, scr, F.lane); }
}
__device__ __forceinline__ void prep_win(const Frame& F, LAS float* scr, int gw, int NGW) {
    constexpr int KB = D / 64, RB = PLD / 32;
    for (int it = gw; it < KB * RB; it += NGW) { const int kb = it / RB, rb = it % RB, n0 = 32 * rb; int sc, nv = 32;
        if (n0 < 2048) sc = n0;
        else if (n0 < 3072) sc = 4096 + (n0 - 2048);
        else if (n0 < 3584) sc = 2048 + (n0 - 3072);
        else if (n0 < 4096) sc = 2560 + (n0 - 3584);
        else if (n0 < 5120) sc = 3072 + (n0 - 4096);
        else if (n0 < 6144) sc = 5136 + (n0 - 5120);
        else if (n0 < 7168) sc = 6160 + (n0 - 6144);
        else if (n0 == 7168) { sc = 5120; nv = 16; }
        else { sc = 0; nv = 0; }
        tr_item(F.in[I_WIN], DIN, D, 64 * kb, sc, nv, F.Win_t, n0, scr, F.lane); }
}
__device__ __forceinline__ void prep_rg(const Frame& F, LAS float* scr, int gw, int NGW) {
    for (int it = gw; it < 2 * 8 * 8; it += NGW) { const int gate = it >> 6, n = (it >> 3) & 7, sub = it & 7, kb = sub >> 2, rb = sub & 3;
        tr_item(F.in[gate ? I_RWX : I_RWA] + (size_t)n * 16384, 128, 128, 64 * kb, 32 * rb, 32, F.Wrg_t + (size_t)(gate * 8 + n) * 16384, 32 * rb, scr, F.lane); }
}
}
namespace mk {
#define MFMA16(a, b, c) __builtin_amdgcn_mfma_f32_16x16x32_bf16((a), (b), (c), 0, 0, 0)
#define MFMA32(a, b, c) __builtin_amdgcn_mfma_f32_32x32x16_bf16((a), (b), (c), 0, 0, 0)
constexpr float LOG2E = 1.4426950408889634f;
__device__ __forceinline__ float bf2f(bf16_t h) { return __builtin_bit_cast(float, (unsigned)h << 16); }
__device__ __forceinline__ float ex2(float x) { return __builtin_amdgcn_exp2f(x); }
__device__ __forceinline__ float sigm(float x) { return __builtin_amdgcn_rcpf(1.0f + ex2(-LOG2E * x)); }
__device__ __forceinline__ float softplus_(float x) { return fmaxf(x, 0.f) + log1pf(__expf(-fabsf(x))); }
__device__ __forceinline__ float gelu_tanh_(float x) { return x * sigm(1.5957691216057308f * (x + 0.044715f * x * x * x)); }
__device__ __forceinline__ float silu_(float x) { return x * sigm(x); }
__device__ __forceinline__ void unpack8(const u32x4 w, float (&f)[8]) { f[0] = bf_lo(w.x); f[1] = bf_hi(w.x); f[2] = bf_lo(w.y); f[3] = bf_hi(w.y); f[4] = bf_lo(w.z); f[5] = bf_hi(w.z); f[6] = bf_lo(w.w); f[7] = bf_hi(w.w); }
__device__ __forceinline__ u32x4 pack8(const float (&f)[8]) { u32x4 w; w.x = pk2(f[0], f[1]); w.y = pk2(f[2], f[3]); w.z = pk2(f[4], f[5]); w.w = pk2(f[6], f[7]); return w; }

constexpr size_t WS_GAGG = WS_WOUT + 2 * MiB, GAGG_FLOATS = 32768 + 128, WS_RAGG = 128 * 1024;
static_assert(WS_GAGG + (size_t)96 * GAGG_FLOATS * 4 <= 256 * MiB && WS_RAGG + 512 * 256 * 4 <= WS_P, "mixer scratch map");

template <bool SAMPLE, int MODE>
__device__ __forceinline__ void rnn_item(const Frame& F, int item) {
    constexpr int XRAW_OFF = 0, XRAW_LD = 136, XCF_OFF = 18432, XCF_LD = 132, XCB_OFF = 52224, XCB_LD = 136, HB_OFF = 69632, CW_OFF = 103424;
    constexpr bool FULL = SAMPLE || MODE == 3;
    const int tid = F.tid, lane = F.lane, wid = F.wave;
    const int seg = SAMPLE ? 0 : (item & 7), n = SAMPLE ? item : ((item >> 3) & 7), b = SAMPLE ? 0 : (item >> 6), ch0 = 128 * n;
    LAS bf16_t* XRAW = (LAS bf16_t*)(F.lds + XRAW_OFF); LAS float* XCF = (LAS float*)(F.lds + XCF_OFF); LAS bf16_t* XCB = (LAS bf16_t*)(F.lds + XCB_OFF);
    LAS float* HB = (LAS float*)(F.lds + HB_OFF); LAS float* CW = (LAS float*)(F.lds + CW_OFF);
    for (int i = tid; i < 5 * 128; i += NTHR) { const int j = i >> 7, c = i & 127; CW[i] = j < 4 ? F.in[I_CW][j * D + ch0 + c] : F.in[I_CB][ch0 + c]; }
    const int q = lane >> 4, cl = 16 * wid + (lane & 15);
    const float ba = F.in[I_RBA][ch0 + cl], bx = F.in[I_RBX][ch0 + cl], sp8 = 8.0f * softplus_(-F.in[I_LAM][ch0 + cl]), sp8l2 = sp8 * LOG2E;
    bf16x8 Bw[2][4];
#pragma unroll
    for (int g = 0; g < 2; ++g)
#pragma unroll
        for (int ks = 0; ks < 4; ++ks) Bw[g][ks] = *(const bf16x8*)(F.Wrg_t + ((size_t)(g * 8 + n) * 128 + cl) * 128 + 32 * ks + 8 * q);
    const int t5 = tid >> 3, c5 = 16 * (tid & 7);
    float* ragg = (float*)(F.ws + WS_RAGG);
    float carry = 0.f, aprod = 1.f;
    if constexpr (!SAMPLE && MODE == 3) {
        for (int s = 0; s < seg; ++s) { const float* ag = ragg + ((size_t)((b * 8 + n) * 8 + s)) * 256; carry = fmaf(ag[cl], carry, ag[128 + cl]); }
    }
    const int ntiles = SAMPLE ? 2 : 4, tile0 = SAMPLE ? 0 : 4 * seg;
    __syncthreads();
    for (int tt = 0; tt < ntiles; ++tt) {
        const int t0 = 64 * (tile0 + tt);
        const size_t row5 = SAMPLE ? (size_t)(MP + t0 + t5) : (size_t)b * TSEQ + t0 + t5;
        bf16_t* yrp = F.P + row5 * PLD + PC_YR + ch0 + c5;
        u32x4 y0 = (u32x4){0u, 0u, 0u, 0u}, y1 = y0;
        if constexpr (FULL) { y0 = *(const u32x4*)yrp; y1 = *(const u32x4*)(yrp + 8); }
        if constexpr (!SAMPLE) {
            for (int e = tid; e < 67 * 16; e += NTHR) { const int i = e >> 4, chk = e & 15, t = t0 - 3 + i; u32x4 v = (u32x4){0u, 0u, 0u, 0u};
                if (t >= 0) v = *(const u32x4*)(F.P + ((size_t)b * TSEQ + t) * PLD + PC_XR + ch0 + 8 * chk);
                *(LAS u32x4*)(XRAW + i * XRAW_LD + 8 * chk) = v; }
            __syncthreads();
            const int c0 = 8 * (tid & 15);
            float w[4][8], cb8[8];
#pragma unroll
            for (int e = 0; e < 8; ++e) { cb8[e] = CW[4 * 128 + c0 + e];
#pragma unroll
                for (int j = 0; j < 4; ++j) w[j][e] = CW[j * 128 + c0 + e]; }
#pragma unroll
            for (int rr = 0; rr < 2; ++rr) { const int t = (tid >> 4) + 32 * rr; float xc[8];
#pragma unroll
                for (int e = 0; e < 8; ++e) xc[e] = cb8[e];
#pragma unroll
                for (int j = 0; j < 4; ++j) { float x[8]; unpack8(*(const LAS u32x4*)(XRAW + (t + j) * XRAW_LD + c0), x);
#pragma unroll
                    for (int e = 0; e < 8; ++e) xc[e] = fmaf(w[j][e], x[e], xc[e]); }
                *(LAS f32x4*)(XCF + t * XCF_LD + c0) = (f32x4){xc[0], xc[1], xc[2], xc[3]}; *(LAS f32x4*)(XCF + t * XCF_LD + c0 + 4) = (f32x4){xc[4], xc[5], xc[6], xc[7]};
                *(LAS u32x4*)(XCB + t * XCB_LD + c0) = pack8(xc); }
        } else {
            const int s = t0 + t5; const bf16_t* xrp = F.P + (size_t)(MP + s) * PLD + PC_XR + ch0 + c5;
            float xr[16]; { float a8[8], b8[8]; unpack8(*(const u32x4*)xrp, a8); unpack8(*(const u32x4*)(xrp + 8), b8);
#pragma unroll
                for (int e = 0; e < 8; ++e) { xr[e] = a8[e]; xr[8 + e] = b8[e]; } }
            const float* bufp = F.in[I_SRC] + (size_t)s * 3 * D + ch0 + c5; float* csp = F.out + O_CS + (size_t)s * 3 * D + ch0 + c5;
            float xc[16];
#pragma unroll
            for (int e = 0; e < 16; ++e) xc[e] = CW[4 * 128 + c5 + e] + CW[3 * 128 + c5 + e] * xr[e];
#pragma unroll
            for (int j = 0; j < 3; ++j)
#pragma unroll
                for (int v4 = 0; v4 < 4; ++v4) { const f32x4 bv = *(const f32x4*)(bufp + j * D + 4 * v4);
#pragma unroll
                    for (int e = 0; e < 4; ++e) xc[4 * v4 + e] = fmaf(CW[j * 128 + c5 + 4 * v4 + e], bv[e], xc[4 * v4 + e]);
                    if (j >= 1) *(f32x4*)(csp + (j - 1) * D + 4 * v4) = bv; }
#pragma unroll
            for (int v4 = 0; v4 < 4; ++v4) { *(f32x4*)(csp + 2 * D + 4 * v4) = (f32x4){xr[4 * v4], xr[4 * v4 + 1], xr[4 * v4 + 2], xr[4 * v4 + 3]};
                *(LAS f32x4*)(XCF + t5 * XCF_LD + c5 + 4 * v4) = (f32x4){xc[4 * v4], xc[4 * v4 + 1], xc[4 * v4 + 2], xc[4 * v4 + 3]}; }
            { float h8[8];
#pragma unroll
              for (int hf = 0; hf < 2; ++hf) {
#pragma unroll
                for (int e = 0; e < 8; ++e) h8[e] = xc[8 * hf + e];
                *(LAS u32x4*)(XCB + t5 * XCB_LD + c5 + 8 * hf) = pack8(h8); } }
        }
        __syncthreads();
        f32x4 acc[4][2];
#pragma unroll
        for (int m = 0; m < 4; ++m) { acc[m][0] = (f32x4){0.f, 0.f, 0.f, 0.f}; acc[m][1] = (f32x4){0.f, 0.f, 0.f, 0.f}; }
#pragma unroll
        for (int m = 0; m < 4; ++m)
#pragma unroll
            for (int ks = 0; ks < 4; ++ks) { const bf16x8 a = *(const LAS bf16x8*)(XCB + (16 * m + (lane & 15)) * XCB_LD + 32 * ks + 8 * q);
                acc[m][0] = MFMA16(a, Bw[0][ks], acc[m][0]); acc[m][1] = MFMA16(a, Bw[1][ks], acc[m][1]); }
#pragma unroll
        for (int m = 0; m < 4; ++m) {
            float av[4], bv[4];
#pragma unroll
            for (int reg = 0; reg < 4; ++reg) { const int t = 16 * m + 4 * q + reg; const float xcv = XCF[t * XCF_LD + cl];
                const float r = sigm(acc[m][0][reg] + ba), ig = sigm(acc[m][1][reg] + bx);
                const float x2 = -2.0f * sp8 * r;
                const float em = -x2 * (1.0f + x2 * (0.5f + x2 * (0.16666667f + x2 * (0.041666668f + x2 * (0.0083333338f + x2 * (0.0013888889f + x2 * 0.00019841270f))))));
                float mult = __builtin_amdgcn_sqrtf(fmaxf(em, 0.f)); if (!SAMPLE && (t0 + t) == 0) mult = 1.0f;
                av[reg] = ex2(-sp8l2 * r); bv[reg] = mult * ig * xcv; }
            if constexpr (!SAMPLE) {
                float Al = 1.f, Hl = 0.f;
#pragma unroll
                for (int reg = 0; reg < 4; ++reg) { Hl = fmaf(av[reg], Hl, bv[reg]); Al *= av[reg]; }
                float hin = carry, cn = carry;
#pragma unroll
                for (int qq = 0; qq < 4; ++qq) { const float Ag = __shfl(Al, (lane & 15) + 16 * qq), Hg = __shfl(Hl, (lane & 15) + 16 * qq);
                    cn = fmaf(Ag, cn, Hg); hin = (qq < q) ? cn : hin; if (MODE == 1) aprod *= Ag; }
                carry = cn;
                if constexpr (MODE == 3) { float hv = hin;
#pragma unroll
                    for (int reg = 0; reg < 4; ++reg) { hv = fmaf(av[reg], hv, bv[reg]); HB[(16 * m + 4 * q + reg) * XCF_LD + cl] = hv; } }
            } else {
#pragma unroll
                for (int reg = 0; reg < 4; ++reg) { const int t = 16 * m + 4 * q + reg; const float h0 = F.in[I_SRH][(size_t)(t0 + t) * D + ch0 + cl];
                    HB[t * XCF_LD + cl] = fmaf(av[reg], h0, bv[reg]); }
            }
        }
        __syncthreads();
        if constexpr (FULL) {
            float h[16], yv[16], o8[8];
#pragma unroll
            for (int v4 = 0; v4 < 4; ++v4) { const f32x4 hv = *(const LAS f32x4*)(HB + t5 * XCF_LD + c5 + 4 * v4); h[4 * v4] = hv[0]; h[4 * v4 + 1] = hv[1]; h[4 * v4 + 2] = hv[2]; h[4 * v4 + 3] = hv[3]; }
            { float a8[8], b8[8]; unpack8(y0, a8); unpack8(y1, b8);
#pragma unroll
              for (int e = 0; e < 8; ++e) { yv[e] = a8[e]; yv[8 + e] = b8[e]; } }
            if constexpr (SAMPLE) { float* hsp = F.out + O_HS + (size_t)(t0 + t5) * D + ch0 + c5;
#pragma unroll
                for (int v4 = 0; v4 < 4; ++v4) *(f32x4*)(hsp + 4 * v4) = (f32x4){h[4 * v4], h[4 * v4 + 1], h[4 * v4 + 2], h[4 * v4 + 3]}; }
#pragma unroll
            for (int hf = 0; hf < 2; ++hf) {
#pragma unroll
                for (int e = 0; e < 8; ++e) o8[e] = h[8 * hf + e] * gelu_tanh_(yv[8 * hf + e]);
                *(u32x4*)(yrp + 8 * hf) = pack8(o8); }
            if constexpr (!SAMPLE) { if (tile0 + tt == 31 && t5 >= 61) { float* cpp = F.out + O_CP + ((size_t)b * 3 + (t5 - 61)) * D + ch0 + c5;
#pragma unroll
                for (int e = 0; e < 16; ++e) cpp[e] = bf2f(XRAW[(t5 + 3) * XRAW_LD + c5 + e]); } }
        }
    }
    if constexpr (!SAMPLE && MODE == 1) { if (q == 0) { float* ag = ragg + (size_t)item * 256; ag[cl] = aprod; ag[128 + cl] = carry; } }
    if constexpr (!SAMPLE && MODE == 3) { if (seg == 7 && q == 0) F.out[O_HP + (size_t)b * D + ch0 + cl] = carry; }
    __syncthreads();
}

__device__ __forceinline__ int crow(int reg, int h) { return (reg & 3) + 8 * (reg >> 2) + 4 * h; }
__device__ __forceinline__ bf16x8 pack_step(const f32x16& x, int s) {
    u32x4 p; p.x = pk2(x[8 * s], x[8 * s + 1]); p.y = pk2(x[8 * s + 2], x[8 * s + 3]); p.z = pk2(x[8 * s + 4], x[8 * s + 5]); p.w = pk2(x[8 * s + 6], x[8 * s + 7]);
    return __builtin_bit_cast(bf16x8, p);
}
template <int MODE>
__device__ __forceinline__ void gla_item(const Frame& F, int item) {
    constexpr int VRAW = 0, VRAW_LD = 264, LRS = 33792, QI = 37888, QK_LD = 136, KI = 55296, OBUF = 0, KET = 72704, T_LD = 72, VT = 91136, ATT = 128000, SEG = 137216, DEC = 139264;
    static_assert(DEC + 512 <= MISC_OFF, "GLA LDS map");
    constexpr bool FULL = (MODE == 3);
    const int tid = F.tid, lane = F.lane, w = F.wave;
    const int j = item & 3, hh = (item >> 2) & 3, b = item >> 4; const size_t rowbase = (size_t)b * TSEQ;
    LAS bf16_t* sVRAW = (LAS bf16_t*)(F.lds + VRAW); LAS float* sLR = (LAS float*)(F.lds + LRS); LAS bf16_t* sQI = (LAS bf16_t*)(F.lds + QI); LAS bf16_t* sKI = (LAS bf16_t*)(F.lds + KI);
    LAS float* sO = (LAS float*)(F.lds + OBUF); LAS bf16_t* sKET = (LAS bf16_t*)(F.lds + KET); LAS bf16_t* sVT = (LAS bf16_t*)(F.lds + VT); LAS bf16_t* sATT = (LAS bf16_t*)(F.lds + ATT);
    LAS float* sSEG = (LAS float*)(F.lds + SEG); LAS float* sDEC = (LAS float*)(F.lds + DEC);
    const int kk = tid & 127, seg = tid >> 7;
    float wl[16];
#pragma unroll
    for (int r = 0; r < 16; ++r) wl[r] = F.in[I_WLR][r * 512 + hh * 128 + kk];
    const float bias = F.in[I_BLR][hh * 128 + kk];
    const int r32 = lane & 31, h = lane >> 5, q = lane >> 4;
    const f32x4 gn = *(const f32x4*)(F.in[I_GNG] + 4 * lane);
    float* gagg = (float*)(F.ws + WS_GAGG);
    f32x16 S[4];
#pragma unroll
    for (int kb = 0; kb < 4; ++kb)
#pragma unroll
        for (int i = 0; i < 16; ++i) S[kb][i] = 0.f;
    float dsum = 0.f;
    if constexpr (FULL) {
        for (int s = 0; s < j; ++s) { const float* ag = gagg + (size_t)((b * 4 + hh) * 3 + s) * GAGG_FLOATS;
            __syncthreads();
            if (tid < 128) sDEC[tid] = ag[32768 + tid];
            __syncthreads();
#pragma unroll
            for (int kb = 0; kb < 4; ++kb)
#pragma unroll
                for (int g4 = 0; g4 < 4; ++g4) { const f32x4 kv = *(const f32x4*)(ag + ((size_t)((w * 4 + kb) * 4 + g4)) * 256 + 4 * lane); const f32x4 dd = *(const LAS f32x4*)(sDEC + 32 * kb + 8 * g4 + 4 * h);
#pragma unroll
                    for (int e = 0; e < 4; ++e) S[kb][4 * g4 + e] = fmaf(S[kb][4 * g4 + e], dd[e], kv[e]); } }
    }
    __syncthreads();
    for (int cn = 8 * j; cn < 8 * j + 8; ++cn) {
        const size_t row0 = rowbase + 64 * cn;
#pragma unroll
        for (int i = 0; i < 4; ++i) { const int e = tid + NTHR * i, row = e >> 5, c16 = e & 31;
            *(LAS u32x4*)(sVRAW + row * VRAW_LD + 8 * c16) = *(const u32x4*)(F.P + (row0 + row) * PLD + PC_V + 256 * hh + 8 * c16); }
        if (tid < 128) { const int row = tid >> 1, hf = tid & 1; float f[8]; unpack8(*(const u32x4*)(F.P + (row0 + row) * PLD + PC_LR + 8 * hf), f);
            *(LAS f32x4*)(sLR + row * 16 + 8 * hf) = (f32x4){f[0], f[1], f[2], f[3]}; *(LAS f32x4*)(sLR + row * 16 + 8 * hf + 4) = (f32x4){f[4], f[5], f[6], f[7]}; }
        bf16_t qv[16], kv[16];
#pragma unroll
        for (int i = 0; i < 16; ++i) { const bf16_t* p = F.P + (row0 + 16 * seg + i) * PLD + 128 * hh + kk; kv[i] = p[PC_K]; qv[i] = FULL ? p[PC_Q] : (bf16_t)0; }
        u32x2 og[8];
        if constexpr (FULL) {
#pragma unroll
            for (int jj = 0; jj < 8; ++jj) og[jj] = *(const u32x2*)(F.P + (row0 + 8 * w + jj) * PLD + PC_OG + 256 * hh + 4 * lane); }
        __syncthreads();
        float c[16]; float run = 0.f;
#pragma unroll
        for (int i = 0; i < 16; ++i) { const LAS float* lr = sLR + (16 * seg + i) * 16; float x = bias;
#pragma unroll
            for (int r4 = 0; r4 < 4; ++r4) { const f32x4 lv = *(const LAS f32x4*)(lr + 4 * r4); x = fmaf(lv[0], wl[4 * r4], x); x = fmaf(lv[1], wl[4 * r4 + 1], x); x = fmaf(lv[2], wl[4 * r4 + 2], x); x = fmaf(lv[3], wl[4 * r4 + 3], x); }
            x = fminf(fmaxf(x, -80.f), 80.f);
            run -= __builtin_amdgcn_logf(1.0f + ex2(-LOG2E * x)) * (1.0f / 16.0f);
            c[i] = run; }
        sSEG[seg * 128 + kk] = run;
        { const int dv = tid & 255, hf = tid >> 8;
#pragma unroll
          for (int s8 = 0; s8 < 4; ++s8) { const int s = 32 * hf + 8 * s8; u32x4 wv; unsigned t[8];
#pragma unroll
              for (int jj = 0; jj < 8; ++jj) t[jj] = sVRAW[(s + jj) * VRAW_LD + dv];
              wv.x = t[0] | (t[1] << 16); wv.y = t[2] | (t[3] << 16); wv.z = t[4] | (t[5] << 16); wv.w = t[6] | (t[7] << 16);
              *(LAS u32x4*)(sVT + dv * T_LD + s) = wv; } }
        __syncthreads();
        { float off = 0.f, tot = 0.f;
#pragma unroll
          for (int s2 = 0; s2 < 4; ++s2) { const float v = sSEG[s2 * 128 + kk]; tot += v; off += (s2 < seg) ? v : 0.f; }
          const float dec = ex2(tot);
          if (seg == 0) { sDEC[kk] = dec; dsum += tot; }
          float ke[16];
#pragma unroll
          for (int i = 0; i < 16; ++i) { const int t = 16 * seg + i; const float bc = off + c[i]; const float eb = ex2(bc), ei = __builtin_amdgcn_rcpf(eb); const float kf = bf2f(kv[i]) * ei;
              ke[i] = kf * dec;
              if constexpr (FULL) { sQI[t * QK_LD + kk] = (bf16_t)(pk2(bf2f(qv[i]) * 0.08838834764831845f * eb, 0.f) & 0xffffu); sKI[t * QK_LD + kk] = (bf16_t)(pk2(kf, 0.f) & 0xffffu); } }
          { float a8[8], b8[8];
#pragma unroll
            for (int e = 0; e < 8; ++e) { a8[e] = ke[e]; b8[e] = ke[8 + e]; }
            *(LAS u32x4*)(sKET + kk * T_LD + 16 * seg) = pack8(a8); *(LAS u32x4*)(sKET + kk * T_LD + 16 * seg + 8) = pack8(b8); } }
        __syncthreads();
        if constexpr (FULL) {
#pragma unroll
            for (int u = 0; u < 2; ++u) { const int T = 2 * w + u, ti = T >> 2, si = T & 3; f32x4 cc = (f32x4){0.f, 0.f, 0.f, 0.f};
                if (si <= ti) {
#pragma unroll
                    for (int ks = 0; ks < 4; ++ks) { const bf16x8 a = *(const LAS bf16x8*)(sKI + (16 * si + (lane & 15)) * QK_LD + 32 * ks + 8 * q), bq = *(const LAS bf16x8*)(sQI + (16 * ti + (lane & 15)) * QK_LD + 32 * ks + 8 * q);
                        cc = MFMA16(a, bq, cc); } }
                const int t = 16 * ti + (lane & 15), s0 = 16 * si + 4 * q; float v[4];
#pragma unroll
                for (int reg = 0; reg < 4; ++reg) v[reg] = (s0 + reg <= t) ? cc[reg] : 0.f;
                u32x2 wv; wv.x = pk2(v[0], v[1]); wv.y = pk2(v[2], v[3]); *(LAS u32x2*)(sATT + t * T_LD + s0) = wv; }
            __syncthreads();
        }
        bf16x8 vf[4];
#pragma unroll
        for (int st = 0; st < 4; ++st) vf[st] = *(const LAS bf16x8*)(sVT + (32 * w + r32) * T_LD + 16 * st + 8 * h);
        f32x16 o[2];
        if constexpr (FULL) {
#pragma unroll
            for (int i = 0; i < 16; ++i) { o[0][i] = 0.f; o[1][i] = 0.f; }
#pragma unroll
            for (int kb = 0; kb < 4; ++kb)
#pragma unroll
                for (int s2 = 0; s2 < 2; ++s2) { const bf16x8 Bf = pack_step(S[kb], s2);
#pragma unroll
                    for (int tb = 0; tb < 2; ++tb) { const LAS bf16_t* qp = sQI + (32 * tb + r32) * QK_LD + 32 * kb + 16 * s2 + 4 * h; const u32x2 lo = *(const LAS u32x2*)qp, hi = *(const LAS u32x2*)(qp + 8);
                        const u32x4 af = (u32x4){lo.x, lo.y, hi.x, hi.y}; o[tb] = MFMA32(__builtin_bit_cast(bf16x8, af), Bf, o[tb]); } }
#pragma unroll
            for (int tb = 0; tb < 2; ++tb)
#pragma unroll
                for (int st = 0; st < 4; ++st) { if (tb == 0 && st >= 2) continue; const bf16x8 af = *(const LAS bf16x8*)(sATT + (32 * tb + r32) * T_LD + 16 * st + 8 * h); o[tb] = MFMA32(af, vf[st], o[tb]); }
        }
#pragma unroll
        for (int kb = 0; kb < 4; ++kb) {
#pragma unroll
            for (int g4 = 0; g4 < 4; ++g4) { const f32x4 dd = *(const LAS f32x4*)(sDEC + 32 * kb + 8 * g4 + 4 * h);
#pragma unroll
                for (int e = 0; e < 4; ++e) S[kb][4 * g4 + e] *= dd[e]; }
#pragma unroll
            for (int st = 0; st < 4; ++st) { const bf16x8 af = *(const LAS bf16x8*)(sKET + (32 * kb + r32) * T_LD + 16 * st + 8 * h); S[kb] = MFMA32(af, vf[st], S[kb]); } }
        __syncthreads();
        if constexpr (FULL) {
#pragma unroll
            for (int tb = 0; tb < 2; ++tb)
#pragma unroll
                for (int i = 0; i < 16; ++i) sO[(32 * tb + crow(i, h)) * 256 + 32 * w + r32] = o[tb][i];
            __syncthreads();
#pragma unroll
            for (int jj = 0; jj < 8; ++jj) { const int t = 8 * w + jj; const f32x4 v = *(const LAS f32x4*)(sO + t * 256 + 4 * lane);
                const float rs = __builtin_amdgcn_rsqf(wave_sum((v[0] * v[0] + v[1] * v[1]) + (v[2] * v[2] + v[3] * v[3])) * (1.0f / 256.0f) + EPS);
                const float g0 = bf_lo(og[jj].x), g1 = bf_hi(og[jj].x), g2 = bf_lo(og[jj].y), g3 = bf_hi(og[jj].y);
                u32x2 wv; wv.x = pk2(v[0] * rs * gn[0] * silu_(g0), v[1] * rs * gn[1] * silu_(g1)); wv.y = pk2(v[2] * rs * gn[2] * silu_(g2), v[3] * rs * gn[3] * silu_(g3));
                *(u32x2*)(F.P + (row0 + t) * PLD + PC_OG + 256 * hh + 4 * lane) = wv; }
            __syncthreads();
        }
    }
    if constexpr (!FULL) {
        float* ag = gagg + (size_t)((b * 4 + hh) * 3 + j) * GAGG_FLOATS;
#pragma unroll
        for (int kb = 0; kb < 4; ++kb)
#pragma unroll
            for (int g4 = 0; g4 < 4; ++g4) *(f32x4*)(ag + ((size_t)((w * 4 + kb) * 4 + g4)) * 256 + 4 * lane) = (f32x4){S[kb][4 * g4], S[kb][4 * g4 + 1], S[kb][4 * g4 + 2], S[kb][4 * g4 + 3]};
        if (seg == 0) ag[32768 + kk] = ex2(dsum);
    } else if (j == 3) {
        float* sp = F.out + O_SP + (size_t)(b * 4 + hh) * 128 * 256;
#pragma unroll
        for (int kb = 0; kb < 4; ++kb)
#pragma unroll
            for (int i = 0; i < 16; ++i) sp[(size_t)(32 * kb + crow(i, h)) * 256 + 32 * w + r32] = S[kb][i];
    }
    __syncthreads();
}

__device__ __forceinline__ void gla_sample_item(const Frame& F, int item) {
    constexpr int SQ = 0, SK = 512, SE = 1024, RED = 2048;
    const int tid = F.tid, lane = F.lane, w = F.wave; const int hh = item & 3, s = item >> 2;
    LAS float* sq = (LAS float*)(F.lds + SQ); LAS float* sk = (LAS float*)(F.lds + SK); LAS float* se = (LAS float*)(F.lds + SE); LAS float* red = (LAS float*)(F.lds + RED);
    const bf16_t* Prow = F.P + (size_t)(MP + s) * PLD;
    if (tid < 128) { float x = F.in[I_BLR][hh * 128 + tid];
#pragma unroll
        for (int r = 0; r < 16; ++r) x = fmaf(bf2f(Prow[PC_LR + r]), F.in[I_WLR][r * 512 + hh * 128 + tid], x);
        se[tid] = __expf(-softplus_(-x) * (1.0f / 16.0f)); sq[tid] = bf2f(Prow[PC_Q + 128 * hh + tid]) * 0.08838834764831845f; sk[tid] = bf2f(Prow[PC_K + 128 * hh + tid]); }
    __syncthreads();
    const u32x2 vw = *(const u32x2*)(Prow + PC_V + 256 * hh + 4 * lane); const f32x4 v4 = (f32x4){bf_lo(vw.x), bf_hi(vw.x), bf_lo(vw.y), bf_hi(vw.y)};
    const float* S0 = F.in[I_SGLA] + ((size_t)(s * 4 + hh) * 128 + 16 * w) * 256 + 4 * lane; float* S1 = F.out + O_SS + ((size_t)(s * 4 + hh) * 128 + 16 * w) * 256 + 4 * lane;
    f32x4 o4 = (f32x4){0.f, 0.f, 0.f, 0.f};
    f32x4 sv[16];
#pragma unroll
    for (int jj = 0; jj < 16; ++jj) sv[jj] = __builtin_nontemporal_load((const f32x4*)(S0 + jj * 256));
#pragma unroll
    for (int jj = 0; jj < 16; ++jj) { const int k = 16 * w + jj; const f32x4 sn = sv[jj] * se[k] + v4 * sk[k]; __builtin_nontemporal_store(sn, (f32x4*)(S1 + jj * 256)); o4 = o4 + sn * sq[k]; }
    *(LAS f32x4*)(red + w * 256 + 4 * lane) = o4;
    __syncthreads();
    if (w == 0) { f32x4 o = (f32x4){0.f, 0.f, 0.f, 0.f};
#pragma unroll
        for (int ww = 0; ww < 8; ++ww) o = o + *(const LAS f32x4*)(red + ww * 256 + 4 * lane);
        const float rs = rsqrtf(wave_sum((o[0] * o[0] + o[1] * o[1]) + (o[2] * o[2] + o[3] * o[3])) * (1.0f / 256.0f) + EPS);
        const f32x4 gn = *(const f32x4*)(F.in[I_GNG] + 4 * lane); bf16_t* ogp = F.P + (size_t)(MP + s) * PLD + PC_OG + 256 * hh + 4 * lane; const u32x2 ogw = *(const u32x2*)ogp;
        u32x2 wv; wv.x = pk2(o[0] * rs * gn[0] * silu_(bf_lo(ogw.x)), o[1] * rs * gn[1] * silu_(bf_hi(ogw.x))); wv.y = pk2(o[2] * rs * gn[2] * silu_(bf_lo(ogw.y)), o[3] * rs * gn[3] * silu_(bf_hi(ogw.y)));
        *(u32x2*)ogp = wv; }
    __syncthreads();
}

template <int APROV>
__device__ __forceinline__ void skinny_piece(const Frame& F, const bf16_t* A, int lda, const bf16_t* Bt, int K, int k0, int nsub, int cb, const SlabMap om, int oslab) {
    constexpr int SA = 0, SB = 34816, LD = 136;
    const int tid = F.tid, lane = F.lane, w = F.wave, fr = lane & 15, fq = lane >> 4;
    LAS bf16_t* sA = (LAS bf16_t*)(F.lds + SA); LAS bf16_t* sB = (LAS bf16_t*)(F.lds + SB);
    f32x4 acc[8];
#pragma unroll
    for (int nb = 0; nb < 8; ++nb) acc[nb] = (f32x4){0.f, 0.f, 0.f, 0.f};
    for (int sub = 0; sub < nsub; ++sub) { const int kk0 = k0 + 128 * sub;
        __syncthreads();
#pragma unroll
        for (int i = 0; i < 4; ++i) { const int e = tid + NTHR * i, row = e >> 4, c16 = e & 15; u32x4 v;
            if constexpr (APROV == 0) v = *(const u32x4*)(A + (size_t)row * lda + kk0 + 8 * c16);
            else { const int cc = kk0 + 8 * c16; const bf16_t* gp = F.P + (size_t)(MP + row) * PLD + cc;
                float ga[8], gb[8], o[8]; unpack8(*(const u32x4*)(gp + PC_GA), ga); unpack8(*(const u32x4*)(gp + PC_GB), gb);
#pragma unroll
                for (int hf = 0; hf < 2; ++hf) { const f32x4 ya = *(const f32x4*)slab_at(F, SLAB_B, 0, row, cc + 4 * hf) + *(const f32x4*)slab_at(F, SLAB_B, 1, row, cc + 4 * hf), yb = *(const f32x4*)slab_at(F, SLAB_B, 2, row, cc + 4 * hf) + *(const f32x4*)slab_at(F, SLAB_B, 3, row, cc + 4 * hf);
#pragma unroll
                    for (int e2 = 0; e2 < 4; ++e2) o[4 * hf + e2] = sigm(ga[4 * hf + e2]) * ya[e2] + sigm(gb[4 * hf + e2]) * yb[e2]; }
                v = pack8(o); }
            *(LAS u32x4*)(sA + row * LD + 8 * c16) = v;
            *(LAS u32x4*)(sB + row * LD + 8 * c16) = *(const u32x4*)(Bt + (size_t)(128 * cb + row) * K + kk0 + 8 * c16); }
        __syncthreads();
        bf16x8 a[4];
#pragma unroll
        for (int s = 0; s < 4; ++s) a[s] = *(const LAS bf16x8*)(sA + (16 * w + fr) * LD + 32 * s + 8 * fq);
#pragma unroll
        for (int nb = 0; nb < 8; ++nb)
#pragma unroll
            for (int s = 0; s < 4; ++s) { const bf16x8 bb = *(const LAS bf16x8*)(sB + (16 * nb + fr) * LD + 32 * s + 8 * fq); acc[nb] = MFMA16(bb, a[s], acc[nb]); }
    }
#pragma unroll
    for (int nb = 0; nb < 8; ++nb) *(f32x4*)slab_at(F, om, oslab, 16 * w + fr, 128 * cb + 16 * nb + 4 * fq) = acc[nb];
    __syncthreads();
}
}
namespace mk {
constexpr int N_PHASES = 13;
__global__ void __launch_bounds__(NTHR, 2) mega_fwd(Args args) {
    extern __shared__ __attribute__((aligned(16))) unsigned char lds_raw[];
    Frame F;
    F.lds = (LAS unsigned char*)lds_raw;
    F.tid = threadIdx.x; F.lane = F.tid & 63; F.wave = __builtin_amdgcn_readfirstlane(F.tid >> 6);
    F.G = gridDim.x; { const int bx = blockIdx.x; F.vcu = (F.G % 8 == 0) ? (bx % 8) * (F.G / 8) + bx / 8 : bx; }
#pragma unroll
    for (int i = 0; i < 24; ++i) F.in[i] = args.in[i];
    F.out = args.out; F.ws = args.ws;
    F.P = (bf16_t*)(args.ws + WS_P);
    unsigned char* ssr = (unsigned char*)(args.out + O_SS);
    F.U = (bf16_t*)(ssr + SS_U); F.Win_t = (bf16_t*)(ssr + SS_WIN); F.Wgu1_t = (bf16_t*)(ssr + SS_WGU1); F.Wd1_t = (bf16_t*)(ssr + SS_WD1);
    F.Wrg_t = (bf16_t*)(args.ws + WS_WRG); F.Wbr_t = (bf16_t*)(args.ws + WS_WBR); F.Wbg_t = (bf16_t*)(args.ws + WS_WBG); F.Wout_t = (bf16_t*)(args.ws + WS_WOUT);
    F.Wgu2_t = (bf16_t*)(args.ws + WS_WGU2); F.Wd2_t = (bf16_t*)(args.ws + WS_WD2);
    volatile LAS unsigned* MISC = (volatile LAS unsigned*)(F.lds + MISC_OFF);
    for (int u = F.tid; u < 128; u += NTHR) MISC[u] = 0u;
    __syncthreads();
    const int lo = args.ph_lo, hi = args.ph_hi;
    XcdBarrier bar; bar.bar = (unsigned*)(args.ws + WS_CTL) + CW_BAR; bar.x = 0; bar.st = nullptr;
    if (hi - lo > 1) bar = xcd_barrier_post((unsigned*)(args.ws + WS_CTL) + CW_BAR, MISC + 8);
#define IN(k) (lo <= (k) && (k) < hi)
#ifdef TIME_PHASE
    unsigned long long tp0 = 0, tp1 = 0;
#define SEAM(k) do { if ((k) == TIME_PHASE) tp1 = __builtin_amdgcn_s_memrealtime(); if (IN(k) && IN((k) + 1)) xcd_barrier(bar); if ((k) + 1 == TIME_PHASE) tp0 = __builtin_amdgcn_s_memrealtime(); } while (0)
#else
#define SEAM(k) do { if (IN(k) && IN((k) + 1)) xcd_barrier(bar); } while (0)
#endif
    const int gw = F.vcu * NWAVES + F.wave, NGW = F.G * NWAVES;
    LAS float* scr = (LAS float*)(F.lds + F.wave * 16384);
    constexpr bool AL = true, SP = true;

    if (IN(0)) {
        prep_wgu(F, F.in[I_F1GU], F.Wgu1_t, scr, gw, NGW);
        prep_plain(F, F.in[I_F1D], FF, D, F.Wd1_t, scr, gw, NGW);
        prep_win(F, scr, gw, NGW);
        prep_rg(F, scr, gw, NGW);
        prep_plain(F, F.in[I_WBR], D, D, F.Wbr_t, scr, gw, NGW);
        prep_plain(F, F.in[I_WBG], D, D, F.Wbg_t, scr, gw, NGW);
        prep_plain(F, F.in[I_WOUT], D, D, F.Wout_t, scr, gw, NGW);
        rowphase0(F);
    }
    SEAM(0);
    if (IN(1)) {
        pg8::Gemm g{F.P + SC_XA, PLD, F.Wgu1_t, MPAD, 2 * FF, D}; pg8::StaticOrder S; S.init(MPAD, 2 * FF, F.G, (int)blockIdx.x);
        pg8::EpiSwiGLU E{F.P + SC_H, PLD};
        pg8::gemm_phase<pg8::EpiSwiGLU, pg8::StaticOrder, AL, SP>(F.lds, g, S, E);
    }
    SEAM(1);
    if (IN(2)) {
        if (F.vcu < 176) skinny_piece<0>(F, F.P + (size_t)MP * PLD + SC_H, PLD, F.Wd1_t, FF, 128 * (F.vcu >> 3), 1, F.vcu & 7, SLAB_D, F.vcu >> 3);
        pg8::Gemm g{F.P + SC_H, PLD, F.Wd1_t, MP, D, FF}; pg8::StaticOrder S; S.init(MP, D, F.G, (int)blockIdx.x);
        pg8::EpiF32 E{(float*)(F.P + SC_F), PLD / 2};
        pg8::gemm_phase<pg8::EpiF32, pg8::StaticOrder, AL, SP>(F.lds, g, S, E);
    }
    SEAM(2);
    if (IN(3)) rowphase1(F);
    SEAM(3);
    if (IN(4)) {
        pg8::Gemm g{F.U, D, F.Win_t, MPAD, PLD, D}; pg8::StaticOrder S; S.init(MPAD, PLD, F.G, (int)blockIdx.x);
        pg8::EpiBf16 E{F.P, PLD};
        pg8::gemm_phase<pg8::EpiBf16, pg8::StaticOrder, AL, SP>(F.lds, g, S, E);
    }
    SEAM(4);
    if (IN(5)) {
        const int c = F.vcu;
        if (c < 96) gla_item<1>(F, (c / 3) * 4 + (c % 3));
        else {
            for (int i = c - 96; i < 448; i += F.G - 96) rnn_item<false, 1>(F, (i / 7) * 8 + (i % 7));
            for (int i = c - 96; i < 2 * MS; i += F.G - 96) gla_sample_item(F, i);
        }
    }
    SEAM(5);
    if (IN(6)) {
        const int c = F.vcu;
        if (c < 128) gla_item<3>(F, c);
        else {
            for (int i = c - 128; i < 512; i += F.G - 128) rnn_item<false, 3>(F, i);
            if (c < 136) rnn_item<true, 3>(F, c - 128);
            for (int i = 2 * MS + c - 128; i < 4 * MS; i += F.G - 128) gla_sample_item(F, i);
        }
    }
    SEAM(6);
    if (IN(7)) {
        if (F.vcu < 32) { const int gsel = F.vcu >> 4, ks = (F.vcu >> 3) & 1, cb = F.vcu & 7;
            skinny_piece<0>(F, F.P + (size_t)MP * PLD + (gsel ? PC_OG : PC_YR), PLD, gsel ? F.Wbg_t : F.Wbr_t, D, 512 * ks, 4, cb, SLAB_B, 2 * gsel + ks); }
        { pg8::Gemm g{F.P + PC_YR, PLD, F.Wbr_t, MP, D, D}; pg8::StaticOrder S; S.init(MP, D, F.G, (int)blockIdx.x);
          pg8::EpiGateA E{F.P + PC_GA, PLD, (float*)(F.P + SC_T), PLD / 2};
          pg8::gemm_phase<pg8::EpiGateA, pg8::StaticOrder, AL, SP>(F.lds, g, S, E); }
        { pg8::Gemm g{F.P + PC_OG, PLD, F.Wbg_t, MP, D, D}; pg8::StaticOrder S; S.init(MP, D, F.G, (int)blockIdx.x);
          pg8::EpiGateB E{F.P + PC_GB, PLD, (const float*)(F.P + SC_T), PLD / 2, F.P + SC_XA, PLD};
          pg8::gemm_phase<pg8::EpiGateB, pg8::StaticOrder, AL, SP>(F.lds, g, S, E); }
    }
    SEAM(7);
    if (IN(8)) {
        if (F.vcu < 64) skinny_piece<1>(F, nullptr, 0, F.Wout_t, D, 128 * (F.vcu >> 3), 1, F.vcu & 7, SLAB_B, 4 + (F.vcu >> 3));
        pg8::Gemm g{F.P + SC_XA, PLD, F.Wout_t, MP, D, D}; pg8::StaticOrder S; S.init(MP, D, F.G, (int)blockIdx.x);
        pg8::EpiF32 E{(float*)(F.P + SC_T), PLD / 2};
        pg8::gemm_phase<pg8::EpiF32, pg8::StaticOrder, AL, SP>(F.lds, g, S, E);
    }
    SEAM(8);
    if (IN(9)) {
        prep_wgu(F, F.in[I_F2GU], F.Wgu2_t, scr, gw, NGW);
        prep_plain(F, F.in[I_F2D], FF, D, F.Wd2_t, scr, gw, NGW);
        rowphase2(F);
    }
    SEAM(9);
    if (IN(10)) {
        pg8::Gemm g{F.P + SC_XA, PLD, F.Wgu2_t, MPAD, 2 * FF, D}; pg8::StaticOrder S; S.init(MPAD, 2 * FF, F.G, (int)blockIdx.x);
        pg8::EpiSwiGLU E{F.P + SC_H, PLD};
        pg8::gemm_phase<pg8::EpiSwiGLU, pg8::StaticOrder, AL, SP>(F.lds, g, S, E);
    }
    SEAM(10);
    if (IN(11)) {
        if (F.vcu < 176) skinny_piece<0>(F, F.P + (size_t)MP * PLD + SC_H, PLD, F.Wd2_t, FF, 128 * (F.vcu >> 3), 1, F.vcu & 7, SLAB_D, F.vcu >> 3);
        pg8::Gemm g{F.P + SC_H, PLD, F.Wd2_t, MP, D, FF}; pg8::StaticOrder S; S.init(MP, D, F.G, (int)blockIdx.x);
        pg8::EpiF32 E{(float*)(F.P + SC_F), PLD / 2};
        pg8::gemm_phase<pg8::EpiF32, pg8::StaticOrder, AL, SP>(F.lds, g, S, E);
    }
    SEAM(11);
    if (IN(12)) rowphase3(F);
#ifdef TIME_PHASE
    if (F.vcu == TIME_VCU) { const unsigned long long te = __builtin_amdgcn_s_memrealtime(), wait = (unsigned long long)(TIME_MULT) * (tp1 - tp0); while (__builtin_amdgcn_s_memrealtime() - te < wait) __builtin_amdgcn_s_sleep(8); }
#endif
#undef IN
#undef SEAM
}

inline int launch(void* const* d_in, void* d_out, void* d_ws, hipStream_t stream, int n_launches, int ph_lo = 0, int ph_hi = 0) {
    static int grid = 0;
    if (grid == 0) {
        int dev = 0, cus = 0, per_cu = 0;
        if (hipGetDevice(&dev) != hipSuccess || hipDeviceGetAttribute(&cus, hipDeviceAttributeMultiprocessorCount, dev) != hipSuccess) { grid = -1; return -1; }
        if (hipFuncSetAttribute((const void*)mega_fwd, hipFuncAttributeMaxDynamicSharedMemorySize, LDS_BYTES) != hipSuccess) { grid = -1; return -1; }
        if (hipOccupancyMaxActiveBlocksPerMultiprocessor(&per_cu, (const void*)mega_fwd, NTHR, LDS_BYTES) != hipSuccess || per_cu < 1) per_cu = 1;
        (void)hipGetLastError();
        grid = cus;
    }
    if (grid < 0) return -1;
    Args a{};
    for (int i = 0; i < 24; ++i) a.in[i] = (const float*)d_in[i];
    a.out = (float*)d_out; a.ws = (unsigned char*)d_ws;
    if (n_launches == 0) { a.ph_lo = ph_lo; a.ph_hi = ph_hi; hipLaunchKernelGGL(mega_fwd, dim3(grid), dim3(NTHR), LDS_BYTES, stream, a); return 0; }
    (void)hipMemsetAsync((char*)d_ws + WS_CTL, 0, CTL_ZERO_BYTES, stream);
    if (n_launches == 1) { a.ph_lo = 0; a.ph_hi = N_PHASES; hipLaunchKernelGGL(mega_fwd, dim3(grid), dim3(NTHR), LDS_BYTES, stream, a); }
    else for (int p = 0; p < N_PHASES; ++p) { a.ph_lo = p; a.ph_hi = p + 1; hipLaunchKernelGGL(mega_fwd, dim3(grid), dim3(NTHR), LDS_BYTES, stream, a); }
    return 0;
}
}
#ifndef MK_NL
#define MK_NL 1
#endif
extern "C" void kernel_launch(void* const* d_in, const int* in_sizes, int n_in,
                              void* d_out, int out_size, void* d_ws, size_t ws_size,
                              hipStream_t stream) {
    mk::launch(d_in, d_out, d_ws, stream, MK_NL);
}
```

```cpp
#include <hip/hip_runtime.h>
#include <cstdio>
#include <cstdint>

#ifndef DBG_STATIC_FLOATS
#define DBG_STATIC_FLOATS 16
#endif
__device__ float g_static[DBG_STATIC_FLOATS];
#define STATIC_TAG (1ull << 62)
template <class T> __device__ __forceinline__ T* fx(T* p) { const unsigned long long v = (unsigned long long)p; return (v & STATIC_TAG) ? (T*)((char*)g_static + (v & (STATIC_TAG - 1))) : p; }
inline float* static_ptr(size_t float_off) { return (float*)(STATIC_TAG | (unsigned long long)(float_off * 4)); }
namespace nv {
constexpr int D = 1024, FF = 2816, DIN = 7184, TSEQ = 2048, NB = 8, NS = 128;
constexpr int C_XR = 0, C_YR = 1024, C_Q = 2048, C_K = 2560, C_V = 3072, C_OG = 4096, C_LR = 5120, C_GA = 5136, C_GB = 6160;
constexpr float EPS = 1e-6f;
constexpr size_t O_YP = 0, O_YS = 16777216, O_HP = 16908288, O_CP = 16916480, O_SP = 16941056, O_HS = 17989632, O_CS = 18120704, O_SS = 18513920;

__device__ __forceinline__ float sigmoidf_(float x) { return 1.f / (1.f + expf(-x)); }
__device__ __forceinline__ float siluf_(float x) { return x / (1.f + expf(-x)); }
__device__ __forceinline__ float softplusf_(float x) { return fmaxf(x, 0.f) + log1pf(expf(-fabsf(x))); }
__device__ __forceinline__ float logsigmoidf_(float x) { return -softplusf_(-x); }
__device__ __forceinline__ float gelu_tanhf_(float x) { const float c = 0.7978845608028654f; return 0.5f * x * (1.f + tanhf(c * (x + 0.044715f * x * x * x))); }

__device__ __forceinline__ float block_sum256(float v, float* red) {
#pragma unroll
    for (int o = 32; o > 0; o >>= 1) v += __shfl_xor(v, o);
    __syncthreads();
    if ((threadIdx.x & 63) == 0) red[threadIdx.x >> 6] = v;
    __syncthreads();
    return red[0] + red[1] + red[2] + red[3];
}
__global__ void k_rmsnorm(const float* x, const float* g, float* y) { x = fx(x); g = fx(g); y = fx(y);
    __shared__ float red[4];
    const size_t r = blockIdx.x; const float* xr = x + r * D; float v[4]; float s = 0.f;
#pragma unroll
    for (int j = 0; j < 4; ++j) { v[j] = xr[threadIdx.x + 256 * j]; s += v[j] * v[j]; }
    const float tot = block_sum256(s, red); const float rs = rsqrtf(tot / D + EPS);
#pragma unroll
    for (int j = 0; j < 4; ++j) y[r * D + threadIdx.x + 256 * j] = v[j] * rs * g[threadIdx.x + 256 * j];
}
__global__ void k_resnorm(const float* base, const float* f, const float* g, float scale, float* out) { base = fx(base); f = fx(f); g = fx(g); out = fx(out);
    __shared__ float red[4];
    const size_t r = blockIdx.x; const float* fr = f + r * D; float v[4]; float s = 0.f;
#pragma unroll
    for (int j = 0; j < 4; ++j) { v[j] = fr[threadIdx.x + 256 * j]; s += v[j] * v[j]; }
    const float tot = block_sum256(s, red); const float rs = rsqrtf(tot / D + EPS);
#pragma unroll
    for (int j = 0; j < 4; ++j) { const int c = threadIdx.x + 256 * j; out[r * D + c] = base[r * D + c] + scale * (v[j] * rs * g[c]); }
}
__global__ void __launch_bounds__(256) k_gemm(const float* A, int lda, const float* B, int ldb, float* C, int ldc, int M, int N, int K, size_t sA, size_t sB, size_t sC) { A = fx(A); B = fx(B); C = fx(C);
    __shared__ float As[16][64 + 1], Bs[16][64 + 1];
    A += blockIdx.z * sA; B += blockIdx.z * sB; C += blockIdx.z * sC;
    const int m0 = blockIdx.y * 64, n0 = blockIdx.x * 64, tx = threadIdx.x & 15, ty = threadIdx.x >> 4;
    float acc[4][4];
#pragma unroll
    for (int i = 0; i < 4; ++i)
#pragma unroll
        for (int j = 0; j < 4; ++j) acc[i][j] = 0.f;
    for (int k0 = 0; k0 < K; k0 += 16) {
#pragma unroll
        for (int i = 0; i < 4; ++i) { const int e = threadIdx.x + 256 * i; const int m = e >> 4, k = e & 15; As[k][m] = A[(size_t)(m0 + m) * lda + k0 + k]; }
#pragma unroll
        for (int i = 0; i < 4; ++i) { const int e = threadIdx.x + 256 * i; const int k = e >> 6, n = e & 63; Bs[k][n] = (n0 + n < N) ? B[(size_t)(k0 + k) * ldb + n0 + n] : 0.f; }
        __syncthreads();
#pragma unroll
        for (int k = 0; k < 16; ++k) { float a[4], b[4];
#pragma unroll
            for (int i = 0; i < 4; ++i) { a[i] = As[k][ty * 4 + i]; b[i] = Bs[k][tx * 4 + i]; }
#pragma unroll
            for (int i = 0; i < 4; ++i)
#pragma unroll
                for (int j = 0; j < 4; ++j) acc[i][j] = fmaf(a[i], b[j], acc[i][j]); }
        __syncthreads();
    }
#pragma unroll
    for (int i = 0; i < 4; ++i)
#pragma unroll
        for (int j = 0; j < 4; ++j) { const int n = n0 + tx * 4 + j; if (n < N) C[(size_t)(m0 + ty * 4 + i) * ldc + n] = acc[i][j]; }
}
__global__ void k_swiglu(const float* gu, float* h, size_t n) { gu = fx(gu); h = fx(h);
    for (size_t i = blockIdx.x * (size_t)blockDim.x + threadIdx.x; i < n; i += (size_t)gridDim.x * blockDim.x) { const size_t r = i / FF, j = i % FF; h[i] = siluf_(gu[r * (2 * FF) + j]) * gu[r * (2 * FF) + FF + j]; }
}
__global__ void k_conv(const float* P, const float* buf, const float* w, const float* b, float* xc, float* conv_new, int T, int nseq) { P = fx(P); buf = fx(buf); w = fx(w); b = fx(b); xc = fx(xc); conv_new = fx(conv_new);
    const size_t n = (size_t)nseq * T * D;
    for (size_t i = blockIdx.x * (size_t)blockDim.x + threadIdx.x; i < n; i += (size_t)gridDim.x * blockDim.x) {
        const int c = (int)(i % D); const size_t row = i / D; const int t = (int)(row % T); const int seq = (int)(row / T);
        float y = b[c];
#pragma unroll
        for (int j = 0; j < 4; ++j) { const int idx = t + j - 3; float xv;
            if (idx >= 0) xv = P[((size_t)seq * T + idx) * DIN + C_XR + c]; else xv = buf ? buf[((size_t)seq * 3 + (3 + idx)) * D + c] : 0.f;
            y += xv * w[j * D + c]; }
        xc[i] = y;
    }
    const size_t n2 = (size_t)nseq * 3 * D;
    for (size_t i = blockIdx.x * (size_t)blockDim.x + threadIdx.x; i < n2; i += (size_t)gridDim.x * blockDim.x) {
        const int c = (int)(i % D); const int j = (int)((i / D) % 3); const int seq = (int)(i / (3 * D));
        const int xi = T + j;
        float v; if (xi >= 3) v = P[((size_t)seq * T + (xi - 3)) * DIN + C_XR + c]; else v = buf ? buf[((size_t)seq * 3 + xi) * D + c] : 0.f;
        conv_new[i] = v;
    }
}
__global__ void k_rg_elem(const float* xc, const float* RA, const float* RX, const float* b_a, const float* b_x, const float* lam, float* a_out, float* bb_out, int T, int nseq, int reset) { xc = fx(xc); RA = fx(RA); RX = fx(RX); b_a = fx(b_a); b_x = fx(b_x); lam = fx(lam); a_out = fx(a_out); bb_out = fx(bb_out);
    const size_t n = (size_t)nseq * T * D;
    for (size_t i = blockIdx.x * (size_t)blockDim.x + threadIdx.x; i < n; i += (size_t)gridDim.x * blockDim.x) {
        const int c = (int)(i % D); const int t = (int)((i / D) % T);
        const float r = sigmoidf_(RA[i] + b_a[c]), ig = sigmoidf_(RX[i] + b_x[c]);
        const float log_a = -8.0f * r * softplusf_(-lam[c]); const float a = expf(log_a);
        float mult = sqrtf(fmaxf(-expm1f(2.0f * log_a), 0.f)); if (reset && t == 0) mult = 1.0f;
        a_out[i] = a; bb_out[i] = mult * ig * xc[i];
    }
}
__global__ void k_scan(const float* a, const float* bb, const float* h0, float* h, float* h_last, int T, int nseq) { a = fx(a); bb = fx(bb); h0 = fx(h0); h = fx(h); h_last = fx(h_last);
    const int i = blockIdx.x * blockDim.x + threadIdx.x; if (i >= nseq * D) return;
    const int c = i % D, seq = i / D; float hv = h0 ? h0[(size_t)seq * D + c] : 0.f;
    for (int t = 0; t < T; ++t) { const size_t o = ((size_t)seq * T + t) * D + c; hv = a[o] * hv + bb[o]; h[o] = hv; }
    h_last[(size_t)seq * D + c] = hv;
}
__global__ void k_gate_rnn(const float* h, const float* P, float* o, size_t n) { h = fx(h); P = fx(P); o = fx(o);
    for (size_t i = blockIdx.x * (size_t)blockDim.x + threadIdx.x; i < n; i += (size_t)gridDim.x * blockDim.x) { const size_t r = i / D; const int c = (int)(i % D); o[i] = h[i] * gelu_tanhf_(P[r * DIN + C_YR + c]); }
}
__global__ void __launch_bounds__(256) k_gla(const float* P, const float* G, const float* blr, const float* S0, float* O, float* S_out, int T) { P = fx(P); G = fx(G); blr = fx(blr); S0 = fx(S0); O = fx(O); S_out = fx(S_out);
    extern __shared__ float S[];
    __shared__ float sq[128], sk[128], se[128];
    const int head = blockIdx.x & 3, seq = blockIdx.x >> 2, dv = threadIdx.x;
    for (int kk = 0; kk < 128; ++kk) S[kk * 256 + dv] = S0 ? S0[(((size_t)seq * 4 + head) * 128 + kk) * 256 + dv] : 0.f;
    for (int t = 0; t < T; ++t) {
        const size_t row = (size_t)seq * T + t;
        __syncthreads();
        if (dv < 128) { sq[dv] = P[row * DIN + C_Q + head * 128 + dv] * 0.08838834764831845f; sk[dv] = P[row * DIN + C_K + head * 128 + dv];
            se[dv] = expf(logsigmoidf_(G[row * 512 + head * 128 + dv] + blr[head * 128 + dv]) * (1.0f / 16.0f)); }
        __syncthreads();
        const float v = P[row * DIN + C_V + head * 256 + dv]; float o = 0.f;
        for (int kk = 0; kk < 128; ++kk) { const float s = S[kk * 256 + dv] * se[kk] + sk[kk] * v; S[kk * 256 + dv] = s; o = fmaf(sq[kk], s, o); }
        O[row * D + head * 256 + dv] = o;
    }
    for (int kk = 0; kk < 128; ++kk) S_out[(((size_t)seq * 4 + head) * 128 + kk) * 256 + dv] = S[kk * 256 + dv];
}
__global__ void k_gla_out(const float* O, const float* P, const float* gn, float* og_out) { O = fx(O); P = fx(P); gn = fx(gn); og_out = fx(og_out);
    __shared__ float red[4];
    const int head = blockIdx.x & 3; const size_t row = blockIdx.x >> 2; const int dv = threadIdx.x;
    const float o = O[row * D + head * 256 + dv]; const float tot = block_sum256(o * o, red); const float rs = rsqrtf(tot / 256.f + EPS);
    og_out[row * D + head * 256 + dv] = o * rs * gn[dv] * siluf_(P[row * DIN + C_OG + head * 256 + dv]);
}
__global__ void k_merge(const float* P, const float* YA, const float* YB, float* m, size_t n) { P = fx(P); YA = fx(YA); YB = fx(YB); m = fx(m);
    for (size_t i = blockIdx.x * (size_t)blockDim.x + threadIdx.x; i < n; i += (size_t)gridDim.x * blockDim.x) { const size_t r = i / D; const int c = (int)(i % D);
        m[i] = sigmoidf_(P[r * DIN + C_GA + c]) * YA[i] + sigmoidf_(P[r * DIN + C_GB + c]) * YB[i]; }
}
struct In { const float *xp, *xs, *srh, *src, *sgla, *ng, *f1gu, *f1d, *win, *cw, *cb, *rwa, *rba, *rwx, *rbx, *lam, *wlr, *blr, *gng, *wbr, *wbg, *wout, *f2gu, *f2d; };
inline In make_in(void* const* d) { In I; const float** p = (const float**)&I; for (int i = 0; i < 24; ++i) p[i] = (const float*)d[i]; return I; }
inline void gemm(hipStream_t st, const float* A, int lda, const float* B, int ldb, float* C, int ldc, int M, int N, int K, int nz = 1, size_t sA = 0, size_t sB = 0, size_t sC = 0) {
    hipLaunchKernelGGL(k_gemm, dim3((N + 63) / 64, M / 64, nz), dim3(256), 0, st, A, lda, B, ldb, C, ldc, M, N, K, sA, sB, sC);
}
struct Outs { float *y, *h_last, *conv_new, *s_new; };
struct Bufs { float *T0, *T1, *T2, *T3, *T4, *T5, *T6, *T7, *T8, *T9, *GU, *HH, *P, *G; };
inline Bufs make_bufs(float* ws, int R) { Bufs B; const size_t RD = (size_t)R * D; B.T0 = ws; B.T1 = B.T0 + RD; B.T2 = B.T1 + RD; B.T3 = B.T2 + RD; B.T4 = B.T3 + RD; B.T5 = B.T4 + RD; B.T6 = B.T5 + RD; B.T7 = B.T6 + RD; B.T8 = B.T7 + RD; B.T9 = B.T8 + RD;
    B.GU = B.T9 + RD; B.HH = B.GU + (size_t)R * 2 * FF; B.P = B.HH + (size_t)R * FF; B.G = B.P + (size_t)R * DIN; return B; }
inline Outs std_outs(float* out, int grp) { Outs o; const bool smp = (grp == NB);
    o.y = smp ? out + O_YS : out + O_YP + (size_t)grp * TSEQ * D; o.h_last = smp ? out + O_HS : out + O_HP + (size_t)grp * D;
    o.conv_new = smp ? out + O_CS : out + O_CP + (size_t)grp * 3 * D; o.s_new = smp ? out + O_SS : out + O_SP + (size_t)grp * 4 * 128 * 256; return o; }
inline void run_group(hipStream_t st, const In& I, const Outs& O, float* ws, int grp, int s_lo = 0, int s_hi = 12) {
    const bool smp = (grp == NB); const int T = smp ? 1 : TSEQ, nseq = smp ? NS : 1, R = T * nseq;
    const float* x = smp ? I.xs : I.xp + (size_t)grp * TSEQ * D;
    const Bufs B = make_bufs(ws, R);
    float *T0 = B.T0, *T1 = B.T1, *T2 = B.T2, *T3 = B.T3, *T4 = B.T4, *T5 = B.T5, *T6 = B.T6, *T7 = B.T7, *T8 = B.T8, *T9 = B.T9, *GU = B.GU, *HH = B.HH, *P = B.P, *G = B.G;
    const float* ng = I.ng; const size_t n1 = (size_t)R * D; const int EB = 1024;
#define STG(k) if (s_lo <= (k) && (k) < s_hi)
    STG(0) hipLaunchKernelGGL(k_rmsnorm, dim3(R), dim3(256), 0, st, x, ng + 0 * D, T0);
    STG(1) { gemm(st, T0, D, I.f1gu, 2 * FF, GU, 2 * FF, R, 2 * FF, D);
        hipLaunchKernelGGL(k_swiglu, dim3(EB), dim3(256), 0, st, GU, HH, (size_t)R * FF); }
    STG(2) gemm(st, HH, FF, I.f1d, D, T1, D, R, D, FF);
    STG(3) { hipLaunchKernelGGL(k_resnorm, dim3(R), dim3(256), 0, st, x, T1, ng + 1 * D, 0.5f, T2);
        hipLaunchKernelGGL(k_rmsnorm, dim3(R), dim3(256), 0, st, T2, ng + 2 * D, T3); }
    STG(4) gemm(st, T3, D, I.win, DIN, P, DIN, R, DIN, D);
    STG(5) { hipLaunchKernelGGL(k_conv, dim3(EB), dim3(256), 0, st, P, smp ? I.src : nullptr, I.cw, I.cb, T4, O.conv_new, T, nseq);
        gemm(st, T4, D, I.rwa, 128, T5, D, R, 128, 128, 8, 128, 128 * 128, 128);
        gemm(st, T4, D, I.rwx, 128, T6, D, R, 128, 128, 8, 128, 128 * 128, 128);
        hipLaunchKernelGGL(k_rg_elem, dim3(EB), dim3(256), 0, st, T4, T5, T6, I.rba, I.rbx, I.lam, T7, T8, T, nseq, smp ? 0 : 1);
        hipLaunchKernelGGL(k_scan, dim3((nseq * D + 255) / 256), dim3(256), 0, st, T7, T8, smp ? I.srh : nullptr, T9, O.h_last, T, nseq);
        hipLaunchKernelGGL(k_gate_rnn, dim3(EB), dim3(256), 0, st, T9, P, T3, n1);
        gemm(st, P + C_LR, DIN, I.wlr, 512, G, 512, R, 512, 16);
        hipLaunchKernelGGL(k_gla, dim3(nseq * 4), dim3(256), 128 * 256 * 4, st, P, G, I.blr, smp ? I.sgla : nullptr, T7, O.s_new, T);
        hipLaunchKernelGGL(k_gla_out, dim3(R * 4), dim3(256), 0, st, T7, P, I.gng, T8); }
    STG(6) { gemm(st, T3, D, I.wbr, D, T5, D, R, D, D);
        gemm(st, T8, D, I.wbg, D, T6, D, R, D, D);
        hipLaunchKernelGGL(k_merge, dim3(EB), dim3(256), 0, st, P, T5, T6, T9, n1); }
    STG(7) gemm(st, T9, D, I.wout, D, T1, D, R, D, D);
    STG(8) { hipLaunchKernelGGL(k_resnorm, dim3(R), dim3(256), 0, st, T2, T1, ng + 3 * D, 1.0f, T2);
        hipLaunchKernelGGL(k_rmsnorm, dim3(R), dim3(256), 0, st, T2, ng + 4 * D, T0); }
    STG(9) { gemm(st, T0, D, I.f2gu, 2 * FF, GU, 2 * FF, R, 2 * FF, D);
        hipLaunchKernelGGL(k_swiglu, dim3(EB), dim3(256), 0, st, GU, HH, (size_t)R * FF); }
    STG(10) gemm(st, HH, FF, I.f2d, D, T1, D, R, D, FF);
    STG(11) hipLaunchKernelGGL(k_resnorm, dim3(R), dim3(256), 0, st, T2, T1, ng + 5 * D, 0.5f, O.y);
#undef STG
}
}
namespace pg8 {
#define PG8_LAS __attribute__((address_space(3)))
typedef unsigned short bf16_t;
typedef short bf16x8 __attribute__((ext_vector_type(8)));
typedef float f32x4 __attribute__((ext_vector_type(4)));
typedef float f32x2 __attribute__((ext_vector_type(2)));
typedef unsigned u32x4 __attribute__((ext_vector_type(4)));
typedef unsigned u32x2 __attribute__((ext_vector_type(2)));
constexpr int BM = 256, BK = 64, HALF = 128, HTB = HALF * BK * 2, STAGE_BYTES = 8 * HTB, NXCD = 8, WGM = 8;

__host__ __device__ __forceinline__ int lds_byte(int r, int c) { const int st = (r >> 4) * 2 + (c >> 5), rr = r & 15, cc = c & 31, ob = rr * 64 + cc * 2; return st * 1024 + (ob ^ (((ob >> 9) & 1) << 5)); }
__host__ __device__ __forceinline__ void stage_rc(int b, int& R, int& C) { const int st = b / 1024, sb = b % 1024, swz = sb ^ (((sb >> 9) & 1) << 5); R = (st >> 1) * 16 + swz / 64; C = (st & 1) * 32 + (swz % 64) / 2; }
__host__ __device__ __forceinline__ int perm32(int rho) { const int n = rho >> 4, i = rho & 15; return 8 * (i >> 2) + 4 * n + (i & 3); }

struct Unit { int pm, pn; };
struct Gemm { const bf16_t* A; int lda; const bf16_t* Bt; int M, N, K; };

struct StaticOrder {
    int nM, nN, nwg, G, c;
    __host__ __device__ void init(int M, int N, int G_, int c_) { nM = M / BM; nN = N / BM; nwg = nM * nN; G = G_; c = c_; }
    __host__ __device__ bool next(int i, Unit& u) const {
        const long L = (long)i * G + c; if (L >= nwg) return false;
        int wgid = (int)L; { const int q = nwg / NXCD, r = nwg % NXCD, xcd = wgid % NXCD, off = wgid / NXCD; wgid = (xcd < r ? xcd * (q + 1) : r * (q + 1) + (xcd - r) * q) + off; }
        const int nig = WGM * nN, gid = wgid / nig, fm = gid * WGM, gsz = (nM - fm) < WGM ? (nM - fm) : WGM;
        u.pm = fm + ((wgid % nig) % gsz); u.pn = (wgid % nig) / gsz; return true;
    }
    __device__ __forceinline__ void a_ready(const Unit&) const {}
    __device__ __forceinline__ void done(const Unit&) const {}
};

__device__ __forceinline__ unsigned f2bf(float f) { unsigned u = __builtin_bit_cast(unsigned, f); return (u + 0x7fffu + ((u >> 16) & 1u)) >> 16; }
typedef __bf16 hwbf16x2 __attribute__((ext_vector_type(2)));
__device__ __forceinline__ unsigned pk2(float lo, float hi) { const f32x2 v = {lo, hi}; return __builtin_bit_cast(unsigned, __builtin_convertvector(v, hwbf16x2)); }
__device__ __forceinline__ float bf_lo(unsigned w) { return __builtin_bit_cast(float, w << 16); }
__device__ __forceinline__ float bf_hi(unsigned w) { return __builtin_bit_cast(float, w & 0xffff0000u); }
__device__ __forceinline__ float fast_sigmoid(float x) { return __builtin_amdgcn_rcpf(1.0f + __builtin_amdgcn_exp2f(-1.4426950408889634f * x)); }

struct EpiF32 {
    static constexpr bool PERM = false, AFTER_DRAIN = false;
    float* C; int ldc;
    __device__ __forceinline__ void operator()(const f32x4 (&acc)[2][2][4][2], const Unit& u, int wr, int wc, int fr, int fq) const {
        const int row0 = u.pm * BM + wr * 64 + fr, col0 = u.pn * BM + wc * 32 + 4 * fq;
#pragma unroll
        for (int ai = 0; ai < 2; ++ai)
#pragma unroll
            for (int m = 0; m < 4; ++m) { float* rowp = C + (size_t)(row0 + ai * HALF + m * 16) * ldc + col0;
#pragma unroll
                for (int bj = 0; bj < 2; ++bj)
#pragma unroll
                    for (int n = 0; n < 2; ++n) *(f32x4*)(rowp + bj * HALF + n * 16) = acc[ai][bj][m][n]; }
    }
};
struct EpiBf16 {
    static constexpr bool PERM = true, AFTER_DRAIN = false;
    bf16_t* O; int ldc;
    __device__ __forceinline__ void operator()(const f32x4 (&acc)[2][2][4][2], const Unit& u, int wr, int wc, int fr, int fq) const {
        const int row0 = u.pm * BM + wr * 64 + fr, col0 = u.pn * BM + wc * 32 + 8 * fq;
#pragma unroll
        for (int ai = 0; ai < 2; ++ai)
#pragma unroll
            for (int m = 0; m < 4; ++m) { bf16_t* rowp = O + (size_t)(row0 + ai * HALF + m * 16) * ldc + col0;
#pragma unroll
                for (int bj = 0; bj < 2; ++bj) { const f32x4 v0 = acc[ai][bj][m][0], v1 = acc[ai][bj][m][1];
                    u32x4 w; w.x = pk2(v0[0], v0[1]); w.y = pk2(v0[2], v0[3]); w.z = pk2(v1[0], v1[1]); w.w = pk2(v1[2], v1[3]);
                    *(u32x4*)(rowp + bj * HALF) = w; } }
    }
};
struct EpiSwiGLU {
    static constexpr bool PERM = true, AFTER_DRAIN = false;
    bf16_t* O; int ldc;
    __device__ __forceinline__ void operator()(const f32x4 (&acc)[2][2][4][2], const Unit& u, int wr, int wc, int fr, int fq) const {
        const int row0 = u.pm * BM + wr * 64 + fr, col0 = u.pn * HALF + wc * 32 + 8 * fq;
#pragma unroll
        for (int ai = 0; ai < 2; ++ai)
#pragma unroll
            for (int m = 0; m < 4; ++m) { bf16_t* rowp = O + (size_t)(row0 + ai * HALF + m * 16) * ldc + col0;
                float h[8];
#pragma unroll
                for (int n = 0; n < 2; ++n)
#pragma unroll
                    for (int e = 0; e < 4; ++e) { const float g = acc[ai][0][m][n][e], up = acc[ai][1][m][n][e]; h[4 * n + e] = g * fast_sigmoid(g) * up; }
                u32x4 w; w.x = pk2(h[0], h[1]); w.y = pk2(h[2], h[3]); w.z = pk2(h[4], h[5]); w.w = pk2(h[6], h[7]);
                *(u32x4*)rowp = w; }
    }
};
struct EpiMerge {
    static constexpr bool PERM = true, AFTER_DRAIN = false, MID = true;
    const bf16_t* GA; const bf16_t* GB; int ldg; bf16_t* O; int ldc;
    __device__ __forceinline__ void mid(f32x4 (&acc)[2][2][4][2], const Unit& u, int wr, int wc, int fr, int fq) const {
        int row0 = u.pm * BM + wr * 64 + fr; const int col0 = u.pn * BM + wc * 32 + 8 * fq;
        asm volatile("" : "+v"(row0));
#pragma unroll
        for (int ai = 0; ai < 2; ++ai)
#pragma unroll
            for (int m = 0; m < 4; ++m) { const size_t row = (size_t)(row0 + ai * HALF + m * 16);
#pragma unroll
                for (int bj = 0; bj < 2; ++bj) { const u32x4 a = *(const u32x4*)(GA + row * ldg + col0 + bj * HALF), b = *(const u32x4*)(GB + row * ldg + col0 + bj * HALF);
#define PG8_RT(x, y) (fast_sigmoid(x) * (1.0f + __builtin_amdgcn_exp2f(-1.4426950408889634f * (y))))
                    f32x4 r0, r1; r0[0] = PG8_RT(bf_lo(a.x), bf_lo(b.x)); r0[1] = PG8_RT(bf_hi(a.x), bf_hi(b.x)); r0[2] = PG8_RT(bf_lo(a.y), bf_lo(b.y)); r0[3] = PG8_RT(bf_hi(a.y), bf_hi(b.y));
                    r1[0] = PG8_RT(bf_lo(a.z), bf_lo(b.z)); r1[1] = PG8_RT(bf_hi(a.z), bf_hi(b.z)); r1[2] = PG8_RT(bf_lo(a.w), bf_lo(b.w)); r1[3] = PG8_RT(bf_hi(a.w), bf_hi(b.w));
#undef PG8_RT
                    acc[ai][bj][m][0] = acc[ai][bj][m][0] * r0; acc[ai][bj][m][1] = acc[ai][bj][m][1] * r1; }
                if (m & 1) asm volatile("" ::: "memory"); }
    }
    __device__ __forceinline__ void operator()(const f32x4 (&acc)[2][2][4][2], const Unit& u, int wr, int wc, int fr, int fq) const {
        int row0 = u.pm * BM + wr * 64 + fr; const int col0 = u.pn * BM + wc * 32 + 8 * fq;
        asm volatile("" : "+v"(row0));
#pragma unroll
        for (int ai = 0; ai < 2; ++ai)
#pragma unroll
            for (int m = 0; m < 4; ++m) { const size_t row = (size_t)(row0 + ai * HALF + m * 16);
#pragma unroll
                for (int bj = 0; bj < 2; ++bj) { const u32x4 g = *(const u32x4*)(GB + row * ldg + col0 + bj * HALF); const f32x4 v0 = acc[ai][bj][m][0], v1 = acc[ai][bj][m][1];
                    u32x4 w; w.x = pk2(fast_sigmoid(bf_lo(g.x)) * v0[0], fast_sigmoid(bf_hi(g.x)) * v0[1]); w.y = pk2(fast_sigmoid(bf_lo(g.y)) * v0[2], fast_sigmoid(bf_hi(g.y)) * v0[3]);
                    w.z = pk2(fast_sigmoid(bf_lo(g.z)) * v1[0], fast_sigmoid(bf_hi(g.z)) * v1[1]); w.w = pk2(fast_sigmoid(bf_lo(g.w)) * v1[2], fast_sigmoid(bf_hi(g.w)) * v1[3]);
                    *(u32x4*)(O + row * ldc + col0 + bj * HALF) = w; } }
    }
};
template <class E> struct has_mid { template <class T> static auto test(int) -> decltype(T::MID, char()); template <class T> static long test(...); static constexpr bool value = sizeof(test<E>(0)) == 1; };

template <class Epi, class Sched, bool ALIGN_EPI = false, bool SP2 = false>
__device__ __forceinline__ void gemm_phase(PG8_LAS unsigned char* lds, const Gemm g, const Sched& S, const Epi& E) {
    const int tid = threadIdx.x, wid = __builtin_amdgcn_readfirstlane(tid >> 6), lane = tid & 63, wr = wid >> 2, wc = wid & 3, fr = lane & 15, fq = lane >> 4;
    const int K = g.K, nt = K / BK;
    unsigned voffA[2], voffB[2];
#pragma unroll
    for (int i = 0; i < 2; ++i) { int R, C; stage_rc(tid * 16 + i * 8192, R, C); const int Rb = Epi::PERM ? ((R & ~31) + perm32(R & 31)) : R;
        voffA[i] = (unsigned)(R * g.lda + C) * 2u; voffB[i] = (unsigned)(Rb * K + C) * 2u; }
    const size_t kstep = (size_t)(BK * 2);
    const size_t hstepA = (size_t)HALF * g.lda * 2, hstepB = (size_t)HALF * K * 2;
    const size_t tstepA = 2 * hstepA, tstepB = 2 * hstepB;
    const unsigned ldsw = (unsigned)wid * 1024u;
    const int aoff = lds_byte(wr * 64 + fr, fq * 8), boff = lds_byte(wc * 32 + fr, fq * 8);
#define PG8_SA(b, h) (((b) * 2 + (h)) * HTB)
#define PG8_SB(b, h) ((4 + (b) * 2 + (h)) * HTB)
#define PG8_STAGE(bufoff, gbase, voff) do { _Pragma("unroll") for (int _i = 0; _i < 2; ++_i) \
        __builtin_amdgcn_global_load_lds((const unsigned*)((const char*)(gbase) + (voff)[_i]), (PG8_LAS unsigned*)(lds + (bufoff) + ldsw + _i * 8192), 16, 0, 0); } while (0)
#define PG8_LDA(dst, b, h) do { _Pragma("unroll") for (int m = 0; m < 4; ++m) _Pragma("unroll") for (int k = 0; k < 2; ++k) dst[m][k] = *(const PG8_LAS bf16x8*)(lds + PG8_SA(b, h) + aoff + m * 2048 + k * 1024); } while (0)
#define PG8_LDB(dst, b, h) do { _Pragma("unroll") for (int n = 0; n < 2; ++n) _Pragma("unroll") for (int k = 0; k < 2; ++k) dst[n][k] = *(const PG8_LAS bf16x8*)(lds + PG8_SB(b, h) + boff + n * 2048 + k * 1024); } while (0)
#define PG8_MMA(ai, bj, At, Bt) do { __builtin_amdgcn_s_setprio(1); _Pragma("unroll") for (int m = 0; m < 4; ++m) _Pragma("unroll") for (int n = 0; n < 2; ++n) _Pragma("unroll") for (int k = 0; k < 2; ++k) \
        acc[ai][bj][m][n] = __builtin_amdgcn_mfma_f32_16x16x32_bf16(Bt[n][k], At[m][k], acc[ai][bj][m][n], 0, 0, 0); __builtin_amdgcn_s_setprio(0); } while (0)
#define PG8_WAIT_V(n) asm volatile("s_waitcnt vmcnt(" #n ")" ::: "memory")
#define PG8_WAIT_L(n) asm volatile("s_waitcnt lgkmcnt(" #n ")" ::: "memory")
#define PG8_BAR __builtin_amdgcn_s_barrier()
#define PG8_SCHED __builtin_amdgcn_sched_barrier(0)
    Unit cur, nxt; int ui = 0;
    if (!S.next(0, cur)) return;
    f32x4 acc[2][2][4][2];
#pragma unroll
    for (int a = 0; a < 2; ++a)
#pragma unroll
        for (int b = 0; b < 2; ++b)
#pragma unroll
            for (int m = 0; m < 4; ++m)
#pragma unroll
                for (int n = 0; n < 2; ++n) acc[a][b][m][n] = (f32x4){0.f, 0.f, 0.f, 0.f};
    bf16x8 At[4][2], B0[2][2], B1[2][2];
    const char* cA = (const char*)g.A + (size_t)cur.pm * tstepA; const char* cB = (const char*)g.Bt + (size_t)cur.pn * tstepB;
    S.a_ready(cur);
    if constexpr (SP2) {
        PG8_STAGE(PG8_SB(0, 0), cB, voffB); PG8_STAGE(PG8_SB(0, 1), cB + hstepB, voffB); PG8_STAGE(PG8_SA(0, 0), cA, voffA); PG8_STAGE(PG8_SA(0, 1), cA + hstepA, voffA);
        if (wr == 1) PG8_BAR;
        PG8_WAIT_V(2); PG8_BAR;
        PG8_STAGE(PG8_SB(1, 0), cB + kstep, voffB); PG8_STAGE(PG8_SA(1, 0), cA + kstep, voffA); PG8_STAGE(PG8_SB(1, 1), cB + hstepB + kstep, voffB);
        PG8_WAIT_V(6); PG8_BAR;
    } else {
        PG8_STAGE(PG8_SB(0, 0), cB, voffB); PG8_STAGE(PG8_SA(0, 0), cA, voffA); PG8_STAGE(PG8_SB(0, 1), cB + hstepB, voffB); PG8_STAGE(PG8_SA(0, 1), cA + hstepA, voffA);
        if (wr == 1) PG8_BAR;
        PG8_WAIT_V(4); PG8_BAR;
        PG8_STAGE(PG8_SB(1, 0), cB + kstep, voffB); PG8_STAGE(PG8_SA(1, 0), cA + kstep, voffA); PG8_STAGE(PG8_SB(1, 1), cB + hstepB + kstep, voffB);
        PG8_WAIT_V(6); PG8_BAR;
    }
    for (;;) {
        const bool has_next = S.next(ui + 1, nxt);
        const char* nA = has_next ? (const char*)g.A + (size_t)nxt.pm * tstepA : cA; const char* nB = has_next ? (const char*)g.Bt + (size_t)nxt.pn * tstepB : cB;
        constexpr int NSEG = has_mid<Epi>::value ? 2 : 1;
        for (int sg = 0; sg < NSEG; ++sg) {
        if constexpr (has_mid<Epi>::value) { if (sg == 1) E.mid(acc, cur, wr, wc, fr, fq); }
        const int t_end = (sg + 1) * (nt / NSEG);
        for (int t = sg * (nt / NSEG); t < t_end; t += 2) {
            const bool last = (t == nt - 2);
            const char* a1 = cA + (size_t)(t + 1) * kstep;
            const char* a2 = last ? nA : cA + (size_t)(t + 2) * kstep; const char* b2 = last ? nB : cB + (size_t)(t + 2) * kstep;
            const char* a3 = a2 + kstep; const char* b3 = b2 + kstep;
            if (last && has_next) S.a_ready(nxt);
            if constexpr (SP2) {
            PG8_LDB(B0, 0, 0); PG8_LDB(B1, 0, 1); PG8_SCHED; PG8_LDA(At, 0, 0); PG8_STAGE(PG8_SA(1, 1), a1 + hstepA, voffA);
            PG8_WAIT_V(8); PG8_WAIT_L(0); PG8_BAR; PG8_MMA(0, 0, At, B0); PG8_MMA(0, 1, At, B1); PG8_BAR; PG8_SCHED;
            PG8_LDA(At, 0, 1); PG8_STAGE(PG8_SB(0, 0), b2, voffB); PG8_STAGE(PG8_SB(0, 1), b2 + hstepB, voffB); PG8_STAGE(PG8_SA(0, 0), a2, voffA);
            PG8_WAIT_V(8); PG8_WAIT_L(0); PG8_BAR; PG8_MMA(1, 0, At, B0); PG8_MMA(1, 1, At, B1); PG8_BAR; PG8_SCHED;
            PG8_LDB(B0, 1, 0); PG8_LDB(B1, 1, 1); PG8_SCHED; PG8_LDA(At, 1, 0); PG8_STAGE(PG8_SA(0, 1), a2 + hstepA, voffA);
            PG8_WAIT_V(8); PG8_WAIT_L(0); PG8_BAR; PG8_MMA(0, 0, At, B0); PG8_MMA(0, 1, At, B1); PG8_BAR; PG8_SCHED;
            PG8_LDA(At, 1, 1); PG8_STAGE(PG8_SB(1, 0), b3, voffB); PG8_STAGE(PG8_SB(1, 1), b3 + hstepB, voffB); PG8_STAGE(PG8_SA(1, 0), a3, voffA);
            PG8_WAIT_V(8); PG8_WAIT_L(0); PG8_BAR; PG8_MMA(1, 0, At, B0); PG8_MMA(1, 1, At, B1); PG8_BAR; PG8_SCHED;
            } else {
            PG8_LDB(B0, 0, 0); PG8_SCHED; PG8_LDA(At, 0, 0); PG8_STAGE(PG8_SA(1, 1), a1 + hstepA, voffA);
            PG8_WAIT_L(8); PG8_BAR; PG8_WAIT_L(0); PG8_MMA(0, 0, At, B0); PG8_BAR; PG8_SCHED;
            PG8_LDB(B1, 0, 1); PG8_STAGE(PG8_SB(0, 0), b2, voffB);
            PG8_BAR; PG8_WAIT_L(0); PG8_MMA(0, 1, At, B1); PG8_BAR;
            PG8_LDA(At, 0, 1); PG8_STAGE(PG8_SA(0, 0), a2, voffA);
            PG8_BAR; PG8_WAIT_L(0); PG8_MMA(1, 0, At, B0); PG8_BAR; PG8_SCHED;
            PG8_STAGE(PG8_SB(0, 1), b2 + hstepB, voffB);
            PG8_WAIT_V(6); PG8_BAR; PG8_MMA(1, 1, At, B1); PG8_BAR;
            PG8_LDB(B0, 1, 0); PG8_SCHED; PG8_LDA(At, 1, 0); PG8_STAGE(PG8_SA(0, 1), a2 + hstepA, voffA);
            PG8_WAIT_L(8); PG8_BAR; PG8_WAIT_L(0); PG8_MMA(0, 0, At, B0); PG8_BAR; PG8_SCHED;
            PG8_LDB(B1, 1, 1); PG8_STAGE(PG8_SB(1, 0), b3, voffB);
            PG8_BAR; PG8_WAIT_L(0); PG8_MMA(0, 1, At, B1); PG8_BAR;
            PG8_LDA(At, 1, 1); PG8_STAGE(PG8_SA(1, 0), a3, voffA);
            PG8_BAR; PG8_WAIT_L(0); PG8_MMA(1, 0, At, B0); PG8_BAR; PG8_SCHED;
            PG8_STAGE(PG8_SB(1, 1), b3 + hstepB, voffB);
            PG8_WAIT_V(6); PG8_BAR; PG8_MMA(1, 1, At, B1); PG8_BAR;
            }
        }
        }
        if constexpr (ALIGN_EPI) { if (wr == 0) PG8_BAR; }
        if constexpr (!Epi::AFTER_DRAIN) { E(acc, cur, wr, wc, fr, fq); S.done(cur); }
        if (!has_next) break;
#pragma unroll
        for (int a = 0; a < 2; ++a)
#pragma unroll
            for (int b = 0; b < 2; ++b)
#pragma unroll
                for (int m = 0; m < 4; ++m)
#pragma unroll
                    for (int n = 0; n < 2; ++n) acc[a][b][m][n] = (f32x4){0.f, 0.f, 0.f, 0.f};
        cur = nxt; cA = nA; cB = nB; ++ui;
        if constexpr (ALIGN_EPI) { if (wr == 1) PG8_BAR; }
    }
    PG8_WAIT_V(0);
    if constexpr (!ALIGN_EPI) { if (wr == 0) PG8_BAR; }
    PG8_BAR;
#undef PG8_SA
#undef PG8_SB
#undef PG8_STAGE
#undef PG8_LDA
#undef PG8_LDB
#undef PG8_MMA
#undef PG8_WAIT_V
#undef PG8_WAIT_L
#undef PG8_BAR
#undef PG8_SCHED
}
}
namespace mk {
using pg8::bf16_t; using pg8::bf16x8; using pg8::f32x4; using pg8::f32x2; using pg8::u32x4; using pg8::u32x2; using pg8::f2bf; using pg8::pk2; using pg8::bf_lo; using pg8::bf_hi;
#define LAS __attribute__((address_space(3)))
typedef float f32x16 __attribute__((ext_vector_type(16)));
constexpr int NWAVES = 8, NTHR = 512;
constexpr int D = 1024, FF = 2816, DIN = 7184, MP = 16384, MS = 128, MT = 16512, MPAD = 16640, TSEQ = 2048, NB = 8;
constexpr int PLD = 7424;
constexpr int PC_XR = 0, PC_YR = 1024, PC_OG = 2048, PC_Q = 3072, PC_K = 3584, PC_V = 4096, PC_GA = 5120, PC_GB = 6144, PC_LR = 7168;
constexpr int SC_XA = 0, SC_H = 1024, SC_T = 3072, SC_F = 5120;
constexpr float EPS = 1e-6f;
constexpr size_t O_YP = 0, O_YS = 16777216, O_HP = 16908288, O_CP = 16916480, O_SP = 16941056, O_HS = 17989632, O_CS = 18120704, O_SS = 18513920;
constexpr size_t MiB = 1u << 20;
constexpr size_t WS_CTL = 0, CTL_ZERO_BYTES = 64 * 1024;
constexpr size_t WS_P = 1 * MiB;
constexpr size_t WS_TAIL = 237 * MiB;
constexpr size_t WS_WRG = WS_TAIL, WS_WBR = WS_TAIL + MiB / 2, WS_WBG = WS_WBR + 2 * MiB, WS_WOUT = WS_WBG + 2 * MiB;
constexpr size_t WS_WGU2 = WS_TAIL, WS_WD2 = WS_TAIL + 11 * MiB;
static_assert(WS_P + (size_t)MPAD * PLD * 2 <= WS_TAIL && WS_WOUT + 2 * MiB <= 256 * MiB && WS_WD2 + (size_t)D * FF * 2 <= 256 * MiB, "d_ws map");
constexpr size_t SS_U = 0, SS_WIN = (size_t)MPAD * D * 2, SS_WGU1 = SS_WIN + (size_t)PLD * D * 2, SS_WD1 = SS_WGU1 + (size_t)2 * FF * D * 2;
static_assert(SS_WD1 + (size_t)D * FF * 2 <= 64 * MiB, "ss-region map");
constexpr int CW_BAR = 4096;
constexpr int LDS_BYTES = 163840, MISC_OFF = LDS_BYTES - 512;

#define RLX_AGENT __ATOMIC_RELAXED, __HIP_MEMORY_SCOPE_AGENT
#define LDS_WAIT() asm volatile("s_waitcnt lgkmcnt(0)" ::: "memory")
#define VM_WAIT() asm volatile("s_waitcnt vmcnt(0)" ::: "memory")

#define XB_TMO      128
#define XB_XCNT(j)  (256  + 64 * (j))
#define XB_XSUB(j)  (1280 + 64 * (j))
#define XB_XGEN(j)  (2304 + 64 * (j))
#define XB_TOP      3328
#define XB_TOPGEN   3392
#define XCD_BAR_WORDS 3456
#define XB_SPIN_CAP (1u << 18)
__device__ __forceinline__ unsigned xb_ld(unsigned* p)              { return __hip_atomic_load(p, __ATOMIC_RELAXED, __HIP_MEMORY_SCOPE_AGENT); }
__device__ __forceinline__ unsigned xb_add(unsigned* p, unsigned v) { return __hip_atomic_fetch_add(p, v, __ATOMIC_RELAXED, __HIP_MEMORY_SCOPE_AGENT); }
__device__ __forceinline__ unsigned xb_xcc_id() { return (unsigned)__builtin_amdgcn_s_getreg((3 << 11) | 20) & 0xFu; }
#define XB_SPIN(cond, bar) do { unsigned _sp = 0; while (cond) { __builtin_amdgcn_s_sleep(1); \
    if ((++_sp & 255u) == 0u) { if (xb_ld(&(bar)[XB_TMO])) break; if (_sp > XB_SPIN_CAP) { atomicAdd(&(bar)[XB_TMO], 1u); break; } } } } while (0)
struct XcdBarrier { unsigned* bar; unsigned x; volatile LAS unsigned* st; };
__device__ __forceinline__ XcdBarrier xcd_barrier_post(unsigned* bar, volatile LAS unsigned* st) {
    XcdBarrier b; b.bar = bar; b.x = xb_xcc_id(); b.st = st;
    if (threadIdx.x == 0) (void)xb_add(&bar[XB_XCNT(b.x)], 1u);
    return b;
}
__device__ __forceinline__ void xcd_barrier_complete(unsigned* bar, unsigned x, unsigned& nloc, unsigned& nx) {
    const unsigned G = gridDim.x * gridDim.y * gridDim.z;
    unsigned sum, cnt, mine, sp = 0u;
    for (;;) {
        sum = 0u; cnt = 0u; mine = 0u;
#pragma unroll
        for (unsigned j = 0; j < 16; ++j) { const unsigned c = xb_ld(&bar[XB_XCNT(j)]); sum += c; cnt += (c > 0u) ? 1u : 0u; mine = (j == x) ? c : mine; }
        if (sum == G) break;
        __builtin_amdgcn_s_sleep(1);
        if ((++sp & 255u) == 0u) { if (xb_ld(&bar[XB_TMO])) break; if (sp > XB_SPIN_CAP) { atomicAdd(&bar[XB_TMO], 1u); break; } }
    }
    nloc = mine > 0u ? mine : 1u; nx = cnt > 0u ? cnt : 1u;
}
__device__ __forceinline__ void xcd_barrier(const XcdBarrier& b) {
    asm volatile("s_waitcnt vmcnt(0)" ::: "memory");
    __syncthreads();
    if (threadIdx.x == 0) {
        unsigned* bar = b.bar;
        __builtin_amdgcn_s_waitcnt(0);
        unsigned nloc = b.st[0], nx = b.st[1];
        if (nloc == 0u) { xcd_barrier_complete(bar, b.x, nloc, nx); b.st[0] = nloc; b.st[1] = nx; }
        const unsigned old = xb_add(&bar[XB_XSUB(b.x)], 1u);
        const unsigned gen = old / nloc;
        if (old + 1u == (gen + 1u) * nloc) {
            __builtin_amdgcn_fence(__ATOMIC_RELEASE, "agent");
            asm volatile("s_waitcnt vmcnt(0)" ::: "memory");
            const unsigned og = xb_add(&bar[XB_TOP], 1u);
            const unsigned tg = og / nx;
            if (og + 1u == (tg + 1u) * nx) xb_add(&bar[XB_TOPGEN], 1u);
            else XB_SPIN(xb_ld(&bar[XB_TOPGEN]) == tg, bar);
            __builtin_amdgcn_fence(__ATOMIC_ACQUIRE, "agent");
            xb_add(&bar[XB_XGEN(b.x)], 1u);
            asm volatile("s_waitcnt vmcnt(0)" ::: "memory");
        } else {
            XB_SPIN(xb_ld(&bar[XB_XGEN(b.x)]) == gen, bar);
            __builtin_amdgcn_fence(__ATOMIC_ACQUIRE, "agent");
            asm volatile("s_waitcnt vmcnt(0)" ::: "memory");
        }
    }
    __syncthreads();
}

struct Args { const float* in[24]; float* out; unsigned char* ws; int ph_lo, ph_hi; };
struct Frame {
    LAS unsigned char* lds; int tid, lane, wave, vcu, G;
    const float* in[24]; float* out; unsigned char* ws;
    bf16_t* P; bf16_t* U; bf16_t* Win_t; bf16_t* Wgu1_t; bf16_t* Wd1_t; bf16_t* Wrg_t; bf16_t* Wbr_t; bf16_t* Wbg_t; bf16_t* Wout_t; bf16_t* Wgu2_t; bf16_t* Wd2_t;
};
enum { I_XP = 0, I_XS, I_SRH, I_SRC, I_SGLA, I_NG, I_F1GU, I_F1D, I_WIN, I_CW, I_CB, I_RWA, I_RBA, I_RWX, I_RBX, I_LAM, I_WLR, I_BLR, I_GNG, I_WBR, I_WBG, I_WOUT, I_F2GU, I_F2D };

__device__ __forceinline__ float wave_sum(float v) {
#pragma unroll
    for (int o = 1; o < 64; o <<= 1) v += __shfl_xor(v, o);
    return v;
}
__device__ __forceinline__ const float* xrow_ptr(const Frame& F, int row) { return row < MP ? F.in[I_XP] + (size_t)row * D : F.in[I_XS] + (size_t)(row - MP) * D; }
__device__ __forceinline__ void load_row16(const float* p, int lane, f32x4 (&v)[4]) {
#pragma unroll
    for (int j = 0; j < 4; ++j) v[j] = *(const f32x4*)(p + 4 * lane + 256 * j);
}
__device__ __forceinline__ float sumsq16(const f32x4 (&v)[4]) { float s = 0.f;
#pragma unroll
    for (int j = 0; j < 4; ++j) s += (v[j].x * v[j].x + v[j].y * v[j].y) + (v[j].z * v[j].z + v[j].w * v[j].w);
    return s; }
__device__ __forceinline__ void store_row16_bf16(bf16_t* p, int lane, const f32x4 (&v)[4]) {
#pragma unroll
    for (int j = 0; j < 4; ++j) { u32x2 w; w.x = pk2(v[j].x, v[j].y); w.y = pk2(v[j].z, v[j].w); *(u32x2*)(p + 4 * lane + 256 * j) = w; }
}
struct SlabMap { int slot, logw; };
__device__ __forceinline__ float* slab_at(const Frame& F, const SlabMap m, int s, int r, int c) {
    return (float*)(F.P + (size_t)(((s * MS + r) << (10 - m.logw)) + (c >> m.logw)) * PLD + m.slot) + (c & ((1 << m.logw) - 1)); }
constexpr SlabMap SLAB_D = {SC_XA, 9};
constexpr SlabMap SLAB_B = {PC_LR, 7};
__device__ __forceinline__ void load_row16_f(const Frame& F, int row, int slot, const SlabMap m, int slab0, int ns, f32x4 (&v)[4]) {
    if (row < MP) { load_row16((const float*)(F.P + (size_t)row * PLD + slot), F.lane, v); return; }
#pragma unroll
    for (int j = 0; j < 4; ++j) v[j] = (f32x4){0.f, 0.f, 0.f, 0.f};
    for (int s = 0; s < ns; ++s) {
#pragma unroll
        for (int j = 0; j < 4; ++j) v[j] = v[j] + *(const f32x4*)slab_at(F, m, slab0 + s, row - MP, 4 * F.lane + 256 * j); }
}
__device__ __forceinline__ void rowphase0(const Frame& F) {
    const int gw = F.vcu * NWAVES + F.wave, NGW = F.G * NWAVES; const float* g0 = F.in[I_NG];
    f32x4 g[4]; load_row16(g0, F.lane, g);
    for (int row = gw; row < MT; row += NGW) {
        f32x4 v[4]; load_row16(xrow_ptr(F, row), F.lane, v);
        const float rs = rsqrtf(wave_sum(sumsq16(v)) * (1.f / D) + EPS);
#pragma unroll
        for (int j = 0; j < 4; ++j) v[j] = v[j] * rs * g[j];
        store_row16_bf16(F.P + (size_t)row * PLD + SC_XA, F.lane, v);
    }
}
__device__ __forceinline__ void rowphase1(const Frame& F) {
    const int gw = F.vcu * NWAVES + F.wave, NGW = F.G * NWAVES; const float* ng = F.in[I_NG];
    f32x4 g1[4], g2[4]; load_row16(ng + 1 * D, F.lane, g1); load_row16(ng + 2 * D, F.lane, g2);
    for (int row = gw; row < MT; row += NGW) {
        f32x4 f[4], x[4]; load_row16_f(F, row, SC_F, SLAB_D, 0, 22, f); load_row16(xrow_ptr(F, row), F.lane, x);
        const float rs = rsqrtf(wave_sum(sumsq16(f)) * (1.f / D) + EPS);
#pragma unroll
        for (int j = 0; j < 4; ++j) x[j] = x[j] + 0.5f * (f[j] * rs * g1[j]);
        float* o = F.out + (size_t)row * D;
#pragma unroll
        for (int j = 0; j < 4; ++j) *(f32x4*)(o + 4 * F.lane + 256 * j) = x[j];
        const float rs2 = rsqrtf(wave_sum(sumsq16(x)) * (1.f / D) + EPS);
#pragma unroll
        for (int j = 0; j < 4; ++j) x[j] = x[j] * rs2 * g2[j];
        store_row16_bf16(F.U + (size_t)row * D, F.lane, x);
    }
}
__device__ __forceinline__ void rowphase2(const Frame& F) {
    const int gw = F.vcu * NWAVES + F.wave, NGW = F.G * NWAVES; const float* ng = F.in[I_NG];
    f32x4 g3[4], g4[4]; load_row16(ng + 3 * D, F.lane, g3); load_row16(ng + 4 * D, F.lane, g4);
    for (int row = gw; row < MT; row += NGW) {
        f32x4 f[4], x[4]; load_row16_f(F, row, SC_T, SLAB_B, 4, 8, f); float* o = F.out + (size_t)row * D; load_row16(o, F.lane, x);
        const float rs = rsqrtf(wave_sum(sumsq16(f)) * (1.f / D) + EPS);
#pragma unroll
        for (int j = 0; j < 4; ++j) x[j] = x[j] + f[j] * rs * g3[j];
#pragma unroll
        for (int j = 0; j < 4; ++j) *(f32x4*)(o + 4 * F.lane + 256 * j) = x[j];
        const float rs2 = rsqrtf(wave_sum(sumsq16(x)) * (1.f / D) + EPS);
#pragma unroll
        for (int j = 0; j < 4; ++j) x[j] = x[j] * rs2 * g4[j];
        store_row16_bf16(F.P + (size_t)row * PLD + SC_XA, F.lane, x);
    }
}
__device__ __forceinline__ void rowphase3(const Frame& F) {
    const int gw = F.vcu * NWAVES + F.wave, NGW = F.G * NWAVES; const float* ng = F.in[I_NG];
    f32x4 g5[4]; load_row16(ng + 5 * D, F.lane, g5);
    for (int row = gw; row < MT; row += NGW) {
        f32x4 f[4], x[4]; load_row16_f(F, row, SC_F, SLAB_D, 0, 22, f); float* o = F.out + (size_t)row * D; load_row16(o, F.lane, x);
        const float rs = rsqrtf(wave_sum(sumsq16(f)) * (1.f / D) + EPS);
#pragma unroll
        for (int j = 0; j < 4; ++j) *(f32x4*)(o + 4 * F.lane + 256 * j) = x[j] + 0.5f * (f[j] * rs * g5[j]);
    }
}

__device__ __forceinline__ void tr_item(const float* W, int ldw, int K, int k0, int scol0, int nvalid, bf16_t* WT, int drow0, LAS float* scr, int lane, int ldt = 0) {
    if (ldt == 0) ldt = K;
    { const int c4 = lane & 7, r = lane >> 3; const bool ok = 4 * c4 < nvalid; f32x4 v[8];
#pragma unroll
      for (int i = 0; i < 8; ++i) v[i] = ok ? *(const f32x4*)(W + (size_t)(k0 + r + 8 * i) * ldw + scol0 + 4 * c4) : (f32x4){0.f, 0.f, 0.f, 0.f};
#pragma unroll
      for (int i = 0; i < 8; ++i) { LAS float* d = scr + (r + 8 * i) * 33 + 4 * c4; d[0] = v[i][0]; d[1] = v[i][1]; d[2] = v[i][2]; d[3] = v[i][3]; } }
    LDS_WAIT(); asm volatile("" ::: "memory");
    const int c = lane & 7;
#pragma unroll
    for (int j = 0; j < 4; ++j) { const int n = (lane >> 3) + 8 * j; const LAS float* s = scr + (8 * c) * 33 + n;
        u32x4 o; o.x = pk2(s[0 * 33], s[1 * 33]); o.y = pk2(s[2 * 33], s[3 * 33]); o.z = pk2(s[4 * 33], s[5 * 33]); o.w = pk2(s[6 * 33], s[7 * 33]);
        *(u32x4*)(WT + (size_t)(drow0 + n) * ldt + k0 + 8 * c) = o; }
    LDS_WAIT(); asm volatile("" ::: "memory");
}
__device__ __forceinline__ void prep_wgu(const Frame& F, const float* W, bf16_t* WT, LAS float* scr, int gw, int NGW) {
    constexpr int KB = D / 64, RB = 2 * FF / 32;
    for (int it = gw; it < KB * RB; it += NGW) { const int kb = it / RB, rb = it % RB, n0 = 32 * rb, pn = n0 >> 8, bj = (n0 >> 7) & 1, j = n0 & 127;
        tr_item(W, 2 * FF, D, 64 * kb, bj * FF + 128 * pn + j, 32, WT, n0, scr, F.lane); }
}
__device__ __forceinline__ void prep_plain(const Frame& F, const float* W, int K, int N, bf16_t* WT, LAS float* scr, int gw, int NGW, int ldt = 0) {
    const int KB = K / 64, RB = N / 32;
    for (int it = gw; it < KB * RB; it += NGW) { const int kb = it / RB, rb = it % RB; tr_item(W, N, K, 64 * kb, 32 * rb, 32, WT, 32 * rb, scr, F.lane, ldt); }
}
__device__ __forceinline__ void prep_win(const Frame& F, LAS float* scr, int gw, int NGW) {
    constexpr int KB = D / 64, RB = PLD / 32;
    for (int it = gw; it < KB * RB; it += NGW) { const int kb = it / RB, rb = it % RB, n0 = 32 * rb; int sc, nv = 32;
        if (n0 < 2048) sc = n0;
        else if (n0 < 3072) sc = 4096 + (n0 - 2048);
        else if (n0 < 3584) sc = 2048 + (n0 - 3072);
        else if (n0 < 4096) sc = 2560 + (n0 - 3584);
        else if (n0 < 5120) sc = 3072 + (n0 - 4096);
        else if (n0 < 6144) sc = 5136 + (n0 - 5120);
        else if (n0 < 7168) sc = 6160 + (n0 - 6144);
        else if (n0 == 7168) { sc = 5120; nv = 16; }
        else { sc = 0; nv = 0; }
        tr_item(F.in[I_WIN], DIN, D, 64 * kb, sc, nv, F.Win_t, n0, scr, F.lane); }
}
__device__ __forceinline__ void prep_rg(const Frame& F, LAS float* scr, int gw, int NGW) {
    for (int it = gw; it < 2 * 8 * 8; it += NGW) { const int gate = it >> 6, n = (it >> 3) & 7, sub = it & 7, kb = sub >> 2, rb = sub & 3;
        tr_item(F.in[gate ? I_RWX : I_RWA] + (size_t)n * 16384, 128, 128, 64 * kb, 32 * rb, 32, F.Wrg_t + (size_t)(gate * 8 + n) * 16384, 32 * rb, scr, F.lane); }
}
}
namespace mk {
#define MFMA16(a, b, c) __builtin_amdgcn_mfma_f32_16x16x32_bf16((a), (b), (c), 0, 0, 0)
#define MFMA32(a, b, c) __builtin_amdgcn_mfma_f32_32x32x16_bf16((a), (b), (c), 0, 0, 0)
constexpr float LOG2E = 1.4426950408889634f;
__device__ __forceinline__ float bf2f(bf16_t h) { return __builtin_bit_cast(float, (unsigned)h << 16); }
__device__ __forceinline__ float ex2(float x) { return __builtin_amdgcn_exp2f(x); }
__device__ __forceinline__ float sigm(float x) { return __builtin_amdgcn_rcpf(1.0f + ex2(-LOG2E * x)); }
__device__ __forceinline__ float softplus_(float x) { return fmaxf(x, 0.f) + log1pf(__expf(-fabsf(x))); }
__device__ __forceinline__ float gelu_tanh_(float x) { return x * sigm(1.5957691216057308f * (x + 0.044715f * x * x * x)); }
__device__ __forceinline__ float silu_(float x) { return x * sigm(x); }
__device__ __forceinline__ void unpack8(const u32x4 w, float (&f)[8]) { f[0] = bf_lo(w.x); f[1] = bf_hi(w.x); f[2] = bf_lo(w.y); f[3] = bf_hi(w.y); f[4] = bf_lo(w.z); f[5] = bf_hi(w.z); f[6] = bf_lo(w.w); f[7] = bf_hi(w.w); }
__device__ __forceinline__ u32x4 pack8(const float (&f)[8]) { u32x4 w; w.x = pk2(f[0], f[1]); w.y = pk2(f[2], f[3]); w.z = pk2(f[4], f[5]); w.w = pk2(f[6], f[7]); return w; }

constexpr size_t WS_GAGG = WS_WOUT + 2 * MiB, GAGG_FLOATS = 32768 + 128, WS_RAGG = 128 * 1024;
static_assert(WS_GAGG + (size_t)96 * GAGG_FLOATS * 4 <= 256 * MiB && WS_RAGG + 512 * 256 * 4 <= WS_P, "mixer scratch map");

template <bool SAMPLE, int MODE>
__device__ __forceinline__ void rnn_item(const Frame& F, int item) {
    constexpr int XRAW_OFF = 0, XRAW_LD = 136, XCF_OFF = 18432, XCF_LD = 132, XCB_OFF = 52224, XCB_LD = 136, HB_OFF = 69632, CW_OFF = 103424;
    constexpr bool FULL = SAMPLE || MODE == 3;
    const int tid = F.tid, lane = F.lane, wid = F.wave;
    const int seg = SAMPLE ? 0 : (item & 7), n = SAMPLE ? item : ((item >> 3) & 7), b = SAMPLE ? 0 : (item >> 6), ch0 = 128 * n;
    LAS bf16_t* XRAW = (LAS bf16_t*)(F.lds + XRAW_OFF); LAS float* XCF = (LAS float*)(F.lds + XCF_OFF); LAS bf16_t* XCB = (LAS bf16_t*)(F.lds + XCB_OFF);
    LAS float* HB = (LAS float*)(F.lds + HB_OFF); LAS float* CW = (LAS float*)(F.lds + CW_OFF);
    for (int i = tid; i < 5 * 128; i += NTHR) { const int j = i >> 7, c = i & 127; CW[i] = j < 4 ? F.in[I_CW][j * D + ch0 + c] : F.in[I_CB][ch0 + c]; }
    const int q = lane >> 4, cl = 16 * wid + (lane & 15);
    const float ba = F.in[I_RBA][ch0 + cl], bx = F.in[I_RBX][ch0 + cl], sp8 = 8.0f * softplus_(-F.in[I_LAM][ch0 + cl]), sp8l2 = sp8 * LOG2E;
    bf16x8 Bw[2][4];
#pragma unroll
    for (int g = 0; g < 2; ++g)
#pragma unroll
        for (int ks = 0; ks < 4; ++ks) Bw[g][ks] = *(const bf16x8*)(F.Wrg_t + ((size_t)(g * 8 + n) * 128 + cl) * 128 + 32 * ks + 8 * q);
    const int t5 = tid >> 3, c5 = 16 * (tid & 7);
    float* ragg = (float*)(F.ws + WS_RAGG);
    float carry = 0.f, aprod = 1.f;
    if constexpr (!SAMPLE && MODE == 3) {
        float fa[7], fh[7];
#pragma unroll
        for (int s = 0; s < 7; ++s) { const float* ag = ragg + ((size_t)((b * 8 + n) * 8 + s)) * 256; fa[s] = s < seg ? ag[cl] : 1.f; fh[s] = s < seg ? ag[128 + cl] : 0.f; }
#pragma unroll
        for (int s = 0; s < 7; ++s) carry = fmaf(fa[s], carry, fh[s]);
    }
    const int ntiles = SAMPLE ? 2 : 4, tile0 = SAMPLE ? 0 : 4 * seg;
    u32x4 pxr[3], py0 = (u32x4){0u, 0u, 0u, 0u}, py1 = py0;
    auto prefetch = [&](int t0n) {
        if constexpr (!SAMPLE) {
#pragma unroll
            for (int i3 = 0; i3 < 3; ++i3) { const int e = tid + NTHR * i3, i = e >> 4, chk = e & 15, t = t0n - 3 + i; pxr[i3] = (u32x4){0u, 0u, 0u, 0u};
                if (e < 67 * 16 && t >= 0) pxr[i3] = *(const u32x4*)(F.P + ((size_t)b * TSEQ + t) * PLD + PC_XR + ch0 + 8 * chk); }
            if constexpr (FULL) { const bf16_t* yp = F.P + ((size_t)b * TSEQ + t0n + t5) * PLD + PC_YR + ch0 + c5; py0 = *(const u32x4*)yp; py1 = *(const u32x4*)(yp + 8); }
        }
    };
    if constexpr (!SAMPLE) prefetch(64 * tile0);
    __syncthreads();
    for (int tt = 0; tt < ntiles; ++tt) {
        const int t0 = 64 * (tile0 + tt);
        const size_t row5 = SAMPLE ? (size_t)(MP + t0 + t5) : (size_t)b * TSEQ + t0 + t5;
        bf16_t* yrp = F.P + row5 * PLD + PC_YR + ch0 + c5;
        u32x4 y0 = py0, y1 = py1;
        if constexpr (SAMPLE) { y0 = *(const u32x4*)yrp; y1 = *(const u32x4*)(yrp + 8); }
        if constexpr (!SAMPLE) {
#pragma unroll
            for (int i3 = 0; i3 < 3; ++i3) { const int e = tid + NTHR * i3, i = e >> 4, chk = e & 15; if (e < 67 * 16) *(LAS u32x4*)(XRAW + i * XRAW_LD + 8 * chk) = pxr[i3]; }
            __syncthreads();
            if (tt + 1 < ntiles) prefetch(t0 + 64);
            const int c0 = 8 * (tid & 15);
            float w[4][8], cb8[8];
#pragma unroll
            for (int e = 0; e < 8; ++e) { cb8[e] = CW[4 * 128 + c0 + e];
#pragma unroll
                for (int j = 0; j < 4; ++j) w[j][e] = CW[j * 128 + c0 + e]; }
#pragma unroll
            for (int rr = 0; rr < 2; ++rr) { const int t = (tid >> 4) + 32 * rr; float xc[8];
#pragma unroll
                for (int e = 0; e < 8; ++e) xc[e] = cb8[e];
#pragma unroll
                for (int j = 0; j < 4; ++j) { float x[8]; unpack8(*(const LAS u32x4*)(XRAW + (t + j) * XRAW_LD + c0), x);
#pragma unroll
                    for (int e = 0; e < 8; ++e) xc[e] = fmaf(w[j][e], x[e], xc[e]); }
                *(LAS f32x4*)(XCF + t * XCF_LD + c0) = (f32x4){xc[0], xc[1], xc[2], xc[3]}; *(LAS f32x4*)(XCF + t * XCF_LD + c0 + 4) = (f32x4){xc[4], xc[5], xc[6], xc[7]};
                *(LAS u32x4*)(XCB + t * XCB_LD + c0) = pack8(xc); }
        } else {
            const int s = t0 + t5; const bf16_t* xrp = F.P + (size_t)(MP + s) * PLD + PC_XR + ch0 + c5;
            float xr[16]; { float a8[8], b8[8]; unpack8(*(const u32x4*)xrp, a8); unpack8(*(const u32x4*)(xrp + 8), b8);
#pragma unroll
                for (int e = 0; e < 8; ++e) { xr[e] = a8[e]; xr[8 + e] = b8[e]; } }
            const float* bufp = F.in[I_SRC] + (size_t)s * 3 * D + ch0 + c5; float* csp = F.out + O_CS + (size_t)s * 3 * D + ch0 + c5;
            float xc[16];
#pragma unroll
            for (int e = 0; e < 16; ++e) xc[e] = CW[4 * 128 + c5 + e] + CW[3 * 128 + c5 + e] * xr[e];
#pragma unroll
            for (int j = 0; j < 3; ++j)
#pragma unroll
                for (int v4 = 0; v4 < 4; ++v4) { const f32x4 bv = *(const f32x4*)(bufp + j * D + 4 * v4);
#pragma unroll
                    for (int e = 0; e < 4; ++e) xc[4 * v4 + e] = fmaf(CW[j * 128 + c5 + 4 * v4 + e], bv[e], xc[4 * v4 + e]);
                    if (j >= 1) *(f32x4*)(csp + (j - 1) * D + 4 * v4) = bv; }
#pragma unroll
            for (int v4 = 0; v4 < 4; ++v4) { *(f32x4*)(csp + 2 * D + 4 * v4) = (f32x4){xr[4 * v4], xr[4 * v4 + 1], xr[4 * v4 + 2], xr[4 * v4 + 3]};
                *(LAS f32x4*)(XCF + t5 * XCF_LD + c5 + 4 * v4) = (f32x4){xc[4 * v4], xc[4 * v4 + 1], xc[4 * v4 + 2], xc[4 * v4 + 3]}; }
            { float h8[8];
#pragma unroll
              for (int hf = 0; hf < 2; ++hf) {
#pragma unroll
                for (int e = 0; e < 8; ++e) h8[e] = xc[8 * hf + e];
                *(LAS u32x4*)(XCB + t5 * XCB_LD + c5 + 8 * hf) = pack8(h8); } }
        }
        __syncthreads();
        f32x4 acc[4][2];
#pragma unroll
        for (int m = 0; m < 4; ++m) { acc[m][0] = (f32x4){0.f, 0.f, 0.f, 0.f}; acc[m][1] = (f32x4){0.f, 0.f, 0.f, 0.f}; }
#pragma unroll
        for (int m = 0; m < 4; ++m)
#pragma unroll
            for (int ks = 0; ks < 4; ++ks) { const bf16x8 a = *(const LAS bf16x8*)(XCB + (16 * m + (lane & 15)) * XCB_LD + 32 * ks + 8 * q);
                acc[m][0] = MFMA16(a, Bw[0][ks], acc[m][0]); acc[m][1] = MFMA16(a, Bw[1][ks], acc[m][1]); }
#pragma unroll
        for (int m = 0; m < 4; ++m) {
            float av[4], bv[4];
#pragma unroll
            for (int reg = 0; reg < 4; ++reg) { const int t = 16 * m + 4 * q + reg; const float xcv = XCF[t * XCF_LD + cl];
                const float r = sigm(acc[m][0][reg] + ba), ig = sigm(acc[m][1][reg] + bx);
                const float x2 = -2.0f * sp8 * r;
                const float em = -x2 * (1.0f + x2 * (0.5f + x2 * (0.16666667f + x2 * (0.041666668f + x2 * (0.0083333338f + x2 * (0.0013888889f + x2 * 0.00019841270f))))));
                float mult = __builtin_amdgcn_sqrtf(fmaxf(em, 0.f)); if (!SAMPLE && (t0 + t) == 0) mult = 1.0f;
                av[reg] = ex2(-sp8l2 * r); bv[reg] = mult * ig * xcv; }
            if constexpr (!SAMPLE) {
                float Al = 1.f, Hl = 0.f;
#pragma unroll
                for (int reg = 0; reg < 4; ++reg) { Hl = fmaf(av[reg], Hl, bv[reg]); Al *= av[reg]; }
                float hin = carry, cn = carry;
#pragma unroll
                for (int qq = 0; qq < 4; ++qq) { const float Ag = __shfl(Al, (lane & 15) + 16 * qq), Hg = __shfl(Hl, (lane & 15) + 16 * qq);
                    cn = fmaf(Ag, cn, Hg); hin = (qq < q) ? cn : hin; if (MODE == 1) aprod *= Ag; }
                carry = cn;
                if constexpr (MODE == 3) { float hv = hin;
#pragma unroll
                    for (int reg = 0; reg < 4; ++reg) { hv = fmaf(av[reg], hv, bv[reg]); HB[(16 * m + 4 * q + reg) * XCF_LD + cl] = hv; } }
            } else {
#pragma unroll
                for (int reg = 0; reg < 4; ++reg) { const int t = 16 * m + 4 * q + reg; const float h0 = F.in[I_SRH][(size_t)(t0 + t) * D + ch0 + cl];
                    HB[t * XCF_LD + cl] = fmaf(av[reg], h0, bv[reg]); }
            }
        }
        __syncthreads();
        if constexpr (FULL) {
            float h[16], yv[16], o8[8];
#pragma unroll
            for (int v4 = 0; v4 < 4; ++v4) { const f32x4 hv = *(const LAS f32x4*)(HB + t5 * XCF_LD + c5 + 4 * v4); h[4 * v4] = hv[0]; h[4 * v4 + 1] = hv[1]; h[4 * v4 + 2] = hv[2]; h[4 * v4 + 3] = hv[3]; }
            { float a8[8], b8[8]; unpack8(y0, a8); unpack8(y1, b8);
#pragma unroll
              for (int e = 0; e < 8; ++e) { yv[e] = a8[e]; yv[8 + e] = b8[e]; } }
            if constexpr (SAMPLE) { float* hsp = F.out + O_HS + (size_t)(t0 + t5) * D + ch0 + c5;
#pragma unroll
                for (int v4 = 0; v4 < 4; ++v4) *(f32x4*)(hsp + 4 * v4) = (f32x4){h[4 * v4], h[4 * v4 + 1], h[4 * v4 + 2], h[4 * v4 + 3]}; }
#pragma unroll
            for (int hf = 0; hf < 2; ++hf) {
#pragma unroll
                for (int e = 0; e < 8; ++e) o8[e] = h[8 * hf + e] * gelu_tanh_(yv[8 * hf + e]);
                *(u32x4*)(yrp + 8 * hf) = pack8(o8); }
            if constexpr (!SAMPLE) { if (tile0 + tt == 31 && t5 >= 61) { float* cpp = F.out + O_CP + ((size_t)b * 3 + (t5 - 61)) * D + ch0 + c5;
#pragma unroll
                for (int e = 0; e < 16; ++e) cpp[e] = bf2f(XRAW[(t5 + 3) * XRAW_LD + c5 + e]); } }
        }
    }
    if constexpr (!SAMPLE && MODE == 1) { if (q == 0) { float* ag = ragg + (size_t)item * 256; ag[cl] = aprod; ag[128 + cl] = carry; } }
    if constexpr (!SAMPLE && MODE == 3) { if (seg == 7 && q == 0) F.out[O_HP + (size_t)b * D + ch0 + cl] = carry; }
    __syncthreads();
}

__device__ __forceinline__ int crow(int reg, int h) { return (reg & 3) + 8 * (reg >> 2) + 4 * h; }
__device__ __forceinline__ bf16x8 pack_step(const f32x16& x, int s) {
    u32x4 p; p.x = pk2(x[8 * s], x[8 * s + 1]); p.y = pk2(x[8 * s + 2], x[8 * s + 3]); p.z = pk2(x[8 * s + 4], x[8 * s + 5]); p.w = pk2(x[8 * s + 6], x[8 * s + 7]);
    return __builtin_bit_cast(bf16x8, p);
}
template <int MODE>
__device__ __forceinline__ void gla_item(const Frame& F, int item) {
    constexpr int VRAW = 0, VRAW_LD = 264, LRS = 33792, QI = 37888, QK_LD = 136, KI = 55296, OBUF = 0, KET = 72704, T_LD = 72, VT = 91136, ATT = 128000, SEG = 137216, DEC = 139264, WLS = 139776;
    static_assert(WLS + 17 * 512 <= MISC_OFF, "GLA LDS map");
    constexpr bool FULL = (MODE == 3);
    const int tid = F.tid, lane = F.lane, w = F.wave;
    const int j = item & 3, hh = (item >> 2) & 3, b = item >> 4; const size_t rowbase = (size_t)b * TSEQ;
    LAS bf16_t* sVRAW = (LAS bf16_t*)(F.lds + VRAW); LAS float* sLR = (LAS float*)(F.lds + LRS); LAS bf16_t* sQI = (LAS bf16_t*)(F.lds + QI); LAS bf16_t* sKI = (LAS bf16_t*)(F.lds + KI);
    LAS float* sO = (LAS float*)(F.lds + OBUF); LAS bf16_t* sKET = (LAS bf16_t*)(F.lds + KET); LAS bf16_t* sVT = (LAS bf16_t*)(F.lds + VT); LAS bf16_t* sATT = (LAS bf16_t*)(F.lds + ATT);
    LAS float* sSEG = (LAS float*)(F.lds + SEG); LAS float* sDEC = (LAS float*)(F.lds + DEC);
    const int kk = tid & 127, seg = tid >> 7;
    LAS float* sWL = (LAS float*)(F.lds + WLS);
    for (int i = tid; i < 17 * 128; i += NTHR) sWL[i] = i < 2048 ? F.in[I_WLR][(i >> 7) * 512 + hh * 128 + (i & 127)] : F.in[I_BLR][hh * 128 + (i & 127)];
    const int r32 = lane & 31, h = lane >> 5, q = lane >> 4;
    float* gagg = (float*)(F.ws + WS_GAGG);
    f32x16 S[4];
#pragma unroll
    for (int kb = 0; kb < 4; ++kb)
#pragma unroll
        for (int i = 0; i < 16; ++i) S[kb][i] = 0.f;
    float dsum = 0.f;
    if constexpr (FULL) {
        for (int s = 0; s < j; ++s) { const float* ag = gagg + (size_t)((b * 4 + hh) * 3 + s) * GAGG_FLOATS;
            __syncthreads();
            if (tid < 128) sDEC[tid] = ag[32768 + tid];
            __syncthreads();
#pragma unroll
            for (int kb = 0; kb < 4; ++kb)
#pragma unroll
                for (int g4 = 0; g4 < 4; ++g4) { const f32x4 kv = *(const f32x4*)(ag + ((size_t)((w * 4 + kb) * 4 + g4)) * 256 + 4 * lane); const f32x4 dd = *(const LAS f32x4*)(sDEC + 32 * kb + 8 * g4 + 4 * h);
#pragma unroll
                    for (int e = 0; e < 4; ++e) S[kb][4 * g4 + e] = fmaf(S[kb][4 * g4 + e], dd[e], kv[e]); } }
    }
    u32x4 pv[4], plr = (u32x4){0u, 0u, 0u, 0u}; bf16_t qv[16], kv[16];
    auto prefetch = [&](size_t r0) {
#pragma unroll
        for (int i = 0; i < 4; ++i) { const int e = tid + NTHR * i, row = e >> 5, c16 = e & 31; pv[i] = *(const u32x4*)(F.P + (r0 + row) * PLD + PC_V + 256 * hh + 8 * c16); }
        if (tid < 128) plr = *(const u32x4*)(F.P + (r0 + (tid >> 1)) * PLD + PC_LR + 8 * (tid & 1));
#pragma unroll
        for (int i = 0; i < 16; ++i) kv[i] = F.P[(r0 + 16 * seg + i) * PLD + PC_K + 128 * hh + kk];
    };
    prefetch(rowbase + 64 * (8 * j));
    __syncthreads();
    for (int cn = 8 * j; cn < 8 * j + 8; ++cn) {
        const size_t row0 = rowbase + 64 * cn;
#pragma unroll
        for (int i = 0; i < 4; ++i) { const int e = tid + NTHR * i, row = e >> 5, c16 = e & 31; *(LAS u32x4*)(sVRAW + row * VRAW_LD + 8 * c16) = pv[i]; }
        if (tid < 128) { const int row = tid >> 1, hf = tid & 1; float f[8]; unpack8(plr, f);
            *(LAS f32x4*)(sLR + row * 16 + 8 * hf) = (f32x4){f[0], f[1], f[2], f[3]}; *(LAS f32x4*)(sLR + row * 16 + 8 * hf + 4) = (f32x4){f[4], f[5], f[6], f[7]}; }
        if constexpr (FULL) {
#pragma unroll
            for (int i = 0; i < 16; ++i) qv[i] = F.P[(row0 + 16 * seg + i) * PLD + PC_Q + 128 * hh + kk]; }
        __syncthreads();
        float c[16]; float run = 0.f; float wl[16];
#pragma unroll
        for (int r = 0; r < 16; ++r) wl[r] = sWL[r * 128 + kk];
        const float bias = sWL[2048 + kk];
#pragma unroll
        for (int i = 0; i < 16; ++i) { const LAS float* lr = sLR + (16 * seg + i) * 16; float x = bias;
#pragma unroll
            for (int r4 = 0; r4 < 4; ++r4) { const f32x4 lv = *(const LAS f32x4*)(lr + 4 * r4); x = fmaf(lv[0], wl[4 * r4], x); x = fmaf(lv[1], wl[4 * r4 + 1], x); x = fmaf(lv[2], wl[4 * r4 + 2], x); x = fmaf(lv[3], wl[4 * r4 + 3], x); }
            x = fminf(fmaxf(x, -80.f), 80.f);
            run -= __builtin_amdgcn_logf(1.0f + ex2(-LOG2E * x)) * (1.0f / 16.0f);
            c[i] = run; }
        sSEG[seg * 128 + kk] = run;
        { const int dv = tid & 255, hf = tid >> 8;
#pragma unroll
          for (int s8 = 0; s8 < 4; ++s8) { const int s = 32 * hf + 8 * s8; u32x4 wv; unsigned t[8];
#pragma unroll
              for (int jj = 0; jj < 8; ++jj) t[jj] = sVRAW[(s + jj) * VRAW_LD + dv];
              wv.x = t[0] | (t[1] << 16); wv.y = t[2] | (t[3] << 16); wv.z = t[4] | (t[5] << 16); wv.w = t[6] | (t[7] << 16);
              *(LAS u32x4*)(sVT + dv * T_LD + s) = wv; } }
        __syncthreads();
        { float off = 0.f, tot = 0.f;
#pragma unroll
          for (int s2 = 0; s2 < 4; ++s2) { const float v = sSEG[s2 * 128 + kk]; tot += v; off += (s2 < seg) ? v : 0.f; }
          const float dec = ex2(tot);
          if (seg == 0) { sDEC[kk] = dec; dsum += tot; }
          float ke[16];
#pragma unroll
          for (int i = 0; i < 16; ++i) { const int t = 16 * seg + i; const float bc = off + c[i]; const float eb = ex2(bc), ei = __builtin_amdgcn_rcpf(eb); const float kf = bf2f(kv[i]) * ei;
              ke[i] = kf * dec;
              if constexpr (FULL) { sQI[t * QK_LD + kk] = (bf16_t)(pk2(bf2f(qv[i]) * 0.08838834764831845f * eb, 0.f) & 0xffffu); sKI[t * QK_LD + kk] = (bf16_t)(pk2(kf, 0.f) & 0xffffu); } }
          { float a8[8], b8[8];
#pragma unroll
            for (int e = 0; e < 8; ++e) { a8[e] = ke[e]; b8[e] = ke[8 + e]; }
            *(LAS u32x4*)(sKET + kk * T_LD + 16 * seg) = pack8(a8); *(LAS u32x4*)(sKET + kk * T_LD + 16 * seg + 8) = pack8(b8); } }
        if (cn + 1 < 8 * j + 8) prefetch(row0 + 64);
        __syncthreads();
        if constexpr (FULL) {
#pragma unroll
            for (int u = 0; u < 2; ++u) { const int T = 2 * w + u, ti = T >> 2, si = T & 3; f32x4 cc = (f32x4){0.f, 0.f, 0.f, 0.f};
                if (si <= ti) {
#pragma unroll
                    for (int ks = 0; ks < 4; ++ks) { const bf16x8 a = *(const LAS bf16x8*)(sKI + (16 * si + (lane & 15)) * QK_LD + 32 * ks + 8 * q), bq = *(const LAS bf16x8*)(sQI + (16 * ti + (lane & 15)) * QK_LD + 32 * ks + 8 * q);
                        cc = MFMA16(a, bq, cc); } }
                const int t = 16 * ti + (lane & 15), s0 = 16 * si + 4 * q; float v[4];
#pragma unroll
                for (int reg = 0; reg < 4; ++reg) v[reg] = (s0 + reg <= t) ? cc[reg] : 0.f;
                u32x2 wv; wv.x = pk2(v[0], v[1]); wv.y = pk2(v[2], v[3]); *(LAS u32x2*)(sATT + t * T_LD + s0) = wv; }
            __syncthreads();
        }
        u32x2 og[8];
        if constexpr (FULL) {
#pragma unroll
            for (int jj = 0; jj < 8; ++jj) og[jj] = *(const u32x2*)(F.P + (row0 + 8 * w + jj) * PLD + PC_OG + 256 * hh + 4 * lane); }
        bf16x8 vf[4];
#pragma unroll
        for (int st = 0; st < 4; ++st) vf[st] = *(const LAS bf16x8*)(sVT + (32 * w + r32) * T_LD + 16 * st + 8 * h);
        f32x16 o[2];
        if constexpr (FULL) {
#pragma unroll
            for (int i = 0; i < 16; ++i) { o[0][i] = 0.f; o[1][i] = 0.f; }
#pragma unroll
            for (int kb = 0; kb < 4; ++kb)
#pragma unroll
                for (int s2 = 0; s2 < 2; ++s2) { const bf16x8 Bf = pack_step(S[kb], s2);
#pragma unroll
                    for (int tb = 0; tb < 2; ++tb) { const LAS bf16_t* qp = sQI + (32 * tb + r32) * QK_LD + 32 * kb + 16 * s2 + 4 * h; const u32x2 lo = *(const LAS u32x2*)qp, hi = *(const LAS u32x2*)(qp + 8);
                        const u32x4 af = (u32x4){lo.x, lo.y, hi.x, hi.y}; o[tb] = MFMA32(__builtin_bit_cast(bf16x8, af), Bf, o[tb]); } }
#pragma unroll
            for (int tb = 0; tb < 2; ++tb)
#pragma unroll
                for (int st = 0; st < 4; ++st) { if (tb == 0 && st >= 2) continue; const bf16x8 af = *(const LAS bf16x8*)(sATT + (32 * tb + r32) * T_LD + 16 * st + 8 * h); o[tb] = MFMA32(af, vf[st], o[tb]); }
        }
#pragma unroll
        for (int kb = 0; kb < 4; ++kb) {
#pragma unroll
            for (int g4 = 0; g4 < 4; ++g4) { const f32x4 dd = *(const LAS f32x4*)(sDEC + 32 * kb + 8 * g4 + 4 * h);
#pragma unroll
                for (int e = 0; e < 4; ++e) S[kb][4 * g4 + e] *= dd[e]; }
#pragma unroll
            for (int st = 0; st < 4; ++st) { const bf16x8 af = *(const LAS bf16x8*)(sKET + (32 * kb + r32) * T_LD + 16 * st + 8 * h); S[kb] = MFMA32(af, vf[st], S[kb]); } }
        __syncthreads();
        if constexpr (FULL) {
#pragma unroll
            for (int tb = 0; tb < 2; ++tb)
#pragma unroll
                for (int i = 0; i < 16; ++i) sO[(32 * tb + crow(i, h)) * 256 + 32 * w + r32] = o[tb][i];
            __syncthreads();
            const f32x4 gn = *(const f32x4*)(F.in[I_GNG] + 4 * lane);
#pragma unroll
            for (int jj = 0; jj < 8; ++jj) { const int t = 8 * w + jj; const f32x4 v = *(const LAS f32x4*)(sO + t * 256 + 4 * lane);
                const float rs = __builtin_amdgcn_rsqf(wave_sum((v[0] * v[0] + v[1] * v[1]) + (v[2] * v[2] + v[3] * v[3])) * (1.0f / 256.0f) + EPS);
                const float g0 = bf_lo(og[jj].x), g1 = bf_hi(og[jj].x), g2 = bf_lo(og[jj].y), g3 = bf_hi(og[jj].y);
                u32x2 wv; wv.x = pk2(v[0] * rs * gn[0] * silu_(g0), v[1] * rs * gn[1] * silu_(g1)); wv.y = pk2(v[2] * rs * gn[2] * silu_(g2), v[3] * rs * gn[3] * silu_(g3));
                *(u32x2*)(F.P + (row0 + t) * PLD + PC_OG + 256 * hh + 4 * lane) = wv; }
            __syncthreads();
        }
    }
    if constexpr (!FULL) {
        float* ag = gagg + (size_t)((b * 4 + hh) * 3 + j) * GAGG_FLOATS;
#pragma unroll
        for (int kb = 0; kb < 4; ++kb)
#pragma unroll
            for (int g4 = 0; g4 < 4; ++g4) *(f32x4*)(ag + ((size_t)((w * 4 + kb) * 4 + g4)) * 256 + 4 * lane) = (f32x4){S[kb][4 * g4], S[kb][4 * g4 + 1], S[kb][4 * g4 + 2], S[kb][4 * g4 + 3]};
        if (seg == 0) ag[32768 + kk] = ex2(dsum);
    } else if (j == 3) {
        float* sp = F.out + O_SP + (size_t)(b * 4 + hh) * 128 * 256;
#pragma unroll
        for (int kb = 0; kb < 4; ++kb)
#pragma unroll
            for (int i = 0; i < 16; ++i) sp[(size_t)(32 * kb + crow(i, h)) * 256 + 32 * w + r32] = S[kb][i];
    }
    __syncthreads();
}

__device__ __forceinline__ void gla_sample_item(const Frame& F, int item) {
    constexpr int SQ = 0, SK = 512, SE = 1024, RED = 2048;
    const int tid = F.tid, lane = F.lane, w = F.wave; const int hh = item & 3, s = item >> 2;
    LAS float* sq = (LAS float*)(F.lds + SQ); LAS float* sk = (LAS float*)(F.lds + SK); LAS float* se = (LAS float*)(F.lds + SE); LAS float* red = (LAS float*)(F.lds + RED);
    const bf16_t* Prow = F.P + (size_t)(MP + s) * PLD;
    if (tid < 128) { float x = F.in[I_BLR][hh * 128 + tid];
#pragma unroll
        for (int r = 0; r < 16; ++r) x = fmaf(bf2f(Prow[PC_LR + r]), F.in[I_WLR][r * 512 + hh * 128 + tid], x);
        se[tid] = __expf(-softplus_(-x) * (1.0f / 16.0f)); sq[tid] = bf2f(Prow[PC_Q + 128 * hh + tid]) * 0.08838834764831845f; sk[tid] = bf2f(Prow[PC_K + 128 * hh + tid]); }
    __syncthreads();
    const u32x2 vw = *(const u32x2*)(Prow + PC_V + 256 * hh + 4 * lane); const f32x4 v4 = (f32x4){bf_lo(vw.x), bf_hi(vw.x), bf_lo(vw.y), bf_hi(vw.y)};
    const float* S0 = F.in[I_SGLA] + ((size_t)(s * 4 + hh) * 128 + 16 * w) * 256 + 4 * lane; float* S1 = F.out + O_SS + ((size_t)(s * 4 + hh) * 128 + 16 * w) * 256 + 4 * lane;
    f32x4 o4 = (f32x4){0.f, 0.f, 0.f, 0.f};
    f32x4 sv[16];
#pragma unroll
    for (int jj = 0; jj < 16; ++jj) sv[jj] = __builtin_nontemporal_load((const f32x4*)(S0 + jj * 256));
#pragma unroll
    for (int jj = 0; jj < 16; ++jj) { const int k = 16 * w + jj; const f32x4 sn = sv[jj] * se[k] + v4 * sk[k]; __builtin_nontemporal_store(sn, (f32x4*)(S1 + jj * 256)); o4 = o4 + sn * sq[k]; }
    *(LAS f32x4*)(red + w * 256 + 4 * lane) = o4;
    __syncthreads();
    if (w == 0) { f32x4 o = (f32x4){0.f, 0.f, 0.f, 0.f};
#pragma unroll
        for (int ww = 0; ww < 8; ++ww) o = o + *(const LAS f32x4*)(red + ww * 256 + 4 * lane);
        const float rs = rsqrtf(wave_sum((o[0] * o[0] + o[1] * o[1]) + (o[2] * o[2] + o[3] * o[3])) * (1.0f / 256.0f) + EPS);
        const f32x4 gn = *(const f32x4*)(F.in[I_GNG] + 4 * lane); bf16_t* ogp = F.P + (size_t)(MP + s) * PLD + PC_OG + 256 * hh + 4 * lane; const u32x2 ogw = *(const u32x2*)ogp;
        u32x2 wv; wv.x = pk2(o[0] * rs * gn[0] * silu_(bf_lo(ogw.x)), o[1] * rs * gn[1] * silu_(bf_hi(ogw.x))); wv.y = pk2(o[2] * rs * gn[2] * silu_(bf_lo(ogw.y)), o[3] * rs * gn[3] * silu_(bf_hi(ogw.y)));
        *(u32x2*)ogp = wv; }
    __syncthreads();
}

template <int APROV>
__device__ __forceinline__ void skinny_piece(const Frame& F, const bf16_t* A, int lda, const bf16_t* Bt, int K, int k0, int nsub, int cb, const SlabMap om, int oslab) {
    constexpr int SA = 0, SB = 34816, LD = 136;
    const int tid = F.tid, lane = F.lane, w = F.wave, fr = lane & 15, fq = lane >> 4;
    LAS bf16_t* sA = (LAS bf16_t*)(F.lds + SA); LAS bf16_t* sB = (LAS bf16_t*)(F.lds + SB);
    f32x4 acc[8];
#pragma unroll
    for (int nb = 0; nb < 8; ++nb) acc[nb] = (f32x4){0.f, 0.f, 0.f, 0.f};
    for (int sub = 0; sub < nsub; ++sub) { const int kk0 = k0 + 128 * sub;
        __syncthreads();
#pragma unroll
        for (int i = 0; i < 4; ++i) { const int e = tid + NTHR * i, row = e >> 4, c16 = e & 15; u32x4 v;
            if constexpr (APROV == 0) v = *(const u32x4*)(A + (size_t)row * lda + kk0 + 8 * c16);
            else { const int cc = kk0 + 8 * c16; const bf16_t* gp = F.P + (size_t)(MP + row) * PLD + cc;
                float ga[8], gb[8], o[8]; unpack8(*(const u32x4*)(gp + PC_GA), ga); unpack8(*(const u32x4*)(gp + PC_GB), gb);
#pragma unroll
                for (int hf = 0; hf < 2; ++hf) { const f32x4 ya = *(const f32x4*)slab_at(F, SLAB_B, 0, row, cc + 4 * hf) + *(const f32x4*)slab_at(F, SLAB_B, 1, row, cc + 4 * hf), yb = *(const f32x4*)slab_at(F, SLAB_B, 2, row, cc + 4 * hf) + *(const f32x4*)slab_at(F, SLAB_B, 3, row, cc + 4 * hf);
#pragma unroll
                    for (int e2 = 0; e2 < 4; ++e2) o[4 * hf + e2] = sigm(ga[4 * hf + e2]) * ya[e2] + sigm(gb[4 * hf + e2]) * yb[e2]; }
                v = pack8(o); }
            *(LAS u32x4*)(sA + row * LD + 8 * c16) = v;
            *(LAS u32x4*)(sB + row * LD + 8 * c16) = *(const u32x4*)(Bt + (size_t)(128 * cb + row) * K + kk0 + 8 * c16); }
        __syncthreads();
        bf16x8 a[4];
#pragma unroll
        for (int s = 0; s < 4; ++s) a[s] = *(const LAS bf16x8*)(sA + (16 * w + fr) * LD + 32 * s + 8 * fq);
#pragma unroll
        for (int nb = 0; nb < 8; ++nb)
#pragma unroll
            for (int s = 0; s < 4; ++s) { const bf16x8 bb = *(const LAS bf16x8*)(sB + (16 * nb + fr) * LD + 32 * s + 8 * fq); acc[nb] = MFMA16(bb, a[s], acc[nb]); }
    }
#pragma unroll
    for (int nb = 0; nb < 8; ++nb) *(f32x4*)slab_at(F, om, oslab, 16 * w + fr, 128 * cb + 16 * nb + 4 * fq) = acc[nb];
    __syncthreads();
}
}
namespace mk {
constexpr int N_PHASES = 13;
__global__ void __launch_bounds__(NTHR, 2) mega_fwd(Args args) {
    extern __shared__ __attribute__((aligned(16))) unsigned char lds_raw[];
    Frame F;
    F.lds = (LAS unsigned char*)lds_raw;
    F.tid = threadIdx.x; F.lane = F.tid & 63; F.wave = __builtin_amdgcn_readfirstlane(F.tid >> 6);
    F.G = gridDim.x; { const int bx = blockIdx.x; F.vcu = (F.G % 8 == 0) ? (bx % 8) * (F.G / 8) + bx / 8 : bx; }
#pragma unroll
    for (int i = 0; i < 24; ++i) F.in[i] = args.in[i];
    F.out = args.out; F.ws = args.ws;
    F.P = (bf16_t*)(args.ws + WS_P);
    unsigned char* ssr = (unsigned char*)(args.out + O_SS);
    F.U = (bf16_t*)(ssr + SS_U); F.Win_t = (bf16_t*)(ssr + SS_WIN); F.Wgu1_t = (bf16_t*)(ssr + SS_WGU1); F.Wd1_t = (bf16_t*)(ssr + SS_WD1);
    F.Wrg_t = (bf16_t*)(args.ws + WS_WRG); F.Wbr_t = (bf16_t*)(args.ws + WS_WBR); F.Wbg_t = (bf16_t*)(args.ws + WS_WBG); F.Wout_t = (bf16_t*)(args.ws + WS_WOUT);
    F.Wgu2_t = (bf16_t*)(args.ws + WS_WGU2); F.Wd2_t = (bf16_t*)(args.ws + WS_WD2);
    volatile LAS unsigned* MISC = (volatile LAS unsigned*)(F.lds + MISC_OFF);
    for (int u = F.tid; u < 128; u += NTHR) MISC[u] = 0u;
    __syncthreads();
    const int lo = args.ph_lo, hi = args.ph_hi;
    XcdBarrier bar; bar.bar = (unsigned*)(args.ws + WS_CTL) + CW_BAR; bar.x = 0; bar.st = nullptr;
    if (hi - lo > 1) bar = xcd_barrier_post((unsigned*)(args.ws + WS_CTL) + CW_BAR, MISC + 8);
#define IN(k) (lo <= (k) && (k) < hi)
#ifdef TIME_PHASE
    unsigned long long tp0 = 0, tp1 = 0;
#ifdef TIME_WALL
#define SEAM(k) do { if (IN(k) && IN((k) + 1)) xcd_barrier(bar); if ((k) == TIME_PHASE) tp1 = __builtin_amdgcn_s_memrealtime(); if ((k) + 1 == TIME_PHASE) tp0 = __builtin_amdgcn_s_memrealtime(); } while (0)
#else
#define SEAM(k) do { if ((k) == TIME_PHASE) tp1 = __builtin_amdgcn_s_memrealtime(); if (IN(k) && IN((k) + 1)) xcd_barrier(bar); if ((k) + 1 == TIME_PHASE) tp0 = __builtin_amdgcn_s_memrealtime(); } while (0)
#endif
#else
#define SEAM(k) do { if (IN(k) && IN((k) + 1)) xcd_barrier(bar); } while (0)
#endif
    const int gw = F.vcu * NWAVES + F.wave, NGW = F.G * NWAVES;
    LAS float* scr = (LAS float*)(F.lds + F.wave * 16384);
    constexpr bool AL = true, SP = true;

    if (IN(0)) {
        prep_wgu(F, F.in[I_F1GU], F.Wgu1_t, scr, gw, NGW);
        prep_plain(F, F.in[I_F1D], FF, D, F.Wd1_t, scr, gw, NGW);
        prep_win(F, scr, gw, NGW);
        prep_rg(F, scr, gw, NGW);
        prep_plain(F, F.in[I_WBR], D, D, F.Wbr_t, scr, gw, NGW, 2 * D);
        prep_plain(F, F.in[I_WBG], D, D, F.Wbr_t + D, scr, gw, NGW, 2 * D);
        prep_plain(F, F.in[I_WOUT], D, D, F.Wout_t, scr, gw, NGW);
        rowphase0(F);
    }
    SEAM(0);
    if (IN(1)) {
        pg8::Gemm g{F.P + SC_XA, PLD, F.Wgu1_t, MPAD, 2 * FF, D}; pg8::StaticOrder S; S.init(MPAD, 2 * FF, F.G, (int)blockIdx.x);
        pg8::EpiSwiGLU E{F.P + SC_H, PLD};
        pg8::gemm_phase<pg8::EpiSwiGLU, pg8::StaticOrder, AL, SP>(F.lds, g, S, E);
    }
    SEAM(1);
    if (IN(2)) {
        if (F.vcu < 176) skinny_piece<0>(F, F.P + (size_t)MP * PLD + SC_H, PLD, F.Wd1_t, FF, 128 * (F.vcu >> 3), 1, F.vcu & 7, SLAB_D, F.vcu >> 3);
        pg8::Gemm g{F.P + SC_H, PLD, F.Wd1_t, MP, D, FF}; pg8::StaticOrder S; S.init(MP, D, F.G, (int)blockIdx.x);
        pg8::EpiF32 E{(float*)(F.P + SC_F), PLD / 2};
        pg8::gemm_phase<pg8::EpiF32, pg8::StaticOrder, AL, SP>(F.lds, g, S, E);
    }
    SEAM(2);
    if (IN(3)) rowphase1(F);
    SEAM(3);
    if (IN(4)) {
        pg8::Gemm g{F.U, D, F.Win_t, MPAD, PLD, D}; pg8::StaticOrder S; S.init(MPAD, PLD, F.G, (int)blockIdx.x);
        pg8::EpiBf16 E{F.P, PLD};
        pg8::gemm_phase<pg8::EpiBf16, pg8::StaticOrder, AL, SP>(F.lds, g, S, E);
    }
    SEAM(4);
    if (IN(5)) {
        const int c = F.vcu;
        if (c < 96) gla_item<1>(F, (c / 3) * 4 + (c % 3));
        else {
            for (int i = c - 96; i < 448; i += F.G - 96) rnn_item<false, 1>(F, (i / 7) * 8 + (i % 7));
            for (int i = c - 96; i < 2 * MS; i += F.G - 96) gla_sample_item(F, i);
        }
    }
    SEAM(5);
    if (IN(6)) {
        const int c = F.vcu;
        if (c < 128) gla_item<3>(F, c);
        else {
            for (int i = c - 128; i < 512; i += F.G - 128) rnn_item<false, 3>(F, i);
            if (c < 136) rnn_item<true, 3>(F, c - 128);
            for (int i = 2 * MS + c - 128; i < 4 * MS; i += F.G - 128) gla_sample_item(F, i);
        }
    }
    SEAM(6);
    if (IN(7)) {
        if (F.vcu < 32) { const int gsel = F.vcu >> 4, ks = (F.vcu >> 3) & 1, cb = F.vcu & 7;
            skinny_piece<0>(F, F.P + (size_t)MP * PLD + (gsel ? PC_OG : PC_YR), PLD, F.Wbr_t + (gsel ? D : 0), 2 * D, 512 * ks, 4, cb, SLAB_B, 2 * gsel + ks); }
        pg8::Gemm g{F.P + PC_YR, PLD, F.Wbr_t, MP, D, 2 * D}; pg8::StaticOrder S; S.init(MP, D, F.G, (int)blockIdx.x);
        pg8::EpiMerge E{F.P + PC_GA, F.P + PC_GB, PLD, F.P + SC_XA, PLD};
        pg8::gemm_phase<pg8::EpiMerge, pg8::StaticOrder, false, SP>(F.lds, g, S, E);
    }
    SEAM(7);
    if (IN(8)) {
        if (F.vcu < 64) skinny_piece<1>(F, nullptr, 0, F.Wout_t, D, 128 * (F.vcu >> 3), 1, F.vcu & 7, SLAB_B, 4 + (F.vcu >> 3));
        pg8::Gemm g{F.P + SC_XA, PLD, F.Wout_t, MP, D, D}; pg8::StaticOrder S; S.init(MP, D, F.G, (int)blockIdx.x);
        pg8::EpiF32 E{(float*)(F.P + SC_T), PLD / 2};
        pg8::gemm_phase<pg8::EpiF32, pg8::StaticOrder, AL, SP>(F.lds, g, S, E);
    }
    SEAM(8);
    if (IN(9)) {
        prep_wgu(F, F.in[I_F2GU], F.Wgu2_t, scr, gw, NGW);
        prep_plain(F, F.in[I_F2D], FF, D, F.Wd2_t, scr, gw, NGW);
        rowphase2(F);
    }
    SEAM(9);
    if (IN(10)) {
        pg8::Gemm g{F.P + SC_XA, PLD, F.Wgu2_t, MPAD, 2 * FF, D}; pg8::StaticOrder S; S.init(MPAD, 2 * FF, F.G, (int)blockIdx.x);
        pg8::EpiSwiGLU E{F.P + SC_H, PLD};
        pg8::gemm_phase<pg8::EpiSwiGLU, pg8::StaticOrder, AL, SP>(F.lds, g, S, E);
    }
    SEAM(10);
    if (IN(11)) {
        if (F.vcu < 176) skinny_piece<0>(F, F.P + (size_t)MP * PLD + SC_H, PLD, F.Wd2_t, FF, 128 * (F.vcu >> 3), 1, F.vcu & 7, SLAB_D, F.vcu >> 3);
        pg8::Gemm g{F.P + SC_H, PLD, F.Wd2_t, MP, D, FF}; pg8::StaticOrder S; S.init(MP, D, F.G, (int)blockIdx.x);
        pg8::EpiF32 E{(float*)(F.P + SC_F), PLD / 2};
        pg8::gemm_phase<pg8::EpiF32, pg8::StaticOrder, AL, SP>(F.lds, g, S, E);
    }
    SEAM(11);
    if (IN(12)) rowphase3(F);
#ifdef TIME_PHASE
    if (F.vcu == TIME_VCU) { const unsigned long long te = __builtin_amdgcn_s_memrealtime(), wait = (unsigned long long)(TIME_MULT) * (tp1 - tp0); while (__builtin_amdgcn_s_memrealtime() - te < wait) __builtin_amdgcn_s_sleep(8); }
#endif
#undef IN
#undef SEAM
}

inline int launch(void* const* d_in, void* d_out, void* d_ws, hipStream_t stream, int n_launches, int ph_lo = 0, int ph_hi = 0) {
    static int grid = 0;
    if (grid == 0) {
        int dev = 0, cus = 0, per_cu = 0;
        if (hipGetDevice(&dev) != hipSuccess || hipDeviceGetAttribute(&cus, hipDeviceAttributeMultiprocessorCount, dev) != hipSuccess) { grid = -1; return -1; }
        if (hipFuncSetAttribute((const void*)mega_fwd, hipFuncAttributeMaxDynamicSharedMemorySize, LDS_BYTES) != hipSuccess) { grid = -1; return -1; }
        if (hipOccupancyMaxActiveBlocksPerMultiprocessor(&per_cu, (const void*)mega_fwd, NTHR, LDS_BYTES) != hipSuccess || per_cu < 1) per_cu = 1;
        (void)hipGetLastError();
        grid = cus;
    }
    if (grid < 0) return -1;
    Args a{};
    for (int i = 0; i < 24; ++i) a.in[i] = (const float*)d_in[i];
    a.out = (float*)d_out; a.ws = (unsigned char*)d_ws;
    if (n_launches == 0) { a.ph_lo = ph_lo; a.ph_hi = ph_hi; hipLaunchKernelGGL(mega_fwd, dim3(grid), dim3(NTHR), LDS_BYTES, stream, a); return 0; }
    (void)hipMemsetAsync((char*)d_ws + WS_CTL, 0, CTL_ZERO_BYTES, stream);
    if (n_launches == 1) { a.ph_lo = 0; a.ph_hi = N_PHASES; hipLaunchKernelGGL(mega_fwd, dim3(grid), dim3(NTHR), LDS_BYTES, stream, a); }
    else for (int p = 0; p < N_PHASES; ++p) { a.ph_lo = p; a.ph_hi = p + 1; hipLaunchKernelGGL(mega_fwd, dim3(grid), dim3(NTHR), LDS_BYTES, stream, a); }
    return 0;
}
}
#ifndef MK_NL
#define MK_NL 1
#endif
extern "C" void kernel_launch(void* const* d_in, const int* in_sizes, int n_in,
                              void* d_out, int out_size, void* d_ws, size_t ws_size,
                              hipStream_t stream) {
    mk::launch(d_in, d_out, d_ws, stream, MK_NL);
}
```

```cpp
#include <hip/hip_runtime.h>
#include <cstdio>
#include <cstdint>

#ifndef DBG_STATIC_FLOATS
#define DBG_STATIC_FLOATS 16
#endif
__device__ float g_static[DBG_STATIC_FLOATS];
#define STATIC_TAG (1ull << 62)
template <class T> __device__ __forceinline__ T* fx(T* p) { const unsigned long long v = (unsigned long long)p; return (v & STATIC_TAG) ? (T*)((char*)g_static + (v & (STATIC_TAG - 1))) : p; }
inline float* static_ptr(size_t float_off) { return (float*)(STATIC_TAG | (unsigned long long)(float_off * 4)); }
namespace nv {
constexpr int D = 1024, FF = 2816, DIN = 7184, TSEQ = 2048, NB = 8, NS = 128;
constexpr int C_XR = 0, C_YR = 1024, C_Q = 2048, C_K = 2560, C_V = 3072, C_OG = 4096, C_LR = 5120, C_GA = 5136, C_GB = 6160;
constexpr float EPS = 1e-6f;
constexpr size_t O_YP = 0, O_YS = 16777216, O_HP = 16908288, O_CP = 16916480, O_SP = 16941056, O_HS = 17989632, O_CS = 18120704, O_SS = 18513920;

__device__ __forceinline__ float sigmoidf_(float x) { return 1.f / (1.f + expf(-x)); }
__device__ __forceinline__ float siluf_(float x) { return x / (1.f + expf(-x)); }
__device__ __forceinline__ float softplusf_(float x) { return fmaxf(x, 0.f) + log1pf(expf(-fabsf(x))); }
__device__ __forceinline__ float logsigmoidf_(float x) { return -softplusf_(-x); }
__device__ __forceinline__ float gelu_tanhf_(float x) { const float c = 0.7978845608028654f; return 0.5f * x * (1.f + tanhf(c * (x + 0.044715f * x * x * x))); }

__device__ __forceinline__ float block_sum256(float v, float* red) {
#pragma unroll
    for (int o = 32; o > 0; o >>= 1) v += __shfl_xor(v, o);
    __syncthreads();
    if ((threadIdx.x & 63) == 0) red[threadIdx.x >> 6] = v;
    __syncthreads();
    return red[0] + red[1] + red[2] + red[3];
}
__global__ void k_rmsnorm(const float* x, const float* g, float* y) { x = fx(x); g = fx(g); y = fx(y);
    __shared__ float red[4];
    const size_t r = blockIdx.x; const float* xr = x + r * D; float v[4]; float s = 0.f;
#pragma unroll
    for (int j = 0; j < 4; ++j) { v[j] = xr[threadIdx.x + 256 * j]; s += v[j] * v[j]; }
    const float tot = block_sum256(s, red); const float rs = rsqrtf(tot / D + EPS);
#pragma unroll
    for (int j = 0; j < 4; ++j) y[r * D + threadIdx.x + 256 * j] = v[j] * rs * g[threadIdx.x + 256 * j];
}
__global__ void k_resnorm(const float* base, const float* f, const float* g, float scale, float* out) { base = fx(base); f = fx(f); g = fx(g); out = fx(out);
    __shared__ float red[4];
    const size_t r = blockIdx.x; const float* fr = f + r * D; float v[4]; float s = 0.f;
#pragma unroll
    for (int j = 0; j < 4; ++j) { v[j] = fr[threadIdx.x + 256 * j]; s += v[j] * v[j]; }
    const float tot = block_sum256(s, red); const float rs = rsqrtf(tot / D + EPS);
#pragma unroll
    for (int j = 0; j < 4; ++j) { const int c = threadIdx.x + 256 * j; out[r * D + c] = base[r * D + c] + scale * (v[j] * rs * g[c]); }
}
__global__ void __launch_bounds__(256) k_gemm(const float* A, int lda, const float* B, int ldb, float* C, int ldc, int M, int N, int K, size_t sA, size_t sB, size_t sC) { A = fx(A); B = fx(B); C = fx(C);
    __shared__ float As[16][64 + 1], Bs[16][64 + 1];
    A += blockIdx.z * sA; B += blockIdx.z * sB; C += blockIdx.z * sC;
    const int m0 = blockIdx.y * 64, n0 = blockIdx.x * 64, tx = threadIdx.x & 15, ty = threadIdx.x >> 4;
    float acc[4][4];
#pragma unroll
    for (int i = 0; i < 4; ++i)
#pragma unroll
        for (int j = 0; j < 4; ++j) acc[i][j] = 0.f;
    for (int k0 = 0; k0 < K; k0 += 16) {
#pragma unroll
        for (int i = 0; i < 4; ++i) { const int e = threadIdx.x + 256 * i; const int m = e >> 4, k = e & 15; As[k][m] = A[(size_t)(m0 + m) * lda + k0 + k]; }
#pragma unroll
        for (int i = 0; i < 4; ++i) { const int e = threadIdx.x + 256 * i; const int k = e >> 6, n = e & 63; Bs[k][n] = (n0 + n < N) ? B[(size_t)(k0 + k) * ldb + n0 + n] : 0.f; }
        __syncthreads();
#pragma unroll
        for (int k = 0; k < 16; ++k) { float a[4], b[4];
#pragma unroll
            for (int i = 0; i < 4; ++i) { a[i] = As[k][ty * 4 + i]; b[i] = Bs[k][tx * 4 + i]; }
#pragma unroll
            for (int i = 0; i < 4; ++i)
#pragma unroll
                for (int j = 0; j < 4; ++j) acc[i][j] = fmaf(a[i], b[j], acc[i][j]); }
        __syncthreads();
    }
#pragma unroll
    for (int i = 0; i < 4; ++i)
#pragma unroll
        for (int j = 0; j < 4; ++j) { const int n = n0 + tx * 4 + j; if (n < N) C[(size_t)(m0 + ty * 4 + i) * ldc + n] = acc[i][j]; }
}
__global__ void k_swiglu(const float* gu, float* h, size_t n) { gu = fx(gu); h = fx(h);
    for (size_t i = blockIdx.x * (size_t)blockDim.x + threadIdx.x; i < n; i += (size_t)gridDim.x * blockDim.x) { const size_t r = i / FF, j = i % FF; h[i] = siluf_(gu[r * (2 * FF) + j]) * gu[r * (2 * FF) + FF + j]; }
}
__global__ void k_conv(const float* P, const float* buf, const float* w, const float* b, float* xc, float* conv_new, int T, int nseq) { P = fx(P); buf = fx(buf); w = fx(w); b = fx(b); xc = fx(xc); conv_new = fx(conv_new);
    const size_t n = (size_t)nseq * T * D;
    for (size_t i = blockIdx.x * (size_t)blockDim.x + threadIdx.x; i < n; i += (size_t)gridDim.x * blockDim.x) {
        const int c = (int)(i % D); const size_t row = i / D; const int t = (int)(row % T); const int seq = (int)(row / T);
        float y = b[c];
#pragma unroll
        for (int j = 0; j < 4; ++j) { const int idx = t + j - 3; float xv;
            if (idx >= 0) xv = P[((size_t)seq * T + idx) * DIN + C_XR + c]; else xv = buf ? buf[((size_t)seq * 3 + (3 + idx)) * D + c] : 0.f;
            y += xv * w[j * D + c]; }
        xc[i] = y;
    }
    const size_t n2 = (size_t)nseq * 3 * D;
    for (size_t i = blockIdx.x * (size_t)blockDim.x + threadIdx.x; i < n2; i += (size_t)gridDim.x * blockDim.x) {
        const int c = (int)(i % D); const int j = (int)((i / D) % 3); const int seq = (int)(i / (3 * D));
        const int xi = T + j;
        float v; if (xi >= 3) v = P[((size_t)seq * T + (xi - 3)) * DIN + C_XR + c]; else v = buf ? buf[((size_t)seq * 3 + xi) * D + c] : 0.f;
        conv_new[i] = v;
    }
}
__global__ void k_rg_elem(const float* xc, const float* RA, const float* RX, const float* b_a, const float* b_x, const float* lam, float* a_out, float* bb_out, int T, int nseq, int reset) { xc = fx(xc); RA = fx(RA); RX = fx(RX); b_a = fx(b_a); b_x = fx(b_x); lam = fx(lam); a_out = fx(a_out); bb_out = fx(bb_out);
    const size_t n = (size_t)nseq * T * D;
    for (size_t i = blockIdx.x * (size_t)blockDim.x + threadIdx.x; i < n; i += (size_t)gridDim.x * blockDim.x) {
        const int c = (int)(i % D); const int t = (int)((i / D) % T);
        const float r = sigmoidf_(RA[i] + b_a[c]), ig = sigmoidf_(RX[i] + b_x[c]);
        const float log_a = -8.0f * r * softplusf_(-lam[c]); const float a = expf(log_a);
        float mult = sqrtf(fmaxf(-expm1f(2.0f * log_a), 0.f)); if (reset && t == 0) mult = 1.0f;
        a_out[i] = a; bb_out[i] = mult * ig * xc[i];
    }
}
__global__ void k_scan(const float* a, const float* bb, const float* h0, float* h, float* h_last, int T, int nseq) { a = fx(a); bb = fx(bb); h0 = fx(h0); h = fx(h); h_last = fx(h_last);
    const int i = blockIdx.x * blockDim.x + threadIdx.x; if (i >= nseq * D) return;
    const int c = i % D, seq = i / D; float hv = h0 ? h0[(size_t)seq * D + c] : 0.f;
    for (int t = 0; t < T; ++t) { const size_t o = ((size_t)seq * T + t) * D + c; hv = a[o] * hv + bb[o]; h[o] = hv; }
    h_last[(size_t)seq * D + c] = hv;
}
__global__ void k_gate_rnn(const float* h, const float* P, float* o, size_t n) { h = fx(h); P = fx(P); o = fx(o);
    for (size_t i = blockIdx.x * (size_t)blockDim.x + threadIdx.x; i < n; i += (size_t)gridDim.x * blockDim.x) { const size_t r = i / D; const int c = (int)(i % D); o[i] = h[i] * gelu_tanhf_(P[r * DIN + C_YR + c]); }
}
__global__ void __launch_bounds__(256) k_gla(const float* P, const float* G, const float* blr, const float* S0, float* O, float* S_out, int T) { P = fx(P); G = fx(G); blr = fx(blr); S0 = fx(S0); O = fx(O); S_out = fx(S_out);
    extern __shared__ float S[];
    __shared__ float sq[128], sk[128], se[128];
    const int head = blockIdx.x & 3, seq = blockIdx.x >> 2, dv = threadIdx.x;
    for (int kk = 0; kk < 128; ++kk) S[kk * 256 + dv] = S0 ? S0[(((size_t)seq * 4 + head) * 128 + kk) * 256 + dv] : 0.f;
    for (int t = 0; t < T; ++t) {
        const size_t row = (size_t)seq * T + t;
        __syncthreads();
        if (dv < 128) { sq[dv] = P[row * DIN + C_Q + head * 128 + dv] * 0.08838834764831845f; sk[dv] = P[row * DIN + C_K + head * 128 + dv];
            se[dv] = expf(logsigmoidf_(G[row * 512 + head * 128 + dv] + blr[head * 128 + dv]) * (1.0f / 16.0f)); }
        __syncthreads();
        const float v = P[row * DIN + C_V + head * 256 + dv]; float o = 0.f;
        for (int kk = 0; kk < 128; ++kk) { const float s = S[kk * 256 + dv] * se[kk] + sk[kk] * v; S[kk * 256 + dv] = s; o = fmaf(sq[kk], s, o); }
        O[row * D + head * 256 + dv] = o;
    }
    for (int kk = 0; kk < 128; ++kk) S_out[(((size_t)seq * 4 + head) * 128 + kk) * 256 + dv] = S[kk * 256 + dv];
}
__global__ void k_gla_out(const float* O, const float* P, const float* gn, float* og_out) { O = fx(O); P = fx(P); gn = fx(gn); og_out = fx(og_out);
    __shared__ float red[4];
    const int head = blockIdx.x & 3; const size_t row = blockIdx.x >> 2; const int dv = threadIdx.x;
    const float o = O[row * D + head * 256 + dv]; const float tot = block_sum256(o * o, red); const float rs = rsqrtf(tot / 256.f + EPS);
    og_out[row * D + head * 256 + dv] = o * rs * gn[dv] * siluf_(P[row * DIN + C_OG + head * 256 + dv]);
}
__global__ void k_merge(const float* P, const float* YA, const float* YB, float* m, size_t n) { P = fx(P); YA = fx(YA); YB = fx(YB); m = fx(m);
    for (size_t i = blockIdx.x * (size_t)blockDim.x + threadIdx.x; i < n; i += (size_t)gridDim.x * blockDim.x) { const size_t r = i / D; const int c = (int)(i % D);
        m[i] = sigmoidf_(P[r * DIN + C_GA + c]) * YA[i] + sigmoidf_(P[r * DIN + C_GB + c]) * YB[i]; }
}
struct In { const float *xp, *xs, *srh, *src, *sgla, *ng, *f1gu, *f1d, *win, *cw, *cb, *rwa, *rba, *rwx, *rbx, *lam, *wlr, *blr, *gng, *wbr, *wbg, *wout, *f2gu, *f2d; };
inline In make_in(void* const* d) { In I; const float** p = (const float**)&I; for (int i = 0; i < 24; ++i) p[i] = (const float*)d[i]; return I; }
inline void gemm(hipStream_t st, const float* A, int lda, const float* B, int ldb, float* C, int ldc, int M, int N, int K, int nz = 1, size_t sA = 0, size_t sB = 0, size_t sC = 0) {
    hipLaunchKernelGGL(k_gemm, dim3((N + 63) / 64, M / 64, nz), dim3(256), 0, st, A, lda, B, ldb, C, ldc, M, N, K, sA, sB, sC);
}
struct Outs { float *y, *h_last, *conv_new, *s_new; };
struct Bufs { float *T0, *T1, *T2, *T3, *T4, *T5, *T6, *T7, *T8, *T9, *GU, *HH, *P, *G; };
inline Bufs make_bufs(float* ws, int R) { Bufs B; const size_t RD = (size_t)R * D; B.T0 = ws; B.T1 = B.T0 + RD; B.T2 = B.T1 + RD; B.T3 = B.T2 + RD; B.T4 = B.T3 + RD; B.T5 = B.T4 + RD; B.T6 = B.T5 + RD; B.T7 = B.T6 + RD; B.T8 = B.T7 + RD; B.T9 = B.T8 + RD;
    B.GU = B.T9 + RD; B.HH = B.GU + (size_t)R * 2 * FF; B.P = B.HH + (size_t)R * FF; B.G = B.P + (size_t)R * DIN; return B; }
inline Outs std_outs(float* out, int grp) { Outs o; const bool smp = (grp == NB);
    o.y = smp ? out + O_YS : out + O_YP + (size_t)grp * TSEQ * D; o.h_last = smp ? out + O_HS : out + O_HP + (size_t)grp * D;
    o.conv_new = smp ? out + O_CS : out + O_CP + (size_t)grp * 3 * D; o.s_new = smp ? out + O_SS : out + O_SP + (size_t)grp * 4 * 128 * 256; return o; }
inline void run_group(hipStream_t st, const In& I, const Outs& O, float* ws, int grp, int s_lo = 0, int s_hi = 12) {
    const bool smp = (grp == NB); const int T = smp ? 1 : TSEQ, nseq = smp ? NS : 1, R = T * nseq;
    const float* x = smp ? I.xs : I.xp + (size_t)grp * TSEQ * D;
    const Bufs B = make_bufs(ws, R);
    float *T0 = B.T0, *T1 = B.T1, *T2 = B.T2, *T3 = B.T3, *T4 = B.T4, *T5 = B.T5, *T6 = B.T6, *T7 = B.T7, *T8 = B.T8, *T9 = B.T9, *GU = B.GU, *HH = B.HH, *P = B.P, *G = B.G;
    const float* ng = I.ng; const size_t n1 = (size_t)R * D; const int EB = 1024;
#define STG(k) if (s_lo <= (k) && (k) < s_hi)
    STG(0) hipLaunchKernelGGL(k_rmsnorm, dim3(R), dim3(256), 0, st, x, ng + 0 * D, T0);
    STG(1) { gemm(st, T0, D, I.f1gu, 2 * FF, GU, 2 * FF, R, 2 * FF, D);
        hipLaunchKernelGGL(k_swiglu, dim3(EB), dim3(256), 0, st, GU, HH, (size_t)R * FF); }
    STG(2) gemm(st, HH, FF, I.f1d, D, T1, D, R, D, FF);
    STG(3) { hipLaunchKernelGGL(k_resnorm, dim3(R), dim3(256), 0, st, x, T1, ng + 1 * D, 0.5f, T2);
        hipLaunchKernelGGL(k_rmsnorm, dim3(R), dim3(256), 0, st, T2, ng + 2 * D, T3); }
    STG(4) gemm(st, T3, D, I.win, DIN, P, DIN, R, DIN, D);
    STG(5) { hipLaunchKernelGGL(k_conv, dim3(EB), dim3(256), 0, st, P, smp ? I.src : nullptr, I.cw, I.cb, T4, O.conv_new, T, nseq);
        gemm(st, T4, D, I.rwa, 128, T5, D, R, 128, 128, 8, 128, 128 * 128, 128);
        gemm(st, T4, D, I.rwx, 128, T6, D, R, 128, 128, 8, 128, 128 * 128, 128);
        hipLaunchKernelGGL(k_rg_elem, dim3(EB), dim3(256), 0, st, T4, T5, T6, I.rba, I.rbx, I.lam, T7, T8, T, nseq, smp ? 0 : 1);
        hipLaunchKernelGGL(k_scan, dim3((nseq * D + 255) / 256), dim3(256), 0, st, T7, T8, smp ? I.srh : nullptr, T9, O.h_last, T, nseq);
        hipLaunchKernelGGL(k_gate_rnn, dim3(EB), dim3(256), 0, st, T9, P, T3, n1);
        gemm(st, P + C_LR, DIN, I.wlr, 512, G, 512, R, 512, 16);
        hipLaunchKernelGGL(k_gla, dim3(nseq * 4), dim3(256), 128 * 256 * 4, st, P, G, I.blr, smp ? I.sgla : nullptr, T7, O.s_new, T);
        hipLaunchKernelGGL(k_gla_out, dim3(R * 4), dim3(256), 0, st, T7, P, I.gng, T8); }
    STG(6) { gemm(st, T3, D, I.wbr, D, T5, D, R, D, D);
        gemm(st, T8, D, I.wbg, D, T6, D, R, D, D);
        hipLaunchKernelGGL(k_merge, dim3(EB), dim3(256), 0, st, P, T5, T6, T9, n1); }
    STG(7) gemm(st, T9, D, I.wout, D, T1, D, R, D, D);
    STG(8) { hipLaunchKernelGGL(k_resnorm, dim3(R), dim3(256), 0, st, T2, T1, ng + 3 * D, 1.0f, T2);
        hipLaunchKernelGGL(k_rmsnorm, dim3(R), dim3(256), 0, st, T2, ng + 4 * D, T0); }
    STG(9) { gemm(st, T0, D, I.f2gu, 2 * FF, GU, 2 * FF, R, 2 * FF, D);
        hipLaunchKernelGGL(k_swiglu, dim3(EB), dim3(256), 0, st, GU, HH, (size_t)R * FF); }
    STG(10) gemm(st, HH, FF, I.f2d, D, T1, D, R, D, FF);
    STG(11) hipLaunchKernelGGL(k_resnorm, dim3(R), dim3(256), 0, st, T2, T1, ng + 5 * D, 0.5f, O.y);
#undef STG
}
}
namespace pg8 {
#define PG8_LAS __attribute__((address_space(3)))
typedef unsigned short bf16_t;
typedef short bf16x8 __attribute__((ext_vector_type(8)));
typedef float f32x4 __attribute__((ext_vector_type(4)));
typedef float f32x2 __attribute__((ext_vector_type(2)));
typedef unsigned u32x4 __attribute__((ext_vector_type(4)));
typedef unsigned u32x2 __attribute__((ext_vector_type(2)));
constexpr int BM = 256, BK = 64, HALF = 128, HTB = HALF * BK * 2, STAGE_BYTES = 8 * HTB, NXCD = 8, WGM = 8;

__host__ __device__ __forceinline__ int lds_byte(int r, int c) { const int st = (r >> 4) * 2 + (c >> 5), rr = r & 15, cc = c & 31, ob = rr * 64 + cc * 2; return st * 1024 + (ob ^ (((ob >> 9) & 1) << 5)); }
__host__ __device__ __forceinline__ void stage_rc(int b, int& R, int& C) { const int st = b / 1024, sb = b % 1024, swz = sb ^ (((sb >> 9) & 1) << 5); R = (st >> 1) * 16 + swz / 64; C = (st & 1) * 32 + (swz % 64) / 2; }
__host__ __device__ __forceinline__ int perm32(int rho) { const int n = rho >> 4, i = rho & 15; return 8 * (i >> 2) + 4 * n + (i & 3); }

struct Unit { int pm, pn; };
struct Gemm { const bf16_t* A; int lda; const bf16_t* Bt; int M, N, K; };

struct StaticOrder {
    int nM, nN, nwg, G, c;
    __host__ __device__ void init(int M, int N, int G_, int c_) { nM = M / BM; nN = N / BM; nwg = nM * nN; G = G_; c = c_; }
    __host__ __device__ bool next(int i, Unit& u) const {
        const long L = (long)i * G + c; if (L >= nwg) return false;
        int wgid = (int)L; { const int q = nwg / NXCD, r = nwg % NXCD, xcd = wgid % NXCD, off = wgid / NXCD; wgid = (xcd < r ? xcd * (q + 1) : r * (q + 1) + (xcd - r) * q) + off; }
        const int nig = WGM * nN, gid = wgid / nig, fm = gid * WGM, gsz = (nM - fm) < WGM ? (nM - fm) : WGM;
        u.pm = fm + ((wgid % nig) % gsz); u.pn = (wgid % nig) / gsz; return true;
    }
    __device__ __forceinline__ void a_ready(const Unit&) const {}
    __device__ __forceinline__ void done(const Unit&) const {}
};

__device__ __forceinline__ unsigned f2bf(float f) { unsigned u = __builtin_bit_cast(unsigned, f); return (u + 0x7fffu + ((u >> 16) & 1u)) >> 16; }
typedef __bf16 hwbf16x2 __attribute__((ext_vector_type(2)));
__device__ __forceinline__ unsigned pk2(float lo, float hi) { const f32x2 v = {lo, hi}; return __builtin_bit_cast(unsigned, __builtin_convertvector(v, hwbf16x2)); }
__device__ __forceinline__ float bf_lo(unsigned w) { return __builtin_bit_cast(float, w << 16); }
__device__ __forceinline__ float bf_hi(unsigned w) { return __builtin_bit_cast(float, w & 0xffff0000u); }
__device__ __forceinline__ float fast_sigmoid(float x) { return __builtin_amdgcn_rcpf(1.0f + __builtin_amdgcn_exp2f(-1.4426950408889634f * x)); }

struct EpiF32 {
    static constexpr bool PERM = false, AFTER_DRAIN = false;
    float* C; int ldc;
    __device__ __forceinline__ void operator()(const f32x4 (&acc)[2][2][4][2], const Unit& u, int wr, int wc, int fr, int fq) const {
        const int row0 = u.pm * BM + wr * 64 + fr, col0 = u.pn * BM + wc * 32 + 4 * fq;
#pragma unroll
        for (int ai = 0; ai < 2; ++ai)
#pragma unroll
            for (int m = 0; m < 4; ++m) { float* rowp = C + (size_t)(row0 + ai * HALF + m * 16) * ldc + col0;
#pragma unroll
                for (int bj = 0; bj < 2; ++bj)
#pragma unroll
                    for (int n = 0; n < 2; ++n) *(f32x4*)(rowp + bj * HALF + n * 16) = acc[ai][bj][m][n]; }
    }
};
struct EpiBf16 {
    static constexpr bool PERM = true, AFTER_DRAIN = false;
    bf16_t* O; int ldc;
    __device__ __forceinline__ void operator()(const f32x4 (&acc)[2][2][4][2], const Unit& u, int wr, int wc, int fr, int fq) const {
        const int row0 = u.pm * BM + wr * 64 + fr, col0 = u.pn * BM + wc * 32 + 8 * fq;
#pragma unroll
        for (int ai = 0; ai < 2; ++ai)
#pragma unroll
            for (int m = 0; m < 4; ++m) { bf16_t* rowp = O + (size_t)(row0 + ai * HALF + m * 16) * ldc + col0;
#pragma unroll
                for (int bj = 0; bj < 2; ++bj) { const f32x4 v0 = acc[ai][bj][m][0], v1 = acc[ai][bj][m][1];
                    u32x4 w; w.x = pk2(v0[0], v0[1]); w.y = pk2(v0[2], v0[3]); w.z = pk2(v1[0], v1[1]); w.w = pk2(v1[2], v1[3]);
                    *(u32x4*)(rowp + bj * HALF) = w; } }
    }
};
struct EpiSwiGLU {
    static constexpr bool PERM = true, AFTER_DRAIN = false;
    bf16_t* O; int ldc;
    __device__ __forceinline__ void operator()(const f32x4 (&acc)[2][2][4][2], const Unit& u, int wr, int wc, int fr, int fq) const {
        const int row0 = u.pm * BM + wr * 64 + fr, col0 = u.pn * HALF + wc * 32 + 8 * fq;
#pragma unroll
        for (int ai = 0; ai < 2; ++ai)
#pragma unroll
            for (int m = 0; m < 4; ++m) { bf16_t* rowp = O + (size_t)(row0 + ai * HALF + m * 16) * ldc + col0;
                float h[8];
#pragma unroll
                for (int n = 0; n < 2; ++n)
#pragma unroll
                    for (int e = 0; e < 4; ++e) { const float g = acc[ai][0][m][n][e], up = acc[ai][1][m][n][e]; h[4 * n + e] = g * fast_sigmoid(g) * up; }
                u32x4 w; w.x = pk2(h[0], h[1]); w.y = pk2(h[2], h[3]); w.z = pk2(h[4], h[5]); w.w = pk2(h[6], h[7]);
                *(u32x4*)rowp = w; }
    }
};
struct EpiMerge {
    static constexpr bool PERM = true, AFTER_DRAIN = false, MID = true;
    const bf16_t* GA; const bf16_t* GB; int ldg; bf16_t* O; int ldc;
    __device__ __forceinline__ void mid(f32x4 (&acc)[2][2][4][2], const Unit& u, int wr, int wc, int fr, int fq) const {
        int row0 = u.pm * BM + wr * 64 + fr; const int col0 = u.pn * BM + wc * 32 + 8 * fq;
        asm volatile("" : "+v"(row0));
#pragma unroll
        for (int ai = 0; ai < 2; ++ai)
#pragma unroll
            for (int m = 0; m < 4; ++m) { const size_t row = (size_t)(row0 + ai * HALF + m * 16);
#pragma unroll
                for (int bj = 0; bj < 2; ++bj) { const u32x4 a = *(const u32x4*)(GA + row * ldg + col0 + bj * HALF), b = *(const u32x4*)(GB + row * ldg + col0 + bj * HALF);
#define PG8_RT(x, y) (fast_sigmoid(x) * (1.0f + __builtin_amdgcn_exp2f(-1.4426950408889634f * (y))))
                    f32x4 r0, r1; r0[0] = PG8_RT(bf_lo(a.x), bf_lo(b.x)); r0[1] = PG8_RT(bf_hi(a.x), bf_hi(b.x)); r0[2] = PG8_RT(bf_lo(a.y), bf_lo(b.y)); r0[3] = PG8_RT(bf_hi(a.y), bf_hi(b.y));
                    r1[0] = PG8_RT(bf_lo(a.z), bf_lo(b.z)); r1[1] = PG8_RT(bf_hi(a.z), bf_hi(b.z)); r1[2] = PG8_RT(bf_lo(a.w), bf_lo(b.w)); r1[3] = PG8_RT(bf_hi(a.w), bf_hi(b.w));
#undef PG8_RT
                    acc[ai][bj][m][0] = acc[ai][bj][m][0] * r0; acc[ai][bj][m][1] = acc[ai][bj][m][1] * r1; }
                if (m & 1) asm volatile("" ::: "memory"); }
    }
    __device__ __forceinline__ void operator()(const f32x4 (&acc)[2][2][4][2], const Unit& u, int wr, int wc, int fr, int fq) const {
        int row0 = u.pm * BM + wr * 64 + fr; const int col0 = u.pn * BM + wc * 32 + 8 * fq;
        asm volatile("" : "+v"(row0));
#pragma unroll
        for (int ai = 0; ai < 2; ++ai)
#pragma unroll
            for (int m = 0; m < 4; ++m) { const size_t row = (size_t)(row0 + ai * HALF + m * 16);
#pragma unroll
                for (int bj = 0; bj < 2; ++bj) { const u32x4 g = *(const u32x4*)(GB + row * ldg + col0 + bj * HALF); const f32x4 v0 = acc[ai][bj][m][0], v1 = acc[ai][bj][m][1];
                    u32x4 w; w.x = pk2(fast_sigmoid(bf_lo(g.x)) * v0[0], fast_sigmoid(bf_hi(g.x)) * v0[1]); w.y = pk2(fast_sigmoid(bf_lo(g.y)) * v0[2], fast_sigmoid(bf_hi(g.y)) * v0[3]);
                    w.z = pk2(fast_sigmoid(bf_lo(g.z)) * v1[0], fast_sigmoid(bf_hi(g.z)) * v1[1]); w.w = pk2(fast_sigmoid(bf_lo(g.w)) * v1[2], fast_sigmoid(bf_hi(g.w)) * v1[3]);
                    *(u32x4*)(O + row * ldc + col0 + bj * HALF) = w; } }
    }
};
template <class E> struct has_mid { template <class T> static auto test(int) -> decltype(T::MID, char()); template <class T> static long test(...); static constexpr bool value = sizeof(test<E>(0)) == 1; };

template <class Epi, class Sched, bool ALIGN_EPI = false, bool SP2 = false>
__device__ __forceinline__ void gemm_phase(PG8_LAS unsigned char* lds, const Gemm g, const Sched& S, const Epi& E) {
    const int tid = threadIdx.x, wid = __builtin_amdgcn_readfirstlane(tid >> 6), lane = tid & 63, wr = wid >> 2, wc = wid & 3, fr = lane & 15, fq = lane >> 4;
    const int K = g.K, nt = K / BK;
    unsigned voffA[2], voffB[2];
#pragma unroll
    for (int i = 0; i < 2; ++i) { int R, C; stage_rc(tid * 16 + i * 8192, R, C); const int Rb = Epi::PERM ? ((R & ~31) + perm32(R & 31)) : R;
        voffA[i] = (unsigned)(R * g.lda + C) * 2u; voffB[i] = (unsigned)(Rb * K + C) * 2u; }
    const size_t kstep = (size_t)(BK * 2);
    const size_t hstepA = (size_t)HALF * g.lda * 2, hstepB = (size_t)HALF * K * 2;
    const size_t tstepA = 2 * hstepA, tstepB = 2 * hstepB;
    const unsigned ldsw = (unsigned)wid * 1024u;
    const int aoff = lds_byte(wr * 64 + fr, fq * 8), boff = lds_byte(wc * 32 + fr, fq * 8);
#define PG8_SA(b, h) (((b) * 2 + (h)) * HTB)
#define PG8_SB(b, h) ((4 + (b) * 2 + (h)) * HTB)
#define PG8_STAGE(bufoff, gbase, voff) do { _Pragma("unroll") for (int _i = 0; _i < 2; ++_i) \
        __builtin_amdgcn_global_load_lds((const unsigned*)((const char*)(gbase) + (voff)[_i]), (PG8_LAS unsigned*)(lds + (bufoff) + ldsw + _i * 8192), 16, 0, 0); } while (0)
#define PG8_LDA(dst, b, h) do { _Pragma("unroll") for (int m = 0; m < 4; ++m) _Pragma("unroll") for (int k = 0; k < 2; ++k) dst[m][k] = *(const PG8_LAS bf16x8*)(lds + PG8_SA(b, h) + aoff + m * 2048 + k * 1024); } while (0)
#define PG8_LDB(dst, b, h) do { _Pragma("unroll") for (int n = 0; n < 2; ++n) _Pragma("unroll") for (int k = 0; k < 2; ++k) dst[n][k] = *(const PG8_LAS bf16x8*)(lds + PG8_SB(b, h) + boff + n * 2048 + k * 1024); } while (0)
#define PG8_MMA(ai, bj, At, Bt) do { __builtin_amdgcn_s_setprio(1); _Pragma("unroll") for (int m = 0; m < 4; ++m) _Pragma("unroll") for (int n = 0; n < 2; ++n) _Pragma("unroll") for (int k = 0; k < 2; ++k) \
        acc[ai][bj][m][n] = __builtin_amdgcn_mfma_f32_16x16x32_bf16(Bt[n][k], At[m][k], acc[ai][bj][m][n], 0, 0, 0); __builtin_amdgcn_s_setprio(0); } while (0)
#define PG8_WAIT_V(n) asm volatile("s_waitcnt vmcnt(" #n ")" ::: "memory")
#define PG8_WAIT_L(n) asm volatile("s_waitcnt lgkmcnt(" #n ")" ::: "memory")
#define PG8_BAR __builtin_amdgcn_s_barrier()
#define PG8_SCHED __builtin_amdgcn_sched_barrier(0)
    Unit cur, nxt; int ui = 0;
    if (!S.next(0, cur)) return;
    f32x4 acc[2][2][4][2];
#pragma unroll
    for (int a = 0; a < 2; ++a)
#pragma unroll
        for (int b = 0; b < 2; ++b)
#pragma unroll
            for (int m = 0; m < 4; ++m)
#pragma unroll
                for (int n = 0; n < 2; ++n) acc[a][b][m][n] = (f32x4){0.f, 0.f, 0.f, 0.f};
    bf16x8 At[4][2], B0[2][2], B1[2][2];
    const char* cA = (const char*)g.A + (size_t)cur.pm * tstepA; const char* cB = (const char*)g.Bt + (size_t)cur.pn * tstepB;
    S.a_ready(cur);
    if constexpr (SP2) {
        PG8_STAGE(PG8_SB(0, 0), cB, voffB); PG8_STAGE(PG8_SB(0, 1), cB + hstepB, voffB); PG8_STAGE(PG8_SA(0, 0), cA, voffA); PG8_STAGE(PG8_SA(0, 1), cA + hstepA, voffA);
        if (wr == 1) PG8_BAR;
        PG8_WAIT_V(2); PG8_BAR;
        PG8_STAGE(PG8_SB(1, 0), cB + kstep, voffB); PG8_STAGE(PG8_SA(1, 0), cA + kstep, voffA); PG8_STAGE(PG8_SB(1, 1), cB + hstepB + kstep, voffB);
        PG8_WAIT_V(6); PG8_BAR;
    } else {
        PG8_STAGE(PG8_SB(0, 0), cB, voffB); PG8_STAGE(PG8_SA(0, 0), cA, voffA); PG8_STAGE(PG8_SB(0, 1), cB + hstepB, voffB); PG8_STAGE(PG8_SA(0, 1), cA + hstepA, voffA);
        if (wr == 1) PG8_BAR;
        PG8_WAIT_V(4); PG8_BAR;
        PG8_STAGE(PG8_SB(1, 0), cB + kstep, voffB); PG8_STAGE(PG8_SA(1, 0), cA + kstep, voffA); PG8_STAGE(PG8_SB(1, 1), cB + hstepB + kstep, voffB);
        PG8_WAIT_V(6); PG8_BAR;
    }
    for (;;) {
        const bool has_next = S.next(ui + 1, nxt);
        const char* nA = has_next ? (const char*)g.A + (size_t)nxt.pm * tstepA : cA; const char* nB = has_next ? (const char*)g.Bt + (size_t)nxt.pn * tstepB : cB;
        constexpr int NSEG = has_mid<Epi>::value ? 2 : 1;
        for (int sg = 0; sg < NSEG; ++sg) {
        if constexpr (has_mid<Epi>::value) { if (sg == 1) E.mid(acc, cur, wr, wc, fr, fq); }
        const int t_end = (sg + 1) * (nt / NSEG);
        for (int t = sg * (nt / NSEG); t < t_end; t += 2) {
            const bool last = (t == nt - 2);
            const char* a1 = cA + (size_t)(t + 1) * kstep;
            const char* a2 = last ? nA : cA + (size_t)(t + 2) * kstep; const char* b2 = last ? nB : cB + (size_t)(t + 2) * kstep;
            const char* a3 = a2 + kstep; const char* b3 = b2 + kstep;
            if (last && has_next) S.a_ready(nxt);
            if constexpr (SP2) {
            PG8_LDB(B0, 0, 0); PG8_LDB(B1, 0, 1); PG8_SCHED; PG8_LDA(At, 0, 0); PG8_STAGE(PG8_SA(1, 1), a1 + hstepA, voffA);
            PG8_WAIT_V(8); PG8_WAIT_L(0); PG8_BAR; PG8_MMA(0, 0, At, B0); PG8_MMA(0, 1, At, B1); PG8_BAR; PG8_SCHED;
            PG8_LDA(At, 0, 1); PG8_STAGE(PG8_SB(0, 0), b2, voffB); PG8_STAGE(PG8_SB(0, 1), b2 + hstepB, voffB); PG8_STAGE(PG8_SA(0, 0), a2, voffA);
            PG8_WAIT_V(8); PG8_WAIT_L(0); PG8_BAR; PG8_MMA(1, 0, At, B0); PG8_MMA(1, 1, At, B1); PG8_BAR; PG8_SCHED;
            PG8_LDB(B0, 1, 0); PG8_LDB(B1, 1, 1); PG8_SCHED; PG8_LDA(At, 1, 0); PG8_STAGE(PG8_SA(0, 1), a2 + hstepA, voffA);
            PG8_WAIT_V(8); PG8_WAIT_L(0); PG8_BAR; PG8_MMA(0, 0, At, B0); PG8_MMA(0, 1, At, B1); PG8_BAR; PG8_SCHED;
            PG8_LDA(At, 1, 1); PG8_STAGE(PG8_SB(1, 0), b3, voffB); PG8_STAGE(PG8_SB(1, 1), b3 + hstepB, voffB); PG8_STAGE(PG8_SA(1, 0), a3, voffA);
            PG8_WAIT_V(8); PG8_WAIT_L(0); PG8_BAR; PG8_MMA(1, 0, At, B0); PG8_MMA(1, 1, At, B1); PG8_BAR; PG8_SCHED;
            } else {
            PG8_LDB(B0, 0, 0); PG8_SCHED; PG8_LDA(At, 0, 0); PG8_STAGE(PG8_SA(1, 1), a1 + hstepA, voffA);
            PG8_WAIT_L(8); PG8_BAR; PG8_WAIT_L(0); PG8_MMA(0, 0, At, B0); PG8_BAR; PG8_SCHED;
            PG8_LDB(B1, 0, 1); PG8_STAGE(PG8_SB(0, 0), b2, voffB);
            PG8_BAR; PG8_WAIT_L(0); PG8_MMA(0, 1, At, B1); PG8_BAR;
            PG8_LDA(At, 0, 1); PG8_STAGE(PG8_SA(0, 0), a2, voffA);
            PG8_BAR; PG8_WAIT_L(0); PG8_MMA(1, 0, At, B0); PG8_BAR; PG8_SCHED;
            PG8_STAGE(PG8_SB(0, 1), b2 + hstepB, voffB);
            PG8_WAIT_V(6); PG8_BAR; PG8_MMA(1, 1, At, B1); PG8_BAR;
            PG8_LDB(B0, 1, 0); PG8_SCHED; PG8_LDA(At, 1, 0); PG8_STAGE(PG8_SA(0, 1), a2 + hstepA, voffA);
            PG8_WAIT_L(8); PG8_BAR; PG8_WAIT_L(0); PG8_MMA(0, 0, At, B0); PG8_BAR; PG8_SCHED;
            PG8_LDB(B1, 1, 1); PG8_STAGE(PG8_SB(1, 0), b3, voffB);
            PG8_BAR; PG8_WAIT_L(0); PG8_MMA(0, 1, At, B1); PG8_BAR;
            PG8_LDA(At, 1, 1); PG8_STAGE(PG8_SA(1, 0), a3, voffA);
            PG8_BAR; PG8_WAIT_L(0); PG8_MMA(1, 0, At, B0); PG8_BAR; PG8_SCHED;
            PG8_STAGE(PG8_SB(1, 1), b3 + hstepB, voffB);
            PG8_WAIT_V(6); PG8_BAR; PG8_MMA(1, 1, At, B1); PG8_BAR;
            }
        }
        }
        if constexpr (ALIGN_EPI) { if (wr == 0) PG8_BAR; }
        if constexpr (!Epi::AFTER_DRAIN) { E(acc, cur, wr, wc, fr, fq); S.done(cur); }
        if (!has_next) break;
#pragma unroll
        for (int a = 0; a < 2; ++a)
#pragma unroll
            for (int b = 0; b < 2; ++b)
#pragma unroll
                for (int m = 0; m < 4; ++m)
#pragma unroll
                    for (int n = 0; n < 2; ++n) acc[a][b][m][n] = (f32x4){0.f, 0.f, 0.f, 0.f};
        cur = nxt; cA = nA; cB = nB; ++ui;
        if constexpr (ALIGN_EPI) { if (wr == 1) PG8_BAR; }
    }
    PG8_WAIT_V(0);
    if constexpr (!ALIGN_EPI) { if (wr == 0) PG8_BAR; }
    PG8_BAR;
#undef PG8_SA
#undef PG8_SB
#undef PG8_STAGE
#undef PG8_LDA
#undef PG8_LDB
#undef PG8_MMA
#undef PG8_WAIT_V
#undef PG8_WAIT_L
#undef PG8_BAR
#undef PG8_SCHED
}
}
namespace mk {
using pg8::bf16_t; using pg8::bf16x8; using pg8::f32x4; using pg8::f32x2; using pg8::u32x4; using pg8::u32x2; using pg8::f2bf; using pg8::pk2; using pg8::bf_lo; using pg8::bf_hi;
#define LAS __attribute__((address_space(3)))
typedef float f32x16 __attribute__((ext_vector_type(16)));
constexpr int NWAVES = 8, NTHR = 512;
constexpr int D = 1024, FF = 2816, DIN = 7184, MP = 16384, MS = 128, MT = 16512, MPAD = 16640, TSEQ = 2048, NB = 8;
constexpr int PLD = 7424;
constexpr int PC_XR = 0, PC_YR = 1024, PC_OG = 2048, PC_Q = 3072, PC_K = 3584, PC_V = 4096, PC_GA = 5120, PC_GB = 6144, PC_LR = 7168;
constexpr int SC_XA = 0, SC_H = 1024, SC_T = 3072, SC_F = 5120;
constexpr float EPS = 1e-6f;
constexpr size_t O_YP = 0, O_YS = 16777216, O_HP = 16908288, O_CP = 16916480, O_SP = 16941056, O_HS = 17989632, O_CS = 18120704, O_SS = 18513920;
constexpr size_t MiB = 1u << 20;
constexpr size_t WS_CTL = 0, CTL_ZERO_BYTES = 64 * 1024;
constexpr size_t WS_P = 1 * MiB;
constexpr size_t WS_TAIL = 237 * MiB;
constexpr size_t WS_WRG = WS_TAIL, WS_WBR = WS_TAIL + MiB / 2, WS_WBG = WS_WBR + 2 * MiB, WS_WOUT = WS_WBG + 2 * MiB;
constexpr size_t WS_WGU2 = WS_TAIL, WS_WD2 = WS_TAIL + 11 * MiB;
static_assert(WS_P + (size_t)MPAD * PLD * 2 <= WS_TAIL && WS_WOUT + 2 * MiB <= 256 * MiB && WS_WD2 + (size_t)D * FF * 2 <= 256 * MiB, "d_ws map");
constexpr size_t SS_U = 0, SS_WIN = (size_t)MPAD * D * 2, SS_WGU1 = SS_WIN + (size_t)PLD * D * 2, SS_WD1 = SS_WGU1 + (size_t)2 * FF * D * 2;
static_assert(SS_WD1 + (size_t)D * FF * 2 <= 64 * MiB, "ss-region map");
constexpr int CW_BAR = 4096;
constexpr int LDS_BYTES = 163840, MISC_OFF = LDS_BYTES - 512;

#define RLX_AGENT __ATOMIC_RELAXED, __HIP_MEMORY_SCOPE_AGENT
#define LDS_WAIT() asm volatile("s_waitcnt lgkmcnt(0)" ::: "memory")
#define VM_WAIT() asm volatile("s_waitcnt vmcnt(0)" ::: "memory")

#define XB_TMO      128
#define XB_XCNT(j)  (256  + 64 * (j))
#define XB_XSUB(j)  (1280 + 64 * (j))
#define XB_XGEN(j)  (2304 + 64 * (j))
#define XB_TOP      3328
#define XB_TOPGEN   3392
#define XCD_BAR_WORDS 3456
#define XB_SPIN_CAP (1u << 18)
__device__ __forceinline__ unsigned xb_ld(unsigned* p)              { return __hip_atomic_load(p, __ATOMIC_RELAXED, __HIP_MEMORY_SCOPE_AGENT); }
__device__ __forceinline__ unsigned xb_add(unsigned* p, unsigned v) { return __hip_atomic_fetch_add(p, v, __ATOMIC_RELAXED, __HIP_MEMORY_SCOPE_AGENT); }
__device__ __forceinline__ unsigned xb_xcc_id() { return (unsigned)__builtin_amdgcn_s_getreg((3 << 11) | 20) & 0xFu; }
#define XB_SPIN(cond, bar) do { unsigned _sp = 0; while (cond) { __builtin_amdgcn_s_sleep(1); \
    if ((++_sp & 255u) == 0u) { if (xb_ld(&(bar)[XB_TMO])) break; if (_sp > XB_SPIN_CAP) { atomicAdd(&(bar)[XB_TMO], 1u); break; } } } } while (0)
struct XcdBarrier { unsigned* bar; unsigned x; volatile LAS unsigned* st; };
__device__ __forceinline__ XcdBarrier xcd_barrier_post(unsigned* bar, volatile LAS unsigned* st) {
    XcdBarrier b; b.bar = bar; b.x = xb_xcc_id(); b.st = st;
    if (threadIdx.x == 0) (void)xb_add(&bar[XB_XCNT(b.x)], 1u);
    return b;
}
__device__ __forceinline__ void xcd_barrier_complete(unsigned* bar, unsigned x, unsigned& nloc, unsigned& nx) {
    const unsigned G = gridDim.x * gridDim.y * gridDim.z;
    unsigned sum, cnt, mine, sp = 0u;
    for (;;) {
        sum = 0u; cnt = 0u; mine = 0u;
#pragma unroll
        for (unsigned j = 0; j < 16; ++j) { const unsigned c = xb_ld(&bar[XB_XCNT(j)]); sum += c; cnt += (c > 0u) ? 1u : 0u; mine = (j == x) ? c : mine; }
        if (sum == G) break;
        __builtin_amdgcn_s_sleep(1);
        if ((++sp & 255u) == 0u) { if (xb_ld(&bar[XB_TMO])) break; if (sp > XB_SPIN_CAP) { atomicAdd(&bar[XB_TMO], 1u); break; } }
    }
    nloc = mine > 0u ? mine : 1u; nx = cnt > 0u ? cnt : 1u;
}
__device__ __forceinline__ void xcd_barrier(const XcdBarrier& b) {
    asm volatile("s_waitcnt vmcnt(0)" ::: "memory");
    __syncthreads();
    if (threadIdx.x == 0) {
        unsigned* bar = b.bar;
        __builtin_amdgcn_s_waitcnt(0);
        unsigned nloc = b.st[0], nx = b.st[1];
        if (nloc == 0u) { xcd_barrier_complete(bar, b.x, nloc, nx); b.st[0] = nloc; b.st[1] = nx; }
        const unsigned old = xb_add(&bar[XB_XSUB(b.x)], 1u);
        const unsigned gen = old / nloc;
        if (old + 1u == (gen + 1u) * nloc) {
            __builtin_amdgcn_fence(__ATOMIC_RELEASE, "agent");
            asm volatile("s_waitcnt vmcnt(0)" ::: "memory");
            const unsigned og = xb_add(&bar[XB_TOP], 1u);
            const unsigned tg = og / nx;
            if (og + 1u == (tg + 1u) * nx) xb_add(&bar[XB_TOPGEN], 1u);
            else XB_SPIN(xb_ld(&bar[XB_TOPGEN]) == tg, bar);
            __builtin_amdgcn_fence(__ATOMIC_ACQUIRE, "agent");
            xb_add(&bar[XB_XGEN(b.x)], 1u);
            asm volatile("s_waitcnt vmcnt(0)" ::: "memory");
        } else {
            XB_SPIN(xb_ld(&bar[XB_XGEN(b.x)]) == gen, bar);
            __builtin_amdgcn_fence(__ATOMIC_ACQUIRE, "agent");
            asm volatile("s_waitcnt vmcnt(0)" ::: "memory");
        }
    }
    __syncthreads();
}

struct Args { const float* in[24]; float* out; unsigned char* ws; int ph_lo, ph_hi; };
struct Frame {
    LAS unsigned char* lds; int tid, lane, wave, vcu, G;
    const float* in[24]; float* out; unsigned char* ws;
    bf16_t* P; bf16_t* U; bf16_t* Win_t; bf16_t* Wgu1_t; bf16_t* Wd1_t; bf16_t* Wrg_t; bf16_t* Wbr_t; bf16_t* Wbg_t; bf16_t* Wout_t; bf16_t* Wgu2_t; bf16_t* Wd2_t;
};
enum { I_XP = 0, I_XS, I_SRH, I_SRC, I_SGLA, I_NG, I_F1GU, I_F1D, I_WIN, I_CW, I_CB, I_RWA, I_RBA, I_RWX, I_RBX, I_LAM, I_WLR, I_BLR, I_GNG, I_WBR, I_WBG, I_WOUT, I_F2GU, I_F2D };

__device__ __forceinline__ float wave_sum(float v) {
#pragma unroll
    for (int o = 1; o < 64; o <<= 1) v += __shfl_xor(v, o);
    return v;
}
__device__ __forceinline__ const float* xrow_ptr(const Frame& F, int row) { return row < MP ? F.in[I_XP] + (size_t)row * D : F.in[I_XS] + (size_t)(row - MP) * D; }
__device__ __forceinline__ void load_row16(const float* p, int lane, f32x4 (&v)[4]) {
#pragma unroll
    for (int j = 0; j < 4; ++j) v[j] = *(const f32x4*)(p + 4 * lane + 256 * j);
}
__device__ __forceinline__ float sumsq16(const f32x4 (&v)[4]) { float s = 0.f;
#pragma unroll
    for (int j = 0; j < 4; ++j) s += (v[j].x * v[j].x + v[j].y * v[j].y) + (v[j].z * v[j].z + v[j].w * v[j].w);
    return s; }
__device__ __forceinline__ void store_row16_bf16(bf16_t* p, int lane, const f32x4 (&v)[4]) {
#pragma unroll
    for (int j = 0; j < 4; ++j) { u32x2 w; w.x = pk2(v[j].x, v[j].y); w.y = pk2(v[j].z, v[j].w); *(u32x2*)(p + 4 * lane + 256 * j) = w; }
}
struct SlabMap { int slot, logw; };
__device__ __forceinline__ float* slab_at(const Frame& F, const SlabMap m, int s, int r, int c) {
    return (float*)(F.P + (size_t)(((s * MS + r) << (10 - m.logw)) + (c >> m.logw)) * PLD + m.slot) + (c & ((1 << m.logw) - 1)); }
constexpr SlabMap SLAB_D = {SC_XA, 9};
constexpr SlabMap SLAB_B = {PC_LR, 7};
__device__ __forceinline__ void load_row16_f(const Frame& F, int row, int slot, const SlabMap m, int slab0, int ns, f32x4 (&v)[4]) {
    if (row < MP) {
#pragma unroll
        for (int j = 0; j < 4; ++j) { const u32x2 w = *(const u32x2*)(F.P + (size_t)row * PLD + slot + 4 * F.lane + 256 * j); v[j] = (f32x4){bf_lo(w.x), bf_hi(w.x), bf_lo(w.y), bf_hi(w.y)}; }
        return; }
#pragma unroll
    for (int j = 0; j < 4; ++j) v[j] = (f32x4){0.f, 0.f, 0.f, 0.f};
    for (int s = 0; s < ns; ++s) {
#pragma unroll
        for (int j = 0; j < 4; ++j) v[j] = v[j] + *(const f32x4*)slab_at(F, m, slab0 + s, row - MP, 4 * F.lane + 256 * j); }
}
__device__ __forceinline__ void rowphase0(const Frame& F) {
    const int gw = F.vcu * NWAVES + F.wave, NGW = F.G * NWAVES; const float* g0 = F.in[I_NG];
    f32x4 g[4]; load_row16(g0, F.lane, g);
    for (int row = gw; row < MT; row += NGW) {
        f32x4 v[4]; load_row16(xrow_ptr(F, row), F.lane, v);
        const float rs = rsqrtf(wave_sum(sumsq16(v)) * (1.f / D) + EPS);
#pragma unroll
        for (int j = 0; j < 4; ++j) v[j] = v[j] * rs * g[j];
        store_row16_bf16(F.P + (size_t)row * PLD + SC_XA, F.lane, v);
    }
}
__device__ __forceinline__ void rowphase1(const Frame& F) {
    const int gw = F.vcu * NWAVES + F.wave, NGW = F.G * NWAVES; const float* ng = F.in[I_NG];
    f32x4 g1[4], g2[4]; load_row16(ng + 1 * D, F.lane, g1); load_row16(ng + 2 * D, F.lane, g2);
    for (int row = gw; row < MT; row += NGW) {
        f32x4 f[4], x[4]; load_row16_f(F, row, SC_F, SLAB_D, 0, 22, f); load_row16(xrow_ptr(F, row), F.lane, x);
        const float rs = rsqrtf(wave_sum(sumsq16(f)) * (1.f / D) + EPS);
#pragma unroll
        for (int j = 0; j < 4; ++j) x[j] = x[j] + 0.5f * (f[j] * rs * g1[j]);
        float* o = F.out + (size_t)row * D;
#pragma unroll
        for (int j = 0; j < 4; ++j) *(f32x4*)(o + 4 * F.lane + 256 * j) = x[j];
        const float rs2 = rsqrtf(wave_sum(sumsq16(x)) * (1.f / D) + EPS);
#pragma unroll
        for (int j = 0; j < 4; ++j) x[j] = x[j] * rs2 * g2[j];
        store_row16_bf16(F.U + (size_t)row * D, F.lane, x);
    }
}
__device__ __forceinline__ void rowphase2(const Frame& F) {
    const int gw = F.vcu * NWAVES + F.wave, NGW = F.G * NWAVES; const float* ng = F.in[I_NG];
    f32x4 g3[4], g4[4]; load_row16(ng + 3 * D, F.lane, g3); load_row16(ng + 4 * D, F.lane, g4);
    for (int row = gw; row < MT; row += NGW) {
        f32x4 f[4], x[4]; load_row16_f(F, row, SC_T, SLAB_B, 4, 8, f); float* o = F.out + (size_t)row * D; load_row16(o, F.lane, x);
        const float rs = rsqrtf(wave_sum(sumsq16(f)) * (1.f / D) + EPS);
#pragma unroll
        for (int j = 0; j < 4; ++j) x[j] = x[j] + f[j] * rs * g3[j];
#pragma unroll
        for (int j = 0; j < 4; ++j) *(f32x4*)(o + 4 * F.lane + 256 * j) = x[j];
        const float rs2 = rsqrtf(wave_sum(sumsq16(x)) * (1.f / D) + EPS);
#pragma unroll
        for (int j = 0; j < 4; ++j) x[j] = x[j] * rs2 * g4[j];
        store_row16_bf16(F.P + (size_t)row * PLD + SC_XA, F.lane, x);
    }
}
__device__ __forceinline__ void rowphase3(const Frame& F) {
    const int gw = F.vcu * NWAVES + F.wave, NGW = F.G * NWAVES; const float* ng = F.in[I_NG];
    f32x4 g5[4]; load_row16(ng + 5 * D, F.lane, g5);
    for (int row = gw; row < MT; row += NGW) {
        f32x4 f[4], x[4]; load_row16_f(F, row, SC_F, SLAB_D, 0, 22, f); float* o = F.out + (size_t)row * D; load_row16(o, F.lane, x);
        const float rs = rsqrtf(wave_sum(sumsq16(f)) * (1.f / D) + EPS);
#pragma unroll
        for (int j = 0; j < 4; ++j) *(f32x4*)(o + 4 * F.lane + 256 * j) = x[j] + 0.5f * (f[j] * rs * g5[j]);
    }
}

__device__ __forceinline__ void tr_item(const float* W, int ldw, int K, int k0, int scol0, int nvalid, bf16_t* WT, int drow0, LAS float* scr, int lane, int ldt = 0) {
    if (ldt == 0) ldt = K;
    { const int c4 = lane & 7, r = lane >> 3; const bool ok = 4 * c4 < nvalid; f32x4 v[8];
#pragma unroll
      for (int i = 0; i < 8; ++i) v[i] = ok ? *(const f32x4*)(W + (size_t)(k0 + r + 8 * i) * ldw + scol0 + 4 * c4) : (f32x4){0.f, 0.f, 0.f, 0.f};
#pragma unroll
      for (int i = 0; i < 8; ++i) { LAS float* d = scr + (r + 8 * i) * 33 + 4 * c4; d[0] = v[i][0]; d[1] = v[i][1]; d[2] = v[i][2]; d[3] = v[i][3]; } }
    LDS_WAIT(); asm volatile("" ::: "memory");
    const int c = lane & 7;
#pragma unroll
    for (int j = 0; j < 4; ++j) { const int n = (lane >> 3) + 8 * j; const LAS float* s = scr + (8 * c) * 33 + n;
        u32x4 o; o.x = pk2(s[0 * 33], s[1 * 33]); o.y = pk2(s[2 * 33], s[3 * 33]); o.z = pk2(s[4 * 33], s[5 * 33]); o.w = pk2(s[6 * 33], s[7 * 33]);
        *(u32x4*)(WT + (size_t)(drow0 + n) * ldt + k0 + 8 * c) = o; }
    LDS_WAIT(); asm volatile("" ::: "memory");
}
__device__ __forceinline__ void prep_wgu(const Frame& F, const float* W, bf16_t* WT, LAS float* scr, int gw, int NGW) {
    constexpr int KB = D / 64, RB = 2 * FF / 32;
    for (int it = gw; it < KB * RB; it += NGW) { const int kb = it / RB, rb = it % RB, n0 = 32 * rb, pn = n0 >> 8, bj = (n0 >> 7) & 1, j = n0 & 127;
        tr_item(W, 2 * FF, D, 64 * kb, bj * FF + 128 * pn + j, 32, WT, n0, scr, F.lane); }
}
__device__ __forceinline__ void prep_plain(const Frame& F, const float* W, int K, int N, bf16_t* WT, LAS float* scr, int gw, int NGW, int ldt = 0) {
    const int KB = K / 64, RB = N / 32;
    for (int it = gw; it < KB * RB; it += NGW) { const int kb = it / RB, rb = it % RB; tr_item(W, N, K, 64 * kb, 32 * rb, 32, WT, 32 * rb, scr, F.lane, ldt); }
}
__device__ __forceinline__ void prep_win(const Frame& F, LAS float* scr, int gw, int NGW) {
    constexpr int KB = D / 64, RB = PLD / 32;
    for (int it = gw; it < KB * RB; it += NGW) { const int kb = it / RB, rb = it % RB, n0 = 32 * rb; int sc, nv = 32;
        if (n0 < 2048) sc = n0;
        else if (n0 < 3072) sc = 4096 + (n0 - 2048);
        else if (n0 < 3584) sc = 2048 + (n0 - 3072);
        else if (n0 < 4096) sc = 2560 + (n0 - 3584);
        else if (n0 < 5120) sc = 3072 + (n0 - 4096);
        else if (n0 < 6144) sc = 5136 + (n0 - 5120);
        else if (n0 < 7168) sc = 6160 + (n0 - 6144);
        else if (n0 == 7168) { sc = 5120; nv = 16; }
        else { sc = 0; nv = 0; }
        tr_item(F.in[I_WIN], DIN, D, 64 * kb, sc, nv, F.Win_t, n0, scr, F.lane); }
}
__device__ __forceinline__ void prep_rg(const Frame& F, LAS float* scr, int gw, int NGW) {
    for (int it = gw; it < 2 * 8 * 8; it += NGW) { const int gate = it >> 6, n = (it >> 3) & 7, sub = it & 7, kb = sub >> 2, rb = sub & 3;
        tr_item(F.in[gate ? I_RWX : I_RWA] + (size_t)n * 16384, 128, 128, 64 * kb, 32 * rb, 32, F.Wrg_t + (size_t)(gate * 8 + n) * 16384, 32 * rb, scr, F.lane); }
}
}
namespace mk {
#define MFMA16(a, b, c) __builtin_amdgcn_mfma_f32_16x16x32_bf16((a), (b), (c), 0, 0, 0)
#define MFMA32(a, b, c) __builtin_amdgcn_mfma_f32_32x32x16_bf16((a), (b), (c), 0, 0, 0)
constexpr float LOG2E = 1.4426950408889634f;
__device__ __forceinline__ float bf2f(bf16_t h) { return __builtin_bit_cast(float, (unsigned)h << 16); }
__device__ __forceinline__ float ex2(float x) { return __builtin_amdgcn_exp2f(x); }
__device__ __forceinline__ float sigm(float x) { return __builtin_amdgcn_rcpf(1.0f + ex2(-LOG2E * x)); }
__device__ __forceinline__ float softplus_(float x) { return fmaxf(x, 0.f) + log1pf(__expf(-fabsf(x))); }
__device__ __forceinline__ float gelu_tanh_(float x) { return x * sigm(1.5957691216057308f * (x + 0.044715f * x * x * x)); }
__device__ __forceinline__ float silu_(float x) { return x * sigm(x); }
__device__ __forceinline__ void unpack8(const u32x4 w, float (&f)[8]) { f[0] = bf_lo(w.x); f[1] = bf_hi(w.x); f[2] = bf_lo(w.y); f[3] = bf_hi(w.y); f[4] = bf_lo(w.z); f[5] = bf_hi(w.z); f[6] = bf_lo(w.w); f[7] = bf_hi(w.w); }
__device__ __forceinline__ u32x4 pack8(const float (&f)[8]) { u32x4 w; w.x = pk2(f[0], f[1]); w.y = pk2(f[2], f[3]); w.z = pk2(f[4], f[5]); w.w = pk2(f[6], f[7]); return w; }

constexpr size_t WS_GAGG = WS_WOUT + 2 * MiB, GAGG_FLOATS = 32768 + 128, WS_RAGG = 128 * 1024;
static_assert(WS_GAGG + (size_t)96 * GAGG_FLOATS * 4 <= 256 * MiB && WS_RAGG + 512 * 256 * 4 <= WS_P, "mixer scratch map");

template <bool SAMPLE, int MODE>
__device__ __forceinline__ void rnn_item(const Frame& F, int item) {
    constexpr int XRAW_OFF = 0, XRAW_LD = 136, XCF_OFF = 18432, XCF_LD = 132, XCB_OFF = 52224, XCB_LD = 136, HB_OFF = 69632, CW_OFF = 103424;
    constexpr bool FULL = SAMPLE || MODE == 3;
    const int tid = F.tid, lane = F.lane, wid = F.wave;
    const int seg = SAMPLE ? 0 : (item & 7), n = SAMPLE ? item : ((item >> 3) & 7), b = SAMPLE ? 0 : (item >> 6), ch0 = 128 * n;
    LAS bf16_t* XRAW = (LAS bf16_t*)(F.lds + XRAW_OFF); LAS float* XCF = (LAS float*)(F.lds + XCF_OFF); LAS bf16_t* XCB = (LAS bf16_t*)(F.lds + XCB_OFF);
    LAS float* HB = (LAS float*)(F.lds + HB_OFF); LAS float* CW = (LAS float*)(F.lds + CW_OFF);
    for (int i = tid; i < 5 * 128; i += NTHR) { const int j = i >> 7, c = i & 127; CW[i] = j < 4 ? F.in[I_CW][j * D + ch0 + c] : F.in[I_CB][ch0 + c]; }
    const int q = lane >> 4, cl = 16 * wid + (lane & 15);
    const float ba = F.in[I_RBA][ch0 + cl], bx = F.in[I_RBX][ch0 + cl], sp8 = 8.0f * softplus_(-F.in[I_LAM][ch0 + cl]), sp8l2 = sp8 * LOG2E;
    bf16x8 Bw[2][4];
#pragma unroll
    for (int g = 0; g < 2; ++g)
#pragma unroll
        for (int ks = 0; ks < 4; ++ks) Bw[g][ks] = *(const bf16x8*)(F.Wrg_t + ((size_t)(g * 8 + n) * 128 + cl) * 128 + 32 * ks + 8 * q);
    const int t5 = tid >> 3, c5 = 16 * (tid & 7);
    float* ragg = (float*)(F.ws + WS_RAGG);
    float carry = 0.f, aprod = 1.f;
    if constexpr (!SAMPLE && MODE == 3) {
        float fa[7], fh[7];
#pragma unroll
        for (int s = 0; s < 7; ++s) { const float* ag = ragg + ((size_t)((b * 8 + n) * 8 + s)) * 256; fa[s] = s < seg ? ag[cl] : 1.f; fh[s] = s < seg ? ag[128 + cl] : 0.f; }
#pragma unroll
        for (int s = 0; s < 7; ++s) carry = fmaf(fa[s], carry, fh[s]);
    }
    const int ntiles = SAMPLE ? 2 : 4, tile0 = SAMPLE ? 0 : 4 * seg;
    u32x4 pxr[3], py0 = (u32x4){0u, 0u, 0u, 0u}, py1 = py0;
    auto prefetch = [&](int t0n) {
        if constexpr (!SAMPLE) {
#pragma unroll
            for (int i3 = 0; i3 < 3; ++i3) { const int e = tid + NTHR * i3, i = e >> 4, chk = e & 15, t = t0n - 3 + i; pxr[i3] = (u32x4){0u, 0u, 0u, 0u};
                if (e < 67 * 16 && t >= 0) pxr[i3] = *(const u32x4*)(F.P + ((size_t)b * TSEQ + t) * PLD + PC_XR + ch0 + 8 * chk); }
            if constexpr (FULL) { const bf16_t* yp = F.P + ((size_t)b * TSEQ + t0n + t5) * PLD + PC_YR + ch0 + c5; py0 = *(const u32x4*)yp; py1 = *(const u32x4*)(yp + 8); }
        }
    };
    if constexpr (!SAMPLE) prefetch(64 * tile0);
    __syncthreads();
    for (int tt = 0; tt < ntiles; ++tt) {
        const int t0 = 64 * (tile0 + tt);
        const size_t row5 = SAMPLE ? (size_t)(MP + t0 + t5) : (size_t)b * TSEQ + t0 + t5;
        bf16_t* yrp = F.P + row5 * PLD + PC_YR + ch0 + c5;
        u32x4 y0 = py0, y1 = py1;
        if constexpr (SAMPLE) { y0 = *(const u32x4*)yrp; y1 = *(const u32x4*)(yrp + 8); }
        if constexpr (!SAMPLE) {
#pragma unroll
            for (int i3 = 0; i3 < 3; ++i3) { const int e = tid + NTHR * i3, i = e >> 4, chk = e & 15; if (e < 67 * 16) *(LAS u32x4*)(XRAW + i * XRAW_LD + 8 * chk) = pxr[i3]; }
            __syncthreads();
            if (tt + 1 < ntiles) prefetch(t0 + 64);
            const int c0 = 8 * (tid & 15);
            float w[4][8], cb8[8];
#pragma unroll
            for (int e = 0; e < 8; ++e) { cb8[e] = CW[4 * 128 + c0 + e];
#pragma unroll
                for (int j = 0; j < 4; ++j) w[j][e] = CW[j * 128 + c0 + e]; }
#pragma unroll
            for (int rr = 0; rr < 2; ++rr) { const int t = (tid >> 4) + 32 * rr; float xc[8];
#pragma unroll
                for (int e = 0; e < 8; ++e) xc[e] = cb8[e];
#pragma unroll
                for (int j = 0; j < 4; ++j) { float x[8]; unpack8(*(const LAS u32x4*)(XRAW + (t + j) * XRAW_LD + c0), x);
#pragma unroll
                    for (int e = 0; e < 8; ++e) xc[e] = fmaf(w[j][e], x[e], xc[e]); }
                *(LAS f32x4*)(XCF + t * XCF_LD + c0) = (f32x4){xc[0], xc[1], xc[2], xc[3]}; *(LAS f32x4*)(XCF + t * XCF_LD + c0 + 4) = (f32x4){xc[4], xc[5], xc[6], xc[7]};
                *(LAS u32x4*)(XCB + t * XCB_LD + c0) = pack8(xc); }
        } else {
            const int s = t0 + t5; const bf16_t* xrp = F.P + (size_t)(MP + s) * PLD + PC_XR + ch0 + c5;
            float xr[16]; { float a8[8], b8[8]; unpack8(*(const u32x4*)xrp, a8); unpack8(*(const u32x4*)(xrp + 8), b8);
#pragma unroll
                for (int e = 0; e < 8; ++e) { xr[e] = a8[e]; xr[8 + e] = b8[e]; } }
            const float* bufp = F.in[I_SRC] + (size_t)s * 3 * D + ch0 + c5; float* csp = F.out + O_CS + (size_t)s * 3 * D + ch0 + c5;
            float xc[16];
#pragma unroll
            for (int e = 0; e < 16; ++e) xc[e] = CW[4 * 128 + c5 + e] + CW[3 * 128 + c5 + e] * xr[e];
#pragma unroll
            for (int j = 0; j < 3; ++j)
#pragma unroll
                for (int v4 = 0; v4 < 4; ++v4) { const f32x4 bv = *(const f32x4*)(bufp + j * D + 4 * v4);
#pragma unroll
                    for (int e = 0; e < 4; ++e) xc[4 * v4 + e] = fmaf(CW[j * 128 + c5 + 4 * v4 + e], bv[e], xc[4 * v4 + e]);
                    if (j >= 1) *(f32x4*)(csp + (j - 1) * D + 4 * v4) = bv; }
#pragma unroll
            for (int v4 = 0; v4 < 4; ++v4) { *(f32x4*)(csp + 2 * D + 4 * v4) = (f32x4){xr[4 * v4], xr[4 * v4 + 1], xr[4 * v4 + 2], xr[4 * v4 + 3]};
                *(LAS f32x4*)(XCF + t5 * XCF_LD + c5 + 4 * v4) = (f32x4){xc[4 * v4], xc[4 * v4 + 1], xc[4 * v4 + 2], xc[4 * v4 + 3]}; }
            { float h8[8];
#pragma unroll
              for (int hf = 0; hf < 2; ++hf) {
#pragma unroll
                for (int e = 0; e < 8; ++e) h8[e] = xc[8 * hf + e];
                *(LAS u32x4*)(XCB + t5 * XCB_LD + c5 + 8 * hf) = pack8(h8); } }
        }
        __syncthreads();
        f32x4 acc[4][2];
#pragma unroll
        for (int m = 0; m < 4; ++m) { acc[m][0] = (f32x4){0.f, 0.f, 0.f, 0.f}; acc[m][1] = (f32x4){0.f, 0.f, 0.f, 0.f}; }
#pragma unroll
        for (int m = 0; m < 4; ++m)
#pragma unroll
            for (int ks = 0; ks < 4; ++ks) { const bf16x8 a = *(const LAS bf16x8*)(XCB + (16 * m + (lane & 15)) * XCB_LD + 32 * ks + 8 * q);
                acc[m][0] = MFMA16(a, Bw[0][ks], acc[m][0]); acc[m][1] = MFMA16(a, Bw[1][ks], acc[m][1]); }
#pragma unroll
        for (int m = 0; m < 4; ++m) {
            float av[4], bv[4];
#pragma unroll
            for (int reg = 0; reg < 4; ++reg) { const int t = 16 * m + 4 * q + reg; const float xcv = XCF[t * XCF_LD + cl];
                const float r = sigm(acc[m][0][reg] + ba), ig = sigm(acc[m][1][reg] + bx);
                const float x2 = -2.0f * sp8 * r;
                const float em = -x2 * (1.0f + x2 * (0.5f + x2 * (0.16666667f + x2 * (0.041666668f + x2 * (0.0083333338f + x2 * (0.0013888889f + x2 * 0.00019841270f))))));
                float mult = __builtin_amdgcn_sqrtf(fmaxf(em, 0.f)); if (!SAMPLE && (t0 + t) == 0) mult = 1.0f;
                av[reg] = ex2(-sp8l2 * r); bv[reg] = mult * ig * xcv; }
            if constexpr (!SAMPLE) {
                float Al = 1.f, Hl = 0.f;
#pragma unroll
                for (int reg = 0; reg < 4; ++reg) { Hl = fmaf(av[reg], Hl, bv[reg]); Al *= av[reg]; }
                float hin = carry, cn = carry;
#pragma unroll
                for (int qq = 0; qq < 4; ++qq) { const float Ag = __shfl(Al, (lane & 15) + 16 * qq), Hg = __shfl(Hl, (lane & 15) + 16 * qq);
                    cn = fmaf(Ag, cn, Hg); hin = (qq < q) ? cn : hin; if (MODE == 1) aprod *= Ag; }
                carry = cn;
                if constexpr (MODE == 3) { float hv = hin;
#pragma unroll
                    for (int reg = 0; reg < 4; ++reg) { hv = fmaf(av[reg], hv, bv[reg]); HB[(16 * m + 4 * q + reg) * XCF_LD + cl] = hv; } }
            } else {
#pragma unroll
                for (int reg = 0; reg < 4; ++reg) { const int t = 16 * m + 4 * q + reg; const float h0 = F.in[I_SRH][(size_t)(t0 + t) * D + ch0 + cl];
                    HB[t * XCF_LD + cl] = fmaf(av[reg], h0, bv[reg]); }
            }
        }
        __syncthreads();
        if constexpr (FULL) {
            float h[16], yv[16], o8[8];
#pragma unroll
            for (int v4 = 0; v4 < 4; ++v4) { const f32x4 hv = *(const LAS f32x4*)(HB + t5 * XCF_LD + c5 + 4 * v4); h[4 * v4] = hv[0]; h[4 * v4 + 1] = hv[1]; h[4 * v4 + 2] = hv[2]; h[4 * v4 + 3] = hv[3]; }
            { float a8[8], b8[8]; unpack8(y0, a8); unpack8(y1, b8);
#pragma unroll
              for (int e = 0; e < 8; ++e) { yv[e] = a8[e]; yv[8 + e] = b8[e]; } }
            if constexpr (SAMPLE) { float* hsp = F.out + O_HS + (size_t)(t0 + t5) * D + ch0 + c5;
#pragma unroll
                for (int v4 = 0; v4 < 4; ++v4) *(f32x4*)(hsp + 4 * v4) = (f32x4){h[4 * v4], h[4 * v4 + 1], h[4 * v4 + 2], h[4 * v4 + 3]}; }
#pragma unroll
            for (int hf = 0; hf < 2; ++hf) {
#pragma unroll
                for (int e = 0; e < 8; ++e) o8[e] = h[8 * hf + e] * gelu_tanh_(yv[8 * hf + e]);
                *(u32x4*)(yrp + 8 * hf) = pack8(o8); }
            if constexpr (!SAMPLE) { if (tile0 + tt == 31 && t5 >= 61) { float* cpp = F.out + O_CP + ((size_t)b * 3 + (t5 - 61)) * D + ch0 + c5;
#pragma unroll
                for (int e = 0; e < 16; ++e) cpp[e] = bf2f(XRAW[(t5 + 3) * XRAW_LD + c5 + e]); } }
        }
    }
    if constexpr (!SAMPLE && MODE == 1) { if (q == 0) { float* ag = ragg + (size_t)item * 256; ag[cl] = aprod; ag[128 + cl] = carry; } }
    if constexpr (!SAMPLE && MODE == 3) { if (seg == 7 && q == 0) F.out[O_HP + (size_t)b * D + ch0 + cl] = carry; }
    __syncthreads();
}

__device__ __forceinline__ int crow(int reg, int h) { return (reg & 3) + 8 * (reg >> 2) + 4 * h; }
__device__ __forceinline__ bf16x8 pack_step(const f32x16& x, int s) {
    u32x4 p; p.x = pk2(x[8 * s], x[8 * s + 1]); p.y = pk2(x[8 * s + 2], x[8 * s + 3]); p.z = pk2(x[8 * s + 4], x[8 * s + 5]); p.w = pk2(x[8 * s + 6], x[8 * s + 7]);
    return __builtin_bit_cast(bf16x8, p);
}
template <int MODE>
__device__ __forceinline__ void gla_item(const Frame& F, int item) {
    constexpr int VRAW = 0, VRAW_LD = 264, LRS = 33792, QI = 37888, QK_LD = 136, KI = 55296, OBUF = 0, KET = 72704, T_LD = 72, VT = 91136, ATT = 128000, SEG = 137216, DEC = 139264, WLS = 139776;
    static_assert(WLS + 17 * 512 <= MISC_OFF, "GLA LDS map");
    constexpr bool FULL = (MODE == 3);
    const int tid = F.tid, lane = F.lane, w = F.wave;
    const int j = item & 3, hh = (item >> 2) & 3, b = item >> 4; const size_t rowbase = (size_t)b * TSEQ;
    LAS bf16_t* sVRAW = (LAS bf16_t*)(F.lds + VRAW); LAS float* sLR = (LAS float*)(F.lds + LRS); LAS bf16_t* sQI = (LAS bf16_t*)(F.lds + QI); LAS bf16_t* sKI = (LAS bf16_t*)(F.lds + KI);
    LAS float* sO = (LAS float*)(F.lds + OBUF); LAS bf16_t* sKET = (LAS bf16_t*)(F.lds + KET); LAS bf16_t* sVT = (LAS bf16_t*)(F.lds + VT); LAS bf16_t* sATT = (LAS bf16_t*)(F.lds + ATT);
    LAS float* sSEG = (LAS float*)(F.lds + SEG); LAS float* sDEC = (LAS float*)(F.lds + DEC);
    const int kk = tid & 127, seg = tid >> 7;
    LAS float* sWL = (LAS float*)(F.lds + WLS);
    for (int i = tid; i < 17 * 128; i += NTHR) sWL[i] = i < 2048 ? F.in[I_WLR][(i >> 7) * 512 + hh * 128 + (i & 127)] : F.in[I_BLR][hh * 128 + (i & 127)];
    const int r32 = lane & 31, h = lane >> 5, q = lane >> 4;
    float* gagg = (float*)(F.ws + WS_GAGG);
    f32x16 S[4];
#pragma unroll
    for (int kb = 0; kb < 4; ++kb)
#pragma unroll
        for (int i = 0; i < 16; ++i) S[kb][i] = 0.f;
    float dsum = 0.f;
    if constexpr (FULL) {
        for (int s = 0; s < j; ++s) { const float* ag = gagg + (size_t)((b * 4 + hh) * 3 + s) * GAGG_FLOATS;
            __syncthreads();
            if (tid < 128) sDEC[tid] = ag[32768 + tid];
            __syncthreads();
#pragma unroll
            for (int kb = 0; kb < 4; ++kb) {
#pragma unroll
                for (int g4 = 0; g4 < 4; ++g4) { const f32x4 kv = *(const f32x4*)(ag + ((size_t)((w * 4 + kb) * 4 + g4)) * 256 + 4 * lane); const f32x4 dd = *(const LAS f32x4*)(sDEC + 32 * kb + 8 * g4 + 4 * h);
#pragma unroll
                    for (int e = 0; e < 4; ++e) S[kb][4 * g4 + e] = fmaf(S[kb][4 * g4 + e], dd[e], kv[e]); }
            asm volatile("" ::: "memory"); }
        }
    }
    const char* Pb = (const char*)F.P;
    const unsigned ov = (unsigned)(((tid >> 5) * PLD + PC_V + 256 * hh + 8 * (tid & 31)) * 2), olr = (unsigned)(((tid >> 1) * PLD + PC_LR + 8 * (tid & 1)) * 2);
    const unsigned okq = (unsigned)(((tid >> 4) * PLD + 128 * hh + 8 * (tid & 15)) * 2), oog = (unsigned)((8 * w * PLD + PC_OG + 256 * hh + 4 * lane) * 2);
    LAS bf16_t* sQR = (LAS bf16_t*)(F.lds + VRAW); LAS bf16_t* sKR = (LAS bf16_t*)(F.lds + VRAW + 16384);
    u32x4 pv[4], plr = (u32x4){0u, 0u, 0u, 0u}, pk[2], pq[2];
    auto prefetch = [&](size_t r0) {
        const char* rb = Pb + r0 * (size_t)(PLD * 2);
        unsigned o1 = ov, o2 = olr, o3 = okq; asm volatile("" : "+v"(o1), "+v"(o2), "+v"(o3));
#pragma unroll
        for (int i = 0; i < 4; ++i) pv[i] = *(const u32x4*)(rb + (o1 + (unsigned)(i * 16 * PLD * 2)));
        if (tid < 128) plr = *(const u32x4*)(rb + o2);
#pragma unroll
        for (int i = 0; i < 2; ++i) pk[i] = *(const u32x4*)(rb + (o3 + (unsigned)((i * 32 * PLD + PC_K) * 2)));
    };
    prefetch(rowbase + 64 * (8 * j));
    __syncthreads();
    for (int cn = 8 * j; cn < 8 * j + 8; ++cn) {
        const size_t row0 = rowbase + 64 * cn;
        if constexpr (FULL) { const char* rb = Pb + row0 * (size_t)(PLD * 2); unsigned o3 = okq; asm volatile("" : "+v"(o3));
#pragma unroll
            for (int i = 0; i < 2; ++i) pq[i] = *(const u32x4*)(rb + (o3 + (unsigned)((i * 32 * PLD + PC_Q) * 2))); }
#pragma unroll
        for (int i = 0; i < 4; ++i) { const int e = tid + NTHR * i, row = e >> 5, c16 = e & 31; *(LAS u32x4*)(sVRAW + row * VRAW_LD + 8 * c16) = pv[i]; }
        if (tid < 128) { const int row = tid >> 1, hf = tid & 1; float f[8]; unpack8(plr, f);
            *(LAS f32x4*)(sLR + row * 16 + 8 * hf) = (f32x4){f[0], f[1], f[2], f[3]}; *(LAS f32x4*)(sLR + row * 16 + 8 * hf + 4) = (f32x4){f[4], f[5], f[6], f[7]}; }
        __syncthreads();
        float c[16]; float run = 0.f; float wl[16];
#pragma unroll
        for (int r = 0; r < 16; ++r) wl[r] = sWL[r * 128 + kk];
        const float bias = sWL[2048 + kk];
#pragma unroll
        for (int i = 0; i < 16; ++i) { const LAS float* lr = sLR + (16 * seg + i) * 16; float x = bias;
#pragma unroll
            for (int r4 = 0; r4 < 4; ++r4) { const f32x4 lv = *(const LAS f32x4*)(lr + 4 * r4); x = fmaf(lv[0], wl[4 * r4], x); x = fmaf(lv[1], wl[4 * r4 + 1], x); x = fmaf(lv[2], wl[4 * r4 + 2], x); x = fmaf(lv[3], wl[4 * r4 + 3], x); }
            x = fminf(fmaxf(x, -80.f), 80.f);
            run -= __builtin_amdgcn_logf(1.0f + ex2(-LOG2E * x)) * (1.0f / 16.0f);
            c[i] = run; if ((i & 3) == 3) __builtin_amdgcn_sched_barrier(0); }
        sSEG[seg * 128 + kk] = run;
        { const int dv = tid & 255, hf = tid >> 8;
#pragma unroll
          for (int s8 = 0; s8 < 4; ++s8) { const int s = 32 * hf + 8 * s8; u32x4 wv; unsigned t[8];
#pragma unroll
              for (int jj = 0; jj < 8; ++jj) t[jj] = sVRAW[(s + jj) * VRAW_LD + dv];
              wv.x = t[0] | (t[1] << 16); wv.y = t[2] | (t[3] << 16); wv.z = t[4] | (t[5] << 16); wv.w = t[6] | (t[7] << 16);
              *(LAS u32x4*)(sVT + dv * T_LD + s) = wv; } }
        __syncthreads();
#pragma unroll
        for (int i = 0; i < 2; ++i) { const int rowq = (tid >> 4) + 32 * i, cq = 8 * (tid & 15); *(LAS u32x4*)(sKR + rowq * 128 + cq) = pk[i]; if constexpr (FULL) *(LAS u32x4*)(sQR + rowq * 128 + cq) = pq[i]; }
        __syncthreads();
        if (cn + 1 < 8 * j + 8) prefetch(row0 + 64);
        { float off = 0.f, tot = 0.f;
#pragma unroll
          for (int s2 = 0; s2 < 4; ++s2) { const float v = sSEG[s2 * 128 + kk]; tot += v; off += (s2 < seg) ? v : 0.f; }
          const float dec = ex2(tot);
          if (seg == 0) { sDEC[kk] = dec; dsum += tot; }
          float ke[16];
#pragma unroll
          for (int i = 0; i < 16; ++i) { const int t = 16 * seg + i; const float bc = off + c[i]; const float eb = ex2(bc), ei = __builtin_amdgcn_rcpf(eb); const float kf = bf2f(sKR[t * 128 + kk]) * ei;
              ke[i] = kf * dec;
              if constexpr (FULL) { sQI[t * QK_LD + kk] = (bf16_t)(pk2(bf2f(sQR[t * 128 + kk]) * 0.08838834764831845f * eb, 0.f) & 0xffffu); sKI[t * QK_LD + kk] = (bf16_t)(pk2(kf, 0.f) & 0xffffu); } }
          { float a8[8], b8[8];
#pragma unroll
            for (int e = 0; e < 8; ++e) { a8[e] = ke[e]; b8[e] = ke[8 + e]; }
            *(LAS u32x4*)(sKET + kk * T_LD + 16 * seg) = pack8(a8); *(LAS u32x4*)(sKET + kk * T_LD + 16 * seg + 8) = pack8(b8); } }
        __syncthreads();
        if constexpr (FULL) {
#pragma unroll
            for (int u = 0; u < 2; ++u) { const int T = 2 * w + u, ti = T >> 2, si = T & 3; f32x4 cc = (f32x4){0.f, 0.f, 0.f, 0.f};
                if (si <= ti) {
#pragma unroll
                    for (int ks = 0; ks < 4; ++ks) { const bf16x8 a = *(const LAS bf16x8*)(sKI + (16 * si + (lane & 15)) * QK_LD + 32 * ks + 8 * q), bq = *(const LAS bf16x8*)(sQI + (16 * ti + (lane & 15)) * QK_LD + 32 * ks + 8 * q);
                        cc = MFMA16(a, bq, cc); } }
                const int t = 16 * ti + (lane & 15), s0 = 16 * si + 4 * q; float v[4];
#pragma unroll
                for (int reg = 0; reg < 4; ++reg) v[reg] = (s0 + reg <= t) ? cc[reg] : 0.f;
                u32x2 wv; wv.x = pk2(v[0], v[1]); wv.y = pk2(v[2], v[3]); *(LAS u32x2*)(sATT + t * T_LD + s0) = wv; }
            __syncthreads();
        }
        bf16x8 vf[4];
#pragma unroll
        for (int st = 0; st < 4; ++st) vf[st] = *(const LAS bf16x8*)(sVT + (32 * w + r32) * T_LD + 16 * st + 8 * h);
        f32x16 o[2];
        if constexpr (FULL) {
#pragma unroll
            for (int i = 0; i < 16; ++i) { o[0][i] = 0.f; o[1][i] = 0.f; }
#pragma unroll
            for (int kb = 0; kb < 4; ++kb)
#pragma unroll
                for (int s2 = 0; s2 < 2; ++s2) { const bf16x8 Bf = pack_step(S[kb], s2);
#pragma unroll
                    for (int tb = 0; tb < 2; ++tb) { const LAS bf16_t* qp = sQI + (32 * tb + r32) * QK_LD + 32 * kb + 16 * s2 + 4 * h; const u32x2 lo = *(const LAS u32x2*)qp, hi = *(const LAS u32x2*)(qp + 8);
                        const u32x4 af = (u32x4){lo.x, lo.y, hi.x, hi.y}; o[tb] = MFMA32(__builtin_bit_cast(bf16x8, af), Bf, o[tb]); }
                    __builtin_amdgcn_sched_barrier(0); }
#pragma unroll
            for (int tb = 0; tb < 2; ++tb)
#pragma unroll
                for (int st = 0; st < 4; ++st) { if (tb == 0 && st >= 2) continue; const bf16x8 af = *(const LAS bf16x8*)(sATT + (32 * tb + r32) * T_LD + 16 * st + 8 * h); o[tb] = MFMA32(af, vf[st], o[tb]); }
        }
#pragma unroll
        for (int kb = 0; kb < 4; ++kb) {
#pragma unroll
            for (int g4 = 0; g4 < 4; ++g4) { const f32x4 dd = *(const LAS f32x4*)(sDEC + 32 * kb + 8 * g4 + 4 * h);
#pragma unroll
                for (int e = 0; e < 4; ++e) S[kb][4 * g4 + e] *= dd[e]; }
#pragma unroll
            for (int st = 0; st < 4; ++st) { const bf16x8 af = *(const LAS bf16x8*)(sKET + (32 * kb + r32) * T_LD + 16 * st + 8 * h); S[kb] = MFMA32(af, vf[st], S[kb]); }
            __builtin_amdgcn_sched_barrier(0); }
        __syncthreads();
        if constexpr (FULL) {
#pragma unroll
            for (int tb = 0; tb < 2; ++tb)
#pragma unroll
                for (int i = 0; i < 16; ++i) sO[(32 * tb + crow(i, h)) * 256 + 32 * w + r32] = o[tb][i];
            __syncthreads();
            const f32x4 gn = *(const f32x4*)(F.in[I_GNG] + 4 * lane);
            u32x2 og[8];
            { const char* rb = Pb + row0 * (size_t)(PLD * 2); unsigned o4 = oog; asm volatile("" : "+v"(o4));
#pragma unroll
            for (int jj = 0; jj < 8; ++jj) og[jj] = *(const u32x2*)(rb + (o4 + (unsigned)(jj * PLD * 2))); }
#pragma unroll
            for (int jj = 0; jj < 8; ++jj) { const int t = 8 * w + jj; const f32x4 v = *(const LAS f32x4*)(sO + t * 256 + 4 * lane);
                const float rs = __builtin_amdgcn_rsqf(wave_sum((v[0] * v[0] + v[1] * v[1]) + (v[2] * v[2] + v[3] * v[3])) * (1.0f / 256.0f) + EPS);
                const float g0 = bf_lo(og[jj].x), g1 = bf_hi(og[jj].x), g2 = bf_lo(og[jj].y), g3 = bf_hi(og[jj].y);
                u32x2 wv; wv.x = pk2(v[0] * rs * gn[0] * silu_(g0), v[1] * rs * gn[1] * silu_(g1)); wv.y = pk2(v[2] * rs * gn[2] * silu_(g2), v[3] * rs * gn[3] * silu_(g3));
                *(u32x2*)(const_cast<char*>(Pb) + row0 * (size_t)(PLD * 2) + (oog + (unsigned)(jj * PLD * 2))) = wv; }
            __syncthreads();
        }
    }
    if constexpr (!FULL) {
        float* ag = gagg + (size_t)((b * 4 + hh) * 3 + j) * GAGG_FLOATS;
#pragma unroll
        for (int kb = 0; kb < 4; ++kb)
#pragma unroll
            for (int g4 = 0; g4 < 4; ++g4) *(f32x4*)(ag + ((size_t)((w * 4 + kb) * 4 + g4)) * 256 + 4 * lane) = (f32x4){S[kb][4 * g4], S[kb][4 * g4 + 1], S[kb][4 * g4 + 2], S[kb][4 * g4 + 3]};
        if (seg == 0) ag[32768 + kk] = ex2(dsum);
    } else if (j == 3) {
        float* sp = F.out + O_SP + (size_t)(b * 4 + hh) * 128 * 256;
#pragma unroll
        for (int kb = 0; kb < 4; ++kb)
#pragma unroll
            for (int i = 0; i < 16; ++i) sp[(size_t)(32 * kb + crow(i, h)) * 256 + 32 * w + r32] = S[kb][i];
    }
    __syncthreads();
}

__device__ __forceinline__ void gla_sample_item(const Frame& F, int item) {
    constexpr int SQ = 0, SK = 512, SE = 1024, RED = 2048;
    const int tid = F.tid, lane = F.lane, w = F.wave; const int hh = item & 3, s = item >> 2;
    LAS float* sq = (LAS float*)(F.lds + SQ); LAS float* sk = (LAS float*)(F.lds + SK); LAS float* se = (LAS float*)(F.lds + SE); LAS float* red = (LAS float*)(F.lds + RED);
    const bf16_t* Prow = F.P + (size_t)(MP + s) * PLD;
    if (tid < 128) { float x = F.in[I_BLR][hh * 128 + tid];
#pragma unroll
        for (int r = 0; r < 16; ++r) x = fmaf(bf2f(Prow[PC_LR + r]), F.in[I_WLR][r * 512 + hh * 128 + tid], x);
        se[tid] = __expf(-softplus_(-x) * (1.0f / 16.0f)); sq[tid] = bf2f(Prow[PC_Q + 128 * hh + tid]) * 0.08838834764831845f; sk[tid] = bf2f(Prow[PC_K + 128 * hh + tid]); }
    __syncthreads();
    const u32x2 vw = *(const u32x2*)(Prow + PC_V + 256 * hh + 4 * lane); const f32x4 v4 = (f32x4){bf_lo(vw.x), bf_hi(vw.x), bf_lo(vw.y), bf_hi(vw.y)};
    const float* S0 = F.in[I_SGLA] + ((size_t)(s * 4 + hh) * 128 + 16 * w) * 256 + 4 * lane; float* S1 = F.out + O_SS + ((size_t)(s * 4 + hh) * 128 + 16 * w) * 256 + 4 * lane;
    f32x4 o4 = (f32x4){0.f, 0.f, 0.f, 0.f};
    f32x4 sv[16];
#pragma unroll
    for (int jj = 0; jj < 16; ++jj) sv[jj] = __builtin_nontemporal_load((const f32x4*)(S0 + jj * 256));
#pragma unroll
    for (int jj = 0; jj < 16; ++jj) { const int k = 16 * w + jj; const f32x4 sn = sv[jj] * se[k] + v4 * sk[k]; __builtin_nontemporal_store(sn, (f32x4*)(S1 + jj * 256)); o4 = o4 + sn * sq[k]; }
    *(LAS f32x4*)(red + w * 256 + 4 * lane) = o4;
    __syncthreads();
    if (w == 0) { f32x4 o = (f32x4){0.f, 0.f, 0.f, 0.f};
#pragma unroll
        for (int ww = 0; ww < 8; ++ww) o = o + *(const LAS f32x4*)(red + ww * 256 + 4 * lane);
        const float rs = rsqrtf(wave_sum((o[0] * o[0] + o[1] * o[1]) + (o[2] * o[2] + o[3] * o[3])) * (1.0f / 256.0f) + EPS);
        const f32x4 gn = *(const f32x4*)(F.in[I_GNG] + 4 * lane); bf16_t* ogp = F.P + (size_t)(MP + s) * PLD + PC_OG + 256 * hh + 4 * lane; const u32x2 ogw = *(const u32x2*)ogp;
        u32x2 wv; wv.x = pk2(o[0] * rs * gn[0] * silu_(bf_lo(ogw.x)), o[1] * rs * gn[1] * silu_(bf_hi(ogw.x))); wv.y = pk2(o[2] * rs * gn[2] * silu_(bf_lo(ogw.y)), o[3] * rs * gn[3] * silu_(bf_hi(ogw.y)));
        *(u32x2*)ogp = wv; }
    __syncthreads();
}

template <int APROV>
__device__ __forceinline__ void skinny_piece(const Frame& F, const bf16_t* A, int lda, const bf16_t* Bt, int K, int k0, int nsub, int cb, const SlabMap om, int oslab) {
    constexpr int SA = 0, SB = 34816, LD = 136;
    const int tid = F.tid, lane = F.lane, w = F.wave, fr = lane & 15, fq = lane >> 4;
    LAS bf16_t* sA = (LAS bf16_t*)(F.lds + SA); LAS bf16_t* sB = (LAS bf16_t*)(F.lds + SB);
    f32x4 acc[8];
#pragma unroll
    for (int nb = 0; nb < 8; ++nb) acc[nb] = (f32x4){0.f, 0.f, 0.f, 0.f};
    for (int sub = 0; sub < nsub; ++sub) { const int kk0 = k0 + 128 * sub;
        __syncthreads();
#pragma unroll
        for (int i = 0; i < 4; ++i) { const int e = tid + NTHR * i, row = e >> 4, c16 = e & 15; u32x4 v;
            if constexpr (APROV == 0) v = *(const u32x4*)(A + (size_t)row * lda + kk0 + 8 * c16);
            else { const int cc = kk0 + 8 * c16; const bf16_t* gp = F.P + (size_t)(MP + row) * PLD + cc;
                float ga[8], gb[8], o[8]; unpack8(*(const u32x4*)(gp + PC_GA), ga); unpack8(*(const u32x4*)(gp + PC_GB), gb);
#pragma unroll
                for (int hf = 0; hf < 2; ++hf) { const f32x4 ya = *(const f32x4*)slab_at(F, SLAB_B, 0, row, cc + 4 * hf) + *(const f32x4*)slab_at(F, SLAB_B, 1, row, cc + 4 * hf), yb = *(const f32x4*)slab_at(F, SLAB_B, 2, row, cc + 4 * hf) + *(const f32x4*)slab_at(F, SLAB_B, 3, row, cc + 4 * hf);
#pragma unroll
                    for (int e2 = 0; e2 < 4; ++e2) o[4 * hf + e2] = sigm(ga[4 * hf + e2]) * ya[e2] + sigm(gb[4 * hf + e2]) * yb[e2]; }
                v = pack8(o); }
            *(LAS u32x4*)(sA + row * LD + 8 * c16) = v;
            *(LAS u32x4*)(sB + row * LD + 8 * c16) = *(const u32x4*)(Bt + (size_t)(128 * cb + row) * K + kk0 + 8 * c16); }
        __syncthreads();
        bf16x8 a[4];
#pragma unroll
        for (int s = 0; s < 4; ++s) a[s] = *(const LAS bf16x8*)(sA + (16 * w + fr) * LD + 32 * s + 8 * fq);
#pragma unroll
        for (int nb = 0; nb < 8; ++nb)
#pragma unroll
            for (int s = 0; s < 4; ++s) { const bf16x8 bb = *(const LAS bf16x8*)(sB + (16 * nb + fr) * LD + 32 * s + 8 * fq); acc[nb] = MFMA16(bb, a[s], acc[nb]); }
    }
#pragma unroll
    for (int nb = 0; nb < 8; ++nb) *(f32x4*)slab_at(F, om, oslab, 16 * w + fr, 128 * cb + 16 * nb + 4 * fq) = acc[nb];
    __syncthreads();
}
}
namespace mk {
constexpr int N_PHASES = 13;
__global__ void __launch_bounds__(NTHR, 2) mega_fwd(Args args) {
    extern __shared__ __attribute__((aligned(16))) unsigned char lds_raw[];
    Frame F;
    F.lds = (LAS unsigned char*)lds_raw;
    F.tid = threadIdx.x; F.lane = F.tid & 63; F.wave = __builtin_amdgcn_readfirstlane(F.tid >> 6);
    F.G = gridDim.x; { const int bx = blockIdx.x; F.vcu = (F.G % 8 == 0) ? (bx % 8) * (F.G / 8) + bx / 8 : bx; }
#pragma unroll
    for (int i = 0; i < 24; ++i) F.in[i] = args.in[i];
    F.out = args.out; F.ws = args.ws;
    F.P = (bf16_t*)(args.ws + WS_P);
    unsigned char* ssr = (unsigned char*)(args.out + O_SS);
    F.U = (bf16_t*)(ssr + SS_U); F.Win_t = (bf16_t*)(ssr + SS_WIN); F.Wgu1_t = (bf16_t*)(ssr + SS_WGU1); F.Wd1_t = (bf16_t*)(ssr + SS_WD1);
    F.Wrg_t = (bf16_t*)(args.ws + WS_WRG); F.Wbr_t = (bf16_t*)(args.ws + WS_WBR); F.Wbg_t = (bf16_t*)(args.ws + WS_WBG); F.Wout_t = (bf16_t*)(args.ws + WS_WOUT);
    F.Wgu2_t = (bf16_t*)(args.ws + WS_WGU2); F.Wd2_t = (bf16_t*)(args.ws + WS_WD2);
    volatile LAS unsigned* MISC = (volatile LAS unsigned*)(F.lds + MISC_OFF);
    for (int u = F.tid; u < 128; u += NTHR) MISC[u] = 0u;
    __syncthreads();
    const int lo = args.ph_lo, hi = args.ph_hi;
    XcdBarrier bar; bar.bar = (unsigned*)(args.ws + WS_CTL) + CW_BAR; bar.x = 0; bar.st = nullptr;
    if (hi - lo > 1) bar = xcd_barrier_post((unsigned*)(args.ws + WS_CTL) + CW_BAR, MISC + 8);
#define IN(k) (lo <= (k) && (k) < hi)
#ifdef TIME_PHASE
    unsigned long long tp0 = 0, tp1 = 0;
#ifdef TIME_WALL
#define SEAM(k) do { if (IN(k) && IN((k) + 1)) xcd_barrier(bar); if ((k) == TIME_PHASE) tp1 = __builtin_amdgcn_s_memrealtime(); if ((k) + 1 == TIME_PHASE) tp0 = __builtin_amdgcn_s_memrealtime(); } while (0)
#else
#define SEAM(k) do { if ((k) == TIME_PHASE) tp1 = __builtin_amdgcn_s_memrealtime(); if (IN(k) && IN((k) + 1)) xcd_barrier(bar); if ((k) + 1 == TIME_PHASE) tp0 = __builtin_amdgcn_s_memrealtime(); } while (0)
#endif
#else
#define SEAM(k) do { if (IN(k) && IN((k) + 1)) xcd_barrier(bar); } while (0)
#endif
    const int gw = F.vcu * NWAVES + F.wave, NGW = F.G * NWAVES;
    LAS float* scr = (LAS float*)(F.lds + F.wave * 16384);
    constexpr bool AL = true, SP = true;

    if (IN(0)) {
        prep_wgu(F, F.in[I_F1GU], F.Wgu1_t, scr, gw, NGW);
        prep_plain(F, F.in[I_F1D], FF, D, F.Wd1_t, scr, gw, NGW);
        prep_win(F, scr, gw, NGW);
        prep_rg(F, scr, gw, NGW);
        prep_plain(F, F.in[I_WBR], D, D, F.Wbr_t, scr, gw, NGW, 2 * D);
        prep_plain(F, F.in[I_WBG], D, D, F.Wbr_t + D, scr, gw, NGW, 2 * D);
        prep_plain(F, F.in[I_WOUT], D, D, F.Wout_t, scr, gw, NGW);
        rowphase0(F);
    }
    SEAM(0);
    if (IN(1)) {
        pg8::Gemm g{F.P + SC_XA, PLD, F.Wgu1_t, MPAD, 2 * FF, D}; pg8::StaticOrder S; S.init(MPAD, 2 * FF, F.G, (int)blockIdx.x);
        pg8::EpiSwiGLU E{F.P + SC_H, PLD};
        pg8::gemm_phase<pg8::EpiSwiGLU, pg8::StaticOrder, AL, SP>(F.lds, g, S, E);
    }
    SEAM(1);
    if (IN(2)) {
        if (F.vcu < 176) skinny_piece<0>(F, F.P + (size_t)MP * PLD + SC_H, PLD, F.Wd1_t, FF, 128 * (F.vcu >> 3), 1, F.vcu & 7, SLAB_D, F.vcu >> 3);
        pg8::Gemm g{F.P + SC_H, PLD, F.Wd1_t, MP, D, FF}; pg8::StaticOrder S; S.init(MP, D, F.G, (int)blockIdx.x);
        pg8::EpiBf16 E{F.P + SC_F, PLD};
        pg8::gemm_phase<pg8::EpiBf16, pg8::StaticOrder, AL, SP>(F.lds, g, S, E);
    }
    SEAM(2);
    if (IN(3)) rowphase1(F);
    SEAM(3);
    if (IN(4)) {
        pg8::Gemm g{F.U, D, F.Win_t, MPAD, PLD, D}; pg8::StaticOrder S; S.init(MPAD, PLD, F.G, (int)blockIdx.x);
        pg8::EpiBf16 E{F.P, PLD};
        pg8::gemm_phase<pg8::EpiBf16, pg8::StaticOrder, AL, SP>(F.lds, g, S, E);
    }
    SEAM(4);
    if (IN(5)) {
        const int c = F.vcu;
        if (c < 96) { gla_item<1>(F, (c / 3) * 4 + (c % 3)); rnn_item<false, 1>(F, (c / 7) * 8 + (c % 7)); }
        else {
            for (int i = c; i < 448; i += F.G - 96) rnn_item<false, 1>(F, (i / 7) * 8 + (i % 7));
            for (int i = c - 96; i < 2 * MS; i += F.G - 96) gla_sample_item(F, i);
        }
    }
    SEAM(5);
    if (IN(6)) {
        const int c = F.vcu;
        if (c < 128) { gla_item<3>(F, c); gla_sample_item(F, 2 * MS + c); }
        else {
            for (int i = c - 128; i < 512; i += F.G - 128) rnn_item<false, 3>(F, i);
            if (c < 136) rnn_item<true, 3>(F, c - 128);
            gla_sample_item(F, 3 * MS + c - 128);
        }
    }
    SEAM(6);
    if (IN(7)) {
        if (F.vcu < 32) { const int gsel = F.vcu >> 4, ks = (F.vcu >> 3) & 1, cb = F.vcu & 7;
            skinny_piece<0>(F, F.P + (size_t)MP * PLD + (gsel ? PC_OG : PC_YR), PLD, F.Wbr_t + (gsel ? D : 0), 2 * D, 512 * ks, 4, cb, SLAB_B, 2 * gsel + ks); }
        pg8::Gemm g{F.P + PC_YR, PLD, F.Wbr_t, MP, D, 2 * D}; pg8::StaticOrder S; S.init(MP, D, F.G, (int)blockIdx.x);
        pg8::EpiMerge E{F.P + PC_GA, F.P + PC_GB, PLD, F.P + SC_XA, PLD};
        pg8::gemm_phase<pg8::EpiMerge, pg8::StaticOrder, false, SP>(F.lds, g, S, E);
    }
    SEAM(7);
    if (IN(8)) {
        if (F.vcu < 64) skinny_piece<1>(F, nullptr, 0, F.Wout_t, D, 128 * (F.vcu >> 3), 1, F.vcu & 7, SLAB_B, 4 + (F.vcu >> 3));
        pg8::Gemm g{F.P + SC_XA, PLD, F.Wout_t, MP, D, D}; pg8::StaticOrder S; S.init(MP, D, F.G, (int)blockIdx.x);
        pg8::EpiBf16 E{F.P + SC_T, PLD};
        pg8::gemm_phase<pg8::EpiBf16, pg8::StaticOrder, AL, SP>(F.lds, g, S, E);
    }
    SEAM(8);
    if (IN(9)) {
        prep_wgu(F, F.in[I_F2GU], F.Wgu2_t, scr, gw, NGW);
        prep_plain(F, F.in[I_F2D], FF, D, F.Wd2_t, scr, gw, NGW);
        rowphase2(F);
    }
    SEAM(9);
    if (IN(10)) {
        pg8::Gemm g{F.P + SC_XA, PLD, F.Wgu2_t, MPAD, 2 * FF, D}; pg8::StaticOrder S; S.init(MPAD, 2 * FF, F.G, (int)blockIdx.x);
        pg8::EpiSwiGLU E{F.P + SC_H, PLD};
        pg8::gemm_phase<pg8::EpiSwiGLU, pg8::StaticOrder, AL, SP>(F.lds, g, S, E);
    }
    SEAM(10);
    if (IN(11)) {
        if (F.vcu < 176) skinny_piece<0>(F, F.P + (size_t)MP * PLD + SC_H, PLD, F.Wd2_t, FF, 128 * (F.vcu >> 3), 1, F.vcu & 7, SLAB_D, F.vcu >> 3);
        pg8::Gemm g{F.P + SC_H, PLD, F.Wd2_t, MP, D, FF}; pg8::StaticOrder S; S.init(MP, D, F.G, (int)blockIdx.x);
        pg8::EpiBf16 E{F.P + SC_F, PLD};
        pg8::gemm_phase<pg8::EpiBf16, pg8::StaticOrder, AL, SP>(F.lds, g, S, E);
    }
    SEAM(11);
    if (IN(12)) rowphase3(F);
#ifdef TIME_PHASE
    if (F.vcu == TIME_VCU) { const unsigned long long te = __builtin_amdgcn_s_memrealtime(), wait = (unsigned long long)(TIME_MULT) * (tp1 - tp0); while (__builtin_amdgcn_s_memrealtime() - te < wait) __builtin_amdgcn_s_sleep(8); }
#endif
#undef IN
#undef SEAM
}

inline int launch(void* const* d_in, void* d_out, void* d_ws, hipStream_t stream, int n_launches, int ph_lo = 0, int ph_hi = 0) {
    static int grid = 0;
    if (grid == 0) {
        int dev = 0, cus = 0, per_cu = 0;
        if (hipGetDevice(&dev) != hipSuccess || hipDeviceGetAttribute(&cus, hipDeviceAttributeMultiprocessorCount, dev) != hipSuccess) { grid = -1; return -1; }
        if (hipFuncSetAttribute((const void*)mega_fwd, hipFuncAttributeMaxDynamicSharedMemorySize, LDS_BYTES) != hipSuccess) { grid = -1; return -1; }
        if (hipOccupancyMaxActiveBlocksPerMultiprocessor(&per_cu, (const void*)mega_fwd, NTHR, LDS_BYTES) != hipSuccess || per_cu < 1) per_cu = 1;
        (void)hipGetLastError();
        grid = cus;
    }
    if (grid < 0) return -1;
    Args a{};
    for (int i = 0; i < 24; ++i) a.in[i] = (const float*)d_in[i];
    a.out = (float*)d_out; a.ws = (unsigned char*)d_ws;
    if (n_launches == 0) { a.ph_lo = ph_lo; a.ph_hi = ph_hi; hipLaunchKernelGGL(mega_fwd, dim3(grid), dim3(NTHR), LDS_BYTES, stream, a); return 0; }
    (void)hipMemsetAsync((char*)d_ws + WS_CTL, 0, CTL_ZERO_BYTES, stream);
    if (n_launches == 1) { a.ph_lo = 0; a.ph_hi = N_PHASES; hipLaunchKernelGGL(mega_fwd, dim3(grid), dim3(NTHR), LDS_BYTES, stream, a); }
    else for (int p = 0; p < N_PHASES; ++p) { a.ph_lo = p; a.ph_hi = p + 1; hipLaunchKernelGGL(mega_fwd, dim3(grid), dim3(NTHR), LDS_BYTES, stream, a); }
    return 0;
}
}
#ifndef MK_NL
#define MK_NL 1
#endif
extern "C" void kernel_launch(void* const* d_in, const int* in_sizes, int n_in,
                              void* d_out, int out_size, void* d_ws, size_t ws_size,
                              hipStream_t stream) {
    mk::launch(d_in, d_out, d_ws, stream, MK_NL);
}
```

```cpp
#include <hip/hip_runtime.h>
#include <cstdio>
#include <cstdint>

#ifndef DBG_STATIC_FLOATS
#define DBG_STATIC_FLOATS 16
#endif
__device__ float g_static[DBG_STATIC_FLOATS];
#define STATIC_TAG (1ull << 62)
template <class T> __device__ __forceinline__ T* fx(T* p) { const unsigned long long v = (unsigned long long)p; return (v & STATIC_TAG) ? (T*)((char*)g_static + (v & (STATIC_TAG - 1))) : p; }
inline float* static_ptr(size_t float_off) { return (float*)(STATIC_TAG | (unsigned long long)(float_off * 4)); }
namespace nv {
constexpr int D = 1024, FF = 2816, DIN = 7184, TSEQ = 2048, NB = 8, NS = 128;
constexpr int C_XR = 0, C_YR = 1024, C_Q = 2048, C_K = 2560, C_V = 3072, C_OG = 4096, C_LR = 5120, C_GA = 5136, C_GB = 6160;
constexpr float EPS = 1e-6f;
constexpr size_t O_YP = 0, O_YS = 16777216, O_HP = 16908288, O_CP = 16916480, O_SP = 16941056, O_HS = 17989632, O_CS = 18120704, O_SS = 18513920;

__device__ __forceinline__ float sigmoidf_(float x) { return 1.f / (1.f + expf(-x)); }
__device__ __forceinline__ float siluf_(float x) { return x / (1.f + expf(-x)); }
__device__ __forceinline__ float softplusf_(float x) { return fmaxf(x, 0.f) + log1pf(expf(-fabsf(x))); }
__device__ __forceinline__ float logsigmoidf_(float x) { return -softplusf_(-x); }
__device__ __forceinline__ float gelu_tanhf_(float x) { const float c = 0.7978845608028654f; return 0.5f * x * (1.f + tanhf(c * (x + 0.044715f * x * x * x))); }

__device__ __forceinline__ float block_sum256(float v, float* red) {
#pragma unroll
    for (int o = 32; o > 0; o >>= 1) v += __shfl_xor(v, o);
    __syncthreads();
    if ((threadIdx.x & 63) == 0) red[threadIdx.x >> 6] = v;
    __syncthreads();
    return red[0] + red[1] + red[2] + red[3];
}
__global__ void k_rmsnorm(const float* x, const float* g, float* y) { x = fx(x); g = fx(g); y = fx(y);
    __shared__ float red[4];
    const size_t r = blockIdx.x; const float* xr = x + r * D; float v[4]; float s = 0.f;
#pragma unroll
    for (int j = 0; j < 4; ++j) { v[j] = xr[threadIdx.x + 256 * j]; s += v[j] * v[j]; }
    const float tot = block_sum256(s, red); const float rs = rsqrtf(tot / D + EPS);
#pragma unroll
    for (int j = 0; j < 4; ++j) y[r * D + threadIdx.x + 256 * j] = v[j] * rs * g[threadIdx.x + 256 * j];
}
__global__ void k_resnorm(const float* base, const float* f, const float* g, float scale, float* out) { base = fx(base); f = fx(f); g = fx(g); out = fx(out);
    __shared__ float red[4];
    const size_t r = blockIdx.x; const float* fr = f + r * D; float v[4]; float s = 0.f;
#pragma unroll
    for (int j = 0; j < 4; ++j) { v[j] = fr[threadIdx.x + 256 * j]; s += v[j] * v[j]; }
    const float tot = block_sum256(s, red); const float rs = rsqrtf(tot / D + EPS);
#pragma unroll
    for (int j = 0; j < 4; ++j) { const int c = threadIdx.x + 256 * j; out[r * D + c] = base[r * D + c] + scale * (v[j] * rs * g[c]); }
}
__global__ void __launch_bounds__(256) k_gemm(const float* A, int lda, const float* B, int ldb, float* C, int ldc, int M, int N, int K, size_t sA, size_t sB, size_t sC) { A = fx(A); B = fx(B); C = fx(C);
    __shared__ float As[16][64 + 1], Bs[16][64 + 1];
    A += blockIdx.z * sA; B += blockIdx.z * sB; C += blockIdx.z * sC;
    const int m0 = blockIdx.y * 64, n0 = blockIdx.x * 64, tx = threadIdx.x & 15, ty = threadIdx.x >> 4;
    float acc[4][4];
#pragma unroll
    for (int i = 0; i < 4; ++i)
#pragma unroll
        for (int j = 0; j < 4; ++j) acc[i][j] = 0.f;
    for (int k0 = 0; k0 < K; k0 += 16) {
#pragma unroll
        for (int i = 0; i < 4; ++i) { const int e = threadIdx.x + 256 * i; const int m = e >> 4, k = e & 15; As[k][m] = A[(size_t)(m0 + m) * lda + k0 + k]; }
#pragma unroll
        for (int i = 0; i < 4; ++i) { const int e = threadIdx.x + 256 * i; const int k = e >> 6, n = e & 63; Bs[k][n] = (n0 + n < N) ? B[(size_t)(k0 + k) * ldb + n0 + n] : 0.f; }
        __syncthreads();
#pragma unroll
        for (int k = 0; k < 16; ++k) { float a[4], b[4];
#pragma unroll
            for (int i = 0; i < 4; ++i) { a[i] = As[k][ty * 4 + i]; b[i] = Bs[k][tx * 4 + i]; }
#pragma unroll
            for (int i = 0; i < 4; ++i)
#pragma unroll
                for (int j = 0; j < 4; ++j) acc[i][j] = fmaf(a[i], b[j], acc[i][j]); }
        __syncthreads();
    }
#pragma unroll
    for (int i = 0; i < 4; ++i)
#pragma unroll
        for (int j = 0; j < 4; ++j) { const int n = n0 + tx * 4 + j; if (n < N) C[(size_t)(m0 + ty * 4 + i) * ldc + n] = acc[i][j]; }
}
__global__ void k_swiglu(const float* gu, float* h, size_t n) { gu = fx(gu); h = fx(h);
    for (size_t i = blockIdx.x * (size_t)blockDim.x + threadIdx.x; i < n; i += (size_t)gridDim.x * blockDim.x) { const size_t r = i / FF, j = i % FF; h[i] = siluf_(gu[r * (2 * FF) + j]) * gu[r * (2 * FF) + FF + j]; }
}
__global__ void k_conv(const float* P, const float* buf, const float* w, const float* b, float* xc, float* conv_new, int T, int nseq) { P = fx(P); buf = fx(buf); w = fx(w); b = fx(b); xc = fx(xc); conv_new = fx(conv_new);
    const size_t n = (size_t)nseq * T * D;
    for (size_t i = blockIdx.x * (size_t)blockDim.x + threadIdx.x; i < n; i += (size_t)gridDim.x * blockDim.x) {
        const int c = (int)(i % D); const size_t row = i / D; const int t = (int)(row % T); const int seq = (int)(row / T);
        float y = b[c];
#pragma unroll
        for (int j = 0; j < 4; ++j) { const int idx = t + j - 3; float xv;
            if (idx >= 0) xv = P[((size_t)seq * T + idx) * DIN + C_XR + c]; else xv = buf ? buf[((size_t)seq * 3 + (3 + idx)) * D + c] : 0.f;
            y += xv * w[j * D + c]; }
        xc[i] = y;
    }
    const size_t n2 = (size_t)nseq * 3 * D;
    for (size_t i = blockIdx.x * (size_t)blockDim.x + threadIdx.x; i < n2; i += (size_t)gridDim.x * blockDim.x) {
        const int c = (int)(i % D); const int j = (int)((i / D) % 3); const int seq = (int)(i / (3 * D));
        const int xi = T + j;
        float v; if (xi >= 3) v = P[((size_t)seq * T + (xi - 3)) * DIN + C_XR + c]; else v = buf ? buf[((size_t)seq * 3 + xi) * D + c] : 0.f;
        conv_new[i] = v;
    }
}
__global__ void k_rg_elem(const float* xc, const float* RA, const float* RX, const float* b_a, const float* b_x, const float* lam, float* a_out, float* bb_out, int T, int nseq, int reset) { xc = fx(xc); RA = fx(RA); RX = fx(RX); b_a = fx(b_a); b_x = fx(b_x); lam = fx(lam); a_out = fx(a_out); bb_out = fx(bb_out);
    const size_t n = (size_t)nseq * T * D;
    for (size_t i = blockIdx.x * (size_t)blockDim.x + threadIdx.x; i < n; i += (size_t)gridDim.x * blockDim.x) {
        const int c = (int)(i % D); const int t = (int)((i / D) % T);
        const float r = sigmoidf_(RA[i] + b_a[c]), ig = sigmoidf_(RX[i] + b_x[c]);
        const float log_a = -8.0f * r * softplusf_(-lam[c]); const float a = expf(log_a);
        float mult = sqrtf(fmaxf(-expm1f(2.0f * log_a), 0.f)); if (reset && t == 0) mult = 1.0f;
        a_out[i] = a; bb_out[i] = mult * ig * xc[i];
    }
}
__global__ void k_scan(const float* a, const float* bb, const float* h0, float* h, float* h_last, int T, int nseq) { a = fx(a); bb = fx(bb); h0 = fx(h0); h = fx(h); h_last = fx(h_last);
    const int i = blockIdx.x * blockDim.x + threadIdx.x; if (i >= nseq * D) return;
    const int c = i % D, seq = i / D; float hv = h0 ? h0[(size_t)seq * D + c] : 0.f;
    for (int t = 0; t < T; ++t) { const size_t o = ((size_t)seq * T + t) * D + c; hv = a[o] * hv + bb[o]; h[o] = hv; }
    h_last[(size_t)seq * D + c] = hv;
}
__global__ void k_gate_rnn(const float* h, const float* P, float* o, size_t n) { h = fx(h); P = fx(P); o = fx(o);
    for (size_t i = blockIdx.x * (size_t)blockDim.x + threadIdx.x; i < n; i += (size_t)gridDim.x * blockDim.x) { const size_t r = i / D; const int c = (int)(i % D); o[i] = h[i] * gelu_tanhf_(P[r * DIN + C_YR + c]); }
}
__global__ void __launch_bounds__(256) k_gla(const float* P, const float* G, const float* blr, const float* S0, float* O, float* S_out, int T) { P = fx(P); G = fx(G); blr = fx(blr); S0 = fx(S0); O = fx(O); S_out = fx(S_out);
    extern __shared__ float S[];
    __shared__ float sq[128], sk[128], se[128];
    const int head = blockIdx.x & 3, seq = blockIdx.x >> 2, dv = threadIdx.x;
    for (int kk = 0; kk < 128; ++kk) S[kk * 256 + dv] = S0 ? S0[(((size_t)seq * 4 + head) * 128 + kk) * 256 + dv] : 0.f;
    for (int t = 0; t < T; ++t) {
        const size_t row = (size_t)seq * T + t;
        __syncthreads();
        if (dv < 128) { sq[dv] = P[row * DIN + C_Q + head * 128 + dv] * 0.08838834764831845f; sk[dv] = P[row * DIN + C_K + head * 128 + dv];
            se[dv] = expf(logsigmoidf_(G[row * 512 + head * 128 + dv] + blr[head * 128 + dv]) * (1.0f / 16.0f)); }
        __syncthreads();
        const float v = P[row * DIN + C_V + head * 256 + dv]; float o = 0.f;
        for (int kk = 0; kk < 128; ++kk) { const float s = S[kk * 256 + dv] * se[kk] + sk[kk] * v; S[kk * 256 + dv] = s; o = fmaf(sq[kk], s, o); }
        O[row * D + head * 256 + dv] = o;
    }
    for (int kk = 0; kk < 128; ++kk) S_out[(((size_t)seq * 4 + head) * 128 + kk) * 256 + dv] = S[kk * 256 + dv];
}
__global__ void k_gla_out(const float* O, const float* P, const float* gn, float* og_out) { O = fx(O); P = fx(P); gn = fx(gn); og_out = fx(og_out);
    __shared__ float red[4];
    const int head = blockIdx.x & 3; const size_t row = blockIdx.x >> 2; const int dv = threadIdx.x;
    const float o = O[row * D + head * 256 + dv]; const float tot = block_sum256(o * o, red); const float rs = rsqrtf(tot / 256.f + EPS);
    og_out[row * D + head * 256 + dv] = o * rs * gn[dv] * siluf_(P[row * DIN + C_OG + head * 256 + dv]);
}
__global__ void k_merge(const float* P, const float* YA, const float* YB, float* m, size_t n) { P = fx(P); YA = fx(YA); YB = fx(YB); m = fx(m);
    for (size_t i = blockIdx.x * (size_t)blockDim.x + threadIdx.x; i < n; i += (size_t)gridDim.x * blockDim.x) { const size_t r = i / D; const int c = (int)(i % D);
        m[i] = sigmoidf_(P[r * DIN + C_GA + c]) * YA[i] + sigmoidf_(P[r * DIN + C_GB + c]) * YB[i]; }
}
struct In { const float *xp, *xs, *srh, *src, *sgla, *ng, *f1gu, *f1d, *win, *cw, *cb, *rwa, *rba, *rwx, *rbx, *lam, *wlr, *blr, *gng, *wbr, *wbg, *wout, *f2gu, *f2d; };
inline In make_in(void* const* d) { In I; const float** p = (const float**)&I; for (int i = 0; i < 24; ++i) p[i] = (const float*)d[i]; return I; }
inline void gemm(hipStream_t st, const float* A, int lda, const float* B, int ldb, float* C, int ldc, int M, int N, int K, int nz = 1, size_t sA = 0, size_t sB = 0, size_t sC = 0) {
    hipLaunchKernelGGL(k_gemm, dim3((N + 63) / 64, M / 64, nz), dim3(256), 0, st, A, lda, B, ldb, C, ldc, M, N, K, sA, sB, sC);
}
struct Outs { float *y, *h_last, *conv_new, *s_new; };
struct Bufs { float *T0, *T1, *T2, *T3, *T4, *T5, *T6, *T7, *T8, *T9, *GU, *HH, *P, *G; };
inline Bufs make_bufs(float* ws, int R) { Bufs B; const size_t RD = (size_t)R * D; B.T0 = ws; B.T1 = B.T0 + RD; B.T2 = B.T1 + RD; B.T3 = B.T2 + RD; B.T4 = B.T3 + RD; B.T5 = B.T4 + RD; B.T6 = B.T5 + RD; B.T7 = B.T6 + RD; B.T8 = B.T7 + RD; B.T9 = B.T8 + RD;
    B.GU = B.T9 + RD; B.HH = B.GU + (size_t)R * 2 * FF; B.P = B.HH + (size_t)R * FF; B.G = B.P + (size_t)R * DIN; return B; }
inline Outs std_outs(float* out, int grp) { Outs o; const bool smp = (grp == NB);
    o.y = smp ? out + O_YS : out + O_YP + (size_t)grp * TSEQ * D; o.h_last = smp ? out + O_HS : out + O_HP + (size_t)grp * D;
    o.conv_new = smp ? out + O_CS : out + O_CP + (size_t)grp * 3 * D; o.s_new = smp ? out + O_SS : out + O_SP + (size_t)grp * 4 * 128 * 256; return o; }
inline void run_group(hipStream_t st, const In& I, const Outs& O, float* ws, int grp, int s_lo = 0, int s_hi = 12) {
    const bool smp = (grp == NB); const int T = smp ? 1 : TSEQ, nseq = smp ? NS : 1, R = T * nseq;
    const float* x = smp ? I.xs : I.xp + (size_t)grp * TSEQ * D;
    const Bufs B = make_bufs(ws, R);
    float *T0 = B.T0, *T1 = B.T1, *T2 = B.T2, *T3 = B.T3, *T4 = B.T4, *T5 = B.T5, *T6 = B.T6, *T7 = B.T7, *T8 = B.T8, *T9 = B.T9, *GU = B.GU, *HH = B.HH, *P = B.P, *G = B.G;
    const float* ng = I.ng; const size_t n1 = (size_t)R * D; const int EB = 1024;
#define STG(k) if (s_lo <= (k) && (k) < s_hi)
    STG(0) hipLaunchKernelGGL(k_rmsnorm, dim3(R), dim3(256), 0, st, x, ng + 0 * D, T0);
    STG(1) { gemm(st, T0, D, I.f1gu, 2 * FF, GU, 2 * FF, R, 2 * FF, D);
        hipLaunchKernelGGL(k_swiglu, dim3(EB), dim3(256), 0, st, GU, HH, (size_t)R * FF); }
    STG(2) gemm(st, HH, FF, I.f1d, D, T1, D, R, D, FF);
    STG(3) { hipLaunchKernelGGL(k_resnorm, dim3(R), dim3(256), 0, st, x, T1, ng + 1 * D, 0.5f, T2);
        hipLaunchKernelGGL(k_rmsnorm, dim3(R), dim3(256), 0, st, T2, ng + 2 * D, T3); }
    STG(4) gemm(st, T3, D, I.win, DIN, P, DIN, R, DIN, D);
    STG(5) { hipLaunchKernelGGL(k_conv, dim3(EB), dim3(256), 0, st, P, smp ? I.src : nullptr, I.cw, I.cb, T4, O.conv_new, T, nseq);
        gemm(st, T4, D, I.rwa, 128, T5, D, R, 128, 128, 8, 128, 128 * 128, 128);
        gemm(st, T4, D, I.rwx, 128, T6, D, R, 128, 128, 8, 128, 128 * 128, 128);
        hipLaunchKernelGGL(k_rg_elem, dim3(EB), dim3(256), 0, st, T4, T5, T6, I.rba, I.rbx, I.lam, T7, T8, T, nseq, smp ? 0 : 1);
        hipLaunchKernelGGL(k_scan, dim3((nseq * D + 255) / 256), dim3(256), 0, st, T7, T8, smp ? I.srh : nullptr, T9, O.h_last, T, nseq);
        hipLaunchKernelGGL(k_gate_rnn, dim3(EB), dim3(256), 0, st, T9, P, T3, n1);
        gemm(st, P + C_LR, DIN, I.wlr, 512, G, 512, R, 512, 16);
        hipLaunchKernelGGL(k_gla, dim3(nseq * 4), dim3(256), 128 * 256 * 4, st, P, G, I.blr, smp ? I.sgla : nullptr, T7, O.s_new, T);
        hipLaunchKernelGGL(k_gla_out, dim3(R * 4), dim3(256), 0, st, T7, P, I.gng, T8); }
    STG(6) { gemm(st, T3, D, I.wbr, D, T5, D, R, D, D);
        gemm(st, T8, D, I.wbg, D, T6, D, R, D, D);
        hipLaunchKernelGGL(k_merge, dim3(EB), dim3(256), 0, st, P, T5, T6, T9, n1); }
    STG(7) gemm(st, T9, D, I.wout, D, T1, D, R, D, D);
    STG(8) { hipLaunchKernelGGL(k_resnorm, dim3(R), dim3(256), 0, st, T2, T1, ng + 3 * D, 1.0f, T2);
        hipLaunchKernelGGL(k_rmsnorm, dim3(R), dim3(256), 0, st, T2, ng + 4 * D, T0); }
    STG(9) { gemm(st, T0, D, I.f2gu, 2 * FF, GU, 2 * FF, R, 2 * FF, D);
        hipLaunchKernelGGL(k_swiglu, dim3(EB), dim3(256), 0, st, GU, HH, (size_t)R * FF); }
    STG(10) gemm(st, HH, FF, I.f2d, D, T1, D, R, D, FF);
    STG(11) hipLaunchKernelGGL(k_resnorm, dim3(R), dim3(256), 0, st, T2, T1, ng + 5 * D, 0.5f, O.y);
#undef STG
}
}
namespace pg8 {
#define PG8_LAS __attribute__((address_space(3)))
typedef unsigned short bf16_t;
typedef short bf16x8 __attribute__((ext_vector_type(8)));
typedef float f32x4 __attribute__((ext_vector_type(4)));
typedef float f32x2 __attribute__((ext_vector_type(2)));
typedef unsigned u32x4 __attribute__((ext_vector_type(4)));
typedef unsigned u32x2 __attribute__((ext_vector_type(2)));
constexpr int BM = 256, BK = 64, HALF = 128, HTB = HALF * BK * 2, STAGE_BYTES = 8 * HTB, NXCD = 8, WGM = 8;

__host__ __device__ __forceinline__ int lds_byte(int r, int c) { const int st = (r >> 4) * 2 + (c >> 5), rr = r & 15, cc = c & 31, ob = rr * 64 + cc * 2; return st * 1024 + (ob ^ (((ob >> 9) & 1) << 5)); }
__host__ __device__ __forceinline__ void stage_rc(int b, int& R, int& C) { const int st = b / 1024, sb = b % 1024, swz = sb ^ (((sb >> 9) & 1) << 5); R = (st >> 1) * 16 + swz / 64; C = (st & 1) * 32 + (swz % 64) / 2; }
__host__ __device__ __forceinline__ int perm32(int rho) { const int n = rho >> 4, i = rho & 15; return 8 * (i >> 2) + 4 * n + (i & 3); }

struct Unit { int pm, pn; };
struct Gemm { const bf16_t* A; int lda; const bf16_t* Bt; int M, N, K; };

struct StaticOrder {
    int nM, nN, nwg, G, c;
    __host__ __device__ void init(int M, int N, int G_, int c_) { nM = M / BM; nN = N / BM; nwg = nM * nN; G = G_; c = c_; }
    __host__ __device__ bool next(int i, Unit& u) const {
        const long L = (long)i * G + c; if (L >= nwg) return false;
        int wgid = (int)L; { const int q = nwg / NXCD, r = nwg % NXCD, xcd = wgid % NXCD, off = wgid / NXCD; wgid = (xcd < r ? xcd * (q + 1) : r * (q + 1) + (xcd - r) * q) + off; }
        const int nig = WGM * nN, gid = wgid / nig, fm = gid * WGM, gsz = (nM - fm) < WGM ? (nM - fm) : WGM;
        u.pm = fm + ((wgid % nig) % gsz); u.pn = (wgid % nig) / gsz; return true;
    }
    __device__ __forceinline__ void a_ready(const Unit&) const {}
    __device__ __forceinline__ void done(const Unit&) const {}
};

__device__ __forceinline__ unsigned f2bf(float f) { unsigned u = __builtin_bit_cast(unsigned, f); return (u + 0x7fffu + ((u >> 16) & 1u)) >> 16; }
typedef __bf16 hwbf16x2 __attribute__((ext_vector_type(2)));
__device__ __forceinline__ unsigned pk2(float lo, float hi) { const f32x2 v = {lo, hi}; return __builtin_bit_cast(unsigned, __builtin_convertvector(v, hwbf16x2)); }
__device__ __forceinline__ float bf_lo(unsigned w) { return __builtin_bit_cast(float, w << 16); }
__device__ __forceinline__ float bf_hi(unsigned w) { return __builtin_bit_cast(float, w & 0xffff0000u); }
__device__ __forceinline__ float fast_sigmoid(float x) { return __builtin_amdgcn_rcpf(1.0f + __builtin_amdgcn_exp2f(-1.4426950408889634f * x)); }

struct EpiF32 {
    static constexpr bool PERM = false, AFTER_DRAIN = false;
    float* C; int ldc;
    __device__ __forceinline__ void operator()(const f32x4 (&acc)[2][2][4][2], const Unit& u, int wr, int wc, int fr, int fq) const {
        const int row0 = u.pm * BM + wr * 64 + fr, col0 = u.pn * BM + wc * 32 + 4 * fq;
#pragma unroll
        for (int ai = 0; ai < 2; ++ai)
#pragma unroll
            for (int m = 0; m < 4; ++m) { float* rowp = C + (size_t)(row0 + ai * HALF + m * 16) * ldc + col0;
#pragma unroll
                for (int bj = 0; bj < 2; ++bj)
#pragma unroll
                    for (int n = 0; n < 2; ++n) *(f32x4*)(rowp + bj * HALF + n * 16) = acc[ai][bj][m][n]; }
    }
};
struct EpiBf16 {
    static constexpr bool PERM = true, AFTER_DRAIN = false;
    bf16_t* O; int ldc;
    __device__ __forceinline__ void operator()(const f32x4 (&acc)[2][2][4][2], const Unit& u, int wr, int wc, int fr, int fq) const {
        const int row0 = u.pm * BM + wr * 64 + fr, col0 = u.pn * BM + wc * 32 + 8 * fq;
#pragma unroll
        for (int ai = 0; ai < 2; ++ai)
#pragma unroll
            for (int m = 0; m < 4; ++m) { bf16_t* rowp = O + (size_t)(row0 + ai * HALF + m * 16) * ldc + col0;
#pragma unroll
                for (int bj = 0; bj < 2; ++bj) { const f32x4 v0 = acc[ai][bj][m][0], v1 = acc[ai][bj][m][1];
                    u32x4 w; w.x = pk2(v0[0], v0[1]); w.y = pk2(v0[2], v0[3]); w.z = pk2(v1[0], v1[1]); w.w = pk2(v1[2], v1[3]);
                    *(u32x4*)(rowp + bj * HALF) = w; } }
    }
};
struct EpiSwiGLU {
    static constexpr bool PERM = true, AFTER_DRAIN = false;
    bf16_t* O; int ldc;
    __device__ __forceinline__ void operator()(const f32x4 (&acc)[2][2][4][2], const Unit& u, int wr, int wc, int fr, int fq) const {
        const int row0 = u.pm * BM + wr * 64 + fr, col0 = u.pn * HALF + wc * 32 + 8 * fq;
#pragma unroll
        for (int ai = 0; ai < 2; ++ai)
#pragma unroll
            for (int m = 0; m < 4; ++m) { bf16_t* rowp = O + (size_t)(row0 + ai * HALF + m * 16) * ldc + col0;
                float h[8];
#pragma unroll
                for (int n = 0; n < 2; ++n)
#pragma unroll
                    for (int e = 0; e < 4; ++e) { const float g = acc[ai][0][m][n][e], up = acc[ai][1][m][n][e]; h[4 * n + e] = g * fast_sigmoid(g) * up; }
                u32x4 w; w.x = pk2(h[0], h[1]); w.y = pk2(h[2], h[3]); w.z = pk2(h[4], h[5]); w.w = pk2(h[6], h[7]);
                *(u32x4*)rowp = w; }
    }
};
struct EpiMerge {
    static constexpr bool PERM = true, AFTER_DRAIN = false, MID = true;
    const bf16_t* GA; const bf16_t* GB; int ldg; bf16_t* O; int ldc;
    __device__ __forceinline__ void mid(f32x4 (&acc)[2][2][4][2], const Unit& u, int wr, int wc, int fr, int fq) const {
        int row0 = u.pm * BM + wr * 64 + fr; const int col0 = u.pn * BM + wc * 32 + 8 * fq;
        asm volatile("" : "+v"(row0));
#pragma unroll
        for (int ai = 0; ai < 2; ++ai)
#pragma unroll
            for (int m = 0; m < 4; ++m) { const size_t row = (size_t)(row0 + ai * HALF + m * 16);
#pragma unroll
                for (int bj = 0; bj < 2; ++bj) { const u32x4 a = *(const u32x4*)(GA + row * ldg + col0 + bj * HALF), b = *(const u32x4*)(GB + row * ldg + col0 + bj * HALF);
#define PG8_RT(x, y) (fast_sigmoid(x) * (1.0f + __builtin_amdgcn_exp2f(-1.4426950408889634f * (y))))
                    f32x4 r0, r1; r0[0] = PG8_RT(bf_lo(a.x), bf_lo(b.x)); r0[1] = PG8_RT(bf_hi(a.x), bf_hi(b.x)); r0[2] = PG8_RT(bf_lo(a.y), bf_lo(b.y)); r0[3] = PG8_RT(bf_hi(a.y), bf_hi(b.y));
                    r1[0] = PG8_RT(bf_lo(a.z), bf_lo(b.z)); r1[1] = PG8_RT(bf_hi(a.z), bf_hi(b.z)); r1[2] = PG8_RT(bf_lo(a.w), bf_lo(b.w)); r1[3] = PG8_RT(bf_hi(a.w), bf_hi(b.w));
#undef PG8_RT
                    acc[ai][bj][m][0] = acc[ai][bj][m][0] * r0; acc[ai][bj][m][1] = acc[ai][bj][m][1] * r1; }
                if (m & 1) asm volatile("" ::: "memory"); }
    }
    __device__ __forceinline__ void operator()(const f32x4 (&acc)[2][2][4][2], const Unit& u, int wr, int wc, int fr, int fq) const {
        int row0 = u.pm * BM + wr * 64 + fr; const int col0 = u.pn * BM + wc * 32 + 8 * fq;
        asm volatile("" : "+v"(row0));
#pragma unroll
        for (int ai = 0; ai < 2; ++ai)
#pragma unroll
            for (int m = 0; m < 4; ++m) { const size_t row = (size_t)(row0 + ai * HALF + m * 16);
#pragma unroll
                for (int bj = 0; bj < 2; ++bj) { const u32x4 g = *(const u32x4*)(GB + row * ldg + col0 + bj * HALF); const f32x4 v0 = acc[ai][bj][m][0], v1 = acc[ai][bj][m][1];
                    u32x4 w; w.x = pk2(fast_sigmoid(bf_lo(g.x)) * v0[0], fast_sigmoid(bf_hi(g.x)) * v0[1]); w.y = pk2(fast_sigmoid(bf_lo(g.y)) * v0[2], fast_sigmoid(bf_hi(g.y)) * v0[3]);
                    w.z = pk2(fast_sigmoid(bf_lo(g.z)) * v1[0], fast_sigmoid(bf_hi(g.z)) * v1[1]); w.w = pk2(fast_sigmoid(bf_lo(g.w)) * v1[2], fast_sigmoid(bf_hi(g.w)) * v1[3]);
                    *(u32x4*)(O + row * ldc + col0 + bj * HALF) = w; } }
    }
};
template <class E> struct has_mid { template <class T> static auto test(int) -> decltype(T::MID, char()); template <class T> static long test(...); static constexpr bool value = sizeof(test<E>(0)) == 1; };

template <class Epi, class Sched, bool ALIGN_EPI = false, bool SP2 = false>
__device__ __forceinline__ void gemm_phase(PG8_LAS unsigned char* lds, const Gemm g, const Sched& S, const Epi& E) {
    const int tid = threadIdx.x, wid = __builtin_amdgcn_readfirstlane(tid >> 6), lane = tid & 63, wr = wid >> 2, wc = wid & 3, fr = lane & 15, fq = lane >> 4;
    const int K = g.K, nt = K / BK;
    unsigned voffA[2], voffB[2];
#pragma unroll
    for (int i = 0; i < 2; ++i) { int R, C; stage_rc(tid * 16 + i * 8192, R, C); const int Rb = Epi::PERM ? ((R & ~31) + perm32(R & 31)) : R;
        voffA[i] = (unsigned)(R * g.lda + C) * 2u; voffB[i] = (unsigned)(Rb * K + C) * 2u; }
    const size_t kstep = (size_t)(BK * 2);
    const size_t hstepA = (size_t)HALF * g.lda * 2, hstepB = (size_t)HALF * K * 2;
    const size_t tstepA = 2 * hstepA, tstepB = 2 * hstepB;
    const unsigned ldsw = (unsigned)wid * 1024u;
    const int aoff = lds_byte(wr * 64 + fr, fq * 8), boff = lds_byte(wc * 32 + fr, fq * 8);
#define PG8_SA(b, h) (((b) * 2 + (h)) * HTB)
#define PG8_SB(b, h) ((4 + (b) * 2 + (h)) * HTB)
#define PG8_STAGE(bufoff, gbase, voff) do { _Pragma("unroll") for (int _i = 0; _i < 2; ++_i) \
        __builtin_amdgcn_global_load_lds((const unsigned*)((const char*)(gbase) + (voff)[_i]), (PG8_LAS unsigned*)(lds + (bufoff) + ldsw + _i * 8192), 16, 0, 0); } while (0)
#define PG8_LDA(dst, b, h) do { _Pragma("unroll") for (int m = 0; m < 4; ++m) _Pragma("unroll") for (int k = 0; k < 2; ++k) dst[m][k] = *(const PG8_LAS bf16x8*)(lds + PG8_SA(b, h) + aoff + m * 2048 + k * 1024); } while (0)
#define PG8_LDB(dst, b, h) do { _Pragma("unroll") for (int n = 0; n < 2; ++n) _Pragma("unroll") for (int k = 0; k < 2; ++k) dst[n][k] = *(const PG8_LAS bf16x8*)(lds + PG8_SB(b, h) + boff + n * 2048 + k * 1024); } while (0)
#define PG8_MMA(ai, bj, At, Bt) do { __builtin_amdgcn_s_setprio(1); _Pragma("unroll") for (int m = 0; m < 4; ++m) _Pragma("unroll") for (int n = 0; n < 2; ++n) _Pragma("unroll") for (int k = 0; k < 2; ++k) \
        acc[ai][bj][m][n] = __builtin_amdgcn_mfma_f32_16x16x32_bf16(Bt[n][k], At[m][k], acc[ai][bj][m][n], 0, 0, 0); __builtin_amdgcn_s_setprio(0); } while (0)
#define PG8_WAIT_V(n) asm volatile("s_waitcnt vmcnt(" #n ")" ::: "memory")
#define PG8_WAIT_L(n) asm volatile("s_waitcnt lgkmcnt(" #n ")" ::: "memory")
#define PG8_BAR __builtin_amdgcn_s_barrier()
#define PG8_SCHED __builtin_amdgcn_sched_barrier(0)
    Unit cur, nxt; int ui = 0;
    if (!S.next(0, cur)) return;
    f32x4 acc[2][2][4][2];
#pragma unroll
    for (int a = 0; a < 2; ++a)
#pragma unroll
        for (int b = 0; b < 2; ++b)
#pragma unroll
            for (int m = 0; m < 4; ++m)
#pragma unroll
                for (int n = 0; n < 2; ++n) acc[a][b][m][n] = (f32x4){0.f, 0.f, 0.f, 0.f};
    bf16x8 At[4][2], B0[2][2], B1[2][2];
    const char* cA = (const char*)g.A + (size_t)cur.pm * tstepA; const char* cB = (const char*)g.Bt + (size_t)cur.pn * tstepB;
    S.a_ready(cur);
    if constexpr (SP2) {
        PG8_STAGE(PG8_SB(0, 0), cB, voffB); PG8_STAGE(PG8_SB(0, 1), cB + hstepB, voffB); PG8_STAGE(PG8_SA(0, 0), cA, voffA); PG8_STAGE(PG8_SA(0, 1), cA + hstepA, voffA);
        if (wr == 1) PG8_BAR;
        PG8_WAIT_V(2); PG8_BAR;
        PG8_STAGE(PG8_SB(1, 0), cB + kstep, voffB); PG8_STAGE(PG8_SA(1, 0), cA + kstep, voffA); PG8_STAGE(PG8_SB(1, 1), cB + hstepB + kstep, voffB);
        PG8_WAIT_V(6); PG8_BAR;
    } else {
        PG8_STAGE(PG8_SB(0, 0), cB, voffB); PG8_STAGE(PG8_SA(0, 0), cA, voffA); PG8_STAGE(PG8_SB(0, 1), cB + hstepB, voffB); PG8_STAGE(PG8_SA(0, 1), cA + hstepA, voffA);
        if (wr == 1) PG8_BAR;
        PG8_WAIT_V(4); PG8_BAR;
        PG8_STAGE(PG8_SB(1, 0), cB + kstep, voffB); PG8_STAGE(PG8_SA(1, 0), cA + kstep, voffA); PG8_STAGE(PG8_SB(1, 1), cB + hstepB + kstep, voffB);
        PG8_WAIT_V(6); PG8_BAR;
    }
    for (;;) {
        const bool has_next = S.next(ui + 1, nxt);
        const char* nA = has_next ? (const char*)g.A + (size_t)nxt.pm * tstepA : cA; const char* nB = has_next ? (const char*)g.Bt + (size_t)nxt.pn * tstepB : cB;
        constexpr int NSEG = has_mid<Epi>::value ? 2 : 1;
        for (int sg = 0; sg < NSEG; ++sg) {
        if constexpr (has_mid<Epi>::value) { if (sg == 1) E.mid(acc, cur, wr, wc, fr, fq); }
        const int t_end = (sg + 1) * (nt / NSEG);
        for (int t = sg * (nt / NSEG); t < t_end; t += 2) {
            const bool last = (t == nt - 2);
            const char* a1 = cA + (size_t)(t + 1) * kstep;
            const char* a2 = last ? nA : cA + (size_t)(t + 2) * kstep; const char* b2 = last ? nB : cB + (size_t)(t + 2) * kstep;
            const char* a3 = a2 + kstep; const char* b3 = b2 + kstep;
            if (last && has_next) S.a_ready(nxt);
            if constexpr (SP2) {
            PG8_LDB(B0, 0, 0); PG8_LDB(B1, 0, 1); PG8_SCHED; PG8_LDA(At, 0, 0); PG8_STAGE(PG8_SA(1, 1), a1 + hstepA, voffA);
            PG8_WAIT_V(8); PG8_WAIT_L(0); PG8_BAR; PG8_MMA(0, 0, At, B0); PG8_MMA(0, 1, At, B1); PG8_BAR; PG8_SCHED;
            PG8_LDA(At, 0, 1); PG8_STAGE(PG8_SB(0, 0), b2, voffB); PG8_STAGE(PG8_SB(0, 1), b2 + hstepB, voffB); PG8_STAGE(PG8_SA(0, 0), a2, voffA);
            PG8_WAIT_V(8); PG8_WAIT_L(0); PG8_BAR; PG8_MMA(1, 0, At, B0); PG8_MMA(1, 1, At, B1); PG8_BAR; PG8_SCHED;
            PG8_LDB(B0, 1, 0); PG8_LDB(B1, 1, 1); PG8_SCHED; PG8_LDA(At, 1, 0); PG8_STAGE(PG8_SA(0, 1), a2 + hstepA, voffA);
            PG8_WAIT_V(8); PG8_WAIT_L(0); PG8_BAR; PG8_MMA(0, 0, At, B0); PG8_MMA(0, 1, At, B1); PG8_BAR; PG8_SCHED;
            PG8_LDA(At, 1, 1); PG8_STAGE(PG8_SB(1, 0), b3, voffB); PG8_STAGE(PG8_SB(1, 1), b3 + hstepB, voffB); PG8_STAGE(PG8_SA(1, 0), a3, voffA);
            PG8_WAIT_V(8); PG8_WAIT_L(0); PG8_BAR; PG8_MMA(1, 0, At, B0); PG8_MMA(1, 1, At, B1); PG8_BAR; PG8_SCHED;
            } else {
            PG8_LDB(B0, 0, 0); PG8_SCHED; PG8_LDA(At, 0, 0); PG8_STAGE(PG8_SA(1, 1), a1 + hstepA, voffA);
            PG8_WAIT_L(8); PG8_BAR; PG8_WAIT_L(0); PG8_MMA(0, 0, At, B0); PG8_BAR; PG8_SCHED;
            PG8_LDB(B1, 0, 1); PG8_STAGE(PG8_SB(0, 0), b2, voffB);
            PG8_BAR; PG8_WAIT_L(0); PG8_MMA(0, 1, At, B1); PG8_BAR;
            PG8_LDA(At, 0, 1); PG8_STAGE(PG8_SA(0, 0), a2, voffA);
            PG8_BAR; PG8_WAIT_L(0); PG8_MMA(1, 0, At, B0); PG8_BAR; PG8_SCHED;
            PG8_STAGE(PG8_SB(0, 1), b2 + hstepB, voffB);
            PG8_WAIT_V(6); PG8_BAR; PG8_MMA(1, 1, At, B1); PG8_BAR;
            PG8_LDB(B0, 1, 0); PG8_SCHED; PG8_LDA(At, 1, 0); PG8_STAGE(PG8_SA(0, 1), a2 + hstepA, voffA);
            PG8_WAIT_L(8); PG8_BAR; PG8_WAIT_L(0); PG8_MMA(0, 0, At, B0); PG8_BAR; PG8_SCHED;
            PG8_LDB(B1, 1, 1); PG8_STAGE(PG8_SB(1, 0), b3, voffB);
            PG8_BAR; PG8_WAIT_L(0); PG8_MMA(0, 1, At, B1); PG8_BAR;
            PG8_LDA(At, 1, 1); PG8_STAGE(PG8_SA(1, 0), a3, voffA);
            PG8_BAR; PG8_WAIT_L(0); PG8_MMA(1, 0, At, B0); PG8_BAR; PG8_SCHED;
            PG8_STAGE(PG8_SB(1, 1), b3 + hstepB, voffB);
            PG8_WAIT_V(6); PG8_BAR; PG8_MMA(1, 1, At, B1); PG8_BAR;
            }
        }
        }
        if constexpr (ALIGN_EPI) { if (wr == 0) PG8_BAR; }
        if constexpr (!Epi::AFTER_DRAIN) { E(acc, cur, wr, wc, fr, fq); S.done(cur); }
        if (!has_next) break;
#pragma unroll
        for (int a = 0; a < 2; ++a)
#pragma unroll
            for (int b = 0; b < 2; ++b)
#pragma unroll
                for (int m = 0; m < 4; ++m)
#pragma unroll
                    for (int n = 0; n < 2; ++n) acc[a][b][m][n] = (f32x4){0.f, 0.f, 0.f, 0.f};
        cur = nxt; cA = nA; cB = nB; ++ui;
        if constexpr (ALIGN_EPI) { if (wr == 1) PG8_BAR; }
    }
    PG8_WAIT_V(0);
    if constexpr (!ALIGN_EPI) { if (wr == 0) PG8_BAR; }
    PG8_BAR;
#undef PG8_SA
#undef PG8_SB
#undef PG8_STAGE
#undef PG8_LDA
#undef PG8_LDB
#undef PG8_MMA
#undef PG8_WAIT_V
#undef PG8_WAIT_L
#undef PG8_BAR
#undef PG8_SCHED
}
}
namespace mk {
using pg8::bf16_t; using pg8::bf16x8; using pg8::f32x4; using pg8::f32x2; using pg8::u32x4; using pg8::u32x2; using pg8::f2bf; using pg8::pk2; using pg8::bf_lo; using pg8::bf_hi;
#define LAS __attribute__((address_space(3)))
typedef float f32x16 __attribute__((ext_vector_type(16)));
constexpr int NWAVES = 8, NTHR = 512;
constexpr int D = 1024, FF = 2816, DIN = 7184, MP = 16384, MS = 128, MT = 16512, MPAD = 16640, TSEQ = 2048, NB = 8;
constexpr int PLD = 7424;
constexpr int PC_XR = 0, PC_YR = 1024, PC_OG = 2048, PC_Q = 3072, PC_K = 3584, PC_V = 4096, PC_GA = 5120, PC_GB = 6144, PC_LR = 7168;
constexpr int SC_XA = 0, SC_H = 1024, SC_T = 3072, SC_F = 5120;
constexpr float EPS = 1e-6f;
constexpr size_t O_YP = 0, O_YS = 16777216, O_HP = 16908288, O_CP = 16916480, O_SP = 16941056, O_HS = 17989632, O_CS = 18120704, O_SS = 18513920;
constexpr size_t MiB = 1u << 20;
constexpr size_t WS_CTL = 0, CTL_ZERO_BYTES = 64 * 1024;
constexpr size_t WS_P = 1 * MiB;
constexpr size_t WS_TAIL = 237 * MiB;
constexpr size_t WS_WRG = WS_TAIL, WS_WBR = WS_TAIL + MiB / 2, WS_WBG = WS_WBR + 2 * MiB, WS_WOUT = WS_WBG + 2 * MiB;
constexpr size_t WS_WGU2 = WS_TAIL, WS_WD2 = WS_TAIL + 11 * MiB;
static_assert(WS_P + (size_t)MPAD * PLD * 2 <= WS_TAIL && WS_WOUT + 2 * MiB <= 256 * MiB && WS_WD2 + (size_t)D * FF * 2 <= 256 * MiB, "d_ws map");
constexpr size_t SS_U = 0, SS_WIN = (size_t)MPAD * D * 2, SS_WGU1 = SS_WIN + (size_t)PLD * D * 2, SS_WD1 = SS_WGU1 + (size_t)2 * FF * D * 2;
static_assert(SS_WD1 + (size_t)D * FF * 2 <= 64 * MiB, "ss-region map");
constexpr int CW_BAR = 4096;
constexpr int LDS_BYTES = 163840, MISC_OFF = LDS_BYTES - 512;

#define RLX_AGENT __ATOMIC_RELAXED, __HIP_MEMORY_SCOPE_AGENT
#define LDS_WAIT() asm volatile("s_waitcnt lgkmcnt(0)" ::: "memory")
#define VM_WAIT() asm volatile("s_waitcnt vmcnt(0)" ::: "memory")

#define XB_TMO      128
#define XB_XCNT(j)  (256  + 64 * (j))
#define XB_XSUB(j)  (1280 + 64 * (j))
#define XB_XGEN(j)  (2304 + 64 * (j))
#define XB_TOP      3328
#define XB_TOPGEN   3392
#define XCD_BAR_WORDS 3456
#define XB_SPIN_CAP (1u << 18)
__device__ __forceinline__ unsigned xb_ld(unsigned* p)              { return __hip_atomic_load(p, __ATOMIC_RELAXED, __HIP_MEMORY_SCOPE_AGENT); }
__device__ __forceinline__ unsigned xb_add(unsigned* p, unsigned v) { return __hip_atomic_fetch_add(p, v, __ATOMIC_RELAXED, __HIP_MEMORY_SCOPE_AGENT); }
__device__ __forceinline__ unsigned xb_xcc_id() { return (unsigned)__builtin_amdgcn_s_getreg((3 << 11) | 20) & 0xFu; }
#define XB_SPIN(cond, bar) do { unsigned _sp = 0; while (cond) { __builtin_amdgcn_s_sleep(1); \
    if ((++_sp & 255u) == 0u) { if (xb_ld(&(bar)[XB_TMO])) break; if (_sp > XB_SPIN_CAP) { atomicAdd(&(bar)[XB_TMO], 1u); break; } } } } while (0)
struct XcdBarrier { unsigned* bar; unsigned x; volatile LAS unsigned* st; };
__device__ __forceinline__ XcdBarrier xcd_barrier_post(unsigned* bar, volatile LAS unsigned* st) {
    XcdBarrier b; b.bar = bar; b.x = xb_xcc_id(); b.st = st;
    if (threadIdx.x == 0) (void)xb_add(&bar[XB_XCNT(b.x)], 1u);
    return b;
}
__device__ __forceinline__ void xcd_barrier_complete(unsigned* bar, unsigned x, unsigned& nloc, unsigned& nx) {
    const unsigned G = gridDim.x * gridDim.y * gridDim.z;
    unsigned sum, cnt, mine, sp = 0u;
    for (;;) {
        sum = 0u; cnt = 0u; mine = 0u;
#pragma unroll
        for (unsigned j = 0; j < 16; ++j) { const unsigned c = xb_ld(&bar[XB_XCNT(j)]); sum += c; cnt += (c > 0u) ? 1u : 0u; mine = (j == x) ? c : mine; }
        if (sum == G) break;
        __builtin_amdgcn_s_sleep(1);
        if ((++sp & 255u) == 0u) { if (xb_ld(&bar[XB_TMO])) break; if (sp > XB_SPIN_CAP) { atomicAdd(&bar[XB_TMO], 1u); break; } }
    }
    nloc = mine > 0u ? mine : 1u; nx = cnt > 0u ? cnt : 1u;
}
__device__ __forceinline__ void xcd_barrier(const XcdBarrier& b) {
    asm volatile("s_waitcnt vmcnt(0)" ::: "memory");
    __syncthreads();
    if (threadIdx.x == 0) {
        unsigned* bar = b.bar;
        __builtin_amdgcn_s_waitcnt(0);
        unsigned nloc = b.st[0], nx = b.st[1];
        if (nloc == 0u) { xcd_barrier_complete(bar, b.x, nloc, nx); b.st[0] = nloc; b.st[1] = nx; }
        const unsigned old = xb_add(&bar[XB_XSUB(b.x)], 1u);
        const unsigned gen = old / nloc;
        if (old + 1u == (gen + 1u) * nloc) {
            __builtin_amdgcn_fence(__ATOMIC_RELEASE, "agent");
            asm volatile("s_waitcnt vmcnt(0)" ::: "memory");
            const unsigned og = xb_add(&bar[XB_TOP], 1u);
            const unsigned tg = og / nx;
            if (og + 1u == (tg + 1u) * nx) xb_add(&bar[XB_TOPGEN], 1u);
            else XB_SPIN(xb_ld(&bar[XB_TOPGEN]) == tg, bar);
            __builtin_amdgcn_fence(__ATOMIC_ACQUIRE, "agent");
            xb_add(&bar[XB_XGEN(b.x)], 1u);
            asm volatile("s_waitcnt vmcnt(0)" ::: "memory");
        } else {
            XB_SPIN(xb_ld(&bar[XB_XGEN(b.x)]) == gen, bar);
            __builtin_amdgcn_fence(__ATOMIC_ACQUIRE, "agent");
            asm volatile("s_waitcnt vmcnt(0)" ::: "memory");
        }
    }
    __syncthreads();
}

struct Args { const float* in[24]; float* out; unsigned char* ws; int ph_lo, ph_hi; };
struct Frame {
    LAS unsigned char* lds; int tid, lane, wave, vcu, G;
    const float* in[24]; float* out; unsigned char* ws;
    bf16_t* P; bf16_t* U; bf16_t* Win_t; bf16_t* Wgu1_t; bf16_t* Wd1_t; bf16_t* Wrg_t; bf16_t* Wbr_t; bf16_t* Wbg_t; bf16_t* Wout_t; bf16_t* Wgu2_t; bf16_t* Wd2_t;
};
enum { I_XP = 0, I_XS, I_SRH, I_SRC, I_SGLA, I_NG, I_F1GU, I_F1D, I_WIN, I_CW, I_CB, I_RWA, I_RBA, I_RWX, I_RBX, I_LAM, I_WLR, I_BLR, I_GNG, I_WBR, I_WBG, I_WOUT, I_F2GU, I_F2D };

__device__ __forceinline__ float wave_sum(float v) {
#pragma unroll
    for (int o = 1; o < 64; o <<= 1) v += __shfl_xor(v, o);
    return v;
}
__device__ __forceinline__ const float* xrow_ptr(const Frame& F, int row) { return row < MP ? F.in[I_XP] + (size_t)row * D : F.in[I_XS] + (size_t)(row - MP) * D; }
__device__ __forceinline__ void load_row16(const float* p, int lane, f32x4 (&v)[4]) {
#pragma unroll
    for (int j = 0; j < 4; ++j) v[j] = *(const f32x4*)(p + 4 * lane + 256 * j);
}
__device__ __forceinline__ float sumsq16(const f32x4 (&v)[4]) { float s = 0.f;
#pragma unroll
    for (int j = 0; j < 4; ++j) s += (v[j].x * v[j].x + v[j].y * v[j].y) + (v[j].z * v[j].z + v[j].w * v[j].w);
    return s; }
__device__ __forceinline__ void store_row16_bf16(bf16_t* p, int lane, const f32x4 (&v)[4]) {
#pragma unroll
    for (int j = 0; j < 4; ++j) { u32x2 w; w.x = pk2(v[j].x, v[j].y); w.y = pk2(v[j].z, v[j].w); *(u32x2*)(p + 4 * lane + 256 * j) = w; }
}
struct SlabMap { int slot, logw; };
__device__ __forceinline__ float* slab_at(const Frame& F, const SlabMap m, int s, int r, int c) {
    return (float*)(F.P + (size_t)(((s * MS + r) << (10 - m.logw)) + (c >> m.logw)) * PLD + m.slot) + (c & ((1 << m.logw) - 1)); }
constexpr SlabMap SLAB_D = {SC_XA, 9};
constexpr SlabMap SLAB_B = {PC_LR, 7};
__device__ __forceinline__ void load_row16_f(const Frame& F, int row, int slot, const SlabMap m, int slab0, int ns, f32x4 (&v)[4]) {
    if (row < MP) {
#pragma unroll
        for (int j = 0; j < 4; ++j) { const u32x2 w = *(const u32x2*)(F.P + (size_t)row * PLD + slot + 4 * F.lane + 256 * j); v[j] = (f32x4){bf_lo(w.x), bf_hi(w.x), bf_lo(w.y), bf_hi(w.y)}; }
        return; }
#pragma unroll
    for (int j = 0; j < 4; ++j) v[j] = (f32x4){0.f, 0.f, 0.f, 0.f};
    for (int s = 0; s < ns; ++s) {
#pragma unroll
        for (int j = 0; j < 4; ++j) v[j] = v[j] + *(const f32x4*)slab_at(F, m, slab0 + s, row - MP, 4 * F.lane + 256 * j); }
}
__device__ __forceinline__ void rowphase0(const Frame& F) {
    const int gw = F.vcu * NWAVES + F.wave, NGW = F.G * NWAVES; const float* g0 = F.in[I_NG];
    f32x4 g[4]; load_row16(g0, F.lane, g);
    for (int row = gw; row < MT; row += NGW) {
        f32x4 v[4]; load_row16(xrow_ptr(F, row), F.lane, v);
        const float rs = rsqrtf(wave_sum(sumsq16(v)) * (1.f / D) + EPS);
#pragma unroll
        for (int j = 0; j < 4; ++j) v[j] = v[j] * rs * g[j];
        store_row16_bf16(F.P + (size_t)row * PLD + SC_XA, F.lane, v);
    }
}
__device__ __forceinline__ void rowphase1(const Frame& F) {
    const int gw = F.vcu * NWAVES + F.wave, NGW = F.G * NWAVES; const float* ng = F.in[I_NG];
    f32x4 g1[4], g2[4]; load_row16(ng + 1 * D, F.lane, g1); load_row16(ng + 2 * D, F.lane, g2);
    for (int row = gw; row < MT; row += NGW) {
        f32x4 f[4], x[4]; load_row16_f(F, row, SC_F, SLAB_D, 0, 22, f); load_row16(xrow_ptr(F, row), F.lane, x);
        const float rs = rsqrtf(wave_sum(sumsq16(f)) * (1.f / D) + EPS);
#pragma unroll
        for (int j = 0; j < 4; ++j) x[j] = x[j] + 0.5f * (f[j] * rs * g1[j]);
        float* o = F.out + (size_t)row * D;
#pragma unroll
        for (int j = 0; j < 4; ++j) *(f32x4*)(o + 4 * F.lane + 256 * j) = x[j];
        const float rs2 = rsqrtf(wave_sum(sumsq16(x)) * (1.f / D) + EPS);
#pragma unroll
        for (int j = 0; j < 4; ++j) x[j] = x[j] * rs2 * g2[j];
        store_row16_bf16(F.U + (size_t)row * D, F.lane, x);
    }
}
__device__ __forceinline__ void rowphase2(const Frame& F) {
    const int gw = F.vcu * NWAVES + F.wave, NGW = F.G * NWAVES; const float* ng = F.in[I_NG];
    f32x4 g3[4], g4[4]; load_row16(ng + 3 * D, F.lane, g3); load_row16(ng + 4 * D, F.lane, g4);
    for (int row = gw; row < MT; row += NGW) {
        f32x4 f[4], x[4]; load_row16_f(F, row, SC_T, SLAB_B, 4, 8, f); float* o = F.out + (size_t)row * D; load_row16(o, F.lane, x);
        const float rs = rsqrtf(wave_sum(sumsq16(f)) * (1.f / D) + EPS);
#pragma unroll
        for (int j = 0; j < 4; ++j) x[j] = x[j] + f[j] * rs * g3[j];
#pragma unroll
        for (int j = 0; j < 4; ++j) *(f32x4*)(o + 4 * F.lane + 256 * j) = x[j];
        const float rs2 = rsqrtf(wave_sum(sumsq16(x)) * (1.f / D) + EPS);
#pragma unroll
        for (int j = 0; j < 4; ++j) x[j] = x[j] * rs2 * g4[j];
        store_row16_bf16(F.P + (size_t)row * PLD + SC_XA, F.lane, x);
    }
}
__device__ __forceinline__ void rowphase3(const Frame& F) {
    const int gw = F.vcu * NWAVES + F.wave, NGW = F.G * NWAVES; const float* ng = F.in[I_NG];
    f32x4 g5[4]; load_row16(ng + 5 * D, F.lane, g5);
    for (int row = gw; row < MT; row += NGW) {
        f32x4 f[4], x[4]; load_row16_f(F, row, SC_F, SLAB_D, 0, 22, f); float* o = F.out + (size_t)row * D; load_row16(o, F.lane, x);
        const float rs = rsqrtf(wave_sum(sumsq16(f)) * (1.f / D) + EPS);
#pragma unroll
        for (int j = 0; j < 4; ++j) *(f32x4*)(o + 4 * F.lane + 256 * j) = x[j] + 0.5f * (f[j] * rs * g5[j]);
    }
}

__device__ __forceinline__ void tr_item(const float* W, int ldw, int K, int k0, int scol0, int nvalid, bf16_t* WT, int drow0, LAS float* scr, int lane, int ldt = 0) {
    if (ldt == 0) ldt = K;
    { const int c4 = lane & 7, r = lane >> 3; const bool ok = 4 * c4 < nvalid; f32x4 v[8];
#pragma unroll
      for (int i = 0; i < 8; ++i) v[i] = ok ? *(const f32x4*)(W + (size_t)(k0 + r + 8 * i) * ldw + scol0 + 4 * c4) : (f32x4){0.f, 0.f, 0.f, 0.f};
#pragma unroll
      for (int i = 0; i < 8; ++i) { LAS float* d = scr + (r + 8 * i) * 33 + 4 * c4; d[0] = v[i][0]; d[1] = v[i][1]; d[2] = v[i][2]; d[3] = v[i][3]; } }
    LDS_WAIT(); asm volatile("" ::: "memory");
    const int c = lane & 7;
#pragma unroll
    for (int j = 0; j < 4; ++j) { const int n = (lane >> 3) + 8 * j; const LAS float* s = scr + (8 * c) * 33 + n;
        u32x4 o; o.x = pk2(s[0 * 33], s[1 * 33]); o.y = pk2(s[2 * 33], s[3 * 33]); o.z = pk2(s[4 * 33], s[5 * 33]); o.w = pk2(s[6 * 33], s[7 * 33]);
        *(u32x4*)(WT + (size_t)(drow0 + n) * ldt + k0 + 8 * c) = o; }
    LDS_WAIT(); asm volatile("" ::: "memory");
}
__device__ __forceinline__ void prep_wgu(const Frame& F, const float* W, bf16_t* WT, LAS float* scr, int gw, int NGW) {
    constexpr int KB = D / 64, RB = 2 * FF / 32;
    for (int it = gw; it < KB * RB; it += NGW) { const int kb = it / RB, rb = it % RB, n0 = 32 * rb, pn = n0 >> 8, bj = (n0 >> 7) & 1, j = n0 & 127;
        tr_item(W, 2 * FF, D, 64 * kb, bj * FF + 128 * pn + j, 32, WT, n0, scr, F.lane); }
}
__device__ __forceinline__ void prep_plain(const Frame& F, const float* W, int K, int N, bf16_t* WT, LAS float* scr, int gw, int NGW, int ldt = 0) {
    const int KB = K / 64, RB = N / 32;
    for (int it = gw; it < KB * RB; it += NGW) { const int kb = it / RB, rb = it % RB; tr_item(W, N, K, 64 * kb, 32 * rb, 32, WT, 32 * rb, scr, F.lane, ldt); }
}
__device__ __forceinline__ void prep_win(const Frame& F, LAS float* scr, int gw, int NGW) {
    constexpr int KB = D / 64, RB = PLD / 32;
    for (int it = gw; it < KB * RB; it += NGW) { const int kb = it / RB, rb = it % RB, n0 = 32 * rb; int sc, nv = 32;
        if (n0 < 2048) sc = n0;
        else if (n0 < 3072) sc = 4096 + (n0 - 2048);
        else if (n0 < 3584) sc = 2048 + (n0 - 3072);
        else if (n0 < 4096) sc = 2560 + (n0 - 3584);
        else if (n0 < 5120) sc = 3072 + (n0 - 4096);
        else if (n0 < 6144) sc = 5136 + (n0 - 5120);
        else if (n0 < 7168) sc = 6160 + (n0 - 6144);
        else if (n0 == 7168) { sc = 5120; nv = 16; }
        else { sc = 0; nv = 0; }
        tr_item(F.in[I_WIN], DIN, D, 64 * kb, sc, nv, F.Win_t, n0, scr, F.lane); }
}
__device__ __forceinline__ void prep_rg(const Frame& F, LAS float* scr, int gw, int NGW) {
    for (int it = gw; it < 2 * 8 * 8; it += NGW) { const int gate = it >> 6, n = (it >> 3) & 7, sub = it & 7, kb = sub >> 2, rb = sub & 3;
        tr_item(F.in[gate ? I_RWX : I_RWA] + (size_t)n * 16384, 128, 128, 64 * kb, 32 * rb, 32, F.Wrg_t + (size_t)(gate * 8 + n) * 16384, 32 * rb, scr, F.lane); }
}
}
namespace mk {
#define MFMA16(a, b, c) __builtin_amdgcn_mfma_f32_16x16x32_bf16((a), (b), (c), 0, 0, 0)
#define MFMA32(a, b, c) __builtin_amdgcn_mfma_f32_32x32x16_bf16((a), (b), (c), 0, 0, 0)
constexpr float LOG2E = 1.4426950408889634f;
__device__ __forceinline__ float bf2f(bf16_t h) { return __builtin_bit_cast(float, (unsigned)h << 16); }
__device__ __forceinline__ float ex2(float x) { return __builtin_amdgcn_exp2f(x); }
__device__ __forceinline__ float sigm(float x) { return __builtin_amdgcn_rcpf(1.0f + ex2(-LOG2E * x)); }
__device__ __forceinline__ float softplus_(float x) { return fmaxf(x, 0.f) + log1pf(__expf(-fabsf(x))); }
__device__ __forceinline__ float gelu_tanh_(float x) { return x * sigm(1.5957691216057308f * (x + 0.044715f * x * x * x)); }
__device__ __forceinline__ float silu_(float x) { return x * sigm(x); }
__device__ __forceinline__ void unpack8(const u32x4 w, float (&f)[8]) { f[0] = bf_lo(w.x); f[1] = bf_hi(w.x); f[2] = bf_lo(w.y); f[3] = bf_hi(w.y); f[4] = bf_lo(w.z); f[5] = bf_hi(w.z); f[6] = bf_lo(w.w); f[7] = bf_hi(w.w); }
__device__ __forceinline__ u32x4 pack8(const float (&f)[8]) { u32x4 w; w.x = pk2(f[0], f[1]); w.y = pk2(f[2], f[3]); w.z = pk2(f[4], f[5]); w.w = pk2(f[6], f[7]); return w; }

constexpr size_t WS_GAGG = WS_WOUT + 2 * MiB, GAGG_FLOATS = 32768 + 128, WS_RAGG = 128 * 1024;
static_assert(WS_GAGG + (size_t)96 * GAGG_FLOATS * 4 <= 256 * MiB && WS_RAGG + 512 * 256 * 4 <= WS_P, "mixer scratch map");

template <bool SAMPLE, int MODE>
__device__ __forceinline__ void rnn_item(const Frame& F, int item) {
    constexpr int XRAW_OFF = 0, XRAW_LD = 136, XCF_OFF = 18432, XCF_LD = 132, XCB_OFF = 52224, XCB_LD = 136, HB_OFF = 69632, CW_OFF = 103424;
    constexpr bool FULL = SAMPLE || MODE == 3;
    const int tid = F.tid, lane = F.lane, wid = F.wave;
    const int seg = SAMPLE ? 0 : (item & 7), n = SAMPLE ? item : ((item >> 3) & 7), b = SAMPLE ? 0 : (item >> 6), ch0 = 128 * n;
    LAS bf16_t* XRAW = (LAS bf16_t*)(F.lds + XRAW_OFF); LAS float* XCF = (LAS float*)(F.lds + XCF_OFF); LAS bf16_t* XCB = (LAS bf16_t*)(F.lds + XCB_OFF);
    LAS float* HB = (LAS float*)(F.lds + HB_OFF); LAS float* CW = (LAS float*)(F.lds + CW_OFF);
    for (int i = tid; i < 5 * 128; i += NTHR) { const int j = i >> 7, c = i & 127; CW[i] = j < 4 ? F.in[I_CW][j * D + ch0 + c] : F.in[I_CB][ch0 + c]; }
    const int q = lane >> 4, cl = 16 * wid + (lane & 15);
    const float ba = F.in[I_RBA][ch0 + cl], bx = F.in[I_RBX][ch0 + cl], sp8 = 8.0f * softplus_(-F.in[I_LAM][ch0 + cl]), sp8l2 = sp8 * LOG2E;
    bf16x8 Bw[2][4];
#pragma unroll
    for (int g = 0; g < 2; ++g)
#pragma unroll
        for (int ks = 0; ks < 4; ++ks) Bw[g][ks] = *(const bf16x8*)(F.Wrg_t + ((size_t)(g * 8 + n) * 128 + cl) * 128 + 32 * ks + 8 * q);
    const int t5 = tid >> 3, c5 = 16 * (tid & 7);
    float* ragg = (float*)(F.ws + WS_RAGG);
    float carry = 0.f, aprod = 1.f;
    if constexpr (!SAMPLE && MODE == 3) {
        float fa[7], fh[7];
#pragma unroll
        for (int s = 0; s < 7; ++s) { const float* ag = ragg + ((size_t)((b * 8 + n) * 8 + s)) * 256; fa[s] = s < seg ? ag[cl] : 1.f; fh[s] = s < seg ? ag[128 + cl] : 0.f; }
#pragma unroll
        for (int s = 0; s < 7; ++s) carry = fmaf(fa[s], carry, fh[s]);
    }
    const int ntiles = SAMPLE ? 2 : 4, tile0 = SAMPLE ? 0 : 4 * seg;
    u32x4 pxr[3], py0 = (u32x4){0u, 0u, 0u, 0u}, py1 = py0;
    auto prefetch = [&](int t0n) {
        if constexpr (!SAMPLE) {
#pragma unroll
            for (int i3 = 0; i3 < 3; ++i3) { const int e = tid + NTHR * i3, i = e >> 4, chk = e & 15, t = t0n - 3 + i; pxr[i3] = (u32x4){0u, 0u, 0u, 0u};
                if (e < 67 * 16 && t >= 0) pxr[i3] = *(const u32x4*)(F.P + ((size_t)b * TSEQ + t) * PLD + PC_XR + ch0 + 8 * chk); }
            if constexpr (FULL) { const bf16_t* yp = F.P + ((size_t)b * TSEQ + t0n + t5) * PLD + PC_YR + ch0 + c5; py0 = *(const u32x4*)yp; py1 = *(const u32x4*)(yp + 8); }
        }
    };
    if constexpr (!SAMPLE) prefetch(64 * tile0);
    __syncthreads();
    for (int tt = 0; tt < ntiles; ++tt) {
        const int t0 = 64 * (tile0 + tt);
        const size_t row5 = SAMPLE ? (size_t)(MP + t0 + t5) : (size_t)b * TSEQ + t0 + t5;
        bf16_t* yrp = F.P + row5 * PLD + PC_YR + ch0 + c5;
        u32x4 y0 = py0, y1 = py1;
        if constexpr (SAMPLE) { y0 = *(const u32x4*)yrp; y1 = *(const u32x4*)(yrp + 8); }
        if constexpr (!SAMPLE) {
#pragma unroll
            for (int i3 = 0; i3 < 3; ++i3) { const int e = tid + NTHR * i3, i = e >> 4, chk = e & 15; if (e < 67 * 16) *(LAS u32x4*)(XRAW + i * XRAW_LD + 8 * chk) = pxr[i3]; }
            __syncthreads();
            if (tt + 1 < ntiles) prefetch(t0 + 64);
            const int c0 = 8 * (tid & 15);
            float w[4][8], cb8[8];
#pragma unroll
            for (int e = 0; e < 8; ++e) { cb8[e] = CW[4 * 128 + c0 + e];
#pragma unroll
                for (int j = 0; j < 4; ++j) w[j][e] = CW[j * 128 + c0 + e]; }
#pragma unroll
            for (int rr = 0; rr < 2; ++rr) { const int t = (tid >> 4) + 32 * rr; float xc[8];
#pragma unroll
                for (int e = 0; e < 8; ++e) xc[e] = cb8[e];
#pragma unroll
                for (int j = 0; j < 4; ++j) { float x[8]; unpack8(*(const LAS u32x4*)(XRAW + (t + j) * XRAW_LD + c0), x);
#pragma unroll
                    for (int e = 0; e < 8; ++e) xc[e] = fmaf(w[j][e], x[e], xc[e]); }
                *(LAS f32x4*)(XCF + t * XCF_LD + c0) = (f32x4){xc[0], xc[1], xc[2], xc[3]}; *(LAS f32x4*)(XCF + t * XCF_LD + c0 + 4) = (f32x4){xc[4], xc[5], xc[6], xc[7]};
                *(LAS u32x4*)(XCB + t * XCB_LD + c0) = pack8(xc); }
        } else {
            const int s = t0 + t5; const bf16_t* xrp = F.P + (size_t)(MP + s) * PLD + PC_XR + ch0 + c5;
            float xr[16]; { float a8[8], b8[8]; unpack8(*(const u32x4*)xrp, a8); unpack8(*(const u32x4*)(xrp + 8), b8);
#pragma unroll
                for (int e = 0; e < 8; ++e) { xr[e] = a8[e]; xr[8 + e] = b8[e]; } }
            const float* bufp = F.in[I_SRC] + (size_t)s * 3 * D + ch0 + c5; float* csp = F.out + O_CS + (size_t)s * 3 * D + ch0 + c5;
            float xc[16];
#pragma unroll
            for (int e = 0; e < 16; ++e) xc[e] = CW[4 * 128 + c5 + e] + CW[3 * 128 + c5 + e] * xr[e];
#pragma unroll
            for (int j = 0; j < 3; ++j)
#pragma unroll
                for (int v4 = 0; v4 < 4; ++v4) { const f32x4 bv = *(const f32x4*)(bufp + j * D + 4 * v4);
#pragma unroll
                    for (int e = 0; e < 4; ++e) xc[4 * v4 + e] = fmaf(CW[j * 128 + c5 + 4 * v4 + e], bv[e], xc[4 * v4 + e]);
                    if (j >= 1) *(f32x4*)(csp + (j - 1) * D + 4 * v4) = bv; }
#pragma unroll
            for (int v4 = 0; v4 < 4; ++v4) { *(f32x4*)(csp + 2 * D + 4 * v4) = (f32x4){xr[4 * v4], xr[4 * v4 + 1], xr[4 * v4 + 2], xr[4 * v4 + 3]};
                *(LAS f32x4*)(XCF + t5 * XCF_LD + c5 + 4 * v4) = (f32x4){xc[4 * v4], xc[4 * v4 + 1], xc[4 * v4 + 2], xc[4 * v4 + 3]}; }
            { float h8[8];
#pragma unroll
              for (int hf = 0; hf < 2; ++hf) {
#pragma unroll
                for (int e = 0; e < 8; ++e) h8[e] = xc[8 * hf + e];
                *(LAS u32x4*)(XCB + t5 * XCB_LD + c5 + 8 * hf) = pack8(h8); } }
        }
        __syncthreads();
        f32x4 acc[4][2];
#pragma unroll
        for (int m = 0; m < 4; ++m) { acc[m][0] = (f32x4){0.f, 0.f, 0.f, 0.f}; acc[m][1] = (f32x4){0.f, 0.f, 0.f, 0.f}; }
#pragma unroll
        for (int m = 0; m < 4; ++m)
#pragma unroll
            for (int ks = 0; ks < 4; ++ks) { const bf16x8 a = *(const LAS bf16x8*)(XCB + (16 * m + (lane & 15)) * XCB_LD + 32 * ks + 8 * q);
                acc[m][0] = MFMA16(a, Bw[0][ks], acc[m][0]); acc[m][1] = MFMA16(a, Bw[1][ks], acc[m][1]); }
#pragma unroll
        for (int m = 0; m < 4; ++m) {
            float av[4], bv[4];
#pragma unroll
            for (int reg = 0; reg < 4; ++reg) { const int t = 16 * m + 4 * q + reg; const float xcv = XCF[t * XCF_LD + cl];
                const float r = sigm(acc[m][0][reg] + ba), ig = sigm(acc[m][1][reg] + bx);
                const float x2 = -2.0f * sp8 * r;
                const float em = -x2 * (1.0f + x2 * (0.5f + x2 * (0.16666667f + x2 * (0.041666668f + x2 * (0.0083333338f + x2 * (0.0013888889f + x2 * 0.00019841270f))))));
                float mult = __builtin_amdgcn_sqrtf(fmaxf(em, 0.f)); if (!SAMPLE && (t0 + t) == 0) mult = 1.0f;
                av[reg] = ex2(-sp8l2 * r); bv[reg] = mult * ig * xcv; }
            if constexpr (!SAMPLE) {
                float Al = 1.f, Hl = 0.f;
#pragma unroll
                for (int reg = 0; reg < 4; ++reg) { Hl = fmaf(av[reg], Hl, bv[reg]); Al *= av[reg]; }
                float hin = carry, cn = carry;
#pragma unroll
                for (int qq = 0; qq < 4; ++qq) { const float Ag = __shfl(Al, (lane & 15) + 16 * qq), Hg = __shfl(Hl, (lane & 15) + 16 * qq);
                    cn = fmaf(Ag, cn, Hg); hin = (qq < q) ? cn : hin; if (MODE == 1) aprod *= Ag; }
                carry = cn;
                if constexpr (MODE == 3) { float hv = hin;
#pragma unroll
                    for (int reg = 0; reg < 4; ++reg) { hv = fmaf(av[reg], hv, bv[reg]); HB[(16 * m + 4 * q + reg) * XCF_LD + cl] = hv; } }
            } else {
#pragma unroll
                for (int reg = 0; reg < 4; ++reg) { const int t = 16 * m + 4 * q + reg; const float h0 = F.in[I_SRH][(size_t)(t0 + t) * D + ch0 + cl];
                    HB[t * XCF_LD + cl] = fmaf(av[reg], h0, bv[reg]); }
            }
        }
        __syncthreads();
        if constexpr (FULL) {
            float h[16], yv[16], o8[8];
#pragma unroll
            for (int v4 = 0; v4 < 4; ++v4) { const f32x4 hv = *(const LAS f32x4*)(HB + t5 * XCF_LD + c5 + 4 * v4); h[4 * v4] = hv[0]; h[4 * v4 + 1] = hv[1]; h[4 * v4 + 2] = hv[2]; h[4 * v4 + 3] = hv[3]; }
            { float a8[8], b8[8]; unpack8(y0, a8); unpack8(y1, b8);
#pragma unroll
              for (int e = 0; e < 8; ++e) { yv[e] = a8[e]; yv[8 + e] = b8[e]; } }
            if constexpr (SAMPLE) { float* hsp = F.out + O_HS + (size_t)(t0 + t5) * D + ch0 + c5;
#pragma unroll
                for (int v4 = 0; v4 < 4; ++v4) *(f32x4*)(hsp + 4 * v4) = (f32x4){h[4 * v4], h[4 * v4 + 1], h[4 * v4 + 2], h[4 * v4 + 3]}; }
#pragma unroll
            for (int hf = 0; hf < 2; ++hf) {
#pragma unroll
                for (int e = 0; e < 8; ++e) o8[e] = h[8 * hf + e] * gelu_tanh_(yv[8 * hf + e]);
                *(u32x4*)(yrp + 8 * hf) = pack8(o8); }
            if constexpr (!SAMPLE) { if (tile0 + tt == 31 && t5 >= 61) { float* cpp = F.out + O_CP + ((size_t)b * 3 + (t5 - 61)) * D + ch0 + c5;
#pragma unroll
                for (int e = 0; e < 16; ++e) cpp[e] = bf2f(XRAW[(t5 + 3) * XRAW_LD + c5 + e]); } }
        }
    }
    if constexpr (!SAMPLE && MODE == 1) { if (q == 0) { float* ag = ragg + (size_t)item * 256; ag[cl] = aprod; ag[128 + cl] = carry; } }
    if constexpr (!SAMPLE && MODE == 3) { if (seg == 7 && q == 0) F.out[O_HP + (size_t)b * D + ch0 + cl] = carry; }
    __syncthreads();
}

__device__ __forceinline__ int crow(int reg, int h) { return (reg & 3) + 8 * (reg >> 2) + 4 * h; }
__device__ __forceinline__ bf16x8 pack_step(const f32x16& x, int s) {
    u32x4 p; p.x = pk2(x[8 * s], x[8 * s + 1]); p.y = pk2(x[8 * s + 2], x[8 * s + 3]); p.z = pk2(x[8 * s + 4], x[8 * s + 5]); p.w = pk2(x[8 * s + 6], x[8 * s + 7]);
    return __builtin_bit_cast(bf16x8, p);
}
template <int MODE>
__device__ __forceinline__ void gla_item(const Frame& F, int item) {
    constexpr int VRAW = 0, VRAW_LD = 264, LRS = 33792, QI = 37888, QK_LD = 136, KI = 55296, OBUF = 0, KET = 72704, T_LD = 72, VT = 91136, ATT = 128000, SEG = 137216, DEC = 139264, WLS = 139776;
    static_assert(WLS + 17 * 512 <= MISC_OFF, "GLA LDS map");
    constexpr bool FULL = (MODE == 3);
    const int tid = F.tid, lane = F.lane, w = F.wave;
    const int j = item & 3, hh = (item >> 2) & 3, b = item >> 4; const size_t rowbase = (size_t)b * TSEQ;
    LAS bf16_t* sVRAW = (LAS bf16_t*)(F.lds + VRAW); LAS float* sLR = (LAS float*)(F.lds + LRS); LAS bf16_t* sQI = (LAS bf16_t*)(F.lds + QI); LAS bf16_t* sKI = (LAS bf16_t*)(F.lds + KI);
    LAS float* sO = (LAS float*)(F.lds + OBUF); LAS bf16_t* sKET = (LAS bf16_t*)(F.lds + KET); LAS bf16_t* sVT = (LAS bf16_t*)(F.lds + VT); LAS bf16_t* sATT = (LAS bf16_t*)(F.lds + ATT);
    LAS float* sSEG = (LAS float*)(F.lds + SEG); LAS float* sDEC = (LAS float*)(F.lds + DEC);
    const int kk = tid & 127, seg = tid >> 7;
    LAS float* sWL = (LAS float*)(F.lds + WLS);
    for (int i = tid; i < 17 * 128; i += NTHR) sWL[i] = i < 2048 ? F.in[I_WLR][(i >> 7) * 512 + hh * 128 + (i & 127)] : F.in[I_BLR][hh * 128 + (i & 127)];
    const int r32 = lane & 31, h = lane >> 5, q = lane >> 4;
    float* gagg = (float*)(F.ws + WS_GAGG);
    f32x16 S[4];
#pragma unroll
    for (int kb = 0; kb < 4; ++kb)
#pragma unroll
        for (int i = 0; i < 16; ++i) S[kb][i] = 0.f;
    float dsum = 0.f;
    if constexpr (FULL) {
        for (int s = 0; s < j; ++s) { const float* ag = gagg + (size_t)((b * 4 + hh) * 3 + s) * GAGG_FLOATS;
            __syncthreads();
            if (tid < 128) sDEC[tid] = ag[32768 + tid];
            __syncthreads();
#pragma unroll
            for (int kb = 0; kb < 4; ++kb) {
#pragma unroll
                for (int g4 = 0; g4 < 4; ++g4) { const f32x4 kv = *(const f32x4*)(ag + ((size_t)((w * 4 + kb) * 4 + g4)) * 256 + 4 * lane); const f32x4 dd = *(const LAS f32x4*)(sDEC + 32 * kb + 8 * g4 + 4 * h);
#pragma unroll
                    for (int e = 0; e < 4; ++e) S[kb][4 * g4 + e] = fmaf(S[kb][4 * g4 + e], dd[e], kv[e]); }
            asm volatile("" ::: "memory"); }
        }
    }
    const char* Pb = (const char*)F.P;
    const unsigned ov = (unsigned)(((tid >> 5) * PLD + PC_V + 256 * hh + 8 * (tid & 31)) * 2), olr = (unsigned)(((tid >> 1) * PLD + PC_LR + 8 * (tid & 1)) * 2);
    const unsigned okq = (unsigned)(((tid >> 4) * PLD + 128 * hh + 8 * (tid & 15)) * 2), oog = (unsigned)((8 * w * PLD + PC_OG + 256 * hh + 4 * lane) * 2);
    LAS bf16_t* sQR = (LAS bf16_t*)(F.lds + VRAW); LAS bf16_t* sKR = (LAS bf16_t*)(F.lds + VRAW + 16384);
    u32x4 pv[4], plr = (u32x4){0u, 0u, 0u, 0u}, pk[2], pq[2];
    auto prefetch = [&](size_t r0) {
        const char* rb = Pb + r0 * (size_t)(PLD * 2);
        unsigned o1 = ov, o2 = olr, o3 = okq; asm volatile("" : "+v"(o1), "+v"(o2), "+v"(o3));
#pragma unroll
        for (int i = 0; i < 4; ++i) pv[i] = *(const u32x4*)(rb + (o1 + (unsigned)(i * 16 * PLD * 2)));
        if (tid < 128) plr = *(const u32x4*)(rb + o2);
#pragma unroll
        for (int i = 0; i < 2; ++i) pk[i] = *(const u32x4*)(rb + (o3 + (unsigned)((i * 32 * PLD + PC_K) * 2)));
    };
    prefetch(rowbase + 64 * (8 * j));
    __syncthreads();
    for (int cn = 8 * j; cn < 8 * j + 8; ++cn) {
        const size_t row0 = rowbase + 64 * cn;
        if constexpr (FULL) { const char* rb = Pb + row0 * (size_t)(PLD * 2); unsigned o3 = okq; asm volatile("" : "+v"(o3));
#pragma unroll
            for (int i = 0; i < 2; ++i) pq[i] = *(const u32x4*)(rb + (o3 + (unsigned)((i * 32 * PLD + PC_Q) * 2))); }
#pragma unroll
        for (int i = 0; i < 4; ++i) { const int e = tid + NTHR * i, row = e >> 5, c16 = e & 31; *(LAS u32x4*)(sVRAW + row * VRAW_LD + 8 * c16) = pv[i]; }
        if (tid < 128) { const int row = tid >> 1, hf = tid & 1; float f[8]; unpack8(plr, f);
            *(LAS f32x4*)(sLR + row * 16 + 8 * hf) = (f32x4){f[0], f[1], f[2], f[3]}; *(LAS f32x4*)(sLR + row * 16 + 8 * hf + 4) = (f32x4){f[4], f[5], f[6], f[7]}; }
        __syncthreads();
        float c[16]; float run = 0.f; float wl[16];
#pragma unroll
        for (int r = 0; r < 16; ++r) wl[r] = sWL[r * 128 + kk];
        const float bias = sWL[2048 + kk];
#pragma unroll
        for (int i = 0; i < 16; ++i) { const LAS float* lr = sLR + (16 * seg + i) * 16; float x = bias;
#pragma unroll
            for (int r4 = 0; r4 < 4; ++r4) { const f32x4 lv = *(const LAS f32x4*)(lr + 4 * r4); x = fmaf(lv[0], wl[4 * r4], x); x = fmaf(lv[1], wl[4 * r4 + 1], x); x = fmaf(lv[2], wl[4 * r4 + 2], x); x = fmaf(lv[3], wl[4 * r4 + 3], x); }
            x = fminf(fmaxf(x, -80.f), 80.f);
            run -= __builtin_amdgcn_logf(1.0f + ex2(-LOG2E * x)) * (1.0f / 16.0f);
            c[i] = run; if ((i & 3) == 3) __builtin_amdgcn_sched_barrier(0); }
        sSEG[seg * 128 + kk] = run;
        { const int dv = tid & 255, hf = tid >> 8;
#pragma unroll
          for (int s8 = 0; s8 < 4; ++s8) { const int s = 32 * hf + 8 * s8; u32x4 wv; unsigned t[8];
#pragma unroll
              for (int jj = 0; jj < 8; ++jj) t[jj] = sVRAW[(s + jj) * VRAW_LD + dv];
              wv.x = t[0] | (t[1] << 16); wv.y = t[2] | (t[3] << 16); wv.z = t[4] | (t[5] << 16); wv.w = t[6] | (t[7] << 16);
              *(LAS u32x4*)(sVT + dv * T_LD + s) = wv; } }
        __syncthreads();
#pragma unroll
        for (int i = 0; i < 2; ++i) { const int rowq = (tid >> 4) + 32 * i, cq = 8 * (tid & 15); *(LAS u32x4*)(sKR + rowq * 128 + cq) = pk[i]; if constexpr (FULL) *(LAS u32x4*)(sQR + rowq * 128 + cq) = pq[i]; }
        __syncthreads();
        if (cn + 1 < 8 * j + 8) prefetch(row0 + 64);
        { float off = 0.f, tot = 0.f;
#pragma unroll
          for (int s2 = 0; s2 < 4; ++s2) { const float v = sSEG[s2 * 128 + kk]; tot += v; off += (s2 < seg) ? v : 0.f; }
          const float dec = ex2(tot);
          if (seg == 0) { sDEC[kk] = dec; dsum += tot; }
          float ke[16];
#pragma unroll
          for (int i = 0; i < 16; ++i) { const int t = 16 * seg + i; const float bc = off + c[i]; const float eb = ex2(bc), ei = __builtin_amdgcn_rcpf(eb); const float kf = bf2f(sKR[t * 128 + kk]) * ei;
              ke[i] = kf * dec;
              if constexpr (FULL) { sQI[t * QK_LD + kk] = (bf16_t)(pk2(bf2f(sQR[t * 128 + kk]) * 0.08838834764831845f * eb, 0.f) & 0xffffu); sKI[t * QK_LD + kk] = (bf16_t)(pk2(kf, 0.f) & 0xffffu); } }
          { float a8[8], b8[8];
#pragma unroll
            for (int e = 0; e < 8; ++e) { a8[e] = ke[e]; b8[e] = ke[8 + e]; }
            *(LAS u32x4*)(sKET + kk * T_LD + 16 * seg) = pack8(a8); *(LAS u32x4*)(sKET + kk * T_LD + 16 * seg + 8) = pack8(b8); } }
        __syncthreads();
        if constexpr (FULL) {
#pragma unroll
            for (int u = 0; u < 2; ++u) { const int T = 2 * w + u, ti = T >> 2, si = T & 3; f32x4 cc = (f32x4){0.f, 0.f, 0.f, 0.f};
                if (si <= ti) {
#pragma unroll
                    for (int ks = 0; ks < 4; ++ks) { const bf16x8 a = *(const LAS bf16x8*)(sKI + (16 * si + (lane & 15)) * QK_LD + 32 * ks + 8 * q), bq = *(const LAS bf16x8*)(sQI + (16 * ti + (lane & 15)) * QK_LD + 32 * ks + 8 * q);
                        cc = MFMA16(a, bq, cc); } }
                const int t = 16 * ti + (lane & 15), s0 = 16 * si + 4 * q; float v[4];
#pragma unroll
                for (int reg = 0; reg < 4; ++reg) v[reg] = (s0 + reg <= t) ? cc[reg] : 0.f;
                u32x2 wv; wv.x = pk2(v[0], v[1]); wv.y = pk2(v[2], v[3]); *(LAS u32x2*)(sATT + t * T_LD + s0) = wv; }
            __syncthreads();
        }
        bf16x8 vf[4];
#pragma unroll
        for (int st = 0; st < 4; ++st) vf[st] = *(const LAS bf16x8*)(sVT + (32 * w + r32) * T_LD + 16 * st + 8 * h);
        f32x16 o[2];
        if constexpr (FULL) {
#pragma unroll
            for (int i = 0; i < 16; ++i) { o[0][i] = 0.f; o[1][i] = 0.f; }
#pragma unroll
            for (int kb = 0; kb < 4; ++kb)
#pragma unroll
                for (int s2 = 0; s2 < 2; ++s2) { const bf16x8 Bf = pack_step(S[kb], s2);
#pragma unroll
                    for (int tb = 0; tb < 2; ++tb) { const LAS bf16_t* qp = sQI + (32 * tb + r32) * QK_LD + 32 * kb + 16 * s2 + 4 * h; const u32x2 lo = *(const LAS u32x2*)qp, hi = *(const LAS u32x2*)(qp + 8);
                        const u32x4 af = (u32x4){lo.x, lo.y, hi.x, hi.y}; o[tb] = MFMA32(__builtin_bit_cast(bf16x8, af), Bf, o[tb]); }
                    __builtin_amdgcn_sched_barrier(0); }
#pragma unroll
            for (int tb = 0; tb < 2; ++tb)
#pragma unroll
                for (int st = 0; st < 4; ++st) { if (tb == 0 && st >= 2) continue; const bf16x8 af = *(const LAS bf16x8*)(sATT + (32 * tb + r32) * T_LD + 16 * st + 8 * h); o[tb] = MFMA32(af, vf[st], o[tb]); }
        }
#pragma unroll
        for (int kb = 0; kb < 4; ++kb) {
#pragma unroll
            for (int g4 = 0; g4 < 4; ++g4) { const f32x4 dd = *(const LAS f32x4*)(sDEC + 32 * kb + 8 * g4 + 4 * h);
#pragma unroll
                for (int e = 0; e < 4; ++e) S[kb][4 * g4 + e] *= dd[e]; }
#pragma unroll
            for (int st = 0; st < 4; ++st) { const bf16x8 af = *(const LAS bf16x8*)(sKET + (32 * kb + r32) * T_LD + 16 * st + 8 * h); S[kb] = MFMA32(af, vf[st], S[kb]); }
            __builtin_amdgcn_sched_barrier(0); }
        __syncthreads();
        if constexpr (FULL) {
#pragma unroll
            for (int tb = 0; tb < 2; ++tb)
#pragma unroll
                for (int i = 0; i < 16; ++i) sO[(32 * tb + crow(i, h)) * 256 + 32 * w + r32] = o[tb][i];
            __syncthreads();
            const f32x4 gn = *(const f32x4*)(F.in[I_GNG] + 4 * lane);
            u32x2 og[8];
            { const char* rb = Pb + row0 * (size_t)(PLD * 2); unsigned o4 = oog; asm volatile("" : "+v"(o4));
#pragma unroll
            for (int jj = 0; jj < 8; ++jj) og[jj] = *(const u32x2*)(rb + (o4 + (unsigned)(jj * PLD * 2))); }
#pragma unroll
            for (int jj = 0; jj < 8; ++jj) { const int t = 8 * w + jj; const f32x4 v = *(const LAS f32x4*)(sO + t * 256 + 4 * lane);
                const float rs = __builtin_amdgcn_rsqf(wave_sum((v[0] * v[0] + v[1] * v[1]) + (v[2] * v[2] + v[3] * v[3])) * (1.0f / 256.0f) + EPS);
                const float g0 = bf_lo(og[jj].x), g1 = bf_hi(og[jj].x), g2 = bf_lo(og[jj].y), g3 = bf_hi(og[jj].y);
                u32x2 wv; wv.x = pk2(v[0] * rs * gn[0] * silu_(g0), v[1] * rs * gn[1] * silu_(g1)); wv.y = pk2(v[2] * rs * gn[2] * silu_(g2), v[3] * rs * gn[3] * silu_(g3));
                *(u32x2*)(const_cast<char*>(Pb) + row0 * (size_t)(PLD * 2) + (oog + (unsigned)(jj * PLD * 2))) = wv; }
            __syncthreads();
        }
    }
    if constexpr (!FULL) {
        float* ag = gagg + (size_t)((b * 4 + hh) * 3 + j) * GAGG_FLOATS;
#pragma unroll
        for (int kb = 0; kb < 4; ++kb)
#pragma unroll
            for (int g4 = 0; g4 < 4; ++g4) *(f32x4*)(ag + ((size_t)((w * 4 + kb) * 4 + g4)) * 256 + 4 * lane) = (f32x4){S[kb][4 * g4], S[kb][4 * g4 + 1], S[kb][4 * g4 + 2], S[kb][4 * g4 + 3]};
        if (seg == 0) ag[32768 + kk] = ex2(dsum);
    } else if (j == 3) {
        float* sp = F.out + O_SP + (size_t)(b * 4 + hh) * 128 * 256;
#pragma unroll
        for (int kb = 0; kb < 4; ++kb)
#pragma unroll
            for (int i = 0; i < 16; ++i) sp[(size_t)(32 * kb + crow(i, h)) * 256 + 32 * w + r32] = S[kb][i];
    }
    __syncthreads();
}

__device__ __forceinline__ void gla_sample_item(const Frame& F, int item) {
    constexpr int SQ = 0, SK = 512, SE = 1024, RED = 2048;
    const int tid = F.tid, lane = F.lane, w = F.wave; const int hh = item & 3, s = item >> 2;
    LAS float* sq = (LAS float*)(F.lds + SQ); LAS float* sk = (LAS float*)(F.lds + SK); LAS float* se = (LAS float*)(F.lds + SE); LAS float* red = (LAS float*)(F.lds + RED);
    const bf16_t* Prow = F.P + (size_t)(MP + s) * PLD;
    if (tid < 128) { float x = F.in[I_BLR][hh * 128 + tid];
#pragma unroll
        for (int r = 0; r < 16; ++r) x = fmaf(bf2f(Prow[PC_LR + r]), F.in[I_WLR][r * 512 + hh * 128 + tid], x);
        se[tid] = __expf(-softplus_(-x) * (1.0f / 16.0f)); sq[tid] = bf2f(Prow[PC_Q + 128 * hh + tid]) * 0.08838834764831845f; sk[tid] = bf2f(Prow[PC_K + 128 * hh + tid]); }
    __syncthreads();
    const u32x2 vw = *(const u32x2*)(Prow + PC_V + 256 * hh + 4 * lane); const f32x4 v4 = (f32x4){bf_lo(vw.x), bf_hi(vw.x), bf_lo(vw.y), bf_hi(vw.y)};
    const float* S0 = F.in[I_SGLA] + ((size_t)(s * 4 + hh) * 128 + 16 * w) * 256 + 4 * lane; float* S1 = F.out + O_SS + ((size_t)(s * 4 + hh) * 128 + 16 * w) * 256 + 4 * lane;
    f32x4 o4 = (f32x4){0.f, 0.f, 0.f, 0.f};
    f32x4 sv[16];
#pragma unroll
    for (int jj = 0; jj < 16; ++jj) sv[jj] = __builtin_nontemporal_load((const f32x4*)(S0 + jj * 256));
#pragma unroll
    for (int jj = 0; jj < 16; ++jj) { const int k = 16 * w + jj; const f32x4 sn = sv[jj] * se[k] + v4 * sk[k]; __builtin_nontemporal_store(sn, (f32x4*)(S1 + jj * 256)); o4 = o4 + sn * sq[k]; }
    *(LAS f32x4*)(red + w * 256 + 4 * lane) = o4;
    __syncthreads();
    if (w == 0) { f32x4 o = (f32x4){0.f, 0.f, 0.f, 0.f};
#pragma unroll
        for (int ww = 0; ww < 8; ++ww) o = o + *(const LAS f32x4*)(red + ww * 256 + 4 * lane);
        const float rs = rsqrtf(wave_sum((o[0] * o[0] + o[1] * o[1]) + (o[2] * o[2] + o[3] * o[3])) * (1.0f / 256.0f) + EPS);
        const f32x4 gn = *(const f32x4*)(F.in[I_GNG] + 4 * lane); bf16_t* ogp = F.P + (size_t)(MP + s) * PLD + PC_OG + 256 * hh + 4 * lane; const u32x2 ogw = *(const u32x2*)ogp;
        u32x2 wv; wv.x = pk2(o[0] * rs * gn[0] * silu_(bf_lo(ogw.x)), o[1] * rs * gn[1] * silu_(bf_hi(ogw.x))); wv.y = pk2(o[2] * rs * gn[2] * silu_(bf_lo(ogw.y)), o[3] * rs * gn[3] * silu_(bf_hi(ogw.y)));
        *(u32x2*)ogp = wv; }
    __syncthreads();
}

template <int APROV>
__device__ __forceinline__ void skinny_piece(const Frame& F, const bf16_t* A, int lda, const bf16_t* Bt, int K, int k0, int nsub, int cb, const SlabMap om, int oslab) {
    constexpr int SA = 0, SB = 34816, LD = 136;
    const int tid = F.tid, lane = F.lane, w = F.wave, fr = lane & 15, fq = lane >> 4;
    LAS bf16_t* sA = (LAS bf16_t*)(F.lds + SA); LAS bf16_t* sB = (LAS bf16_t*)(F.lds + SB);
    f32x4 acc[8];
#pragma unroll
    for (int nb = 0; nb < 8; ++nb) acc[nb] = (f32x4){0.f, 0.f, 0.f, 0.f};
    for (int sub = 0; sub < nsub; ++sub) { const int kk0 = k0 + 128 * sub;
        __syncthreads();
#pragma unroll
        for (int i = 0; i < 4; ++i) { const int e = tid + NTHR * i, row = e >> 4, c16 = e & 15; u32x4 v;
            if constexpr (APROV == 0) v = *(const u32x4*)(A + (size_t)row * lda + kk0 + 8 * c16);
            else { const int cc = kk0 + 8 * c16; const bf16_t* gp = F.P + (size_t)(MP + row) * PLD + cc;
                float ga[8], gb[8], o[8]; unpack8(*(const u32x4*)(gp + PC_GA), ga); unpack8(*(const u32x4*)(gp + PC_GB), gb);
#pragma unroll
                for (int hf = 0; hf < 2; ++hf) { const f32x4 ya = *(const f32x4*)slab_at(F, SLAB_B, 0, row, cc + 4 * hf) + *(const f32x4*)slab_at(F, SLAB_B, 1, row, cc + 4 * hf), yb = *(const f32x4*)slab_at(F, SLAB_B, 2, row, cc + 4 * hf) + *(const f32x4*)slab_at(F, SLAB_B, 3, row, cc + 4 * hf);
#pragma unroll
                    for (int e2 = 0; e2 < 4; ++e2) o[4 * hf + e2] = sigm(ga[4 * hf + e2]) * ya[e2] + sigm(gb[4 * hf + e2]) * yb[e2]; }
                v = pack8(o); }
            *(LAS u32x4*)(sA + row * LD + 8 * c16) = v;
            *(LAS u32x4*)(sB + row * LD + 8 * c16) = *(const u32x4*)(Bt + (size_t)(128 * cb + row) * K + kk0 + 8 * c16); }
        __syncthreads();
        bf16x8 a[4];
#pragma unroll
        for (int s = 0; s < 4; ++s) a[s] = *(const LAS bf16x8*)(sA + (16 * w + fr) * LD + 32 * s + 8 * fq);
#pragma unroll
        for (int nb = 0; nb < 8; ++nb)
#pragma unroll
            for (int s = 0; s < 4; ++s) { const bf16x8 bb = *(const LAS bf16x8*)(sB + (16 * nb + fr) * LD + 32 * s + 8 * fq); acc[nb] = MFMA16(bb, a[s], acc[nb]); }
    }
#pragma unroll
    for (int nb = 0; nb < 8; ++nb) *(f32x4*)slab_at(F, om, oslab, 16 * w + fr, 128 * cb + 16 * nb + 4 * fq) = acc[nb];
    __syncthreads();
}
}
namespace mk {
constexpr int N_PHASES = 13;
__global__ void __launch_bounds__(NTHR, 2) mega_fwd(Args args) {
    extern __shared__ __attribute__((aligned(16))) unsigned char lds_raw[];
    Frame F;
    F.lds = (LAS unsigned char*)lds_raw;
    F.tid = threadIdx.x; F.lane = F.tid & 63; F.wave = __builtin_amdgcn_readfirstlane(F.tid >> 6);
    F.G = gridDim.x; { const int bx = blockIdx.x; F.vcu = (F.G % 8 == 0) ? (bx % 8) * (F.G / 8) + bx / 8 : bx; }
#pragma unroll
    for (int i = 0; i < 24; ++i) F.in[i] = args.in[i];
    F.out = args.out; F.ws = args.ws;
    F.P = (bf16_t*)(args.ws + WS_P);
    unsigned char* ssr = (unsigned char*)(args.out + O_SS);
    F.U = (bf16_t*)(ssr + SS_U); F.Win_t = (bf16_t*)(ssr + SS_WIN); F.Wgu1_t = (bf16_t*)(ssr + SS_WGU1); F.Wd1_t = (bf16_t*)(ssr + SS_WD1);
    F.Wrg_t = (bf16_t*)(args.ws + WS_WRG); F.Wbr_t = (bf16_t*)(args.ws + WS_WBR); F.Wbg_t = (bf16_t*)(args.ws + WS_WBG); F.Wout_t = (bf16_t*)(args.ws + WS_WOUT);
    F.Wgu2_t = (bf16_t*)(args.ws + WS_WGU2); F.Wd2_t = (bf16_t*)(args.ws + WS_WD2);
    volatile LAS unsigned* MISC = (volatile LAS unsigned*)(F.lds + MISC_OFF);
    for (int u = F.tid; u < 128; u += NTHR) MISC[u] = 0u;
    __syncthreads();
    const int lo = args.ph_lo, hi = args.ph_hi;
    XcdBarrier bar; bar.bar = (unsigned*)(args.ws + WS_CTL) + CW_BAR; bar.x = 0; bar.st = nullptr;
    if (hi - lo > 1) bar = xcd_barrier_post((unsigned*)(args.ws + WS_CTL) + CW_BAR, MISC + 8);
#define IN(k) (lo <= (k) && (k) < hi)
#ifdef TIME_PHASE
    unsigned long long tp0 = 0, tp1 = 0;
#ifdef TIME_WALL
#define SEAM(k) do { if (IN(k) && IN((k) + 1)) xcd_barrier(bar); if ((k) == TIME_PHASE) tp1 = __builtin_amdgcn_s_memrealtime(); if ((k) + 1 == TIME_PHASE) tp0 = __builtin_amdgcn_s_memrealtime(); } while (0)
#else
#define SEAM(k) do { if ((k) == TIME_PHASE) tp1 = __builtin_amdgcn_s_memrealtime(); if (IN(k) && IN((k) + 1)) xcd_barrier(bar); if ((k) + 1 == TIME_PHASE) tp0 = __builtin_amdgcn_s_memrealtime(); } while (0)
#endif
#else
#define SEAM(k) do { if (IN(k) && IN((k) + 1)) xcd_barrier(bar); } while (0)
#endif
    const int gw = F.vcu * NWAVES + F.wave, NGW = F.G * NWAVES;
    LAS float* scr = (LAS float*)(F.lds + F.wave * 16384);
    constexpr bool AL = true, SP = true;

    if (IN(0)) {
        prep_wgu(F, F.in[I_F1GU], F.Wgu1_t, scr, gw, NGW);
        prep_plain(F, F.in[I_F1D], FF, D, F.Wd1_t, scr, gw, NGW);
        rowphase0(F);
    }
    SEAM(0);
    if (IN(1)) {
        pg8::Gemm g{F.P + SC_XA, PLD, F.Wgu1_t, MPAD, 2 * FF, D}; pg8::StaticOrder S; S.init(MPAD, 2 * FF, F.G, (int)blockIdx.x);
        pg8::EpiSwiGLU E{F.P + SC_H, PLD};
        pg8::gemm_phase<pg8::EpiSwiGLU, pg8::StaticOrder, AL, SP>(F.lds, g, S, E);
        { constexpr int NU = (MPAD / 256) * (2 * FF / 256); const int full = NU % F.G;
          if (NU > F.G && full > 0 && (int)blockIdx.x >= full) prep_win(F, scr, ((int)blockIdx.x - full) * NWAVES + F.wave, (F.G - full) * NWAVES);
          else if (!(NU > F.G && full > 0)) prep_win(F, scr, gw, NGW); }
    }
    SEAM(1);
    if (IN(2)) {
        if (F.vcu < 176) skinny_piece<0>(F, F.P + (size_t)MP * PLD + SC_H, PLD, F.Wd1_t, FF, 128 * (F.vcu >> 3), 1, F.vcu & 7, SLAB_D, F.vcu >> 3);
        pg8::Gemm g{F.P + SC_H, PLD, F.Wd1_t, MP, D, FF}; pg8::StaticOrder S; S.init(MP, D, F.G, (int)blockIdx.x);
        pg8::EpiBf16 E{F.P + SC_F, PLD};
        pg8::gemm_phase<pg8::EpiBf16, pg8::StaticOrder, AL, SP>(F.lds, g, S, E);
    }
    SEAM(2);
    if (IN(3)) rowphase1(F);
    SEAM(3);
    if (IN(4)) {
        pg8::Gemm g{F.U, D, F.Win_t, MPAD, PLD, D}; pg8::StaticOrder S; S.init(MPAD, PLD, F.G, (int)blockIdx.x);
        pg8::EpiBf16 E{F.P, PLD};
        pg8::gemm_phase<pg8::EpiBf16, pg8::StaticOrder, AL, SP>(F.lds, g, S, E);
        { constexpr int NU = (MPAD / 256) * (PLD / 256); const int full = NU % F.G; const bool part = NU > F.G && full > 0;
          const int g2 = part ? ((int)blockIdx.x - full) * NWAVES + F.wave : gw, n2 = part ? (F.G - full) * NWAVES : NGW;
          if (!part || (int)blockIdx.x >= full) {
              prep_rg(F, scr, g2, n2);
              prep_plain(F, F.in[I_WBR], D, D, F.Wbr_t, scr, g2, n2, 2 * D);
              prep_plain(F, F.in[I_WBG], D, D, F.Wbr_t + D, scr, g2, n2, 2 * D);
              prep_plain(F, F.in[I_WOUT], D, D, F.Wout_t, scr, g2, n2); } }
    }
    SEAM(4);
    if (IN(5)) {
        const int c = F.vcu;
        if (c < 96) { gla_item<1>(F, (c / 3) * 4 + (c % 3)); rnn_item<false, 1>(F, (c / 7) * 8 + (c % 7)); }
        else {
            for (int i = c; i < 448; i += F.G - 96) rnn_item<false, 1>(F, (i / 7) * 8 + (i % 7));
            for (int i = c - 96; i < 2 * MS; i += F.G - 96) gla_sample_item(F, i);
        }
    }
    SEAM(5);
    if (IN(6)) {
        const int c = F.vcu;
        if (c < 128) { gla_item<3>(F, c); gla_sample_item(F, 2 * MS + c); }
        else {
            for (int i = c - 128; i < 512; i += F.G - 128) rnn_item<false, 3>(F, i);
            if (c < 136) rnn_item<true, 3>(F, c - 128);
            gla_sample_item(F, 3 * MS + c - 128);
        }
    }
    SEAM(6);
    if (IN(7)) {
        if (F.vcu < 32) { const int gsel = F.vcu >> 4, ks = (F.vcu >> 3) & 1, cb = F.vcu & 7;
            skinny_piece<0>(F, F.P + (size_t)MP * PLD + (gsel ? PC_OG : PC_YR), PLD, F.Wbr_t + (gsel ? D : 0), 2 * D, 512 * ks, 4, cb, SLAB_B, 2 * gsel + ks); }
        pg8::Gemm g{F.P + PC_YR, PLD, F.Wbr_t, MP, D, 2 * D}; pg8::StaticOrder S; S.init(MP, D, F.G, (int)blockIdx.x);
        pg8::EpiMerge E{F.P + PC_GA, F.P + PC_GB, PLD, F.P + SC_XA, PLD};
        pg8::gemm_phase<pg8::EpiMerge, pg8::StaticOrder, false, SP>(F.lds, g, S, E);
    }
    SEAM(7);
    if (IN(8)) {
        if (F.vcu < 64) skinny_piece<1>(F, nullptr, 0, F.Wout_t, D, 128 * (F.vcu >> 3), 1, F.vcu & 7, SLAB_B, 4 + (F.vcu >> 3));
        pg8::Gemm g{F.P + SC_XA, PLD, F.Wout_t, MP, D, D}; pg8::StaticOrder S; S.init(MP, D, F.G, (int)blockIdx.x);
        pg8::EpiBf16 E{F.P + SC_T, PLD};
        pg8::gemm_phase<pg8::EpiBf16, pg8::StaticOrder, AL, SP>(F.lds, g, S, E);
    }
    SEAM(8);
    if (IN(9)) {
        prep_wgu(F, F.in[I_F2GU], F.Wgu2_t, scr, gw, NGW);
        rowphase2(F);
    }
    SEAM(9);
    if (IN(10)) {
        pg8::Gemm g{F.P + SC_XA, PLD, F.Wgu2_t, MPAD, 2 * FF, D}; pg8::StaticOrder S; S.init(MPAD, 2 * FF, F.G, (int)blockIdx.x);
        pg8::EpiSwiGLU E{F.P + SC_H, PLD};
        pg8::gemm_phase<pg8::EpiSwiGLU, pg8::StaticOrder, AL, SP>(F.lds, g, S, E);
        { constexpr int NU = (MPAD / 256) * (2 * FF / 256); const int full = NU % F.G; const bool part = NU > F.G && full > 0;
          if (!part || (int)blockIdx.x >= full) prep_plain(F, F.in[I_F2D], FF, D, F.Wd2_t, scr, part ? ((int)blockIdx.x - full) * NWAVES + F.wave : gw, part ? (F.G - full) * NWAVES : NGW); }
    }
    SEAM(10);
    if (IN(11)) {
        if (F.vcu < 176) skinny_piece<0>(F, F.P + (size_t)MP * PLD + SC_H, PLD, F.Wd2_t, FF, 128 * (F.vcu >> 3), 1, F.vcu & 7, SLAB_D, F.vcu >> 3);
        pg8::Gemm g{F.P + SC_H, PLD, F.Wd2_t, MP, D, FF}; pg8::StaticOrder S; S.init(MP, D, F.G, (int)blockIdx.x);
        pg8::EpiBf16 E{F.P + SC_F, PLD};
        pg8::gemm_phase<pg8::EpiBf16, pg8::StaticOrder, AL, SP>(F.lds, g, S, E);
    }
    SEAM(11);
    if (IN(12)) rowphase3(F);
#ifdef TIME_PHASE
    if (F.vcu == TIME_VCU) { const unsigned long long te = __builtin_amdgcn_s_memrealtime(), wait = (unsigned long long)(TIME_MULT) * (tp1 - tp0); while (__builtin_amdgcn_s_memrealtime() - te < wait) __builtin_amdgcn_s_sleep(8); }
#endif
#undef IN
#undef SEAM
}

inline int launch(void* const* d_in, void* d_out, void* d_ws, hipStream_t stream, int n_launches, int ph_lo = 0, int ph_hi = 0) {
    static int grid = 0;
    if (grid == 0) {
        int dev = 0, cus = 0, per_cu = 0;
        if (hipGetDevice(&dev) != hipSuccess || hipDeviceGetAttribute(&cus, hipDeviceAttributeMultiprocessorCount, dev) != hipSuccess) { grid = -1; return -1; }
        if (hipFuncSetAttribute((const void*)mega_fwd, hipFuncAttributeMaxDynamicSharedMemorySize, LDS_BYTES) != hipSuccess) { grid = -1; return -1; }
        if (hipOccupancyMaxActiveBlocksPerMultiprocessor(&per_cu, (const void*)mega_fwd, NTHR, LDS_BYTES) != hipSuccess || per_cu < 1) per_cu = 1;
        (void)hipGetLastError();
        grid = cus;
    }
    if (grid < 0) return -1;
    Args a{};
    for (int i = 0; i < 24; ++i) a.in[i] = (const float*)d_in[i];
    a.out = (float*)d_out; a.ws = (unsigned char*)d_ws;
    if (n_launches == 0) { a.ph_lo = ph_lo; a.ph_hi = ph_hi; hipLaunchKernelGGL(mega_fwd, dim3(grid), dim3(NTHR), LDS_BYTES, stream, a); return 0; }
    (void)hipMemsetAsync((char*)d_ws + WS_CTL, 0, CTL_ZERO_BYTES, stream);
    if (n_launches == 1) { a.ph_lo = 0; a.ph_hi = N_PHASES; hipLaunchKernelGGL(mega_fwd, dim3(grid), dim3(NTHR), LDS_BYTES, stream, a); }
    else for (int p = 0; p < N_PHASES; ++p) { a.ph_lo = p; a.ph_hi = p + 1; hipLaunchKernelGGL(mega_fwd, dim3(grid), dim3(NTHR), LDS_BYTES, stream, a); }
    return 0;
}
}
#ifndef MK_NL
#define MK_NL 1
#endif
extern "C" void kernel_launch(void* const* d_in, const int* in_sizes, int n_in,
                              void* d_out, int out_size, void* d_ws, size_t ws_size,
                              hipStream_t stream) {
    mk::launch(d_in, d_out, d_ws, stream, MK_NL);
}
```

```cpp
#include <hip/hip_runtime.h>
#include <cstdio>
#include <cstdint>

#ifndef DBG_STATIC_FLOATS
#define DBG_STATIC_FLOATS 16
#endif
__device__ float g_static[DBG_STATIC_FLOATS];
#define STATIC_TAG (1ull << 62)
template <class T> __device__ __forceinline__ T* fx(T* p) { const unsigned long long v = (unsigned long long)p; return (v & STATIC_TAG) ? (T*)((char*)g_static + (v & (STATIC_TAG - 1))) : p; }
inline float* static_ptr(size_t float_off) { return (float*)(STATIC_TAG | (unsigned long long)(float_off * 4)); }
namespace nv {
constexpr int D = 1024, FF = 2816, DIN = 7184, TSEQ = 2048, NB = 8, NS = 128;
constexpr int C_XR = 0, C_YR = 1024, C_Q = 2048, C_K = 2560, C_V = 3072, C_OG = 4096, C_LR = 5120, C_GA = 5136, C_GB = 6160;
constexpr float EPS = 1e-6f;
constexpr size_t O_YP = 0, O_YS = 16777216, O_HP = 16908288, O_CP = 16916480, O_SP = 16941056, O_HS = 17989632, O_CS = 18120704, O_SS = 18513920;

__device__ __forceinline__ float sigmoidf_(float x) { return 1.f / (1.f + expf(-x)); }
__device__ __forceinline__ float siluf_(float x) { return x / (1.f + expf(-x)); }
__device__ __forceinline__ float softplusf_(float x) { return fmaxf(x, 0.f) + log1pf(expf(-fabsf(x))); }
__device__ __forceinline__ float logsigmoidf_(float x) { return -softplusf_(-x); }
__device__ __forceinline__ float gelu_tanhf_(float x) { const float c = 0.7978845608028654f; return 0.5f * x * (1.f + tanhf(c * (x + 0.044715f * x * x * x))); }

__device__ __forceinline__ float block_sum256(float v, float* red) {
#pragma unroll
    for (int o = 32; o > 0; o >>= 1) v += __shfl_xor(v, o);
    __syncthreads();
    if ((threadIdx.x & 63) == 0) red[threadIdx.x >> 6] = v;
    __syncthreads();
    return red[0] + red[1] + red[2] + red[3];
}
__global__ void k_rmsnorm(const float* x, const float* g, float* y) { x = fx(x); g = fx(g); y = fx(y);
    __shared__ float red[4];
    const size_t r = blockIdx.x; const float* xr = x + r * D; float v[4]; float s = 0.f;
#pragma unroll
    for (int j = 0; j < 4; ++j) { v[j] = xr[threadIdx.x + 256 * j]; s += v[j] * v[j]; }
    const float tot = block_sum256(s, red); const float rs = rsqrtf(tot / D + EPS);
#pragma unroll
    for (int j = 0; j < 4; ++j) y[r * D + threadIdx.x + 256 * j] = v[j] * rs * g[threadIdx.x + 256 * j];
}
__global__ void k_resnorm(const float* base, const float* f, const float* g, float scale, float* out) { base = fx(base); f = fx(f); g = fx(g); out = fx(out);
    __shared__ float red[4];
    const size_t r = blockIdx.x; const float* fr = f + r * D; float v[4]; float s = 0.f;
#pragma unroll
    for (int j = 0; j < 4; ++j) { v[j] = fr[threadIdx.x + 256 * j]; s += v[j] * v[j]; }
    const float tot = block_sum256(s, red); const float rs = rsqrtf(tot / D + EPS);
#pragma unroll
    for (int j = 0; j < 4; ++j) { const int c = threadIdx.x + 256 * j; out[r * D + c] = base[r * D + c] + scale * (v[j] * rs * g[c]); }
}
__global__ void __launch_bounds__(256) k_gemm(const float* A, int lda, const float* B, int ldb, float* C, int ldc, int M, int N, int K, size_t sA, size_t sB, size_t sC) { A = fx(A); B = fx(B); C = fx(C);
    __shared__ float As[16][64 + 1], Bs[16][64 + 1];
    A += blockIdx.z * sA; B += blockIdx.z * sB; C += blockIdx.z * sC;
    const int m0 = blockIdx.y * 64, n0 = blockIdx.x * 64, tx = threadIdx.x & 15, ty = threadIdx.x >> 4;
    float acc[4][4];
#pragma unroll
    for (int i = 0; i < 4; ++i)
#pragma unroll
        for (int j = 0; j < 4; ++j) acc[i][j] = 0.f;
    for (int k0 = 0; k0 < K; k0 += 16) {
#pragma unroll
        for (int i = 0; i < 4; ++i) { const int e = threadIdx.x + 256 * i; const int m = e >> 4, k = e & 15; As[k][m] = A[(size_t)(m0 + m) * lda + k0 + k]; }
#pragma unroll
        for (int i = 0; i < 4; ++i) { const int e = threadIdx.x + 256 * i; const int k = e >> 6, n = e & 63; Bs[k][n] = (n0 + n < N) ? B[(size_t)(k0 + k) * ldb + n0 + n] : 0.f; }
        __syncthreads();
#pragma unroll
        for (int k = 0; k < 16; ++k) { float a[4], b[4];
#pragma unroll
            for (int i = 0; i < 4; ++i) { a[i] = As[k][ty * 4 + i]; b[i] = Bs[k][tx * 4 + i]; }
#pragma unroll
            for (int i = 0; i < 4; ++i)
#pragma unroll
                for (int j = 0; j < 4; ++j) acc[i][j] = fmaf(a[i], b[j], acc[i][j]); }
        __syncthreads();
    }
#pragma unroll
    for (int i = 0; i < 4; ++i)
#pragma unroll
        for (int j = 0; j < 4; ++j) { const int n = n0 + tx * 4 + j; if (n < N) C[(size_t)(m0 + ty * 4 + i) * ldc + n] = acc[i][j]; }
}
__global__ void k_swiglu(const float* gu, float* h, size_t n) { gu = fx(gu); h = fx(h);
    for (size_t i = blockIdx.x * (size_t)blockDim.x + threadIdx.x; i < n; i += (size_t)gridDim.x * blockDim.x) { const size_t r = i / FF, j = i % FF; h[i] = siluf_(gu[r * (2 * FF) + j]) * gu[r * (2 * FF) + FF + j]; }
}
__global__ void k_conv(const float* P, const float* buf, const float* w, const float* b, float* xc, float* conv_new, int T, int nseq) { P = fx(P); buf = fx(buf); w = fx(w); b = fx(b); xc = fx(xc); conv_new = fx(conv_new);
    const size_t n = (size_t)nseq * T * D;
    for (size_t i = blockIdx.x * (size_t)blockDim.x + threadIdx.x; i < n; i += (size_t)gridDim.x * blockDim.x) {
        const int c = (int)(i % D); const size_t row = i / D; const int t = (int)(row % T); const int seq = (int)(row / T);
        float y = b[c];
#pragma unroll
        for (int j = 0; j < 4; ++j) { const int idx = t + j - 3; float xv;
            if (idx >= 0) xv = P[((size_t)seq * T + idx) * DIN + C_XR + c]; else xv = buf ? buf[((size_t)seq * 3 + (3 + idx)) * D + c] : 0.f;
            y += xv * w[j * D + c]; }
        xc[i] = y;
    }
    const size_t n2 = (size_t)nseq * 3 * D;
    for (size_t i = blockIdx.x * (size_t)blockDim.x + threadIdx.x; i < n2; i += (size_t)gridDim.x * blockDim.x) {
        const int c = (int)(i % D); const int j = (int)((i / D) % 3); const int seq = (int)(i / (3 * D));
        const int xi = T + j;
        float v; if (xi >= 3) v = P[((size_t)seq * T + (xi - 3)) * DIN + C_XR + c]; else v = buf ? buf[((size_t)seq * 3 + xi) * D + c] : 0.f;
        conv_new[i] = v;
    }
}
__global__ void k_rg_elem(const float* xc, const float* RA, const float* RX, const float* b_a, const float* b_x, const float* lam, float* a_out, float* bb_out, int T, int nseq, int reset) { xc = fx(xc); RA = fx(RA); RX = fx(RX); b_a = fx(b_a); b_x = fx(b_x); lam = fx(lam); a_out = fx(a_out); bb_out = fx(bb_out);
    const size_t n = (size_t)nseq * T * D;
    for (size_t i = blockIdx.x * (size_t)blockDim.x + threadIdx.x; i < n; i += (size_t)gridDim.x * blockDim.x) {
        const int c = (int)(i % D); const int t = (int)((i / D) % T);
        const float r = sigmoidf_(RA[i] + b_a[c]), ig = sigmoidf_(RX[i] + b_x[c]);
        const float log_a = -8.0f * r * softplusf_(-lam[c]); const float a = expf(log_a);
        float mult = sqrtf(fmaxf(-expm1f(2.0f * log_a), 0.f)); if (reset && t == 0) mult = 1.0f;
        a_out[i] = a; bb_out[i] = mult * ig * xc[i];
    }
}
__global__ void k_scan(const float* a, const float* bb, const float* h0, float* h, float* h_last, int T, int nseq) { a = fx(a); bb = fx(bb); h0 = fx(h0); h = fx(h); h_last = fx(h_last);
    const int i = blockIdx.x * blockDim.x + threadIdx.x; if (i >= nseq * D) return;
    const int c = i % D, seq = i / D; float hv = h0 ? h0[(size_t)seq * D + c] : 0.f;
    for (int t = 0; t < T; ++t) { const size_t o = ((size_t)seq * T + t) * D + c; hv = a[o] * hv + bb[o]; h[o] = hv; }
    h_last[(size_t)seq * D + c] = hv;
}
__global__ void k_gate_rnn(const float* h, const float* P, float* o, size_t n) { h = fx(h); P = fx(P); o = fx(o);
    for (size_t i = blockIdx.x * (size_t)blockDim.x + threadIdx.x; i < n; i += (size_t)gridDim.x * blockDim.x) { const size_t r = i / D; const int c = (int)(i % D); o[i] = h[i] * gelu_tanhf_(P[r * DIN + C_YR + c]); }
}
__global__ void __launch_bounds__(256) k_gla(const float* P, const float* G, const float* blr, const float* S0, float* O, float* S_out, int T) { P = fx(P); G = fx(G); blr = fx(blr); S0 = fx(S0); O = fx(O); S_out = fx(S_out);
    extern __shared__ float S[];
    __shared__ float sq[128], sk[128], se[128];
    const int head = blockIdx.x & 3, seq = blockIdx.x >> 2, dv = threadIdx.x;
    for (int kk = 0; kk < 128; ++kk) S[kk * 256 + dv] = S0 ? S0[(((size_t)seq * 4 + head) * 128 + kk) * 256 + dv] : 0.f;
    for (int t = 0; t < T; ++t) {
        const size_t row = (size_t)seq * T + t;
        __syncthreads();
        if (dv < 128) { sq[dv] = P[row * DIN + C_Q + head * 128 + dv] * 0.08838834764831845f; sk[dv] = P[row * DIN + C_K + head * 128 + dv];
            se[dv] = expf(logsigmoidf_(G[row * 512 + head * 128 + dv] + blr[head * 128 + dv]) * (1.0f / 16.0f)); }
        __syncthreads();
        const float v = P[row * DIN + C_V + head * 256 + dv]; float o = 0.f;
        for (int kk = 0; kk < 128; ++kk) { const float s = S[kk * 256 + dv] * se[kk] + sk[kk] * v; S[kk * 256 + dv] = s; o = fmaf(sq[kk], s, o); }
        O[row * D + head * 256 + dv] = o;
    }
    for (int kk = 0; kk < 128; ++kk) S_out[(((size_t)seq * 4 + head) * 128 + kk) * 256 + dv] = S[kk * 256 + dv];
}
__global__ void k_gla_out(const float* O, const float* P, const float* gn, float* og_out) { O = fx(O); P = fx(P); gn = fx(gn); og_out = fx(og_out);
    __shared__ float red[4];
    const int head = blockIdx.x & 3; const size_t row = blockIdx.x >> 2; const int dv = threadIdx.x;
    const float o = O[row * D + head * 256 + dv]; const float tot = block_sum256(o * o, red); const float rs = rsqrtf(tot / 256.f + EPS);
    og_out[row * D + head * 256 + dv] = o * rs * gn[dv] * siluf_(P[row * DIN + C_OG + head * 256 + dv]);
}
__global__ void k_merge(const float* P, const float* YA, const float* YB, float* m, size_t n) { P = fx(P); YA = fx(YA); YB = fx(YB); m = fx(m);
    for (size_t i = blockIdx.x * (size_t)blockDim.x + threadIdx.x; i < n; i += (size_t)gridDim.x * blockDim.x) { const size_t r = i / D; const int c = (int)(i % D);
        m[i] = sigmoidf_(P[r * DIN + C_GA + c]) * YA[i] + sigmoidf_(P[r * DIN + C_GB + c]) * YB[i]; }
}
struct In { const float *xp, *xs, *srh, *src, *sgla, *ng, *f1gu, *f1d, *win, *cw, *cb, *rwa, *rba, *rwx, *rbx, *lam, *wlr, *blr, *gng, *wbr, *wbg, *wout, *f2gu, *f2d; };
inline In make_in(void* const* d) { In I; const float** p = (const float**)&I; for (int i = 0; i < 24; ++i) p[i] = (const float*)d[i]; return I; }
inline void gemm(hipStream_t st, const float* A, int lda, const float* B, int ldb, float* C, int ldc, int M, int N, int K, int nz = 1, size_t sA = 0, size_t sB = 0, size_t sC = 0) {
    hipLaunchKernelGGL(k_gemm, dim3((N + 63) / 64, M / 64, nz), dim3(256), 0, st, A, lda, B, ldb, C, ldc, M, N, K, sA, sB, sC);
}
struct Outs { float *y, *h_last, *conv_new, *s_new; };
struct Bufs { float *T0, *T1, *T2, *T3, *T4, *T5, *T6, *T7, *T8, *T9, *GU, *HH, *P, *G; };
inline Bufs make_bufs(float* ws, int R) { Bufs B; const size_t RD = (size_t)R * D; B.T0 = ws; B.T1 = B.T0 + RD; B.T2 = B.T1 + RD; B.T3 = B.T2 + RD; B.T4 = B.T3 + RD; B.T5 = B.T4 + RD; B.T6 = B.T5 + RD; B.T7 = B.T6 + RD; B.T8 = B.T7 + RD; B.T9 = B.T8 + RD;
    B.GU = B.T9 + RD; B.HH = B.GU + (size_t)R * 2 * FF; B.P = B.HH + (size_t)R * FF; B.G = B.P + (size_t)R * DIN; return B; }
inline Outs std_outs(float* out, int grp) { Outs o; const bool smp = (grp == NB);
    o.y = smp ? out + O_YS : out + O_YP + (size_t)grp * TSEQ * D; o.h_last = smp ? out + O_HS : out + O_HP + (size_t)grp * D;
    o.conv_new = smp ? out + O_CS : out + O_CP + (size_t)grp * 3 * D; o.s_new = smp ? out + O_SS : out + O_SP + (size_t)grp * 4 * 128 * 256; return o; }
inline void run_group(hipStream_t st, const In& I, const Outs& O, float* ws, int grp, int s_lo = 0, int s_hi = 12) {
    const bool smp = (grp == NB); const int T = smp ? 1 : TSEQ, nseq = smp ? NS : 1, R = T * nseq;
    const float* x = smp ? I.xs : I.xp + (size_t)grp * TSEQ * D;
    const Bufs B = make_bufs(ws, R);
    float *T0 = B.T0, *T1 = B.T1, *T2 = B.T2, *T3 = B.T3, *T4 = B.T4, *T5 = B.T5, *T6 = B.T6, *T7 = B.T7, *T8 = B.T8, *T9 = B.T9, *GU = B.GU, *HH = B.HH, *P = B.P, *G = B.G;
    const float* ng = I.ng; const size_t n1 = (size_t)R * D; const int EB = 1024;
#define STG(k) if (s_lo <= (k) && (k) < s_hi)
    STG(0) hipLaunchKernelGGL(k_rmsnorm, dim3(R), dim3(256), 0, st, x, ng + 0 * D, T0);
    STG(1) { gemm(st, T0, D, I.f1gu, 2 * FF, GU, 2 * FF, R, 2 * FF, D);
        hipLaunchKernelGGL(k_swiglu, dim3(EB), dim3(256), 0, st, GU, HH, (size_t)R * FF); }
    STG(2) gemm(st, HH, FF, I.f1d, D, T1, D, R, D, FF);
    STG(3) { hipLaunchKernelGGL(k_resnorm, dim3(R), dim3(256), 0, st, x, T1, ng + 1 * D, 0.5f, T2);
        hipLaunchKernelGGL(k_rmsnorm, dim3(R), dim3(256), 0, st, T2, ng + 2 * D, T3); }
    STG(4) gemm(st, T3, D, I.win, DIN, P, DIN, R, DIN, D);
    STG(5) { hipLaunchKernelGGL(k_conv, dim3(EB), dim3(256), 0, st, P, smp ? I.src : nullptr, I.cw, I.cb, T4, O.conv_new, T, nseq);
        gemm(st, T4, D, I.rwa, 128, T5, D, R, 128, 128, 8, 128, 128 * 128, 128);
        gemm(st, T4, D, I.rwx, 128, T6, D, R, 128, 128, 8, 128, 128 * 128, 128);
        hipLaunchKernelGGL(k_rg_elem, dim3(EB), dim3(256), 0, st, T4, T5, T6, I.rba, I.rbx, I.lam, T7, T8, T, nseq, smp ? 0 : 1);
        hipLaunchKernelGGL(k_scan, dim3((nseq * D + 255) / 256), dim3(256), 0, st, T7, T8, smp ? I.srh : nullptr, T9, O.h_last, T, nseq);
        hipLaunchKernelGGL(k_gate_rnn, dim3(EB), dim3(256), 0, st, T9, P, T3, n1);
        gemm(st, P + C_LR, DIN, I.wlr, 512, G, 512, R, 512, 16);
        hipLaunchKernelGGL(k_gla, dim3(nseq * 4), dim3(256), 128 * 256 * 4, st, P, G, I.blr, smp ? I.sgla : nullptr, T7, O.s_new, T);
        hipLaunchKernelGGL(k_gla_out, dim3(R * 4), dim3(256), 0, st, T7, P, I.gng, T8); }
    STG(6) { gemm(st, T3, D, I.wbr, D, T5, D, R, D, D);
        gemm(st, T8, D, I.wbg, D, T6, D, R, D, D);
        hipLaunchKernelGGL(k_merge, dim3(EB), dim3(256), 0, st, P, T5, T6, T9, n1); }
    STG(7) gemm(st, T9, D, I.wout, D, T1, D, R, D, D);
    STG(8) { hipLaunchKernelGGL(k_resnorm, dim3(R), dim3(256), 0, st, T2, T1, ng + 3 * D, 1.0f, T2);
        hipLaunchKernelGGL(k_rmsnorm, dim3(R), dim3(256), 0, st, T2, ng + 4 * D, T0); }
    STG(9) { gemm(st, T0, D, I.f2gu, 2 * FF, GU, 2 * FF, R, 2 * FF, D);
        hipLaunchKernelGGL(k_swiglu, dim3(EB), dim3(256), 0, st, GU, HH, (size_t)R * FF); }
    STG(10) gemm(st, HH, FF, I.f2d, D, T1, D, R, D, FF);
    STG(11) hipLaunchKernelGGL(k_resnorm, dim3(R), dim3(256), 0, st, T2, T1, ng + 5 * D, 0.5f, O.y);
#undef STG
}
}
namespace pg8 {
#define PG8_LAS __attribute__((address_space(3)))
typedef unsigned short bf16_t;
typedef short bf16x8 __attribute__((ext_vector_type(8)));
typedef float f32x4 __attribute__((ext_vector_type(4)));
typedef float f32x2 __attribute__((ext_vector_type(2)));
typedef unsigned u32x4 __attribute__((ext_vector_type(4)));
typedef unsigned u32x2 __attribute__((ext_vector_type(2)));
constexpr int BM = 256, BK = 64, HALF = 128, HTB = HALF * BK * 2, STAGE_BYTES = 8 * HTB, NXCD = 8, WGM = 8;

__host__ __device__ __forceinline__ int lds_byte(int r, int c) { const int st = (r >> 4) * 2 + (c >> 5), rr = r & 15, cc = c & 31, ob = rr * 64 + cc * 2; return st * 1024 + (ob ^ (((ob >> 9) & 1) << 5)); }
__host__ __device__ __forceinline__ void stage_rc(int b, int& R, int& C) { const int st = b / 1024, sb = b % 1024, swz = sb ^ (((sb >> 9) & 1) << 5); R = (st >> 1) * 16 + swz / 64; C = (st & 1) * 32 + (swz % 64) / 2; }
__host__ __device__ __forceinline__ int perm32(int rho) { const int n = rho >> 4, i = rho & 15; return 8 * (i >> 2) + 4 * n + (i & 3); }

struct Unit { int pm, pn; };
struct Gemm { const bf16_t* A; int lda; const bf16_t* Bt; int M, N, K; };

struct StaticOrder {
    int nM, nN, nwg, G, c;
    __host__ __device__ void init(int M, int N, int G_, int c_) { nM = M / BM; nN = N / BM; nwg = nM * nN; G = G_; c = c_; }
    __host__ __device__ bool next(int i, Unit& u) const {
        const long L = (long)i * G + c; if (L >= nwg) return false;
        int wgid = (int)L; { const int q = nwg / NXCD, r = nwg % NXCD, xcd = wgid % NXCD, off = wgid / NXCD; wgid = (xcd < r ? xcd * (q + 1) : r * (q + 1) + (xcd - r) * q) + off; }
        const int nig = WGM * nN, gid = wgid / nig, fm = gid * WGM, gsz = (nM - fm) < WGM ? (nM - fm) : WGM;
        u.pm = fm + ((wgid % nig) % gsz); u.pn = (wgid % nig) / gsz; return true;
    }
    __device__ __forceinline__ void a_ready(const Unit&) const {}
    __device__ __forceinline__ void done(const Unit&) const {}
};

__device__ __forceinline__ unsigned f2bf(float f) { unsigned u = __builtin_bit_cast(unsigned, f); return (u + 0x7fffu + ((u >> 16) & 1u)) >> 16; }
typedef __bf16 hwbf16x2 __attribute__((ext_vector_type(2)));
__device__ __forceinline__ unsigned pk2(float lo, float hi) { const f32x2 v = {lo, hi}; return __builtin_bit_cast(unsigned, __builtin_convertvector(v, hwbf16x2)); }
__device__ __forceinline__ float bf_lo(unsigned w) { return __builtin_bit_cast(float, w << 16); }
__device__ __forceinline__ float bf_hi(unsigned w) { return __builtin_bit_cast(float, w & 0xffff0000u); }
__device__ __forceinline__ float fast_sigmoid(float x) { return __builtin_amdgcn_rcpf(1.0f + __builtin_amdgcn_exp2f(-1.4426950408889634f * x)); }

struct EpiF32 {
    static constexpr bool PERM = false, AFTER_DRAIN = false;
    float* C; int ldc;
    __device__ __forceinline__ void operator()(const f32x4 (&acc)[2][2][4][2], const Unit& u, int wr, int wc, int fr, int fq) const {
        const int row0 = u.pm * BM + wr * 64 + fr, col0 = u.pn * BM + wc * 32 + 4 * fq;
#pragma unroll
        for (int ai = 0; ai < 2; ++ai)
#pragma unroll
            for (int m = 0; m < 4; ++m) { float* rowp = C + (size_t)(row0 + ai * HALF + m * 16) * ldc + col0;
#pragma unroll
                for (int bj = 0; bj < 2; ++bj)
#pragma unroll
                    for (int n = 0; n < 2; ++n) *(f32x4*)(rowp + bj * HALF + n * 16) = acc[ai][bj][m][n]; }
    }
};
struct EpiBf16 {
    static constexpr bool PERM = true, AFTER_DRAIN = false;
    bf16_t* O; int ldc;
    __device__ __forceinline__ void operator()(const f32x4 (&acc)[2][2][4][2], const Unit& u, int wr, int wc, int fr, int fq) const {
        const int row0 = u.pm * BM + wr * 64 + fr, col0 = u.pn * BM + wc * 32 + 8 * fq;
#pragma unroll
        for (int ai = 0; ai < 2; ++ai)
#pragma unroll
            for (int m = 0; m < 4; ++m) { bf16_t* rowp = O + (size_t)(row0 + ai * HALF + m * 16) * ldc + col0;
#pragma unroll
                for (int bj = 0; bj < 2; ++bj) { const f32x4 v0 = acc[ai][bj][m][0], v1 = acc[ai][bj][m][1];
                    u32x4 w; w.x = pk2(v0[0], v0[1]); w.y = pk2(v0[2], v0[3]); w.z = pk2(v1[0], v1[1]); w.w = pk2(v1[2], v1[3]);
                    *(u32x4*)(rowp + bj * HALF) = w; } }
    }
};
struct EpiSwiGLU {
    static constexpr bool PERM = true, AFTER_DRAIN = false;
    bf16_t* O; int ldc;
    __device__ __forceinline__ void operator()(const f32x4 (&acc)[2][2][4][2], const Unit& u, int wr, int wc, int fr, int fq) const {
        const int row0 = u.pm * BM + wr * 64 + fr, col0 = u.pn * HALF + wc * 32 + 8 * fq;
#pragma unroll
        for (int ai = 0; ai < 2; ++ai)
#pragma unroll
            for (int m = 0; m < 4; ++m) { bf16_t* rowp = O + (size_t)(row0 + ai * HALF + m * 16) * ldc + col0;
                float h[8];
#pragma unroll
                for (int n = 0; n < 2; ++n)
#pragma unroll
                    for (int e = 0; e < 4; ++e) { const float g = acc[ai][0][m][n][e], up = acc[ai][1][m][n][e]; h[4 * n + e] = g * fast_sigmoid(g) * up; }
                u32x4 w; w.x = pk2(h[0], h[1]); w.y = pk2(h[2], h[3]); w.z = pk2(h[4], h[5]); w.w = pk2(h[6], h[7]);
                *(u32x4*)rowp = w; }
    }
};
struct EpiMerge {
    static constexpr bool PERM = true, AFTER_DRAIN = false, MID = true;
    const bf16_t* GA; const bf16_t* GB; int ldg; bf16_t* O; int ldc;
    __device__ __forceinline__ void mid(f32x4 (&acc)[2][2][4][2], const Unit& u, int wr, int wc, int fr, int fq) const {
        int row0 = u.pm * BM + wr * 64 + fr; const int col0 = u.pn * BM + wc * 32 + 8 * fq;
        asm volatile("" : "+v"(row0));
#pragma unroll
        for (int ai = 0; ai < 2; ++ai)
#pragma unroll
            for (int m = 0; m < 4; ++m) { const size_t row = (size_t)(row0 + ai * HALF + m * 16);
#pragma unroll
                for (int bj = 0; bj < 2; ++bj) { const u32x4 a = *(const u32x4*)(GA + row * ldg + col0 + bj * HALF), b = *(const u32x4*)(GB + row * ldg + col0 + bj * HALF);
#define PG8_RT(x, y) (fast_sigmoid(x) * (1.0f + __builtin_amdgcn_exp2f(-1.4426950408889634f * (y))))
                    f32x4 r0, r1; r0[0] = PG8_RT(bf_lo(a.x), bf_lo(b.x)); r0[1] = PG8_RT(bf_hi(a.x), bf_hi(b.x)); r0[2] = PG8_RT(bf_lo(a.y), bf_lo(b.y)); r0[3] = PG8_RT(bf_hi(a.y), bf_hi(b.y));
                    r1[0] = PG8_RT(bf_lo(a.z), bf_lo(b.z)); r1[1] = PG8_RT(bf_hi(a.z), bf_hi(b.z)); r1[2] = PG8_RT(bf_lo(a.w), bf_lo(b.w)); r1[3] = PG8_RT(bf_hi(a.w), bf_hi(b.w));
#undef PG8_RT
                    acc[ai][bj][m][0] = acc[ai][bj][m][0] * r0; acc[ai][bj][m][1] = acc[ai][bj][m][1] * r1; }
                if (m & 1) asm volatile("" ::: "memory"); }
    }
    __device__ __forceinline__ void operator()(const f32x4 (&acc)[2][2][4][2], const Unit& u, int wr, int wc, int fr, int fq) const {
        int row0 = u.pm * BM + wr * 64 + fr; const int col0 = u.pn * BM + wc * 32 + 8 * fq;
        asm volatile("" : "+v"(row0));
#pragma unroll
        for (int ai = 0; ai < 2; ++ai)
#pragma unroll
            for (int m = 0; m < 4; ++m) { const size_t row = (size_t)(row0 + ai * HALF + m * 16);
#pragma unroll
                for (int bj = 0; bj < 2; ++bj) { const u32x4 g = *(const u32x4*)(GB + row * ldg + col0 + bj * HALF); const f32x4 v0 = acc[ai][bj][m][0], v1 = acc[ai][bj][m][1];
                    u32x4 w; w.x = pk2(fast_sigmoid(bf_lo(g.x)) * v0[0], fast_sigmoid(bf_hi(g.x)) * v0[1]); w.y = pk2(fast_sigmoid(bf_lo(g.y)) * v0[2], fast_sigmoid(bf_hi(g.y)) * v0[3]);
                    w.z = pk2(fast_sigmoid(bf_lo(g.z)) * v1[0], fast_sigmoid(bf_hi(g.z)) * v1[1]); w.w = pk2(fast_sigmoid(bf_lo(g.w)) * v1[2], fast_sigmoid(bf_hi(g.w)) * v1[3]);
                    *(u32x4*)(O + row * ldc + col0 + bj * HALF) = w; } }
    }
};
template <class E> struct has_mid { template <class T> static auto test(int) -> decltype(T::MID, char()); template <class T> static long test(...); static constexpr bool value = sizeof(test<E>(0)) == 1; };

template <class Epi, class Sched, bool ALIGN_EPI = false, bool SP2 = false>
__device__ __forceinline__ void gemm_phase(PG8_LAS unsigned char* lds, const Gemm g, const Sched& S, const Epi& E) {
    const int tid = threadIdx.x, wid = __builtin_amdgcn_readfirstlane(tid >> 6), lane = tid & 63, wr = wid >> 2, wc = wid & 3, fr = lane & 15, fq = lane >> 4;
    const int K = g.K, nt = K / BK;
    unsigned voffA[2], voffB[2];
#pragma unroll
    for (int i = 0; i < 2; ++i) { int R, C; stage_rc(tid * 16 + i * 8192, R, C); const int Rb = Epi::PERM ? ((R & ~31) + perm32(R & 31)) : R;
        voffA[i] = (unsigned)(R * g.lda + C) * 2u; voffB[i] = (unsigned)(Rb * K + C) * 2u; }
    const size_t kstep = (size_t)(BK * 2);
    const size_t hstepA = (size_t)HALF * g.lda * 2, hstepB = (size_t)HALF * K * 2;
    const size_t tstepA = 2 * hstepA, tstepB = 2 * hstepB;
    const unsigned ldsw = (unsigned)wid * 1024u;
    const int aoff = lds_byte(wr * 64 + fr, fq * 8), boff = lds_byte(wc * 32 + fr, fq * 8);
#define PG8_SA(b, h) (((b) * 2 + (h)) * HTB)
#define PG8_SB(b, h) ((4 + (b) * 2 + (h)) * HTB)
#define PG8_STAGE(bufoff, gbase, voff) do { _Pragma("unroll") for (int _i = 0; _i < 2; ++_i) \
        __builtin_amdgcn_global_load_lds((const unsigned*)((const char*)(gbase) + (voff)[_i]), (PG8_LAS unsigned*)(lds + (bufoff) + ldsw + _i * 8192), 16, 0, 0); } while (0)
#define PG8_LDA(dst, b, h) do { _Pragma("unroll") for (int m = 0; m < 4; ++m) _Pragma("unroll") for (int k = 0; k < 2; ++k) dst[m][k] = *(const PG8_LAS bf16x8*)(lds + PG8_SA(b, h) + aoff + m * 2048 + k * 1024); } while (0)
#define PG8_LDB(dst, b, h) do { _Pragma("unroll") for (int n = 0; n < 2; ++n) _Pragma("unroll") for (int k = 0; k < 2; ++k) dst[n][k] = *(const PG8_LAS bf16x8*)(lds + PG8_SB(b, h) + boff + n * 2048 + k * 1024); } while (0)
#define PG8_MMA(ai, bj, At, Bt) do { __builtin_amdgcn_s_setprio(1); _Pragma("unroll") for (int m = 0; m < 4; ++m) _Pragma("unroll") for (int n = 0; n < 2; ++n) _Pragma("unroll") for (int k = 0; k < 2; ++k) \
        acc[ai][bj][m][n] = __builtin_amdgcn_mfma_f32_16x16x32_bf16(Bt[n][k], At[m][k], acc[ai][bj][m][n], 0, 0, 0); __builtin_amdgcn_s_setprio(0); } while (0)
#define PG8_WAIT_V(n) asm volatile("s_waitcnt vmcnt(" #n ")" ::: "memory")
#define PG8_WAIT_L(n) asm volatile("s_waitcnt lgkmcnt(" #n ")" ::: "memory")
#define PG8_BAR __builtin_amdgcn_s_barrier()
#define PG8_SCHED __builtin_amdgcn_sched_barrier(0)
    Unit cur, nxt; int ui = 0;
    if (!S.next(0, cur)) return;
    f32x4 acc[2][2][4][2];
#pragma unroll
    for (int a = 0; a < 2; ++a)
#pragma unroll
        for (int b = 0; b < 2; ++b)
#pragma unroll
            for (int m = 0; m < 4; ++m)
#pragma unroll
                for (int n = 0; n < 2; ++n) acc[a][b][m][n] = (f32x4){0.f, 0.f, 0.f, 0.f};
    bf16x8 At[4][2], B0[2][2], B1[2][2];
    const char* cA = (const char*)g.A + (size_t)cur.pm * tstepA; const char* cB = (const char*)g.Bt + (size_t)cur.pn * tstepB;
    S.a_ready(cur);
    if constexpr (SP2) {
        PG8_STAGE(PG8_SB(0, 0), cB, voffB); PG8_STAGE(PG8_SB(0, 1), cB + hstepB, voffB); PG8_STAGE(PG8_SA(0, 0), cA, voffA); PG8_STAGE(PG8_SA(0, 1), cA + hstepA, voffA);
        if (wr == 1) PG8_BAR;
        PG8_WAIT_V(2); PG8_BAR;
        PG8_STAGE(PG8_SB(1, 0), cB + kstep, voffB); PG8_STAGE(PG8_SA(1, 0), cA + kstep, voffA); PG8_STAGE(PG8_SB(1, 1), cB + hstepB + kstep, voffB);
        PG8_WAIT_V(6); PG8_BAR;
    } else {
        PG8_STAGE(PG8_SB(0, 0), cB, voffB); PG8_STAGE(PG8_SA(0, 0), cA, voffA); PG8_STAGE(PG8_SB(0, 1), cB + hstepB, voffB); PG8_STAGE(PG8_SA(0, 1), cA + hstepA, voffA);
        if (wr == 1) PG8_BAR;
        PG8_WAIT_V(4); PG8_BAR;
        PG8_STAGE(PG8_SB(1, 0), cB + kstep, voffB); PG8_STAGE(PG8_SA(1, 0), cA + kstep, voffA); PG8_STAGE(PG8_SB(1, 1), cB + hstepB + kstep, voffB);
        PG8_WAIT_V(6); PG8_BAR;
    }
    for (;;) {
        const bool has_next = S.next(ui + 1, nxt);
        const char* nA = has_next ? (const char*)g.A + (size_t)nxt.pm * tstepA : cA; const char* nB = has_next ? (const char*)g.Bt + (size_t)nxt.pn * tstepB : cB;
        constexpr int NSEG = has_mid<Epi>::value ? 2 : 1;
        for (int sg = 0; sg < NSEG; ++sg) {
        if constexpr (has_mid<Epi>::value) { if (sg == 1) E.mid(acc, cur, wr, wc, fr, fq); }
        const int t_end = (sg + 1) * (nt / NSEG);
        for (int t = sg * (nt / NSEG); t < t_end; t += 2) {
            const bool last = (t == nt - 2);
            const char* a1 = cA + (size_t)(t + 1) * kstep;
            const char* a2 = last ? nA : cA + (size_t)(t + 2) * kstep; const char* b2 = last ? nB : cB + (size_t)(t + 2) * kstep;
            const char* a3 = a2 + kstep; const char* b3 = b2 + kstep;
            if (last && has_next) S.a_ready(nxt);
            if constexpr (SP2) {
            PG8_LDB(B0, 0, 0); PG8_LDB(B1, 0, 1); PG8_SCHED; PG8_LDA(At, 0, 0); PG8_STAGE(PG8_SA(1, 1), a1 + hstepA, voffA);
            PG8_WAIT_V(8); PG8_WAIT_L(0); PG8_BAR; PG8_MMA(0, 0, At, B0); PG8_MMA(0, 1, At, B1); PG8_BAR; PG8_SCHED;
            PG8_LDA(At, 0, 1); PG8_STAGE(PG8_SB(0, 0), b2, voffB); PG8_STAGE(PG8_SB(0, 1), b2 + hstepB, voffB); PG8_STAGE(PG8_SA(0, 0), a2, voffA);
            PG8_WAIT_V(8); PG8_WAIT_L(0); PG8_BAR; PG8_MMA(1, 0, At, B0); PG8_MMA(1, 1, At, B1); PG8_BAR; PG8_SCHED;
            PG8_LDB(B0, 1, 0); PG8_LDB(B1, 1, 1); PG8_SCHED; PG8_LDA(At, 1, 0); PG8_STAGE(PG8_SA(0, 1), a2 + hstepA, voffA);
            PG8_WAIT_V(8); PG8_WAIT_L(0); PG8_BAR; PG8_MMA(0, 0, At, B0); PG8_MMA(0, 1, At, B1); PG8_BAR; PG8_SCHED;
            PG8_LDA(At, 1, 1); PG8_STAGE(PG8_SB(1, 0), b3, voffB); PG8_STAGE(PG8_SB(1, 1), b3 + hstepB, voffB); PG8_STAGE(PG8_SA(1, 0), a3, voffA);
            PG8_WAIT_V(8); PG8_WAIT_L(0); PG8_BAR; PG8_MMA(1, 0, At, B0); PG8_MMA(1, 1, At, B1); PG8_BAR; PG8_SCHED;
            } else {
            PG8_LDB(B0, 0, 0); PG8_SCHED; PG8_LDA(At, 0, 0); PG8_STAGE(PG8_SA(1, 1), a1 + hstepA, voffA);
            PG8_WAIT_L(8); PG8_BAR; PG8_WAIT_L(0); PG8_MMA(0, 0, At, B0); PG8_BAR; PG8_SCHED;
            PG8_LDB(B1, 0, 1); PG8_STAGE(PG8_SB(0, 0), b2, voffB);
            PG8_BAR; PG8_WAIT_L(0); PG8_MMA(0, 1, At, B1); PG8_BAR;
            PG8_LDA(At, 0, 1); PG8_STAGE(PG8_SA(0, 0), a2, voffA);
            PG8_BAR; PG8_WAIT_L(0); PG8_MMA(1, 0, At, B0); PG8_BAR; PG8_SCHED;
            PG8_STAGE(PG8_SB(0, 1), b2 + hstepB, voffB);
            PG8_WAIT_V(6); PG8_BAR; PG8_MMA(1, 1, At, B1); PG8_BAR;
            PG8_LDB(B0, 1, 0); PG8_SCHED; PG8_LDA(At, 1, 0); PG8_STAGE(PG8_SA(0, 1), a2 + hstepA, voffA);
            PG8_WAIT_L(8); PG8_BAR; PG8_WAIT_L(0); PG8_MMA(0, 0, At, B0); PG8_BAR; PG8_SCHED;
            PG8_LDB(B1, 1, 1); PG8_STAGE(PG8_SB(1, 0), b3, voffB);
            PG8_BAR; PG8_WAIT_L(0); PG8_MMA(0, 1, At, B1); PG8_BAR;
            PG8_LDA(At, 1, 1); PG8_STAGE(PG8_SA(1, 0), a3, voffA);
            PG8_BAR; PG8_WAIT_L(0); PG8_MMA(1, 0, At, B0); PG8_BAR; PG8_SCHED;
            PG8_STAGE(PG8_SB(1, 1), b3 + hstepB, voffB);
            PG8_WAIT_V(6); PG8_BAR; PG8_MMA(1, 1, At, B1); PG8_BAR;
            }
        }
        }
        if constexpr (ALIGN_EPI) { if (wr == 0) PG8_BAR; }
        if constexpr (!Epi::AFTER_DRAIN) { E(acc, cur, wr, wc, fr, fq); S.done(cur); }
        if (!has_next) break;
#pragma unroll
        for (int a = 0; a < 2; ++a)
#pragma unroll
            for (int b = 0; b < 2; ++b)
#pragma unroll
                for (int m = 0; m < 4; ++m)
#pragma unroll
                    for (int n = 0; n < 2; ++n) acc[a][b][m][n] = (f32x4){0.f, 0.f, 0.f, 0.f};
        cur = nxt; cA = nA; cB = nB; ++ui;
        if constexpr (ALIGN_EPI) { if (wr == 1) PG8_BAR; }
    }
    PG8_WAIT_V(0);
    if constexpr (!ALIGN_EPI) { if (wr == 0) PG8_BAR; }
    PG8_BAR;
#undef PG8_SA
#undef PG8_SB
#undef PG8_STAGE
#undef PG8_LDA
#undef PG8_LDB
#undef PG8_MMA
#undef PG8_WAIT_V
#undef PG8_WAIT_L
#undef PG8_BAR
#undef PG8_SCHED
}
}
namespace mk {
using pg8::bf16_t; using pg8::bf16x8; using pg8::f32x4; using pg8::f32x2; using pg8::u32x4; using pg8::u32x2; using pg8::f2bf; using pg8::pk2; using pg8::bf_lo; using pg8::bf_hi;
#define LAS __attribute__((address_space(3)))
typedef float f32x16 __attribute__((ext_vector_type(16)));
constexpr int NWAVES = 8, NTHR = 512;
constexpr int D = 1024, FF = 2816, DIN = 7184, MP = 16384, MS = 128, MT = 16512, MPAD = 16640, TSEQ = 2048, NB = 8;
constexpr int PLD = 7424;
constexpr int PC_XR = 0, PC_YR = 1024, PC_OG = 2048, PC_Q = 3072, PC_K = 3584, PC_V = 4096, PC_GA = 5120, PC_GB = 6144, PC_LR = 7168;
constexpr int SC_XA = 0, SC_H = 1024, SC_T = 3072, SC_F = 5120;
constexpr float EPS = 1e-6f;
constexpr size_t O_YP = 0, O_YS = 16777216, O_HP = 16908288, O_CP = 16916480, O_SP = 16941056, O_HS = 17989632, O_CS = 18120704, O_SS = 18513920;
constexpr size_t MiB = 1u << 20;
constexpr size_t WS_CTL = 0, CTL_ZERO_BYTES = 64 * 1024;
constexpr size_t WS_P = 1 * MiB;
constexpr size_t WS_TAIL = 237 * MiB;
constexpr size_t WS_WRG = WS_TAIL, WS_WBR = WS_TAIL + MiB / 2, WS_WBG = WS_WBR + 2 * MiB, WS_WOUT = WS_WBG + 2 * MiB;
constexpr size_t WS_WGU2 = WS_TAIL, WS_WD2 = WS_TAIL + 11 * MiB;
static_assert(WS_P + (size_t)MPAD * PLD * 2 <= WS_TAIL && WS_WOUT + 2 * MiB <= 256 * MiB && WS_WD2 + (size_t)D * FF * 2 <= 256 * MiB, "d_ws map");
constexpr size_t SS_U = 0, SS_WIN = (size_t)MPAD * D * 2, SS_WGU1 = SS_WIN + (size_t)PLD * D * 2, SS_WD1 = SS_WGU1 + (size_t)2 * FF * D * 2;
static_assert(SS_WD1 + (size_t)D * FF * 2 <= 64 * MiB, "ss-region map");
constexpr int CW_BAR = 4096;
constexpr int LDS_BYTES = 163840, MISC_OFF = LDS_BYTES - 512;

#define RLX_AGENT __ATOMIC_RELAXED, __HIP_MEMORY_SCOPE_AGENT
#define LDS_WAIT() asm volatile("s_waitcnt lgkmcnt(0)" ::: "memory")
#define VM_WAIT() asm volatile("s_waitcnt vmcnt(0)" ::: "memory")

#define XB_TMO      128
#define XB_XCNT(j)  (256  + 64 * (j))
#define XB_XSUB(j)  (1280 + 64 * (j))
#define XB_XGEN(j)  (2304 + 64 * (j))
#define XB_TOP      3328
#define XB_TOPGEN   3392
#define XCD_BAR_WORDS 3456
#define XB_SPIN_CAP (1u << 18)
__device__ __forceinline__ unsigned xb_ld(unsigned* p)              { return __hip_atomic_load(p, __ATOMIC_RELAXED, __HIP_MEMORY_SCOPE_AGENT); }
__device__ __forceinline__ unsigned xb_add(unsigned* p, unsigned v) { return __hip_atomic_fetch_add(p, v, __ATOMIC_RELAXED, __HIP_MEMORY_SCOPE_AGENT); }
__device__ __forceinline__ unsigned xb_xcc_id() { return (unsigned)__builtin_amdgcn_s_getreg((3 << 11) | 20) & 0xFu; }
#define XB_SPIN(cond, bar) do { unsigned _sp = 0; while (cond) { __builtin_amdgcn_s_sleep(1); \
    if ((++_sp & 255u) == 0u) { if (xb_ld(&(bar)[XB_TMO])) break; if (_sp > XB_SPIN_CAP) { atomicAdd(&(bar)[XB_TMO], 1u); break; } } } } while (0)
struct XcdBarrier { unsigned* bar; unsigned x; volatile LAS unsigned* st; };
__device__ __forceinline__ XcdBarrier xcd_barrier_post(unsigned* bar, volatile LAS unsigned* st) {
    XcdBarrier b; b.bar = bar; b.x = xb_xcc_id(); b.st = st;
    if (threadIdx.x == 0) (void)xb_add(&bar[XB_XCNT(b.x)], 1u);
    return b;
}
__device__ __forceinline__ void xcd_barrier_complete(unsigned* bar, unsigned x, unsigned& nloc, unsigned& nx) {
    const unsigned G = gridDim.x * gridDim.y * gridDim.z;
    unsigned sum, cnt, mine, sp = 0u;
    for (;;) {
        sum = 0u; cnt = 0u; mine = 0u;
#pragma unroll
        for (unsigned j = 0; j < 16; ++j) { const unsigned c = xb_ld(&bar[XB_XCNT(j)]); sum += c; cnt += (c > 0u) ? 1u : 0u; mine = (j == x) ? c : mine; }
        if (sum == G) break;
        __builtin_amdgcn_s_sleep(1);
        if ((++sp & 255u) == 0u) { if (xb_ld(&bar[XB_TMO])) break; if (sp > XB_SPIN_CAP) { atomicAdd(&bar[XB_TMO], 1u); break; } }
    }
    nloc = mine > 0u ? mine : 1u; nx = cnt > 0u ? cnt : 1u;
}
__device__ __forceinline__ void xcd_barrier(const XcdBarrier& b) {
    asm volatile("s_waitcnt vmcnt(0)" ::: "memory");
    __syncthreads();
    if (threadIdx.x == 0) {
        unsigned* bar = b.bar;
        __builtin_amdgcn_s_waitcnt(0);
        unsigned nloc = b.st[0], nx = b.st[1];
        if (nloc == 0u) { xcd_barrier_complete(bar, b.x, nloc, nx); b.st[0] = nloc; b.st[1] = nx; }
        const unsigned old = xb_add(&bar[XB_XSUB(b.x)], 1u);
        const unsigned gen = old / nloc;
        if (old + 1u == (gen + 1u) * nloc) {
            __builtin_amdgcn_fence(__ATOMIC_RELEASE, "agent");
            asm volatile("s_waitcnt vmcnt(0)" ::: "memory");
            const unsigned og = xb_add(&bar[XB_TOP], 1u);
            const unsigned tg = og / nx;
            if (og + 1u == (tg + 1u) * nx) xb_add(&bar[XB_TOPGEN], 1u);
            else XB_SPIN(xb_ld(&bar[XB_TOPGEN]) == tg, bar);
            __builtin_amdgcn_fence(__ATOMIC_ACQUIRE, "agent");
            xb_add(&bar[XB_XGEN(b.x)], 1u);
            asm volatile("s_waitcnt vmcnt(0)" ::: "memory");
        } else {
            XB_SPIN(xb_ld(&bar[XB_XGEN(b.x)]) == gen, bar);
            __builtin_amdgcn_fence(__ATOMIC_ACQUIRE, "agent");
            asm volatile("s_waitcnt vmcnt(0)" ::: "memory");
        }
    }
    __syncthreads();
}

struct Args { const float* in[24]; float* out; unsigned char* ws; int ph_lo, ph_hi; };
struct Frame {
    LAS unsigned char* lds; int tid, lane, wave, vcu, G;
    const float* in[24]; float* out; unsigned char* ws;
    bf16_t* P; bf16_t* U; bf16_t* Win_t; bf16_t* Wgu1_t; bf16_t* Wd1_t; bf16_t* Wrg_t; bf16_t* Wbr_t; bf16_t* Wbg_t; bf16_t* Wout_t; bf16_t* Wgu2_t; bf16_t* Wd2_t;
};
enum { I_XP = 0, I_XS, I_SRH, I_SRC, I_SGLA, I_NG, I_F1GU, I_F1D, I_WIN, I_CW, I_CB, I_RWA, I_RBA, I_RWX, I_RBX, I_LAM, I_WLR, I_BLR, I_GNG, I_WBR, I_WBG, I_WOUT, I_F2GU, I_F2D };

__device__ __forceinline__ float wave_sum(float v) {
#pragma unroll
    for (int o = 1; o < 64; o <<= 1) v += __shfl_xor(v, o);
    return v;
}
__device__ __forceinline__ const float* xrow_ptr(const Frame& F, int row) { return row < MP ? F.in[I_XP] + (size_t)row * D : F.in[I_XS] + (size_t)(row - MP) * D; }
__device__ __forceinline__ void load_row16(const float* p, int lane, f32x4 (&v)[4]) {
#pragma unroll
    for (int j = 0; j < 4; ++j) v[j] = *(const f32x4*)(p + 4 * lane + 256 * j);
}
__device__ __forceinline__ float sumsq16(const f32x4 (&v)[4]) { float s = 0.f;
#pragma unroll
    for (int j = 0; j < 4; ++j) s += (v[j].x * v[j].x + v[j].y * v[j].y) + (v[j].z * v[j].z + v[j].w * v[j].w);
    return s; }
__device__ __forceinline__ void store_row16_bf16(bf16_t* p, int lane, const f32x4 (&v)[4]) {
#pragma unroll
    for (int j = 0; j < 4; ++j) { u32x2 w; w.x = pk2(v[j].x, v[j].y); w.y = pk2(v[j].z, v[j].w); *(u32x2*)(p + 4 * lane + 256 * j) = w; }
}
struct SlabMap { int slot, logw; };
__device__ __forceinline__ float* slab_at(const Frame& F, const SlabMap m, int s, int r, int c) {
    return (float*)(F.P + (size_t)(((s * MS + r) << (10 - m.logw)) + (c >> m.logw)) * PLD + m.slot) + (c & ((1 << m.logw) - 1)); }
constexpr SlabMap SLAB_D = {SC_XA, 9};
constexpr SlabMap SLAB_B = {PC_LR, 7};
__device__ __forceinline__ void load_row16_f(const Frame& F, int row, int slot, const SlabMap m, int slab0, int ns, f32x4 (&v)[4]) {
    if (row < MP) {
#pragma unroll
        for (int j = 0; j < 4; ++j) { const u32x2 w = *(const u32x2*)(F.P + (size_t)row * PLD + slot + 4 * F.lane + 256 * j); v[j] = (f32x4){bf_lo(w.x), bf_hi(w.x), bf_lo(w.y), bf_hi(w.y)}; }
        return; }
#pragma unroll
    for (int j = 0; j < 4; ++j) v[j] = (f32x4){0.f, 0.f, 0.f, 0.f};
    for (int s = 0; s < ns; ++s) {
#pragma unroll
        for (int j = 0; j < 4; ++j) v[j] = v[j] + *(const f32x4*)slab_at(F, m, slab0 + s, row - MP, 4 * F.lane + 256 * j); }
}
__device__ __forceinline__ void rowphase0(const Frame& F) {
    const int gw = F.vcu * NWAVES + F.wave, NGW = F.G * NWAVES; const float* g0 = F.in[I_NG];
    f32x4 g[4]; load_row16(g0, F.lane, g);
    for (int row = gw; row < MT; row += NGW) {
        f32x4 v[4]; load_row16(xrow_ptr(F, row), F.lane, v);
        const float rs = rsqrtf(wave_sum(sumsq16(v)) * (1.f / D) + EPS);
#pragma unroll
        for (int j = 0; j < 4; ++j) v[j] = v[j] * rs * g[j];
        store_row16_bf16(F.P + (size_t)row * PLD + SC_XA, F.lane, v);
    }
}
__device__ __forceinline__ void rowphase1(const Frame& F) {
    const int gw = F.vcu * NWAVES + F.wave, NGW = F.G * NWAVES; const float* ng = F.in[I_NG];
    f32x4 g1[4], g2[4]; load_row16(ng + 1 * D, F.lane, g1); load_row16(ng + 2 * D, F.lane, g2);
    for (int row = gw; row < MT; row += NGW) {
        f32x4 f[4], x[4]; load_row16_f(F, row, SC_F, SLAB_D, 0, 22, f); load_row16(xrow_ptr(F, row), F.lane, x);
        const float rs = rsqrtf(wave_sum(sumsq16(f)) * (1.f / D) + EPS);
#pragma unroll
        for (int j = 0; j < 4; ++j) x[j] = x[j] + 0.5f * (f[j] * rs * g1[j]);
        float* o = F.out + (size_t)row * D;
#pragma unroll
        for (int j = 0; j < 4; ++j) *(f32x4*)(o + 4 * F.lane + 256 * j) = x[j];
        const float rs2 = rsqrtf(wave_sum(sumsq16(x)) * (1.f / D) + EPS);
#pragma unroll
        for (int j = 0; j < 4; ++j) x[j] = x[j] * rs2 * g2[j];
        store_row16_bf16(F.U + (size_t)row * D, F.lane, x);
    }
}
__device__ __forceinline__ void rowphase2(const Frame& F) {
    const int gw = F.vcu * NWAVES + F.wave, NGW = F.G * NWAVES; const float* ng = F.in[I_NG];
    f32x4 g3[4], g4[4]; load_row16(ng + 3 * D, F.lane, g3); load_row16(ng + 4 * D, F.lane, g4);
    for (int row = gw; row < MT; row += NGW) {
        f32x4 f[4], x[4]; load_row16_f(F, row, SC_T, SLAB_B, 4, 8, f); float* o = F.out + (size_t)row * D; load_row16(o, F.lane, x);
        const float rs = rsqrtf(wave_sum(sumsq16(f)) * (1.f / D) + EPS);
#pragma unroll
        for (int j = 0; j < 4; ++j) x[j] = x[j] + f[j] * rs * g3[j];
#pragma unroll
        for (int j = 0; j < 4; ++j) *(f32x4*)(o + 4 * F.lane + 256 * j) = x[j];
        const float rs2 = rsqrtf(wave_sum(sumsq16(x)) * (1.f / D) + EPS);
#pragma unroll
        for (int j = 0; j < 4; ++j) x[j] = x[j] * rs2 * g4[j];
        store_row16_bf16(F.P + (size_t)row * PLD + SC_XA, F.lane, x);
    }
}
__device__ __forceinline__ void rowphase3(const Frame& F) {
    const int gw = F.vcu * NWAVES + F.wave, NGW = F.G * NWAVES; const float* ng = F.in[I_NG];
    f32x4 g5[4]; load_row16(ng + 5 * D, F.lane, g5);
    for (int row = gw; row < MT; row += NGW) {
        f32x4 f[4], x[4]; load_row16_f(F, row, SC_F, SLAB_D, 0, 22, f); float* o = F.out + (size_t)row * D; load_row16(o, F.lane, x);
        const float rs = rsqrtf(wave_sum(sumsq16(f)) * (1.f / D) + EPS);
#pragma unroll
        for (int j = 0; j < 4; ++j) *(f32x4*)(o + 4 * F.lane + 256 * j) = x[j] + 0.5f * (f[j] * rs * g5[j]);
    }
}

__device__ __forceinline__ void tr_item(const float* W, int ldw, int K, int k0, int scol0, int nvalid, bf16_t* WT, int drow0, LAS float* scr, int lane, int ldt = 0) {
    if (ldt == 0) ldt = K;
    { const int c4 = lane & 7, r = lane >> 3; const bool ok = 4 * c4 < nvalid; f32x4 v[8];
#pragma unroll
      for (int i = 0; i < 8; ++i) v[i] = ok ? *(const f32x4*)(W + (size_t)(k0 + r + 8 * i) * ldw + scol0 + 4 * c4) : (f32x4){0.f, 0.f, 0.f, 0.f};
#pragma unroll
      for (int i = 0; i < 8; ++i) { LAS float* d = scr + (r + 8 * i) * 33 + 4 * c4; d[0] = v[i][0]; d[1] = v[i][1]; d[2] = v[i][2]; d[3] = v[i][3]; } }
    LDS_WAIT(); asm volatile("" ::: "memory");
    const int c = lane & 7;
#pragma unroll
    for (int j = 0; j < 4; ++j) { const int n = (lane >> 3) + 8 * j; const LAS float* s = scr + (8 * c) * 33 + n;
        u32x4 o; o.x = pk2(s[0 * 33], s[1 * 33]); o.y = pk2(s[2 * 33], s[3 * 33]); o.z = pk2(s[4 * 33], s[5 * 33]); o.w = pk2(s[6 * 33], s[7 * 33]);
        *(u32x4*)(WT + (size_t)(drow0 + n) * ldt + k0 + 8 * c) = o; }
    LDS_WAIT(); asm volatile("" ::: "memory");
}
__device__ __forceinline__ void prep_wgu(const Frame& F, const float* W, bf16_t* WT, LAS float* scr, int gw, int NGW) {
    constexpr int KB = D / 64, RB = 2 * FF / 32;
    for (int it = gw; it < KB * RB; it += NGW) { const int kb = it / RB, rb = it % RB, n0 = 32 * rb, pn = n0 >> 8, bj = (n0 >> 7) & 1, j = n0 & 127;
        tr_item(W, 2 * FF, D, 64 * kb, bj * FF + 128 * pn + j, 32, WT, n0, scr, F.lane); }
}
__device__ __forceinline__ void prep_plain(const Frame& F, const float* W, int K, int N, bf16_t* WT, LAS float* scr, int gw, int NGW, int ldt = 0) {
    const int KB = K / 64, RB = N / 32;
    for (int it = gw; it < KB * RB; it += NGW) { const int kb = it / RB, rb = it % RB; tr_item(W, N, K, 64 * kb, 32 * rb, 32, WT, 32 * rb, scr, F.lane, ldt); }
}
__device__ __forceinline__ void prep_win(const Frame& F, LAS float* scr, int gw, int NGW) {
    constexpr int KB = D / 64, RB = PLD / 32;
    for (int it = gw; it < KB * RB; it += NGW) { const int kb = it / RB, rb = it % RB, n0 = 32 * rb; int sc, nv = 32;
        if (n0 < 2048) sc = n0;
        else if (n0 < 3072) sc = 4096 + (n0 - 2048);
        else if (n0 < 3584) sc = 2048 + (n0 - 3072);
        else if (n0 < 4096) sc = 2560 + (n0 - 3584);
        else if (n0 < 5120) sc = 3072 + (n0 - 4096);
        else if (n0 < 6144) sc = 5136 + (n0 - 5120);
        else if (n0 < 7168) sc = 6160 + (n0 - 6144);
        else if (n0 == 7168) { sc = 5120; nv = 16; }
        else { sc = 0; nv = 0; }
        tr_item(F.in[I_WIN], DIN, D, 64 * kb, sc, nv, F.Win_t, n0, scr, F.lane); }
}
__device__ __forceinline__ void prep_rg(const Frame& F, LAS float* scr, int gw, int NGW) {
    for (int it = gw; it < 2 * 8 * 8; it += NGW) { const int gate = it >> 6, n = (it >> 3) & 7, sub = it & 7, kb = sub >> 2, rb = sub & 3;
        tr_item(F.in[gate ? I_RWX : I_RWA] + (size_t)n * 16384, 128, 128, 64 * kb, 32 * rb, 32, F.Wrg_t + (size_t)(gate * 8 + n) * 16384, 32 * rb, scr, F.lane); }
}
}
namespace mk {
#define MFMA16(a, b, c) __builtin_amdgcn_mfma_f32_16x16x32_bf16((a), (b), (c), 0, 0, 0)
#define MFMA32(a, b, c) __builtin_amdgcn_mfma_f32_32x32x16_bf16((a), (b), (c), 0, 0, 0)
constexpr float LOG2E = 1.4426950408889634f;
__device__ __forceinline__ float bf2f(bf16_t h) { return __builtin_bit_cast(float, (unsigned)h << 16); }
__device__ __forceinline__ float ex2(float x) { return __builtin_amdgcn_exp2f(x); }
__device__ __forceinline__ float sigm(float x) { return __builtin_amdgcn_rcpf(1.0f + ex2(-LOG2E * x)); }
__device__ __forceinline__ float softplus_(float x) { return fmaxf(x, 0.f) + log1pf(__expf(-fabsf(x))); }
__device__ __forceinline__ float gelu_tanh_(float x) { return x * sigm(1.5957691216057308f * (x + 0.044715f * x * x * x)); }
__device__ __forceinline__ float silu_(float x) { return x * sigm(x); }
__device__ __forceinline__ void unpack8(const u32x4 w, float (&f)[8]) { f[0] = bf_lo(w.x); f[1] = bf_hi(w.x); f[2] = bf_lo(w.y); f[3] = bf_hi(w.y); f[4] = bf_lo(w.z); f[5] = bf_hi(w.z); f[6] = bf_lo(w.w); f[7] = bf_hi(w.w); }
__device__ __forceinline__ u32x4 pack8(const float (&f)[8]) { u32x4 w; w.x = pk2(f[0], f[1]); w.y = pk2(f[2], f[3]); w.z = pk2(f[4], f[5]); w.w = pk2(f[6], f[7]); return w; }

constexpr size_t WS_GAGG = WS_WOUT + 2 * MiB, GAGG_FLOATS = 32768 + 128, WS_RAGG = 128 * 1024;
static_assert(WS_GAGG + (size_t)96 * GAGG_FLOATS * 4 <= 256 * MiB && WS_RAGG + 512 * 256 * 4 <= WS_P, "mixer scratch map");

#ifdef TIME_RSUB
#define RT(k) do { if (!SAMPLE && MODE == 3 && F.vcu == 200) { const unsigned long long now_ = __builtin_amdgcn_s_memrealtime(); volatile LAS unsigned long long* tq_ = (volatile LAS unsigned long long*)(F.lds + MISC_OFF + 64); if ((k) == TIME_RSUB && F.tid == 0) tq_[0] += now_ - tq_[1]; if (F.tid == 0) tq_[1] = now_; } } while (0)
#else
#define RT(k) do {} while (0)
#endif
template <bool SAMPLE, int MODE>
__device__ __forceinline__ void rnn_item(const Frame& F, int item) {
    constexpr int XRAW_OFF = 0, XRAW_LD = 136, XCF_OFF = 18432, XCF_LD = 132, XCB_OFF = 52224, XCB_LD = 136, HB_OFF = 69632, CW_OFF = 103424;
    constexpr bool FULL = SAMPLE || MODE == 3;
    const int tid = F.tid, lane = F.lane, wid = F.wave;
    const int seg = SAMPLE ? 0 : (MODE == 3 ? 2 * (item & 3) : (item & 7)), n = SAMPLE ? item : (MODE == 3 ? ((item >> 2) & 7) : ((item >> 3) & 7)), b = SAMPLE ? 0 : (MODE == 3 ? (item >> 5) : (item >> 6)), ch0 = 128 * n;
    LAS bf16_t* XRAW = (LAS bf16_t*)(F.lds + XRAW_OFF); LAS float* XCF = (LAS float*)(F.lds + XCF_OFF); LAS bf16_t* XCB = (LAS bf16_t*)(F.lds + XCB_OFF);
    LAS float* HB = (LAS float*)(F.lds + HB_OFF); LAS float* CW = (LAS float*)(F.lds + CW_OFF);
    for (int i = tid; i < 5 * 128; i += NTHR) { const int j = i >> 7, c = i & 127; CW[i] = j < 4 ? F.in[I_CW][j * D + ch0 + c] : F.in[I_CB][ch0 + c]; }
    const int q = lane >> 4, cl = 16 * wid + (lane & 15);
    const float ba = F.in[I_RBA][ch0 + cl], bx = F.in[I_RBX][ch0 + cl], sp8 = 8.0f * softplus_(-F.in[I_LAM][ch0 + cl]), sp8l2 = sp8 * LOG2E;
    bf16x8 Bw[2][4];
#pragma unroll
    for (int g = 0; g < 2; ++g)
#pragma unroll
        for (int ks = 0; ks < 4; ++ks) Bw[g][ks] = *(const bf16x8*)(F.Wrg_t + ((size_t)(g * 8 + n) * 128 + cl) * 128 + 32 * ks + 8 * q);
    const int t5 = tid >> 3, c5 = 16 * (tid & 7);
    float* ragg = (float*)(F.ws + WS_RAGG);
    float carry = 0.f, aprod = 1.f;
    if constexpr (!SAMPLE && MODE == 3) {
        float fa[7], fh[7];
#pragma unroll
        for (int s = 0; s < 7; ++s) { const float* ag = ragg + ((size_t)((b * 8 + n) * 8 + s)) * 256; fa[s] = s < seg ? ag[cl] : 1.f; fh[s] = s < seg ? ag[128 + cl] : 0.f; }
#pragma unroll
        for (int s = 0; s < 7; ++s) carry = fmaf(fa[s], carry, fh[s]);
    }
    const int ntiles = SAMPLE ? 2 : (MODE == 3 ? 8 : 4), tile0 = SAMPLE ? 0 : 4 * seg;
    u32x4 pxr[3], py0 = (u32x4){0u, 0u, 0u, 0u}, py1 = py0;
    auto prefetch = [&](int t0n) {
        if constexpr (!SAMPLE) {
#pragma unroll
            for (int i3 = 0; i3 < 3; ++i3) { const int e = tid + NTHR * i3, i = e >> 4, chk = e & 15, t = t0n - 3 + i; pxr[i3] = (u32x4){0u, 0u, 0u, 0u};
                if (e < 67 * 16 && t >= 0) pxr[i3] = *(const u32x4*)(F.P + ((size_t)b * TSEQ + t) * PLD + PC_XR + ch0 + 8 * chk); }
            if constexpr (FULL) { const bf16_t* yp = F.P + ((size_t)b * TSEQ + t0n + t5) * PLD + PC_YR + ch0 + c5; py0 = *(const u32x4*)yp; py1 = *(const u32x4*)(yp + 8); }
        }
    };
    if constexpr (!SAMPLE) prefetch(64 * tile0);
    __syncthreads();
    for (int tt = 0; tt < ntiles; ++tt) {
        RT(0);
        const int t0 = 64 * (tile0 + tt);
        const size_t row5 = SAMPLE ? (size_t)(MP + t0 + t5) : (size_t)b * TSEQ + t0 + t5;
        bf16_t* yrp = F.P + row5 * PLD + PC_YR + ch0 + c5;
        u32x4 y0 = py0, y1 = py1;
        if constexpr (SAMPLE) { y0 = *(const u32x4*)yrp; y1 = *(const u32x4*)(yrp + 8); }
        if constexpr (!SAMPLE) {
#pragma unroll
            for (int i3 = 0; i3 < 3; ++i3) { const int e = tid + NTHR * i3, i = e >> 4, chk = e & 15; if (e < 67 * 16) *(LAS u32x4*)(XRAW + i * XRAW_LD + 8 * chk) = pxr[i3]; }
            __syncthreads(); RT(1);
            if (tt + 1 < ntiles) prefetch(t0 + 64);
            const int c0 = 8 * (tid & 15);
            float w[4][8], cb8[8];
#pragma unroll
            for (int e = 0; e < 8; ++e) { cb8[e] = CW[4 * 128 + c0 + e];
#pragma unroll
                for (int j = 0; j < 4; ++j) w[j][e] = CW[j * 128 + c0 + e]; }
#pragma unroll
            for (int rr = 0; rr < 2; ++rr) { const int t = (tid >> 4) + 32 * rr; float xc[8];
#pragma unroll
                for (int e = 0; e < 8; ++e) xc[e] = cb8[e];
#pragma unroll
                for (int j = 0; j < 4; ++j) { float x[8]; unpack8(*(const LAS u32x4*)(XRAW + (t + j) * XRAW_LD + c0), x);
#pragma unroll
                    for (int e = 0; e < 8; ++e) xc[e] = fmaf(w[j][e], x[e], xc[e]); }
                *(LAS f32x4*)(XCF + t * XCF_LD + c0) = (f32x4){xc[0], xc[1], xc[2], xc[3]}; *(LAS f32x4*)(XCF + t * XCF_LD + c0 + 4) = (f32x4){xc[4], xc[5], xc[6], xc[7]};
                *(LAS u32x4*)(XCB + t * XCB_LD + c0) = pack8(xc); }
        } else {
            const int s = t0 + t5; const bf16_t* xrp = F.P + (size_t)(MP + s) * PLD + PC_XR + ch0 + c5;
            float xr[16]; { float a8[8], b8[8]; unpack8(*(const u32x4*)xrp, a8); unpack8(*(const u32x4*)(xrp + 8), b8);
#pragma unroll
                for (int e = 0; e < 8; ++e) { xr[e] = a8[e]; xr[8 + e] = b8[e]; } }
            const float* bufp = F.in[I_SRC] + (size_t)s * 3 * D + ch0 + c5; float* csp = F.out + O_CS + (size_t)s * 3 * D + ch0 + c5;
            float xc[16];
#pragma unroll
            for (int e = 0; e < 16; ++e) xc[e] = CW[4 * 128 + c5 + e] + CW[3 * 128 + c5 + e] * xr[e];
#pragma unroll
            for (int j = 0; j < 3; ++j)
#pragma unroll
                for (int v4 = 0; v4 < 4; ++v4) { const f32x4 bv = *(const f32x4*)(bufp + j * D + 4 * v4);
#pragma unroll
                    for (int e = 0; e < 4; ++e) xc[4 * v4 + e] = fmaf(CW[j * 128 + c5 + 4 * v4 + e], bv[e], xc[4 * v4 + e]);
                    if (j >= 1) *(f32x4*)(csp + (j - 1) * D + 4 * v4) = bv; }
#pragma unroll
            for (int v4 = 0; v4 < 4; ++v4) { *(f32x4*)(csp + 2 * D + 4 * v4) = (f32x4){xr[4 * v4], xr[4 * v4 + 1], xr[4 * v4 + 2], xr[4 * v4 + 3]};
                *(LAS f32x4*)(XCF + t5 * XCF_LD + c5 + 4 * v4) = (f32x4){xc[4 * v4], xc[4 * v4 + 1], xc[4 * v4 + 2], xc[4 * v4 + 3]}; }
            { float h8[8];
#pragma unroll
              for (int hf = 0; hf < 2; ++hf) {
#pragma unroll
                for (int e = 0; e < 8; ++e) h8[e] = xc[8 * hf + e];
                *(LAS u32x4*)(XCB + t5 * XCB_LD + c5 + 8 * hf) = pack8(h8); } }
        }
        __syncthreads(); RT(2);
        f32x4 acc[4][2];
#pragma unroll
        for (int m = 0; m < 4; ++m) { acc[m][0] = (f32x4){0.f, 0.f, 0.f, 0.f}; acc[m][1] = (f32x4){0.f, 0.f, 0.f, 0.f}; }
#pragma unroll
        for (int m = 0; m < 4; ++m)
#pragma unroll
            for (int ks = 0; ks < 4; ++ks) { const bf16x8 a = *(const LAS bf16x8*)(XCB + (16 * m + (lane & 15)) * XCB_LD + 32 * ks + 8 * q);
                acc[m][0] = MFMA16(a, Bw[0][ks], acc[m][0]); acc[m][1] = MFMA16(a, Bw[1][ks], acc[m][1]); }
#pragma unroll
        for (int m = 0; m < 4; ++m) {
            float av[4], bv[4];
#pragma unroll
            for (int reg = 0; reg < 4; ++reg) { const int t = 16 * m + 4 * q + reg; const float xcv = XCF[t * XCF_LD + cl];
                const float r = sigm(acc[m][0][reg] + ba), ig = sigm(acc[m][1][reg] + bx);
                const float x2 = -2.0f * sp8 * r;
                const float em = -x2 * (1.0f + x2 * (0.5f + x2 * (0.16666667f + x2 * (0.041666668f + x2 * (0.0083333338f + x2 * 0.0013888889f)))));
                float mult = __builtin_amdgcn_sqrtf(fmaxf(em, 0.f)); if (!SAMPLE && (t0 + t) == 0) mult = 1.0f;
                av[reg] = ex2(-sp8l2 * r); bv[reg] = mult * ig * xcv; }
            if constexpr (!SAMPLE) {
                float Al = 1.f, Hl = 0.f;
#pragma unroll
                for (int reg = 0; reg < 4; ++reg) { Hl = fmaf(av[reg], Hl, bv[reg]); Al *= av[reg]; }
                float hin = carry, cn = carry;
#pragma unroll
                for (int qq = 0; qq < 4; ++qq) { const float Ag = __shfl(Al, (lane & 15) + 16 * qq), Hg = __shfl(Hl, (lane & 15) + 16 * qq);
                    cn = fmaf(Ag, cn, Hg); hin = (qq < q) ? cn : hin; if (MODE == 1) aprod *= Ag; }
                carry = cn;
                if constexpr (MODE == 3) { float hv = hin;
#pragma unroll
                    for (int reg = 0; reg < 4; ++reg) { hv = fmaf(av[reg], hv, bv[reg]); HB[(16 * m + 4 * q + reg) * XCF_LD + cl] = hv; } }
            } else {
#pragma unroll
                for (int reg = 0; reg < 4; ++reg) { const int t = 16 * m + 4 * q + reg; const float h0 = F.in[I_SRH][(size_t)(t0 + t) * D + ch0 + cl];
                    HB[t * XCF_LD + cl] = fmaf(av[reg], h0, bv[reg]); }
            }
        }
        __syncthreads(); RT(3);
        if constexpr (FULL) {
            float h[16], yv[16], o8[8];
#pragma unroll
            for (int v4 = 0; v4 < 4; ++v4) { const f32x4 hv = *(const LAS f32x4*)(HB + t5 * XCF_LD + c5 + 4 * v4); h[4 * v4] = hv[0]; h[4 * v4 + 1] = hv[1]; h[4 * v4 + 2] = hv[2]; h[4 * v4 + 3] = hv[3]; }
            { float a8[8], b8[8]; unpack8(y0, a8); unpack8(y1, b8);
#pragma unroll
              for (int e = 0; e < 8; ++e) { yv[e] = a8[e]; yv[8 + e] = b8[e]; } }
            if constexpr (SAMPLE) { float* hsp = F.out + O_HS + (size_t)(t0 + t5) * D + ch0 + c5;
#pragma unroll
                for (int v4 = 0; v4 < 4; ++v4) *(f32x4*)(hsp + 4 * v4) = (f32x4){h[4 * v4], h[4 * v4 + 1], h[4 * v4 + 2], h[4 * v4 + 3]}; }
#pragma unroll
            for (int hf = 0; hf < 2; ++hf) {
#pragma unroll
                for (int e = 0; e < 8; ++e) o8[e] = h[8 * hf + e] * gelu_tanh_(yv[8 * hf + e]);
                *(u32x4*)(yrp + 8 * hf) = pack8(o8); }
            if constexpr (!SAMPLE) { if (tile0 + tt == 31 && t5 >= 61) { float* cpp = F.out + O_CP + ((size_t)b * 3 + (t5 - 61)) * D + ch0 + c5;
#pragma unroll
                for (int e = 0; e < 16; ++e) cpp[e] = bf2f(XRAW[(t5 + 3) * XRAW_LD + c5 + e]); } }
        }
        RT(4);
    }
    if constexpr (!SAMPLE && MODE == 1) { if (q == 0) { float* ag = ragg + (size_t)item * 256; ag[cl] = aprod; ag[128 + cl] = carry; } }
    if constexpr (!SAMPLE && MODE == 3) { if (seg == 6 && q == 0) F.out[O_HP + (size_t)b * D + ch0 + cl] = carry; }
    __syncthreads();
}

__device__ __forceinline__ int crow(int reg, int h) { return (reg & 3) + 8 * (reg >> 2) + 4 * h; }
__device__ __forceinline__ bf16x8 pack_step(const f32x16& x, int s) {
    u32x4 p; p.x = pk2(x[8 * s], x[8 * s + 1]); p.y = pk2(x[8 * s + 2], x[8 * s + 3]); p.z = pk2(x[8 * s + 4], x[8 * s + 5]); p.w = pk2(x[8 * s + 6], x[8 * s + 7]);
    return __builtin_bit_cast(bf16x8, p);
}
#ifdef TIME_SUB
#define GT(k) do { if (MODE == 3 && F.vcu == 0) { const unsigned long long now_ = __builtin_amdgcn_s_memrealtime(); volatile LAS unsigned long long* tq_ = (volatile LAS unsigned long long*)(F.lds + MISC_OFF + 64); if ((k) == TIME_SUB && F.tid == 0) tq_[0] += now_ - tq_[1]; if (F.tid == 0) tq_[1] = now_; } } while (0)
#else
#define GT(k) do {} while (0)
#endif
template <int MODE>
__device__ __forceinline__ void gla_item(const Frame& F, int item) {
    constexpr int VRAW = 0, VRAW_LD = 264, LRS = 33792, QI = 37888, QK_LD = 136, KI = 55296, OBUF = 72704, OGT = 0, KET = 72704, T_LD = 72, VT = 91136, ATT = 128000, SEG = 137216, DEC = 139264, WLS = 139776;
    static_assert(WLS + 17 * 512 <= MISC_OFF, "GLA LDS map");
    constexpr bool FULL = (MODE == 3);
    const int tid = F.tid, lane = F.lane, w = F.wave;
    const int j = item & 3, hh = (item >> 2) & 3, b = item >> 4; const size_t rowbase = (size_t)b * TSEQ;
    LAS bf16_t* sVRAW = (LAS bf16_t*)(F.lds + VRAW); LAS bf16_t* sQI = (LAS bf16_t*)(F.lds + QI); LAS bf16_t* sKI = (LAS bf16_t*)(F.lds + KI);
    LAS float* sO = (LAS float*)(F.lds + OBUF); LAS bf16_t* sKET = (LAS bf16_t*)(F.lds + KET); LAS bf16_t* sVT = (LAS bf16_t*)(F.lds + VT); LAS bf16_t* sATT = (LAS bf16_t*)(F.lds + ATT);
    LAS float* sSEG = (LAS float*)(F.lds + SEG); LAS float* sDEC = (LAS float*)(F.lds + DEC);
    const int kk = tid & 127, seg = tid >> 7;
    LAS bf16_t* sLRb = (LAS bf16_t*)(F.lds + LRS); LAS float* sG = (LAS float*)(F.lds + QI);
    bf16x8 Bwl; { float wv[8];
#pragma unroll
        for (int jj = 0; jj < 8; ++jj) wv[jj] = (lane >> 4) < 2 ? F.in[I_WLR][(8 * (lane >> 4) + jj) * 512 + hh * 128 + 16 * w + (lane & 15)] : 0.f;
        Bwl = __builtin_bit_cast(bf16x8, pack8(wv)); }
    const float bias = F.in[I_BLR][hh * 128 + kk];
    const int r32 = lane & 31, h = lane >> 5, q = lane >> 4;
    float* gagg = (float*)(F.ws + WS_GAGG);
    f32x16 S[4];
#pragma unroll
    for (int kb = 0; kb < 4; ++kb)
#pragma unroll
        for (int i = 0; i < 16; ++i) S[kb][i] = 0.f;
    float dsum = 0.f;
    if constexpr (FULL) {
        for (int s = 0; s < j; ++s) { const float* ag = gagg + (size_t)((b * 4 + hh) * 3 + s) * GAGG_FLOATS;
            __syncthreads();
            if (tid < 128) sDEC[tid] = ag[32768 + tid];
            __syncthreads();
#pragma unroll
            for (int kb = 0; kb < 4; ++kb) {
#pragma unroll
                for (int g4 = 0; g4 < 4; ++g4) { const f32x4 kv = *(const f32x4*)(ag + ((size_t)((w * 4 + kb) * 4 + g4)) * 256 + 4 * lane); const f32x4 dd = *(const LAS f32x4*)(sDEC + 32 * kb + 8 * g4 + 4 * h);
#pragma unroll
                    for (int e = 0; e < 4; ++e) S[kb][4 * g4 + e] = fmaf(S[kb][4 * g4 + e], dd[e], kv[e]); }
            asm volatile("" ::: "memory"); }
        }
    }
    const char* Pb = (const char*)F.P;
    const unsigned ov = (unsigned)(((tid >> 5) * PLD + PC_V + 256 * hh + 8 * (tid & 31)) * 2), olr = (unsigned)(((tid >> 1) * PLD + PC_LR + 8 * (tid & 1)) * 2);
    const unsigned okq = (unsigned)(((tid >> 4) * PLD + 128 * hh + 8 * (tid & 15)) * 2), oog = (unsigned)((8 * w * PLD + PC_OG + 256 * hh + 4 * lane) * 2);
    LAS bf16_t* sQR = (LAS bf16_t*)(F.lds + VRAW); LAS bf16_t* sKR = (LAS bf16_t*)(F.lds + VRAW + 16384);
    u32x4 pv[4], plr = (u32x4){0u, 0u, 0u, 0u}, pk[2], pq[2];
    auto prefetch = [&](size_t r0) {
        const char* rb = Pb + r0 * (size_t)(PLD * 2);
        unsigned o1 = ov, o2 = olr, o3 = okq; asm volatile("" : "+v"(o1), "+v"(o2), "+v"(o3));
#pragma unroll
        for (int i = 0; i < 4; ++i) pv[i] = *(const u32x4*)(rb + (o1 + (unsigned)(i * 16 * PLD * 2)));
        if (tid < 128) plr = *(const u32x4*)(rb + o2);
#pragma unroll
        for (int i = 0; i < 2; ++i) pk[i] = *(const u32x4*)(rb + (o3 + (unsigned)((i * 32 * PLD + PC_K) * 2)));
    };
    prefetch(rowbase + 64 * (8 * j));
    __syncthreads();
    for (int cn = 8 * j; cn < 8 * j + 8; ++cn) {
        const size_t row0 = rowbase + 64 * cn;
        GT(0);
        if constexpr (FULL) { const char* rb = Pb + row0 * (size_t)(PLD * 2); unsigned o3 = okq; asm volatile("" : "+v"(o3));
#pragma unroll
            for (int i = 0; i < 2; ++i) pq[i] = *(const u32x4*)(rb + (o3 + (unsigned)((i * 32 * PLD + PC_Q) * 2))); }
#pragma unroll
        for (int i = 0; i < 4; ++i) { const int e = tid + NTHR * i, row = e >> 5, c16 = e & 31; *(LAS u32x4*)(sVRAW + row * VRAW_LD + 8 * c16) = pv[i]; }
        if (tid < 128) { *(LAS u32x4*)(sLRb + (tid >> 1) * 32 + 8 * (tid & 1)) = plr; *(LAS u32x4*)(sLRb + (tid >> 1) * 32 + 16 + 8 * (tid & 1)) = (u32x4){0u, 0u, 0u, 0u}; }
        __syncthreads(); GT(1);
#pragma unroll
        for (int m = 0; m < 4; ++m) { const bf16x8 a = *(const LAS bf16x8*)(sLRb + (16 * m + (lane & 15)) * 32 + 8 * q); const f32x4 cg = MFMA16(a, Bwl, ((f32x4){0.f, 0.f, 0.f, 0.f}));
#pragma unroll
            for (int reg = 0; reg < 4; ++reg) sG[(16 * m + 4 * q + reg) * 128 + 16 * w + (lane & 15)] = cg[reg]; }
        { const int dv = tid & 255, hf = tid >> 8;
#pragma unroll
          for (int s8 = 0; s8 < 4; ++s8) { const int s = 32 * hf + 8 * s8; u32x4 wv; unsigned t[8];
#pragma unroll
              for (int jj = 0; jj < 8; ++jj) t[jj] = sVRAW[(s + jj) * VRAW_LD + dv];
              wv.x = t[0] | (t[1] << 16); wv.y = t[2] | (t[3] << 16); wv.z = t[4] | (t[5] << 16); wv.w = t[6] | (t[7] << 16);
              *(LAS u32x4*)(sVT + dv * T_LD + s) = wv; } }
        __syncthreads(); GT(2);
        float c[16]; float run = 0.f;
#pragma unroll
        for (int i = 0; i < 16; ++i) { float x = sG[(16 * seg + i) * 128 + kk] + bias;
            x = fminf(fmaxf(x, -80.f), 80.f);
            run -= __builtin_amdgcn_logf(1.0f + ex2(-LOG2E * x)) * (1.0f / 16.0f);
            c[i] = run; }
        sSEG[seg * 128 + kk] = run;
#pragma unroll
        for (int i = 0; i < 2; ++i) { const int rowq = (tid >> 4) + 32 * i, cq = 8 * (tid & 15); *(LAS u32x4*)(sKR + rowq * 128 + cq) = pk[i]; if constexpr (FULL) *(LAS u32x4*)(sQR + rowq * 128 + cq) = pq[i]; }
        __syncthreads(); GT(3);
        if (cn + 1 < 8 * j + 8) prefetch(row0 + 64);
        { float off = 0.f, tot = 0.f;
#pragma unroll
          for (int s2 = 0; s2 < 4; ++s2) { const float v = sSEG[s2 * 128 + kk]; tot += v; off += (s2 < seg) ? v : 0.f; }
          const float dec = ex2(tot);
          if (seg == 0) { sDEC[kk] = dec; dsum += tot; }
          float ke[16];
#pragma unroll
          for (int i = 0; i < 16; ++i) { const int t = 16 * seg + i; const float bc = off + c[i]; const float eb = ex2(bc), ei = __builtin_amdgcn_rcpf(eb); const float kf = bf2f(sKR[t * 128 + kk]) * ei;
              ke[i] = kf * dec;
              if constexpr (FULL) { sQI[t * QK_LD + kk] = (bf16_t)(pk2(bf2f(sQR[t * 128 + kk]) * 0.08838834764831845f * eb, 0.f) & 0xffffu); sKI[t * QK_LD + kk] = (bf16_t)(pk2(kf, 0.f) & 0xffffu); } }
          { float a8[8], b8[8];
#pragma unroll
            for (int e = 0; e < 8; ++e) { a8[e] = ke[e]; b8[e] = ke[8 + e]; }
            *(LAS u32x4*)(sKET + kk * T_LD + 16 * seg) = pack8(a8); *(LAS u32x4*)(sKET + kk * T_LD + 16 * seg + 8) = pack8(b8); } }
        __syncthreads(); GT(4);
        if constexpr (FULL) {
            const char* gp = Pb + (row0 + 8 * w) * (size_t)(PLD * 2) + (size_t)((PC_OG + 256 * hh) * 2); unsigned o5 = (unsigned)((lane >> 5) * PLD * 2 + (lane & 31) * 16); asm volatile("" : "+v"(o5));
#pragma unroll
            for (int i = 0; i < 4; ++i) __builtin_amdgcn_global_load_lds((const unsigned*)(gp + (o5 + (unsigned)(2 * i * PLD * 2))), (LAS unsigned*)(F.lds + OGT + w * 4096 + i * 1024), 16, 0, 0); }
        if constexpr (FULL) {
#pragma unroll
            for (int u = 0; u < 2; ++u) { const int T = 2 * w + u, ti = T >> 2, si = T & 3; f32x4 cc = (f32x4){0.f, 0.f, 0.f, 0.f};
                if (si <= ti) {
#pragma unroll
                    for (int ks = 0; ks < 4; ++ks) { const bf16x8 a = *(const LAS bf16x8*)(sKI + (16 * si + (lane & 15)) * QK_LD + 32 * ks + 8 * q), bq = *(const LAS bf16x8*)(sQI + (16 * ti + (lane & 15)) * QK_LD + 32 * ks + 8 * q);
                        cc = MFMA16(a, bq, cc); } }
                const int t = 16 * ti + (lane & 15), s0 = 16 * si + 4 * q; float v[4];
#pragma unroll
                for (int reg = 0; reg < 4; ++reg) v[reg] = (s0 + reg <= t) ? cc[reg] : 0.f;
                u32x2 wv; wv.x = pk2(v[0], v[1]); wv.y = pk2(v[2], v[3]); *(LAS u32x2*)(sATT + t * T_LD + s0) = wv; }
            asm volatile("s_waitcnt lgkmcnt(0)" ::: "memory"); __builtin_amdgcn_s_barrier(); asm volatile("" ::: "memory"); GT(5);
        }
        bf16x8 vf[4];
#pragma unroll
        for (int st = 0; st < 4; ++st) vf[st] = *(const LAS bf16x8*)(sVT + (32 * w + r32) * T_LD + 16 * st + 8 * h);
        f32x16 o[2];
        if constexpr (FULL) {
#pragma unroll
            for (int i = 0; i < 16; ++i) { o[0][i] = 0.f; o[1][i] = 0.f; }
#pragma unroll
            for (int kb = 0; kb < 4; ++kb)
#pragma unroll
                for (int s2 = 0; s2 < 2; ++s2) { const bf16x8 Bf = pack_step(S[kb], s2);
#pragma unroll
                    for (int tb = 0; tb < 2; ++tb) { const LAS bf16_t* qp = sQI + (32 * tb + r32) * QK_LD + 32 * kb + 16 * s2 + 4 * h; const u32x2 lo = *(const LAS u32x2*)qp, hi = *(const LAS u32x2*)(qp + 8);
                        const u32x4 af = (u32x4){lo.x, lo.y, hi.x, hi.y}; o[tb] = MFMA32(__builtin_bit_cast(bf16x8, af), Bf, o[tb]); }
                    }
#pragma unroll
            for (int tb = 0; tb < 2; ++tb)
#pragma unroll
                for (int st = 0; st < 4; ++st) { if (tb == 0 && st >= 2) continue; const bf16x8 af = *(const LAS bf16x8*)(sATT + (32 * tb + r32) * T_LD + 16 * st + 8 * h); o[tb] = MFMA32(af, vf[st], o[tb]); }
        }
#pragma unroll
        for (int kb = 0; kb < 4; ++kb) {
#pragma unroll
            for (int g4 = 0; g4 < 4; ++g4) { const f32x4 dd = *(const LAS f32x4*)(sDEC + 32 * kb + 8 * g4 + 4 * h);
#pragma unroll
                for (int e = 0; e < 4; ++e) S[kb][4 * g4 + e] *= dd[e]; }
#pragma unroll
            for (int st = 0; st < 4; ++st) { const bf16x8 af = *(const LAS bf16x8*)(sKET + (32 * kb + r32) * T_LD + 16 * st + 8 * h); S[kb] = MFMA32(af, vf[st], S[kb]); } }
        if constexpr (FULL) { asm volatile("s_waitcnt lgkmcnt(0)" ::: "memory"); __builtin_amdgcn_s_barrier(); asm volatile("" ::: "memory"); } else __syncthreads();
        GT(6);
        if constexpr (FULL) {
#pragma unroll
            for (int tb = 0; tb < 2; ++tb)
#pragma unroll
                for (int i = 0; i < 16; ++i) sO[(32 * tb + crow(i, h)) * 256 + 32 * w + r32] = o[tb][i];
            __syncthreads(); GT(7);
            const f32x4 gn = *(const f32x4*)(F.in[I_GNG] + 4 * lane);
#pragma unroll
            for (int jj = 0; jj < 8; ++jj) { const int t = 8 * w + jj; const f32x4 v = *(const LAS f32x4*)(sO + t * 256 + 4 * lane);
                const float rs = __builtin_amdgcn_rsqf(wave_sum((v[0] * v[0] + v[1] * v[1]) + (v[2] * v[2] + v[3] * v[3])) * (1.0f / 256.0f) + EPS);
                const u32x2 ogw = *(const LAS u32x2*)(F.lds + OGT + w * 4096 + jj * 512 + lane * 8); const float g0 = bf_lo(ogw.x), g1 = bf_hi(ogw.x), g2 = bf_lo(ogw.y), g3 = bf_hi(ogw.y);
                u32x2 wv; wv.x = pk2(v[0] * rs * gn[0] * silu_(g0), v[1] * rs * gn[1] * silu_(g1)); wv.y = pk2(v[2] * rs * gn[2] * silu_(g2), v[3] * rs * gn[3] * silu_(g3));
                *(u32x2*)(const_cast<char*>(Pb) + row0 * (size_t)(PLD * 2) + (oog + (unsigned)(jj * PLD * 2))) = wv; }
            __syncthreads(); GT(8);
        }
    }
    if constexpr (!FULL) {
        float* ag = gagg + (size_t)((b * 4 + hh) * 3 + j) * GAGG_FLOATS;
#pragma unroll
        for (int kb = 0; kb < 4; ++kb)
#pragma unroll
            for (int g4 = 0; g4 < 4; ++g4) *(f32x4*)(ag + ((size_t)((w * 4 + kb) * 4 + g4)) * 256 + 4 * lane) = (f32x4){S[kb][4 * g4], S[kb][4 * g4 + 1], S[kb][4 * g4 + 2], S[kb][4 * g4 + 3]};
        if (seg == 0) ag[32768 + kk] = ex2(dsum);
    } else if (j == 3) {
        float* sp = F.out + O_SP + (size_t)(b * 4 + hh) * 128 * 256;
#pragma unroll
        for (int kb = 0; kb < 4; ++kb)
#pragma unroll
            for (int i = 0; i < 16; ++i) sp[(size_t)(32 * kb + crow(i, h)) * 256 + 32 * w + r32] = S[kb][i];
    }
    __syncthreads();
}

__device__ __forceinline__ void gla_sample_item(const Frame& F, int item) {
    constexpr int SQ = 0, SK = 512, SE = 1024, RED = 2048;
    const int tid = F.tid, lane = F.lane, w = F.wave; const int hh = item & 3, s = item >> 2;
    LAS float* sq = (LAS float*)(F.lds + SQ); LAS float* sk = (LAS float*)(F.lds + SK); LAS float* se = (LAS float*)(F.lds + SE); LAS float* red = (LAS float*)(F.lds + RED);
    const bf16_t* Prow = F.P + (size_t)(MP + s) * PLD;
    if (tid < 128) { float x = F.in[I_BLR][hh * 128 + tid];
#pragma unroll
        for (int r = 0; r < 16; ++r) x = fmaf(bf2f(Prow[PC_LR + r]), F.in[I_WLR][r * 512 + hh * 128 + tid], x);
        se[tid] = __expf(-softplus_(-x) * (1.0f / 16.0f)); sq[tid] = bf2f(Prow[PC_Q + 128 * hh + tid]) * 0.08838834764831845f; sk[tid] = bf2f(Prow[PC_K + 128 * hh + tid]); }
    __syncthreads();
    const u32x2 vw = *(const u32x2*)(Prow + PC_V + 256 * hh + 4 * lane); const f32x4 v4 = (f32x4){bf_lo(vw.x), bf_hi(vw.x), bf_lo(vw.y), bf_hi(vw.y)};
    const float* S0 = F.in[I_SGLA] + ((size_t)(s * 4 + hh) * 128 + 16 * w) * 256 + 4 * lane; float* S1 = F.out + O_SS + ((size_t)(s * 4 + hh) * 128 + 16 * w) * 256 + 4 * lane;
    f32x4 o4 = (f32x4){0.f, 0.f, 0.f, 0.f};
    f32x4 sv[16];
#pragma unroll
    for (int jj = 0; jj < 16; ++jj) sv[jj] = __builtin_nontemporal_load((const f32x4*)(S0 + jj * 256));
#pragma unroll
    for (int jj = 0; jj < 16; ++jj) { const int k = 16 * w + jj; const f32x4 sn = sv[jj] * se[k] + v4 * sk[k]; __builtin_nontemporal_store(sn, (f32x4*)(S1 + jj * 256)); o4 = o4 + sn * sq[k]; }
    *(LAS f32x4*)(red + w * 256 + 4 * lane) = o4;
    __syncthreads();
    if (w == 0) { f32x4 o = (f32x4){0.f, 0.f, 0.f, 0.f};
#pragma unroll
        for (int ww = 0; ww < 8; ++ww) o = o + *(const LAS f32x4*)(red + ww * 256 + 4 * lane);
        const float rs = rsqrtf(wave_sum((o[0] * o[0] + o[1] * o[1]) + (o[2] * o[2] + o[3] * o[3])) * (1.0f / 256.0f) + EPS);
        const f32x4 gn = *(const f32x4*)(F.in[I_GNG] + 4 * lane); bf16_t* ogp = F.P + (size_t)(MP + s) * PLD + PC_OG + 256 * hh + 4 * lane; const u32x2 ogw = *(const u32x2*)ogp;
        u32x2 wv; wv.x = pk2(o[0] * rs * gn[0] * silu_(bf_lo(ogw.x)), o[1] * rs * gn[1] * silu_(bf_hi(ogw.x))); wv.y = pk2(o[2] * rs * gn[2] * silu_(bf_lo(ogw.y)), o[3] * rs * gn[3] * silu_(bf_hi(ogw.y)));
        *(u32x2*)ogp = wv; }
    __syncthreads();
}

template <int APROV>
__device__ __forceinline__ void skinny_piece(const Frame& F, const bf16_t* A, int lda, const bf16_t* Bt, int K, int k0, int nsub, int cb, const SlabMap om, int oslab) {
    constexpr int SA = 0, SB = 34816, LD = 136;
    const int tid = F.tid, lane = F.lane, w = F.wave, fr = lane & 15, fq = lane >> 4;
    LAS bf16_t* sA = (LAS bf16_t*)(F.lds + SA); LAS bf16_t* sB = (LAS bf16_t*)(F.lds + SB);
    f32x4 acc[8];
#pragma unroll
    for (int nb = 0; nb < 8; ++nb) acc[nb] = (f32x4){0.f, 0.f, 0.f, 0.f};
    for (int sub = 0; sub < nsub; ++sub) { const int kk0 = k0 + 128 * sub;
        __syncthreads();
#pragma unroll
        for (int i = 0; i < 4; ++i) { const int e = tid + NTHR * i, row = e >> 4, c16 = e & 15; u32x4 v;
            if constexpr (APROV == 0) v = *(const u32x4*)(A + (size_t)row * lda + kk0 + 8 * c16);
            else { const int cc = kk0 + 8 * c16; const bf16_t* gp = F.P + (size_t)(MP + row) * PLD + cc;
                float ga[8], gb[8], o[8]; unpack8(*(const u32x4*)(gp + PC_GA), ga); unpack8(*(const u32x4*)(gp + PC_GB), gb);
#pragma unroll
                for (int hf = 0; hf < 2; ++hf) { const f32x4 ya = *(const f32x4*)slab_at(F, SLAB_B, 0, row, cc + 4 * hf) + *(const f32x4*)slab_at(F, SLAB_B, 1, row, cc + 4 * hf), yb = *(const f32x4*)slab_at(F, SLAB_B, 2, row, cc + 4 * hf) + *(const f32x4*)slab_at(F, SLAB_B, 3, row, cc + 4 * hf);
#pragma unroll
                    for (int e2 = 0; e2 < 4; ++e2) o[4 * hf + e2] = sigm(ga[4 * hf + e2]) * ya[e2] + sigm(gb[4 * hf + e2]) * yb[e2]; }
                v = pack8(o); }
            *(LAS u32x4*)(sA + row * LD + 8 * c16) = v;
            *(LAS u32x4*)(sB + row * LD + 8 * c16) = *(const u32x4*)(Bt + (size_t)(128 * cb + row) * K + kk0 + 8 * c16); }
        __syncthreads();
        bf16x8 a[4];
#pragma unroll
        for (int s = 0; s < 4; ++s) a[s] = *(const LAS bf16x8*)(sA + (16 * w + fr) * LD + 32 * s + 8 * fq);
#pragma unroll
        for (int nb = 0; nb < 8; ++nb)
#pragma unroll
            for (int s = 0; s < 4; ++s) { const bf16x8 bb = *(const LAS bf16x8*)(sB + (16 * nb + fr) * LD + 32 * s + 8 * fq); acc[nb] = MFMA16(bb, a[s], acc[nb]); }
    }
#pragma unroll
    for (int nb = 0; nb < 8; ++nb) *(f32x4*)slab_at(F, om, oslab, 16 * w + fr, 128 * cb + 16 * nb + 4 * fq) = acc[nb];
    __syncthreads();
}
}
namespace mk {
constexpr int N_PHASES = 13;
__global__ void __launch_bounds__(NTHR, 2) mega_fwd(Args args) {
    extern __shared__ __attribute__((aligned(16))) unsigned char lds_raw[];
    Frame F;
    F.lds = (LAS unsigned char*)lds_raw;
    F.tid = threadIdx.x; F.lane = F.tid & 63; F.wave = __builtin_amdgcn_readfirstlane(F.tid >> 6);
    F.G = gridDim.x; { const int bx = blockIdx.x; F.vcu = (F.G % 8 == 0) ? (bx % 8) * (F.G / 8) + bx / 8 : bx; }
#pragma unroll
    for (int i = 0; i < 24; ++i) F.in[i] = args.in[i];
    F.out = args.out; F.ws = args.ws;
    F.P = (bf16_t*)(args.ws + WS_P);
    unsigned char* ssr = (unsigned char*)(args.out + O_SS);
    F.U = (bf16_t*)(ssr + SS_U); F.Win_t = (bf16_t*)(ssr + SS_WIN); F.Wgu1_t = (bf16_t*)(ssr + SS_WGU1); F.Wd1_t = (bf16_t*)(ssr + SS_WD1);
    F.Wrg_t = (bf16_t*)(args.ws + WS_WRG); F.Wbr_t = (bf16_t*)(args.ws + WS_WBR); F.Wbg_t = (bf16_t*)(args.ws + WS_WBG); F.Wout_t = (bf16_t*)(args.ws + WS_WOUT);
    F.Wgu2_t = (bf16_t*)(args.ws + WS_WGU2); F.Wd2_t = (bf16_t*)(args.ws + WS_WD2);
    volatile LAS unsigned* MISC = (volatile LAS unsigned*)(F.lds + MISC_OFF);
    for (int u = F.tid; u < 128; u += NTHR) MISC[u] = 0u;
    __syncthreads();
    const int lo = args.ph_lo, hi = args.ph_hi;
    XcdBarrier bar; bar.bar = (unsigned*)(args.ws + WS_CTL) + CW_BAR; bar.x = 0; bar.st = nullptr;
    if (hi - lo > 1) bar = xcd_barrier_post((unsigned*)(args.ws + WS_CTL) + CW_BAR, MISC + 8);
#define IN(k) (lo <= (k) && (k) < hi)
#ifdef TIME_PHASE
    unsigned long long tp0 = __builtin_amdgcn_s_memrealtime(), tp1 = 0;
#ifdef TIME_WALL
#define SEAM(k) do { if (IN(k) && IN((k) + 1)) xcd_barrier(bar); if ((k) == TIME_PHASE) tp1 = __builtin_amdgcn_s_memrealtime(); if ((k) + 1 == TIME_PHASE) tp0 = __builtin_amdgcn_s_memrealtime(); } while (0)
#else
#define SEAM(k) do { if ((k) == TIME_PHASE) tp1 = __builtin_amdgcn_s_memrealtime(); if (IN(k) && IN((k) + 1)) xcd_barrier(bar); if ((k) + 1 == TIME_PHASE) tp0 = __builtin_amdgcn_s_memrealtime(); } while (0)
#endif
#else
#define SEAM(k) do { if (IN(k) && IN((k) + 1)) xcd_barrier(bar); } while (0)
#endif
    const int gw = F.vcu * NWAVES + F.wave, NGW = F.G * NWAVES;
    LAS float* scr = (LAS float*)(F.lds + F.wave * 16384);
    constexpr bool AL = true, SP = true;

    if (IN(0)) {
        prep_wgu(F, F.in[I_F1GU], F.Wgu1_t, scr, gw, NGW);
        prep_plain(F, F.in[I_F1D], FF, D, F.Wd1_t, scr, gw, NGW);
        rowphase0(F);
    }
    SEAM(0);
    if (IN(1)) {
        pg8::Gemm g{F.P + SC_XA, PLD, F.Wgu1_t, MPAD, 2 * FF, D}; pg8::StaticOrder S; S.init(MPAD, 2 * FF, F.G, (int)blockIdx.x);
        pg8::EpiSwiGLU E{F.P + SC_H, PLD};
        pg8::gemm_phase<pg8::EpiSwiGLU, pg8::StaticOrder, AL, SP>(F.lds, g, S, E);
        { constexpr int NU = (MPAD / 256) * (2 * FF / 256); const int full = NU % F.G;
          if (NU > F.G && full > 0 && (int)blockIdx.x >= full) prep_win(F, scr, ((int)blockIdx.x - full) * NWAVES + F.wave, (F.G - full) * NWAVES);
          else if (!(NU > F.G && full > 0)) prep_win(F, scr, gw, NGW); }
    }
    SEAM(1);
    if (IN(2)) {
        if (F.vcu < 176) skinny_piece<0>(F, F.P + (size_t)MP * PLD + SC_H, PLD, F.Wd1_t, FF, 128 * (F.vcu >> 3), 1, F.vcu & 7, SLAB_D, F.vcu >> 3);
        pg8::Gemm g{F.P + SC_H, PLD, F.Wd1_t, MP, D, FF}; pg8::StaticOrder S; S.init(MP, D, F.G, (int)blockIdx.x);
        pg8::EpiBf16 E{F.P + SC_F, PLD};
        pg8::gemm_phase<pg8::EpiBf16, pg8::StaticOrder, AL, SP>(F.lds, g, S, E);
    }
    SEAM(2);
    if (IN(3)) rowphase1(F);
    SEAM(3);
    if (IN(4)) {
        pg8::Gemm g{F.U, D, F.Win_t, MPAD, PLD, D}; pg8::StaticOrder S; S.init(MPAD, PLD, F.G, (int)blockIdx.x);
        pg8::EpiBf16 E{F.P, PLD};
        pg8::gemm_phase<pg8::EpiBf16, pg8::StaticOrder, AL, SP>(F.lds, g, S, E);
        { constexpr int NU = (MPAD / 256) * (PLD / 256); const int full = NU % F.G; const bool part = NU > F.G && full > 0;
          const int g2 = part ? ((int)blockIdx.x - full) * NWAVES + F.wave : gw, n2 = part ? (F.G - full) * NWAVES : NGW;
          if (!part || (int)blockIdx.x >= full) {
              prep_rg(F, scr, g2, n2);
              prep_plain(F, F.in[I_WBR], D, D, F.Wbr_t, scr, g2, n2, 2 * D);
              prep_plain(F, F.in[I_WBG], D, D, F.Wbr_t + D, scr, g2, n2, 2 * D);
              prep_plain(F, F.in[I_WOUT], D, D, F.Wout_t, scr, g2, n2); } }
    }
    SEAM(4);
    if (IN(5)) {
        const int c = F.vcu;
        if (c < 96) { gla_item<1>(F, (c / 3) * 4 + (c % 3)); rnn_item<false, 1>(F, (c / 7) * 8 + (c % 7)); }
        else {
            const int o = c - 96, no = F.G - 96;
            for (int i = 96 + o; i < 448; i += no) rnn_item<false, 1>(F, (i / 7) * 8 + (i % 7));
            if (o >= 32 || no != 160) for (int i = (no == 160 ? o - 32 : o); i < 2 * MS; i += (no == 160 ? 128 : no)) gla_sample_item(F, i);
        }
    }
    SEAM(5);
    if (IN(6)) {
        const int c = F.vcu;
        if (c < 128) { gla_item<3>(F, c); gla_sample_item(F, 2 * MS + c); }
        else {
            for (int i = c - 128; i < 256; i += F.G - 128) rnn_item<false, 3>(F, i);
            if (c < 136) rnn_item<true, 3>(F, c - 128);
            gla_sample_item(F, 3 * MS + c - 128);
        }
    }
    SEAM(6);
    if (IN(7)) {
        if (F.vcu < 32) { const int gsel = F.vcu >> 4, ks = (F.vcu >> 3) & 1, cb = F.vcu & 7;
            skinny_piece<0>(F, F.P + (size_t)MP * PLD + (gsel ? PC_OG : PC_YR), PLD, F.Wbr_t + (gsel ? D : 0), 2 * D, 512 * ks, 4, cb, SLAB_B, 2 * gsel + ks); }
        pg8::Gemm g{F.P + PC_YR, PLD, F.Wbr_t, MP, D, 2 * D}; pg8::StaticOrder S; S.init(MP, D, F.G, (int)blockIdx.x);
        pg8::EpiMerge E{F.P + PC_GA, F.P + PC_GB, PLD, F.P + SC_XA, PLD};
        pg8::gemm_phase<pg8::EpiMerge, pg8::StaticOrder, false, SP>(F.lds, g, S, E);
    }
    SEAM(7);
    if (IN(8)) {
        if (F.vcu < 64) skinny_piece<1>(F, nullptr, 0, F.Wout_t, D, 128 * (F.vcu >> 3), 1, F.vcu & 7, SLAB_B, 4 + (F.vcu >> 3));
        pg8::Gemm g{F.P + SC_XA, PLD, F.Wout_t, MP, D, D}; pg8::StaticOrder S; S.init(MP, D, F.G, (int)blockIdx.x);
        pg8::EpiBf16 E{F.P + SC_T, PLD};
        pg8::gemm_phase<pg8::EpiBf16, pg8::StaticOrder, AL, SP>(F.lds, g, S, E);
    }
    SEAM(8);
    if (IN(9)) {
        prep_wgu(F, F.in[I_F2GU], F.Wgu2_t, scr, gw, NGW);
        rowphase2(F);
    }
    SEAM(9);
    if (IN(10)) {
        pg8::Gemm g{F.P + SC_XA, PLD, F.Wgu2_t, MPAD, 2 * FF, D}; pg8::StaticOrder S; S.init(MPAD, 2 * FF, F.G, (int)blockIdx.x);
        pg8::EpiSwiGLU E{F.P + SC_H, PLD};
        pg8::gemm_phase<pg8::EpiSwiGLU, pg8::StaticOrder, AL, SP>(F.lds, g, S, E);
        { constexpr int NU = (MPAD / 256) * (2 * FF / 256); const int full = NU % F.G; const bool part = NU > F.G && full > 0;
          if (!part || (int)blockIdx.x >= full) prep_plain(F, F.in[I_F2D], FF, D, F.Wd2_t, scr, part ? ((int)blockIdx.x - full) * NWAVES + F.wave : gw, part ? (F.G - full) * NWAVES : NGW); }
    }
    SEAM(10);
    if (IN(11)) {
        if (F.vcu < 176) skinny_piece<0>(F, F.P + (size_t)MP * PLD + SC_H, PLD, F.Wd2_t, FF, 128 * (F.vcu >> 3), 1, F.vcu & 7, SLAB_D, F.vcu >> 3);
        pg8::Gemm g{F.P + SC_H, PLD, F.Wd2_t, MP, D, FF}; pg8::StaticOrder S; S.init(MP, D, F.G, (int)blockIdx.x);
        pg8::EpiBf16 E{F.P + SC_F, PLD};
        pg8::gemm_phase<pg8::EpiBf16, pg8::StaticOrder, AL, SP>(F.lds, g, S, E);
    }
    SEAM(11);
    if (IN(12)) rowphase3(F);
#ifdef TIME_PHASE
#ifdef TIME_SUB
    if (F.vcu == 0) { tp0 = 0; tp1 = ((volatile LAS unsigned long long*)(F.lds + MISC_OFF + 64))[0]; }
#endif
#ifdef TIME_RSUB
    if (F.vcu == 200) { tp0 = 0; tp1 = ((volatile LAS unsigned long long*)(F.lds + MISC_OFF + 64))[0]; }
#endif
    if (F.vcu == TIME_VCU) { const unsigned long long te = __builtin_amdgcn_s_memrealtime(), wait = (unsigned long long)(TIME_MULT) * (tp1 - tp0); while (__builtin_amdgcn_s_memrealtime() - te < wait) __builtin_amdgcn_s_sleep(8); }
#endif
#undef IN
#undef SEAM
}

inline int launch(void* const* d_in, void* d_out, void* d_ws, hipStream_t stream, int n_launches, int ph_lo = 0, int ph_hi = 0) {
    static int grid = 0;
    if (grid == 0) {
        int dev = 0, cus = 0, per_cu = 0;
        if (hipGetDevice(&dev) != hipSuccess || hipDeviceGetAttribute(&cus, hipDeviceAttributeMultiprocessorCount, dev) != hipSuccess) { grid = -1; return -1; }
        if (hipFuncSetAttribute((const void*)mega_fwd, hipFuncAttributeMaxDynamicSharedMemorySize, LDS_BYTES) != hipSuccess) { grid = -1; return -1; }
        if (hipOccupancyMaxActiveBlocksPerMultiprocessor(&per_cu, (const void*)mega_fwd, NTHR, LDS_BYTES) != hipSuccess || per_cu < 1) per_cu = 1;
        (void)hipGetLastError();
        grid = cus;
    }
    if (grid < 0) return -1;
    Args a{};
    for (int i = 0; i < 24; ++i) a.in[i] = (const float*)d_in[i];
    a.out = (float*)d_out; a.ws = (unsigned char*)d_ws;
    if (n_launches == 0) { a.ph_lo = ph_lo; a.ph_hi = ph_hi; hipLaunchKernelGGL(mega_fwd, dim3(grid), dim3(NTHR), LDS_BYTES, stream, a); return 0; }
    (void)hipMemsetAsync((char*)d_ws + WS_CTL, 0, CTL_ZERO_BYTES, stream);
    if (n_launches == 1) { a.ph_lo = 0; a.ph_hi = N_PHASES; hipLaunchKernelGGL(mega_fwd, dim3(grid), dim3(NTHR), LDS_BYTES, stream, a); }
    else for (int p = 0; p < N_PHASES; ++p) { a.ph_lo = p; a.ph_hi = p + 1; hipLaunchKernelGGL(mega_fwd, dim3(grid), dim3(NTHR), LDS_BYTES, stream, a); }
    return 0;
}
}
#ifndef MK_NL
#define MK_NL 1
#endif
extern "C" void kernel_launch(void* const* d_in, const int* in_sizes, int n_in,
                              void* d_out, int out_size, void* d_ws, size_t ws_size,
                              hipStream_t stream) {
    mk::launch(d_in, d_out, d_ws, stream, MK_NL);
}
```

```cpp
#include <hip/hip_runtime.h>
#include <cstdio>
#include <cstdint>
namespace pg8 {
#define PG8_LAS __attribute__((address_space(3)))
typedef unsigned short bf16_t;
typedef short bf16x8 __attribute__((ext_vector_type(8)));
typedef float f32x4 __attribute__((ext_vector_type(4)));
typedef float f32x2 __attribute__((ext_vector_type(2)));
typedef unsigned u32x4 __attribute__((ext_vector_type(4)));
typedef unsigned u32x2 __attribute__((ext_vector_type(2)));
constexpr int BM = 256, BK = 64, HALF = 128, HTB = HALF * BK * 2, STAGE_BYTES = 8 * HTB, NXCD = 8, WGM = 8;

__host__ __device__ __forceinline__ int lds_byte(int r, int c) { const int st = (r >> 4) * 2 + (c >> 5), rr = r & 15, cc = c & 31, ob = rr * 64 + cc * 2; return st * 1024 + (ob ^ (((ob >> 9) & 1) << 5)); }
__host__ __device__ __forceinline__ void stage_rc(int b, int& R, int& C) { const int st = b / 1024, sb = b % 1024, swz = sb ^ (((sb >> 9) & 1) << 5); R = (st >> 1) * 16 + swz / 64; C = (st & 1) * 32 + (swz % 64) / 2; }
__host__ __device__ __forceinline__ int perm32(int rho) { const int n = rho >> 4, i = rho & 15; return 8 * (i >> 2) + 4 * n + (i & 3); }

struct Unit { int pm, pn; };
struct Gemm { const bf16_t* A; int lda; const bf16_t* Bt; int M, N, K; };

struct StaticOrder {
    int nM, nN, nwg, G, c;
    __host__ __device__ void init(int M, int N, int G_, int c_) { nM = M / BM; nN = N / BM; nwg = nM * nN; G = G_; c = c_; }
    __host__ __device__ bool next(int i, Unit& u) const {
        const long L = (long)i * G + c; if (L >= nwg) return false;
        int wgid = (int)L; { const int q = nwg / NXCD, r = nwg % NXCD, xcd = wgid % NXCD, off = wgid / NXCD; wgid = (xcd < r ? xcd * (q + 1) : r * (q + 1) + (xcd - r) * q) + off; }
        const int nig = WGM * nN, gid = wgid / nig, fm = gid * WGM, gsz = (nM - fm) < WGM ? (nM - fm) : WGM;
        u.pm = fm + ((wgid % nig) % gsz); u.pn = (wgid % nig) / gsz; return true;
    }
    __device__ __forceinline__ void a_ready(const Unit&) const {}
    __device__ __forceinline__ void done(const Unit&) const {}
};

__device__ __forceinline__ unsigned f2bf(float f) { unsigned u = __builtin_bit_cast(unsigned, f); return (u + 0x7fffu + ((u >> 16) & 1u)) >> 16; }
typedef __bf16 hwbf16x2 __attribute__((ext_vector_type(2)));
__device__ __forceinline__ unsigned pk2(float lo, float hi) { const f32x2 v = {lo, hi}; return __builtin_bit_cast(unsigned, __builtin_convertvector(v, hwbf16x2)); }
__device__ __forceinline__ float bf_lo(unsigned w) { return __builtin_bit_cast(float, w << 16); }
__device__ __forceinline__ float bf_hi(unsigned w) { return __builtin_bit_cast(float, w & 0xffff0000u); }
__device__ __forceinline__ float fast_sigmoid(float x) { return __builtin_amdgcn_rcpf(1.0f + __builtin_amdgcn_exp2f(-1.4426950408889634f * x)); }

struct EpiF32 {
    static constexpr bool PERM = false, AFTER_DRAIN = false;
    float* C; int ldc;
    __device__ __forceinline__ void operator()(const f32x4 (&acc)[2][2][4][2], const Unit& u, int wr, int wc, int fr, int fq) const {
        const int row0 = u.pm * BM + wr * 64 + fr, col0 = u.pn * BM + wc * 32 + 4 * fq;
#pragma unroll
        for (int ai = 0; ai < 2; ++ai)
#pragma unroll
            for (int m = 0; m < 4; ++m) { float* rowp = C + (size_t)(row0 + ai * HALF + m * 16) * ldc + col0;
#pragma unroll
                for (int bj = 0; bj < 2; ++bj)
#pragma unroll
                    for (int n = 0; n < 2; ++n) *(f32x4*)(rowp + bj * HALF + n * 16) = acc[ai][bj][m][n]; }
    }
};
struct EpiBf16 {
    static constexpr bool PERM = true, AFTER_DRAIN = false;
    bf16_t* O; int ldc;
    __device__ __forceinline__ void operator()(const f32x4 (&acc)[2][2][4][2], const Unit& u, int wr, int wc, int fr, int fq) const {
        const int row0 = u.pm * BM + wr * 64 + fr, col0 = u.pn * BM + wc * 32 + 8 * fq;
#pragma unroll
        for (int ai = 0; ai < 2; ++ai)
#pragma unroll
            for (int m = 0; m < 4; ++m) { bf16_t* rowp = O + (size_t)(row0 + ai * HALF + m * 16) * ldc + col0;
#pragma unroll
                for (int bj = 0; bj < 2; ++bj) { const f32x4 v0 = acc[ai][bj][m][0], v1 = acc[ai][bj][m][1];
                    u32x4 w; w.x = pk2(v0[0], v0[1]); w.y = pk2(v0[2], v0[3]); w.z = pk2(v1[0], v1[1]); w.w = pk2(v1[2], v1[3]);
                    *(u32x4*)(rowp + bj * HALF) = w; } }
    }
};
struct EpiSwiGLU {
    static constexpr bool PERM = true, AFTER_DRAIN = false;
    bf16_t* O; int ldc;
    __device__ __forceinline__ void operator()(const f32x4 (&acc)[2][2][4][2], const Unit& u, int wr, int wc, int fr, int fq) const {
        const int row0 = u.pm * BM + wr * 64 + fr, col0 = u.pn * HALF + wc * 32 + 8 * fq;
#pragma unroll
        for (int ai = 0; ai < 2; ++ai)
#pragma unroll
            for (int m = 0; m < 4; ++m) { bf16_t* rowp = O + (size_t)(row0 + ai * HALF + m * 16) * ldc + col0;
                float h[8];
#pragma unroll
                for (int n = 0; n < 2; ++n)
#pragma unroll
                    for (int e = 0; e < 4; ++e) { const float g = acc[ai][0][m][n][e], up = acc[ai][1][m][n][e]; h[4 * n + e] = g * fast_sigmoid(g) * up; }
                u32x4 w; w.x = pk2(h[0], h[1]); w.y = pk2(h[2], h[3]); w.z = pk2(h[4], h[5]); w.w = pk2(h[6], h[7]);
                *(u32x4*)rowp = w; }
    }
};
struct EpiMerge {
    static constexpr bool PERM = true, AFTER_DRAIN = false, MID = true;
    const bf16_t* GA; const bf16_t* GB; int ldg; bf16_t* O; int ldc;
    __device__ __forceinline__ void mid(f32x4 (&acc)[2][2][4][2], const Unit& u, int wr, int wc, int fr, int fq) const {
        int row0 = u.pm * BM + wr * 64 + fr; const int col0 = u.pn * BM + wc * 32 + 8 * fq;
        asm volatile("" : "+v"(row0));
#pragma unroll
        for (int ai = 0; ai < 2; ++ai)
#pragma unroll
            for (int m = 0; m < 4; ++m) { const size_t row = (size_t)(row0 + ai * HALF + m * 16);
#pragma unroll
                for (int bj = 0; bj < 2; ++bj) { const u32x4 a = *(const u32x4*)(GA + row * ldg + col0 + bj * HALF), b = *(const u32x4*)(GB + row * ldg + col0 + bj * HALF);
#define PG8_RT(x, y) (fast_sigmoid(x) * (1.0f + __builtin_amdgcn_exp2f(-1.4426950408889634f * (y))))
                    f32x4 r0, r1; r0[0] = PG8_RT(bf_lo(a.x), bf_lo(b.x)); r0[1] = PG8_RT(bf_hi(a.x), bf_hi(b.x)); r0[2] = PG8_RT(bf_lo(a.y), bf_lo(b.y)); r0[3] = PG8_RT(bf_hi(a.y), bf_hi(b.y));
                    r1[0] = PG8_RT(bf_lo(a.z), bf_lo(b.z)); r1[1] = PG8_RT(bf_hi(a.z), bf_hi(b.z)); r1[2] = PG8_RT(bf_lo(a.w), bf_lo(b.w)); r1[3] = PG8_RT(bf_hi(a.w), bf_hi(b.w));
#undef PG8_RT
                    acc[ai][bj][m][0] = acc[ai][bj][m][0] * r0; acc[ai][bj][m][1] = acc[ai][bj][m][1] * r1; }
                if (m & 1) asm volatile("" ::: "memory"); }
    }
    __device__ __forceinline__ void operator()(const f32x4 (&acc)[2][2][4][2], const Unit& u, int wr, int wc, int fr, int fq) const {
        int row0 = u.pm * BM + wr * 64 + fr; const int col0 = u.pn * BM + wc * 32 + 8 * fq;
        asm volatile("" : "+v"(row0));
#pragma unroll
        for (int ai = 0; ai < 2; ++ai)
#pragma unroll
            for (int m = 0; m < 4; ++m) { const size_t row = (size_t)(row0 + ai * HALF + m * 16);
#pragma unroll
                for (int bj = 0; bj < 2; ++bj) { const u32x4 g = *(const u32x4*)(GB + row * ldg + col0 + bj * HALF); const f32x4 v0 = acc[ai][bj][m][0], v1 = acc[ai][bj][m][1];
                    u32x4 w; w.x = pk2(fast_sigmoid(bf_lo(g.x)) * v0[0], fast_sigmoid(bf_hi(g.x)) * v0[1]); w.y = pk2(fast_sigmoid(bf_lo(g.y)) * v0[2], fast_sigmoid(bf_hi(g.y)) * v0[3]);
                    w.z = pk2(fast_sigmoid(bf_lo(g.z)) * v1[0], fast_sigmoid(bf_hi(g.z)) * v1[1]); w.w = pk2(fast_sigmoid(bf_lo(g.w)) * v1[2], fast_sigmoid(bf_hi(g.w)) * v1[3]);
                    *(u32x4*)(O + row * ldc + col0 + bj * HALF) = w; } }
    }
};
template <class E> struct has_mid { template <class T> static auto test(int) -> decltype(T::MID, char()); template <class T> static long test(...); static constexpr bool value = sizeof(test<E>(0)) == 1; };

template <class Epi, class Sched, bool ALIGN_EPI = false, bool SP2 = false>
__device__ __forceinline__ void gemm_phase(PG8_LAS unsigned char* lds, const Gemm g, const Sched& S, const Epi& E) {
    const int tid = threadIdx.x, wid = __builtin_amdgcn_readfirstlane(tid >> 6), lane = tid & 63, wr = wid >> 2, wc = wid & 3, fr = lane & 15, fq = lane >> 4;
    const int K = g.K, nt = K / BK;
    unsigned voffA[2], voffB[2];
#pragma unroll
    for (int i = 0; i < 2; ++i) { int R, C; stage_rc(tid * 16 + i * 8192, R, C); const int Rb = Epi::PERM ? ((R & ~31) + perm32(R & 31)) : R;
        voffA[i] = (unsigned)(R * g.lda + C) * 2u; voffB[i] = (unsigned)(Rb * K + C) * 2u; }
    const size_t kstep = (size_t)(BK * 2);
    const size_t hstepA = (size_t)HALF * g.lda * 2, hstepB = (size_t)HALF * K * 2;
    const size_t tstepA = 2 * hstepA, tstepB = 2 * hstepB;
    const unsigned ldsw = (unsigned)wid * 1024u;
    const int aoff = lds_byte(wr * 64 + fr, fq * 8), boff = lds_byte(wc * 32 + fr, fq * 8);
#define PG8_SA(b, h) (((b) * 2 + (h)) * HTB)
#define PG8_SB(b, h) ((4 + (b) * 2 + (h)) * HTB)
#define PG8_STAGE(bufoff, gbase, voff) do { _Pragma("unroll") for (int _i = 0; _i < 2; ++_i) \
        __builtin_amdgcn_global_load_lds((const unsigned*)((const char*)(gbase) + (voff)[_i]), (PG8_LAS unsigned*)(lds + (bufoff) + ldsw + _i * 8192), 16, 0, 0); } while (0)
#define PG8_LDA(dst, b, h) do { _Pragma("unroll") for (int m = 0; m < 4; ++m) _Pragma("unroll") for (int k = 0; k < 2; ++k) dst[m][k] = *(const PG8_LAS bf16x8*)(lds + PG8_SA(b, h) + aoff + m * 2048 + k * 1024); } while (0)
#define PG8_LDB(dst, b, h) do { _Pragma("unroll") for (int n = 0; n < 2; ++n) _Pragma("unroll") for (int k = 0; k < 2; ++k) dst[n][k] = *(const PG8_LAS bf16x8*)(lds + PG8_SB(b, h) + boff + n * 2048 + k * 1024); } while (0)
#define PG8_MMA(ai, bj, At, Bt) do { __builtin_amdgcn_s_setprio(1); _Pragma("unroll") for (int m = 0; m < 4; ++m) _Pragma("unroll") for (int n = 0; n < 2; ++n) _Pragma("unroll") for (int k = 0; k < 2; ++k) \
        acc[ai][bj][m][n] = __builtin_amdgcn_mfma_f32_16x16x32_bf16(Bt[n][k], At[m][k], acc[ai][bj][m][n], 0, 0, 0); __builtin_amdgcn_s_setprio(0); } while (0)
#define PG8_WAIT_V(n) asm volatile("s_waitcnt vmcnt(" #n ")" ::: "memory")
#define PG8_WAIT_L(n) asm volatile("s_waitcnt lgkmcnt(" #n ")" ::: "memory")
#define PG8_BAR __builtin_amdgcn_s_barrier()
#define PG8_SCHED __builtin_amdgcn_sched_barrier(0)
    Unit cur, nxt; int ui = 0;
    if (!S.next(0, cur)) return;
    f32x4 acc[2][2][4][2];
#pragma unroll
    for (int a = 0; a < 2; ++a)
#pragma unroll
        for (int b = 0; b < 2; ++b)
#pragma unroll
            for (int m = 0; m < 4; ++m)
#pragma unroll
                for (int n = 0; n < 2; ++n) acc[a][b][m][n] = (f32x4){0.f, 0.f, 0.f, 0.f};
    bf16x8 At[4][2], B0[2][2], B1[2][2];
    const char* cA = (const char*)g.A + (size_t)cur.pm * tstepA; const char* cB = (const char*)g.Bt + (size_t)cur.pn * tstepB;
    S.a_ready(cur);
    if constexpr (SP2) {
        PG8_STAGE(PG8_SB(0, 0), cB, voffB); PG8_STAGE(PG8_SB(0, 1), cB + hstepB, voffB); PG8_STAGE(PG8_SA(0, 0), cA, voffA); PG8_STAGE(PG8_SA(0, 1), cA + hstepA, voffA);
        if (wr == 1) PG8_BAR;
        PG8_WAIT_V(2); PG8_BAR;
        PG8_STAGE(PG8_SB(1, 0), cB + kstep, voffB); PG8_STAGE(PG8_SA(1, 0), cA + kstep, voffA); PG8_STAGE(PG8_SB(1, 1), cB + hstepB + kstep, voffB);
        PG8_WAIT_V(6); PG8_BAR;
    } else {
        PG8_STAGE(PG8_SB(0, 0), cB, voffB); PG8_STAGE(PG8_SA(0, 0), cA, voffA); PG8_STAGE(PG8_SB(0, 1), cB + hstepB, voffB); PG8_STAGE(PG8_SA(0, 1), cA + hstepA, voffA);
        if (wr == 1) PG8_BAR;
        PG8_WAIT_V(4); PG8_BAR;
        PG8_STAGE(PG8_SB(1, 0), cB + kstep, voffB); PG8_STAGE(PG8_SA(1, 0), cA + kstep, voffA); PG8_STAGE(PG8_SB(1, 1), cB + hstepB + kstep, voffB);
        PG8_WAIT_V(6); PG8_BAR;
    }
    for (;;) {
        const bool has_next = S.next(ui + 1, nxt);
        const char* nA = has_next ? (const char*)g.A + (size_t)nxt.pm * tstepA : cA; const char* nB = has_next ? (const char*)g.Bt + (size_t)nxt.pn * tstepB : cB;
        constexpr int NSEG = has_mid<Epi>::value ? 2 : 1;
        for (int sg = 0; sg < NSEG; ++sg) {
        if constexpr (has_mid<Epi>::value) { if (sg == 1) E.mid(acc, cur, wr, wc, fr, fq); }
        const int t_end = (sg + 1) * (nt / NSEG);
        for (int t = sg * (nt / NSEG); t < t_end; t += 2) {
            const bool last = (t == nt - 2);
            const char* a1 = cA + (size_t)(t + 1) * kstep;
            const char* a2 = last ? nA : cA + (size_t)(t + 2) * kstep; const char* b2 = last ? nB : cB + (size_t)(t + 2) * kstep;
            const char* a3 = a2 + kstep; const char* b3 = b2 + kstep;
            if (last && has_next) S.a_ready(nxt);
            if constexpr (SP2) {
            PG8_LDB(B0, 0, 0); PG8_LDB(B1, 0, 1); PG8_SCHED; PG8_LDA(At, 0, 0); PG8_STAGE(PG8_SA(1, 1), a1 + hstepA, voffA);
            PG8_WAIT_V(8); PG8_WAIT_L(0); PG8_BAR; PG8_MMA(0, 0, At, B0); PG8_MMA(0, 1, At, B1); PG8_BAR; PG8_SCHED;
            PG8_LDA(At, 0, 1); PG8_STAGE(PG8_SB(0, 0), b2, voffB); PG8_STAGE(PG8_SB(0, 1), b2 + hstepB, voffB); PG8_STAGE(PG8_SA(0, 0), a2, voffA);
            PG8_WAIT_V(8); PG8_WAIT_L(0); PG8_BAR; PG8_MMA(1, 0, At, B0); PG8_MMA(1, 1, At, B1); PG8_BAR; PG8_SCHED;
            PG8_LDB(B0, 1, 0); PG8_LDB(B1, 1, 1); PG8_SCHED; PG8_LDA(At, 1, 0); PG8_STAGE(PG8_SA(0, 1), a2 + hstepA, voffA);
            PG8_WAIT_V(8); PG8_WAIT_L(0); PG8_BAR; PG8_MMA(0, 0, At, B0); PG8_MMA(0, 1, At, B1); PG8_BAR; PG8_SCHED;
            PG8_LDA(At, 1, 1); PG8_STAGE(PG8_SB(1, 0), b3, voffB); PG8_STAGE(PG8_SB(1, 1), b3 + hstepB, voffB); PG8_STAGE(PG8_SA(1, 0), a3, voffA);
            PG8_WAIT_V(8); PG8_WAIT_L(0); PG8_BAR; PG8_MMA(1, 0, At, B0); PG8_MMA(1, 1, At, B1); PG8_BAR; PG8_SCHED;
            } else {
            PG8_LDB(B0, 0, 0); PG8_SCHED; PG8_LDA(At, 0, 0); PG8_STAGE(PG8_SA(1, 1), a1 + hstepA, voffA);
            PG8_WAIT_L(8); PG8_BAR; PG8_WAIT_L(0); PG8_MMA(0, 0, At, B0); PG8_BAR; PG8_SCHED;
            PG8_LDB(B1, 0, 1); PG8_STAGE(PG8_SB(0, 0), b2, voffB);
            PG8_BAR; PG8_WAIT_L(0); PG8_MMA(0, 1, At, B1); PG8_BAR;
            PG8_LDA(At, 0, 1); PG8_STAGE(PG8_SA(0, 0), a2, voffA);
            PG8_BAR; PG8_WAIT_L(0); PG8_MMA(1, 0, At, B0); PG8_BAR; PG8_SCHED;
            PG8_STAGE(PG8_SB(0, 1), b2 + hstepB, voffB);
            PG8_WAIT_V(6); PG8_BAR; PG8_MMA(1, 1, At, B1); PG8_BAR;
            PG8_LDB(B0, 1, 0); PG8_SCHED; PG8_LDA(At, 1, 0); PG8_STAGE(PG8_SA(0, 1), a2 + hstepA, voffA);
            PG8_WAIT_L(8); PG8_BAR; PG8_WAIT_L(0); PG8_MMA(0, 0, At, B0); PG8_BAR; PG8_SCHED;
            PG8_LDB(B1, 1, 1); PG8_STAGE(PG8_SB(1, 0), b3, voffB);
            PG8_BAR; PG8_WAIT_L(0); PG8_MMA(0, 1, At, B1); PG8_BAR;
            PG8_LDA(At, 1, 1); PG8_STAGE(PG8_SA(1, 0), a3, voffA);
            PG8_BAR; PG8_WAIT_L(0); PG8_MMA(1, 0, At, B0); PG8_BAR; PG8_SCHED;
            PG8_STAGE(PG8_SB(1, 1), b3 + hstepB, voffB);
            PG8_WAIT_V(6); PG8_BAR; PG8_MMA(1, 1, At, B1); PG8_BAR;
            }
        }
        }
        if constexpr (ALIGN_EPI) { if (wr == 0) PG8_BAR; }
        if constexpr (!Epi::AFTER_DRAIN) { E(acc, cur, wr, wc, fr, fq); S.done(cur); }
        if (!has_next) break;
#pragma unroll
        for (int a = 0; a < 2; ++a)
#pragma unroll
            for (int b = 0; b < 2; ++b)
#pragma unroll
                for (int m = 0; m < 4; ++m)
#pragma unroll
                    for (int n = 0; n < 2; ++n) acc[a][b][m][n] = (f32x4){0.f, 0.f, 0.f, 0.f};
        cur = nxt; cA = nA; cB = nB; ++ui;
        if constexpr (ALIGN_EPI) { if (wr == 1) PG8_BAR; }
    }
    PG8_WAIT_V(0);
    if constexpr (!ALIGN_EPI) { if (wr == 0) PG8_BAR; }
    PG8_BAR;
#undef PG8_SA
#undef PG8_SB
#undef PG8_STAGE
#undef PG8_LDA
#undef PG8_LDB
#undef PG8_MMA
#undef PG8_WAIT_V
#undef PG8_WAIT_L
#undef PG8_BAR
#undef PG8_SCHED
}
}
namespace mk {
using pg8::bf16_t; using pg8::bf16x8; using pg8::f32x4; using pg8::f32x2; using pg8::u32x4; using pg8::u32x2; using pg8::f2bf; using pg8::pk2; using pg8::bf_lo; using pg8::bf_hi;
#define LAS __attribute__((address_space(3)))
typedef float f32x16 __attribute__((ext_vector_type(16)));
constexpr int NWAVES = 8, NTHR = 512;
constexpr int D = 1024, FF = 2816, DIN = 7184, MP = 16384, MS = 128, MT = 16512, MPAD = 16640, TSEQ = 2048, NB = 8;
constexpr int PLD = 7424;
constexpr int PC_XR = 0, PC_YR = 1024, PC_OG = 2048, PC_Q = 3072, PC_K = 3584, PC_V = 4096, PC_GA = 5120, PC_GB = 6144, PC_LR = 7168;
constexpr int SC_XA = 0, SC_H = 1024, SC_T = 3072, SC_F = 5120;
constexpr float EPS = 1e-6f;
constexpr size_t O_YP = 0, O_YS = 16777216, O_HP = 16908288, O_CP = 16916480, O_SP = 16941056, O_HS = 17989632, O_CS = 18120704, O_SS = 18513920;
constexpr size_t MiB = 1u << 20;
constexpr size_t WS_CTL = 0, CTL_ZERO_BYTES = 64 * 1024;
constexpr size_t WS_P = 1 * MiB;
constexpr size_t WS_TAIL = 237 * MiB;
constexpr size_t WS_WRG = WS_TAIL, WS_WBR = WS_TAIL + MiB / 2, WS_WBG = WS_WBR + 2 * MiB, WS_WOUT = WS_WBG + 2 * MiB;
constexpr size_t WS_WGU2 = WS_TAIL, WS_WD2 = WS_TAIL + 11 * MiB;
static_assert(WS_P + (size_t)MPAD * PLD * 2 <= WS_TAIL && WS_WOUT + 2 * MiB <= 256 * MiB && WS_WD2 + (size_t)D * FF * 2 <= 256 * MiB, "d_ws map");
constexpr size_t SS_U = 0, SS_WIN = (size_t)MPAD * D * 2, SS_WGU1 = SS_WIN + (size_t)PLD * D * 2, SS_WD1 = SS_WGU1 + (size_t)2 * FF * D * 2;
static_assert(SS_WD1 + (size_t)D * FF * 2 <= 64 * MiB, "ss-region map");
constexpr int CW_BAR = 4096;
constexpr int LDS_BYTES = 163840, MISC_OFF = LDS_BYTES - 512;

#define RLX_AGENT __ATOMIC_RELAXED, __HIP_MEMORY_SCOPE_AGENT
#define LDS_WAIT() asm volatile("s_waitcnt lgkmcnt(0)" ::: "memory")
#define VM_WAIT() asm volatile("s_waitcnt vmcnt(0)" ::: "memory")

#define XB_TMO      128
#define XB_XCNT(j)  (256  + 64 * (j))
#define XB_XSUB(j)  (1280 + 64 * (j))
#define XB_XGEN(j)  (2304 + 64 * (j))
#define XB_TOP      3328
#define XB_TOPGEN   3392
#define XCD_BAR_WORDS 3456
#define XB_SPIN_CAP (1u << 18)
__device__ __forceinline__ unsigned xb_ld(unsigned* p)              { return __hip_atomic_load(p, __ATOMIC_RELAXED, __HIP_MEMORY_SCOPE_AGENT); }
__device__ __forceinline__ unsigned xb_add(unsigned* p, unsigned v) { return __hip_atomic_fetch_add(p, v, __ATOMIC_RELAXED, __HIP_MEMORY_SCOPE_AGENT); }
__device__ __forceinline__ unsigned xb_xcc_id() { return (unsigned)__builtin_amdgcn_s_getreg((3 << 11) | 20) & 0xFu; }
#define XB_SPIN(cond, bar) do { unsigned _sp = 0; while (cond) { __builtin_amdgcn_s_sleep(1); \
    if ((++_sp & 255u) == 0u) { if (xb_ld(&(bar)[XB_TMO])) break; if (_sp > XB_SPIN_CAP) { atomicAdd(&(bar)[XB_TMO], 1u); break; } } } } while (0)
struct XcdBarrier { unsigned* bar; unsigned x; volatile LAS unsigned* st; };
__device__ __forceinline__ XcdBarrier xcd_barrier_post(unsigned* bar, volatile LAS unsigned* st) {
    XcdBarrier b; b.bar = bar; b.x = xb_xcc_id(); b.st = st;
    if (threadIdx.x == 0) (void)xb_add(&bar[XB_XCNT(b.x)], 1u);
    return b;
}
__device__ __forceinline__ void xcd_barrier_complete(unsigned* bar, unsigned x, unsigned& nloc, unsigned& nx) {
    const unsigned G = gridDim.x * gridDim.y * gridDim.z;
    unsigned sum, cnt, mine, sp = 0u;
    for (;;) {
        sum = 0u; cnt = 0u; mine = 0u;
#pragma unroll
        for (unsigned j = 0; j < 16; ++j) { const unsigned c = xb_ld(&bar[XB_XCNT(j)]); sum += c; cnt += (c > 0u) ? 1u : 0u; mine = (j == x) ? c : mine; }
        if (sum == G) break;
        __builtin_amdgcn_s_sleep(1);
        if ((++sp & 255u) == 0u) { if (xb_ld(&bar[XB_TMO])) break; if (sp > XB_SPIN_CAP) { atomicAdd(&bar[XB_TMO], 1u); break; } }
    }
    nloc = mine > 0u ? mine : 1u; nx = cnt > 0u ? cnt : 1u;
}
__device__ __forceinline__ void xcd_barrier(const XcdBarrier& b) {
    asm volatile("s_waitcnt vmcnt(0)" ::: "memory");
    __syncthreads();
    if (threadIdx.x == 0) {
        unsigned* bar = b.bar;
        __builtin_amdgcn_s_waitcnt(0);
        unsigned nloc = b.st[0], nx = b.st[1];
        if (nloc == 0u) { xcd_barrier_complete(bar, b.x, nloc, nx); b.st[0] = nloc; b.st[1] = nx; }
        const unsigned old = xb_add(&bar[XB_XSUB(b.x)], 1u);
        const unsigned gen = old / nloc;
        if (old + 1u == (gen + 1u) * nloc) {
            __builtin_amdgcn_fence(__ATOMIC_RELEASE, "agent");
            asm volatile("s_waitcnt vmcnt(0)" ::: "memory");
            const unsigned og = xb_add(&bar[XB_TOP], 1u);
            const unsigned tg = og / nx;
            if (og + 1u == (tg + 1u) * nx) xb_add(&bar[XB_TOPGEN], 1u);
            else XB_SPIN(xb_ld(&bar[XB_TOPGEN]) == tg, bar);
            __builtin_amdgcn_fence(__ATOMIC_ACQUIRE, "agent");
            xb_add(&bar[XB_XGEN(b.x)], 1u);
            asm volatile("s_waitcnt vmcnt(0)" ::: "memory");
        } else {
            XB_SPIN(xb_ld(&bar[XB_XGEN(b.x)]) == gen, bar);
            __builtin_amdgcn_fence(__ATOMIC_ACQUIRE, "agent");
            asm volatile("s_waitcnt vmcnt(0)" ::: "memory");
        }
    }
    __syncthreads();
}

struct Args { const float* in[24]; float* out; unsigned char* ws; int ph_lo, ph_hi; };
struct Frame {
    LAS unsigned char* lds; int tid, lane, wave, vcu, G;
    const float* in[24]; float* out; unsigned char* ws;
    bf16_t* P; bf16_t* U; bf16_t* Win_t; bf16_t* Wgu1_t; bf16_t* Wd1_t; bf16_t* Wrg_t; bf16_t* Wbr_t; bf16_t* Wbg_t; bf16_t* Wout_t; bf16_t* Wgu2_t; bf16_t* Wd2_t;
};
enum { I_XP = 0, I_XS, I_SRH, I_SRC, I_SGLA, I_NG, I_F1GU, I_F1D, I_WIN, I_CW, I_CB, I_RWA, I_RBA, I_RWX, I_RBX, I_LAM, I_WLR, I_BLR, I_GNG, I_WBR, I_WBG, I_WOUT, I_F2GU, I_F2D };

__device__ __forceinline__ float wave_sum(float v) {
#pragma unroll
    for (int o = 1; o < 64; o <<= 1) v += __shfl_xor(v, o);
    return v;
}
__device__ __forceinline__ const float* xrow_ptr(const Frame& F, int row) { return row < MP ? F.in[I_XP] + (size_t)row * D : F.in[I_XS] + (size_t)(row - MP) * D; }
__device__ __forceinline__ void load_row16(const float* p, int lane, f32x4 (&v)[4]) {
#pragma unroll
    for (int j = 0; j < 4; ++j) v[j] = *(const f32x4*)(p + 4 * lane + 256 * j);
}
__device__ __forceinline__ float sumsq16(const f32x4 (&v)[4]) { float s = 0.f;
#pragma unroll
    for (int j = 0; j < 4; ++j) s += (v[j].x * v[j].x + v[j].y * v[j].y) + (v[j].z * v[j].z + v[j].w * v[j].w);
    return s; }
__device__ __forceinline__ void store_row16_bf16(bf16_t* p, int lane, const f32x4 (&v)[4]) {
#pragma unroll
    for (int j = 0; j < 4; ++j) { u32x2 w; w.x = pk2(v[j].x, v[j].y); w.y = pk2(v[j].z, v[j].w); *(u32x2*)(p + 4 * lane + 256 * j) = w; }
}
struct SlabMap { int slot, logw; };
__device__ __forceinline__ float* slab_at(const Frame& F, const SlabMap m, int s, int r, int c) {
    return (float*)(F.P + (size_t)(((s * MS + r) << (10 - m.logw)) + (c >> m.logw)) * PLD + m.slot) + (c & ((1 << m.logw) - 1)); }
constexpr SlabMap SLAB_D = {SC_XA, 9};
constexpr SlabMap SLAB_B = {PC_LR, 7};
__device__ __forceinline__ void load_row16_f(const Frame& F, int row, int slot, const SlabMap m, int slab0, int ns, f32x4 (&v)[4]) {
    if (row < MP) {
#pragma unroll
        for (int j = 0; j < 4; ++j) { const u32x2 w = *(const u32x2*)(F.P + (size_t)row * PLD + slot + 4 * F.lane + 256 * j); v[j] = (f32x4){bf_lo(w.x), bf_hi(w.x), bf_lo(w.y), bf_hi(w.y)}; }
        return; }
#pragma unroll
    for (int j = 0; j < 4; ++j) v[j] = (f32x4){0.f, 0.f, 0.f, 0.f};
    for (int s = 0; s < ns; ++s) {
#pragma unroll
        for (int j = 0; j < 4; ++j) v[j] = v[j] + *(const f32x4*)slab_at(F, m, slab0 + s, row - MP, 4 * F.lane + 256 * j); }
}
__device__ __forceinline__ void rowphase0(const Frame& F) {
    const int gw = F.vcu * NWAVES + F.wave, NGW = F.G * NWAVES; const float* g0 = F.in[I_NG];
    f32x4 g[4]; load_row16(g0, F.lane, g);
    for (int row = gw; row < MT; row += NGW) {
        f32x4 v[4]; load_row16(xrow_ptr(F, row), F.lane, v);
        const float rs = rsqrtf(wave_sum(sumsq16(v)) * (1.f / D) + EPS);
#pragma unroll
        for (int j = 0; j < 4; ++j) v[j] = v[j] * rs * g[j];
        store_row16_bf16(F.P + (size_t)row * PLD + SC_XA, F.lane, v);
    }
}
__device__ __forceinline__ void rowphase1(const Frame& F) {
    const int gw = F.vcu * NWAVES + F.wave, NGW = F.G * NWAVES; const float* ng = F.in[I_NG];
    f32x4 g1[4], g2[4]; load_row16(ng + 1 * D, F.lane, g1); load_row16(ng + 2 * D, F.lane, g2);
    for (int row = gw; row < MT; row += NGW) {
        f32x4 f[4], x[4]; load_row16_f(F, row, SC_F, SLAB_D, 0, 22, f); load_row16(xrow_ptr(F, row), F.lane, x);
        const float rs = rsqrtf(wave_sum(sumsq16(f)) * (1.f / D) + EPS);
#pragma unroll
        for (int j = 0; j < 4; ++j) x[j] = x[j] + 0.5f * (f[j] * rs * g1[j]);
        float* o = F.out + (size_t)row * D;
#pragma unroll
        for (int j = 0; j < 4; ++j) *(f32x4*)(o + 4 * F.lane + 256 * j) = x[j];
        const float rs2 = rsqrtf(wave_sum(sumsq16(x)) * (1.f / D) + EPS);
#pragma unroll
        for (int j = 0; j < 4; ++j) x[j] = x[j] * rs2 * g2[j];
        store_row16_bf16(F.U + (size_t)row * D, F.lane, x);
    }
}
__device__ __forceinline__ void rowphase2(const Frame& F) {
    const int gw = F.vcu * NWAVES + F.wave, NGW = F.G * NWAVES; const float* ng = F.in[I_NG];
    f32x4 g3[4], g4[4]; load_row16(ng + 3 * D, F.lane, g3); load_row16(ng + 4 * D, F.lane, g4);
    for (int row = gw; row < MT; row += NGW) {
        f32x4 f[4], x[4]; load_row16_f(F, row, SC_T, SLAB_B, 4, 8, f); float* o = F.out + (size_t)row * D; load_row16(o, F.lane, x);
        const float rs = rsqrtf(wave_sum(sumsq16(f)) * (1.f / D) + EPS);
#pragma unroll
        for (int j = 0; j < 4; ++j) x[j] = x[j] + f[j] * rs * g3[j];
#pragma unroll
        for (int j = 0; j < 4; ++j) *(f32x4*)(o + 4 * F.lane + 256 * j) = x[j];
        const float rs2 = rsqrtf(wave_sum(sumsq16(x)) * (1.f / D) + EPS);
#pragma unroll
        for (int j = 0; j < 4; ++j) x[j] = x[j] * rs2 * g4[j];
        store_row16_bf16(F.P + (size_t)row * PLD + SC_XA, F.lane, x);
    }
}
__device__ __forceinline__ void rowphase3(const Frame& F) {
    const int gw = F.vcu * NWAVES + F.wave, NGW = F.G * NWAVES; const float* ng = F.in[I_NG];
    f32x4 g5[4]; load_row16(ng + 5 * D, F.lane, g5);
    for (int row = gw; row < MT; row += NGW) {
        f32x4 f[4], x[4]; load_row16_f(F, row, SC_F, SLAB_D, 0, 22, f); float* o = F.out + (size_t)row * D; load_row16(o, F.lane, x);
        const float rs = rsqrtf(wave_sum(sumsq16(f)) * (1.f / D) + EPS);
#pragma unroll
        for (int j = 0; j < 4; ++j) *(f32x4*)(o + 4 * F.lane + 256 * j) = x[j] + 0.5f * (f[j] * rs * g5[j]);
    }
}

__device__ __forceinline__ void tr_item(const float* W, int ldw, int K, int k0, int scol0, int nvalid, bf16_t* WT, int drow0, LAS float* scr, int lane, int ldt = 0) {
    if (ldt == 0) ldt = K;
    { const int c4 = lane & 7, r = lane >> 3; const bool ok = 4 * c4 < nvalid; f32x4 v[8];
#pragma unroll
      for (int i = 0; i < 8; ++i) v[i] = ok ? *(const f32x4*)(W + (size_t)(k0 + r + 8 * i) * ldw + scol0 + 4 * c4) : (f32x4){0.f, 0.f, 0.f, 0.f};
#pragma unroll
      for (int i = 0; i < 8; ++i) { LAS float* d = scr + (r + 8 * i) * 33 + 4 * c4; d[0] = v[i][0]; d[1] = v[i][1]; d[2] = v[i][2]; d[3] = v[i][3]; } }
    LDS_WAIT(); asm volatile("" ::: "memory");
    const int c = lane & 7;
#pragma unroll
    for (int j = 0; j < 4; ++j) { const int n = (lane >> 3) + 8 * j; const LAS float* s = scr + (8 * c) * 33 + n;
        u32x4 o; o.x = pk2(s[0 * 33], s[1 * 33]); o.y = pk2(s[2 * 33], s[3 * 33]); o.z = pk2(s[4 * 33], s[5 * 33]); o.w = pk2(s[6 * 33], s[7 * 33]);
        *(u32x4*)(WT + (size_t)(drow0 + n) * ldt + k0 + 8 * c) = o; }
    LDS_WAIT(); asm volatile("" ::: "memory");
}
__device__ __forceinline__ void prep_wgu(const Frame& F, const float* W, bf16_t* WT, LAS float* scr, int gw, int NGW) {
    constexpr int KB = D / 64, RB = 2 * FF / 32;
    for (int it = gw; it < KB * RB; it += NGW) { const int kb = it / RB, rb = it % RB, n0 = 32 * rb, pn = n0 >> 8, bj = (n0 >> 7) & 1, j = n0 & 127;
        tr_item(W, 2 * FF, D, 64 * kb, bj * FF + 128 * pn + j, 32, WT, n0, scr, F.lane); }
}
__device__ __forceinline__ void prep_plain(const Frame& F, const float* W, int K, int N, bf16_t* WT, LAS float* scr, int gw, int NGW, int ldt = 0) {
    const int KB = K / 64, RB = N / 32;
    for (int it = gw; it < KB * RB; it += NGW) { const int kb = it / RB, rb = it % RB; tr_item(W, N, K, 64 * kb, 32 * rb, 32, WT, 32 * rb, scr, F.lane, ldt); }
}
__device__ __forceinline__ void prep_win(const Frame& F, LAS float* scr, int gw, int NGW) {
    constexpr int KB = D / 64, RB = PLD / 32;
    for (int it = gw; it < KB * RB; it += NGW) { const int kb = it / RB, rb = it % RB, n0 = 32 * rb; int sc, nv = 32;
        if (n0 < 2048) sc = n0;
        else if (n0 < 3072) sc = 4096 + (n0 - 2048);
        else if (n0 < 3584) sc = 2048 + (n0 - 3072);
        else if (n0 < 4096) sc = 2560 + (n0 - 3584);
        else if (n0 < 5120) sc = 3072 + (n0 - 4096);
        else if (n0 < 6144) sc = 5136 + (n0 - 5120);
        else if (n0 < 7168) sc = 6160 + (n0 - 6144);
        else if (n0 == 7168) { sc = 5120; nv = 16; }
        else { sc = 0; nv = 0; }
        tr_item(F.in[I_WIN], DIN, D, 64 * kb, sc, nv, F.Win_t, n0, scr, F.lane); }
}
__device__ __forceinline__ void prep_rg(const Frame& F, LAS float* scr, int gw, int NGW) {
    for (int it = gw; it < 2 * 8 * 8; it += NGW) { const int gate = it >> 6, n = (it >> 3) & 7, sub = it & 7, kb = sub >> 2, rb = sub & 3;
        tr_item(F.in[gate ? I_RWX : I_RWA] + (size_t)n * 16384, 128, 128, 64 * kb, 32 * rb, 32, F.Wrg_t + (size_t)(gate * 8 + n) * 16384, 32 * rb, scr, F.lane); }
}
}
namespace mk {
#define MFMA16(a, b, c) __builtin_amdgcn_mfma_f32_16x16x32_bf16((a), (b), (c), 0, 0, 0)
#define MFMA32(a, b, c) __builtin_amdgcn_mfma_f32_32x32x16_bf16((a), (b), (c), 0, 0, 0)
constexpr float LOG2E = 1.4426950408889634f;
__device__ __forceinline__ float bf2f(bf16_t h) { return __builtin_bit_cast(float, (unsigned)h << 16); }
__device__ __forceinline__ float ex2(float x) { return __builtin_amdgcn_exp2f(x); }
__device__ __forceinline__ float sigm(float x) { return __builtin_amdgcn_rcpf(1.0f + ex2(-LOG2E * x)); }
__device__ __forceinline__ float softplus_(float x) { return fmaxf(x, 0.f) + log1pf(__expf(-fabsf(x))); }
__device__ __forceinline__ float gelu_tanh_(float x) { return x * sigm(1.5957691216057308f * (x + 0.044715f * x * x * x)); }
__device__ __forceinline__ float silu_(float x) { return x * sigm(x); }
__device__ __forceinline__ void unpack8(const u32x4 w, float (&f)[8]) { f[0] = bf_lo(w.x); f[1] = bf_hi(w.x); f[2] = bf_lo(w.y); f[3] = bf_hi(w.y); f[4] = bf_lo(w.z); f[5] = bf_hi(w.z); f[6] = bf_lo(w.w); f[7] = bf_hi(w.w); }
__device__ __forceinline__ u32x4 pack8(const float (&f)[8]) { u32x4 w; w.x = pk2(f[0], f[1]); w.y = pk2(f[2], f[3]); w.z = pk2(f[4], f[5]); w.w = pk2(f[6], f[7]); return w; }

constexpr size_t WS_GAGG = WS_WOUT + 2 * MiB, GAGG_FLOATS = 32768 + 128, WS_RAGG = 128 * 1024;
static_assert(WS_GAGG + (size_t)96 * GAGG_FLOATS * 4 <= 256 * MiB && WS_RAGG + 512 * 256 * 4 <= WS_P, "mixer scratch map");

#ifdef TIME_RSUB
#define RT(k) do { if (!SAMPLE && MODE == 3 && F.vcu == 200) { const unsigned long long now_ = __builtin_amdgcn_s_memrealtime(); volatile LAS unsigned long long* tq_ = (volatile LAS unsigned long long*)(F.lds + MISC_OFF + 64); if ((k) == TIME_RSUB && F.tid == 0) tq_[0] += now_ - tq_[1]; if (F.tid == 0) tq_[1] = now_; } } while (0)
#else
#define RT(k) do {} while (0)
#endif
template <bool SAMPLE, int MODE>
__device__ __forceinline__ void rnn_item(const Frame& F, int item) {
    constexpr int XRAW_OFF = 0, XRAW_LD = 136, XCF_OFF = 18432, XCF_LD = 132, XCB_OFF = 52224, XCB_LD = 136, HB_OFF = 69632, CW_OFF = 103424;
    constexpr bool FULL = SAMPLE || MODE == 3;
    const int tid = F.tid, lane = F.lane, wid = F.wave;
    const int seg = SAMPLE ? 0 : (MODE == 3 ? 2 * (item & 3) : (item & 7)), n = SAMPLE ? item : (MODE == 3 ? ((item >> 2) & 7) : ((item >> 3) & 7)), b = SAMPLE ? 0 : (MODE == 3 ? (item >> 5) : (item >> 6)), ch0 = 128 * n;
    LAS bf16_t* XRAW = (LAS bf16_t*)(F.lds + XRAW_OFF); LAS float* XCF = (LAS float*)(F.lds + XCF_OFF); LAS bf16_t* XCB = (LAS bf16_t*)(F.lds + XCB_OFF);
    LAS float* HB = (LAS float*)(F.lds + HB_OFF); LAS float* CW = (LAS float*)(F.lds + CW_OFF);
    for (int i = tid; i < 5 * 128; i += NTHR) { const int j = i >> 7, c = i & 127; CW[i] = j < 4 ? F.in[I_CW][j * D + ch0 + c] : F.in[I_CB][ch0 + c]; }
    const int q = lane >> 4, cl = 16 * wid + (lane & 15);
    const float ba = F.in[I_RBA][ch0 + cl], bx = F.in[I_RBX][ch0 + cl], sp8 = 8.0f * softplus_(-F.in[I_LAM][ch0 + cl]), sp8l2 = sp8 * LOG2E;
    bf16x8 Bw[2][4];
#pragma unroll
    for (int g = 0; g < 2; ++g)
#pragma unroll
        for (int ks = 0; ks < 4; ++ks) Bw[g][ks] = *(const bf16x8*)(F.Wrg_t + ((size_t)(g * 8 + n) * 128 + cl) * 128 + 32 * ks + 8 * q);
    const int t5 = tid >> 3, c5 = 16 * (tid & 7);
    float* ragg = (float*)(F.ws + WS_RAGG);
    float carry = 0.f, aprod = 1.f;
    if constexpr (!SAMPLE && MODE == 3) {
        float fa[7], fh[7];
#pragma unroll
        for (int s = 0; s < 7; ++s) { const float* ag = ragg + ((size_t)((b * 8 + n) * 8 + s)) * 256; fa[s] = s < seg ? ag[cl] : 1.f; fh[s] = s < seg ? ag[128 + cl] : 0.f; }
#pragma unroll
        for (int s = 0; s < 7; ++s) carry = fmaf(fa[s], carry, fh[s]);
    }
    const int ntiles = SAMPLE ? 2 : (MODE == 3 ? 8 : 4), tile0 = SAMPLE ? 0 : 4 * seg;
    u32x4 pxr[3], py0 = (u32x4){0u, 0u, 0u, 0u}, py1 = py0;
    auto prefetch = [&](int t0n) {
        if constexpr (!SAMPLE) {
#pragma unroll
            for (int i3 = 0; i3 < 3; ++i3) { const int e = tid + NTHR * i3, i = e >> 4, chk = e & 15, t = t0n - 3 + i; pxr[i3] = (u32x4){0u, 0u, 0u, 0u};
                if (e < 67 * 16 && t >= 0) pxr[i3] = *(const u32x4*)(F.P + ((size_t)b * TSEQ + t) * PLD + PC_XR + ch0 + 8 * chk); }
            if constexpr (FULL) { const bf16_t* yp = F.P + ((size_t)b * TSEQ + t0n + t5) * PLD + PC_YR + ch0 + c5; py0 = *(const u32x4*)yp; py1 = *(const u32x4*)(yp + 8); }
        }
    };
    if constexpr (!SAMPLE) prefetch(64 * tile0);
    __syncthreads();
    for (int tt = 0; tt < ntiles; ++tt) {
        RT(0);
        const int t0 = 64 * (tile0 + tt);
        const size_t row5 = SAMPLE ? (size_t)(MP + t0 + t5) : (size_t)b * TSEQ + t0 + t5;
        bf16_t* yrp = F.P + row5 * PLD + PC_YR + ch0 + c5;
        u32x4 y0 = py0, y1 = py1;
        if constexpr (SAMPLE) { y0 = *(const u32x4*)yrp; y1 = *(const u32x4*)(yrp + 8); }
        if constexpr (!SAMPLE) {
#pragma unroll
            for (int i3 = 0; i3 < 3; ++i3) { const int e = tid + NTHR * i3, i = e >> 4, chk = e & 15; if (e < 67 * 16) *(LAS u32x4*)(XRAW + i * XRAW_LD + 8 * chk) = pxr[i3]; }
            __syncthreads(); RT(1);
            if (tt + 1 < ntiles) prefetch(t0 + 64);
            const int c0 = 8 * (tid & 15);
            float w[4][8], cb8[8];
#pragma unroll
            for (int e = 0; e < 8; ++e) { cb8[e] = CW[4 * 128 + c0 + e];
#pragma unroll
                for (int j = 0; j < 4; ++j) w[j][e] = CW[j * 128 + c0 + e]; }
#pragma unroll
            for (int rr = 0; rr < 2; ++rr) { const int t = (tid >> 4) + 32 * rr; float xc[8];
#pragma unroll
                for (int e = 0; e < 8; ++e) xc[e] = cb8[e];
#pragma unroll
                for (int j = 0; j < 4; ++j) { float x[8]; unpack8(*(const LAS u32x4*)(XRAW + (t + j) * XRAW_LD + c0), x);
#pragma unroll
                    for (int e = 0; e < 8; ++e) xc[e] = fmaf(w[j][e], x[e], xc[e]); }
                *(LAS f32x4*)(XCF + t * XCF_LD + c0) = (f32x4){xc[0], xc[1], xc[2], xc[3]}; *(LAS f32x4*)(XCF + t * XCF_LD + c0 + 4) = (f32x4){xc[4], xc[5], xc[6], xc[7]};
                *(LAS u32x4*)(XCB + t * XCB_LD + c0) = pack8(xc); }
        } else {
            const int s = t0 + t5; const bf16_t* xrp = F.P + (size_t)(MP + s) * PLD + PC_XR + ch0 + c5;
            float xr[16]; { float a8[8], b8[8]; unpack8(*(const u32x4*)xrp, a8); unpack8(*(const u32x4*)(xrp + 8), b8);
#pragma unroll
                for (int e = 0; e < 8; ++e) { xr[e] = a8[e]; xr[8 + e] = b8[e]; } }
            const float* bufp = F.in[I_SRC] + (size_t)s * 3 * D + ch0 + c5; float* csp = F.out + O_CS + (size_t)s * 3 * D + ch0 + c5;
            float xc[16];
#pragma unroll
            for (int e = 0; e < 16; ++e) xc[e] = CW[4 * 128 + c5 + e] + CW[3 * 128 + c5 + e] * xr[e];
#pragma unroll
            for (int j = 0; j < 3; ++j)
#pragma unroll
                for (int v4 = 0; v4 < 4; ++v4) { const f32x4 bv = *(const f32x4*)(bufp + j * D + 4 * v4);
#pragma unroll
                    for (int e = 0; e < 4; ++e) xc[4 * v4 + e] = fmaf(CW[j * 128 + c5 + 4 * v4 + e], bv[e], xc[4 * v4 + e]);
                    if (j >= 1) *(f32x4*)(csp + (j - 1) * D + 4 * v4) = bv; }
#pragma unroll
            for (int v4 = 0; v4 < 4; ++v4) { *(f32x4*)(csp + 2 * D + 4 * v4) = (f32x4){xr[4 * v4], xr[4 * v4 + 1], xr[4 * v4 + 2], xr[4 * v4 + 3]};
                *(LAS f32x4*)(XCF + t5 * XCF_LD + c5 + 4 * v4) = (f32x4){xc[4 * v4], xc[4 * v4 + 1], xc[4 * v4 + 2], xc[4 * v4 + 3]}; }
            { float h8[8];
#pragma unroll
              for (int hf = 0; hf < 2; ++hf) {
#pragma unroll
                for (int e = 0; e < 8; ++e) h8[e] = xc[8 * hf + e];
                *(LAS u32x4*)(XCB + t5 * XCB_LD + c5 + 8 * hf) = pack8(h8); } }
        }
        __syncthreads(); RT(2);
        f32x4 acc[4][2];
#pragma unroll
        for (int m = 0; m < 4; ++m) { acc[m][0] = (f32x4){0.f, 0.f, 0.f, 0.f}; acc[m][1] = (f32x4){0.f, 0.f, 0.f, 0.f}; }
#pragma unroll
        for (int m = 0; m < 4; ++m)
#pragma unroll
            for (int ks = 0; ks < 4; ++ks) { const bf16x8 a = *(const LAS bf16x8*)(XCB + (16 * m + (lane & 15)) * XCB_LD + 32 * ks + 8 * q);
                acc[m][0] = MFMA16(a, Bw[0][ks], acc[m][0]); acc[m][1] = MFMA16(a, Bw[1][ks], acc[m][1]); }
#pragma unroll
        for (int m = 0; m < 4; ++m) {
            float av[4], bv[4];
#pragma unroll
            for (int reg = 0; reg < 4; ++reg) { const int t = 16 * m + 4 * q + reg; const float xcv = XCF[t * XCF_LD + cl];
                const float r = sigm(acc[m][0][reg] + ba), ig = sigm(acc[m][1][reg] + bx);
                const float x2 = -2.0f * sp8 * r;
                const float em = -x2 * (1.0f + x2 * (0.5f + x2 * (0.16666667f + x2 * (0.041666668f + x2 * (0.0083333338f + x2 * 0.0013888889f)))));
                float mult = __builtin_amdgcn_sqrtf(fmaxf(em, 0.f)); if (!SAMPLE && (t0 + t) == 0) mult = 1.0f;
                av[reg] = ex2(-sp8l2 * r); bv[reg] = mult * ig * xcv; }
            if constexpr (!SAMPLE) {
                float Al = 1.f, Hl = 0.f;
#pragma unroll
                for (int reg = 0; reg < 4; ++reg) { Hl = fmaf(av[reg], Hl, bv[reg]); Al *= av[reg]; }
                float hin = carry, cn = carry;
#pragma unroll
                for (int qq = 0; qq < 4; ++qq) { const float Ag = __shfl(Al, (lane & 15) + 16 * qq), Hg = __shfl(Hl, (lane & 15) + 16 * qq);
                    cn = fmaf(Ag, cn, Hg); hin = (qq < q) ? cn : hin; if (MODE == 1) aprod *= Ag; }
                carry = cn;
                if constexpr (MODE == 3) { float hv = hin;
#pragma unroll
                    for (int reg = 0; reg < 4; ++reg) { hv = fmaf(av[reg], hv, bv[reg]); HB[(16 * m + 4 * q + reg) * XCF_LD + cl] = hv; } }
            } else {
#pragma unroll
                for (int reg = 0; reg < 4; ++reg) { const int t = 16 * m + 4 * q + reg; const float h0 = F.in[I_SRH][(size_t)(t0 + t) * D + ch0 + cl];
                    HB[t * XCF_LD + cl] = fmaf(av[reg], h0, bv[reg]); }
            }
        }
        __syncthreads(); RT(3);
        if constexpr (FULL) {
            float h[16], yv[16], o8[8];
#pragma unroll
            for (int v4 = 0; v4 < 4; ++v4) { const f32x4 hv = *(const LAS f32x4*)(HB + t5 * XCF_LD + c5 + 4 * v4); h[4 * v4] = hv[0]; h[4 * v4 + 1] = hv[1]; h[4 * v4 + 2] = hv[2]; h[4 * v4 + 3] = hv[3]; }
            { float a8[8], b8[8]; unpack8(y0, a8); unpack8(y1, b8);
#pragma unroll
              for (int e = 0; e < 8; ++e) { yv[e] = a8[e]; yv[8 + e] = b8[e]; } }
            if constexpr (SAMPLE) { float* hsp = F.out + O_HS + (size_t)(t0 + t5) * D + ch0 + c5;
#pragma unroll
                for (int v4 = 0; v4 < 4; ++v4) *(f32x4*)(hsp + 4 * v4) = (f32x4){h[4 * v4], h[4 * v4 + 1], h[4 * v4 + 2], h[4 * v4 + 3]}; }
#pragma unroll
            for (int hf = 0; hf < 2; ++hf) {
#pragma unroll
                for (int e = 0; e < 8; ++e) o8[e] = h[8 * hf + e] * gelu_tanh_(yv[8 * hf + e]);
                *(u32x4*)(yrp + 8 * hf) = pack8(o8); }
            if constexpr (!SAMPLE) { if (tile0 + tt == 31 && t5 >= 61) { float* cpp = F.out + O_CP + ((size_t)b * 3 + (t5 - 61)) * D + ch0 + c5;
#pragma unroll
                for (int e = 0; e < 16; ++e) cpp[e] = bf2f(XRAW[(t5 + 3) * XRAW_LD + c5 + e]); } }
        }
        RT(4);
    }
    if constexpr (!SAMPLE && MODE == 1) { if (q == 0) { float* ag = ragg + (size_t)item * 256; ag[cl] = aprod; ag[128 + cl] = carry; } }
    if constexpr (!SAMPLE && MODE == 3) { if (seg == 6 && q == 0) F.out[O_HP + (size_t)b * D + ch0 + cl] = carry; }
    __syncthreads();
}

__device__ __forceinline__ int crow(int reg, int h) { return (reg & 3) + 8 * (reg >> 2) + 4 * h; }
__device__ __forceinline__ bf16x8 pack_step(const f32x16& x, int s) {
    u32x4 p; p.x = pk2(x[8 * s], x[8 * s + 1]); p.y = pk2(x[8 * s + 2], x[8 * s + 3]); p.z = pk2(x[8 * s + 4], x[8 * s + 5]); p.w = pk2(x[8 * s + 6], x[8 * s + 7]);
    return __builtin_bit_cast(bf16x8, p);
}
#ifdef TIME_SUB
#define GT(k) do { if (MODE == 3 && F.vcu == 0) { const unsigned long long now_ = __builtin_amdgcn_s_memrealtime(); volatile LAS unsigned long long* tq_ = (volatile LAS unsigned long long*)(F.lds + MISC_OFF + 64); if ((k) == TIME_SUB && F.tid == 0) tq_[0] += now_ - tq_[1]; if (F.tid == 0) tq_[1] = now_; } } while (0)
#else
#define GT(k) do {} while (0)
#endif
template <int MODE>
__device__ __forceinline__ void gla_item(const Frame& F, int item) {
    constexpr int VRAW = 0, VRAW_LD = 264, LRS = 33792, QI = 37888, QK_LD = 136, KI = 55296, OBUF = 72704, OGT = 0, KET = 72704, T_LD = 72, VT = 91136, ATT = 128000, SEG = 137216, DEC = 139264, WLS = 139776;
    static_assert(WLS + 17 * 512 <= MISC_OFF, "GLA LDS map");
    constexpr bool FULL = (MODE == 3);
    const int tid = F.tid, lane = F.lane, w = F.wave;
    const int j = item & 3, hh = (item >> 2) & 3, b = item >> 4; const size_t rowbase = (size_t)b * TSEQ;
    LAS bf16_t* sVRAW = (LAS bf16_t*)(F.lds + VRAW); LAS bf16_t* sQI = (LAS bf16_t*)(F.lds + QI); LAS bf16_t* sKI = (LAS bf16_t*)(F.lds + KI);
    LAS float* sO = (LAS float*)(F.lds + OBUF); LAS bf16_t* sKET = (LAS bf16_t*)(F.lds + KET); LAS bf16_t* sVT = (LAS bf16_t*)(F.lds + VT); LAS bf16_t* sATT = (LAS bf16_t*)(F.lds + ATT);
    LAS float* sSEG = (LAS float*)(F.lds + SEG); LAS float* sDEC = (LAS float*)(F.lds + DEC);
    const int kk = tid & 127, seg = tid >> 7;
    LAS bf16_t* sLRb = (LAS bf16_t*)(F.lds + LRS); LAS float* sG = (LAS float*)(F.lds + QI);
    bf16x8 Bwl; { float wv[8];
#pragma unroll
        for (int jj = 0; jj < 8; ++jj) wv[jj] = (lane >> 4) < 2 ? F.in[I_WLR][(8 * (lane >> 4) + jj) * 512 + hh * 128 + 16 * w + (lane & 15)] : 0.f;
        Bwl = __builtin_bit_cast(bf16x8, pack8(wv)); }
    const float bias = F.in[I_BLR][hh * 128 + kk];
    const int r32 = lane & 31, h = lane >> 5, q = lane >> 4;
    float* gagg = (float*)(F.ws + WS_GAGG);
    f32x16 S[4];
#pragma unroll
    for (int kb = 0; kb < 4; ++kb)
#pragma unroll
        for (int i = 0; i < 16; ++i) S[kb][i] = 0.f;
    float dsum = 0.f;
    if constexpr (FULL) {
        for (int s = 0; s < j; ++s) { const float* ag = gagg + (size_t)((b * 4 + hh) * 3 + s) * GAGG_FLOATS;
            __syncthreads();
            if (tid < 128) sDEC[tid] = ag[32768 + tid];
            __syncthreads();
#pragma unroll
            for (int kb = 0; kb < 4; ++kb) {
#pragma unroll
                for (int g4 = 0; g4 < 4; ++g4) { const f32x4 kv = *(const f32x4*)(ag + ((size_t)((w * 4 + kb) * 4 + g4)) * 256 + 4 * lane); const f32x4 dd = *(const LAS f32x4*)(sDEC + 32 * kb + 8 * g4 + 4 * h);
#pragma unroll
                    for (int e = 0; e < 4; ++e) S[kb][4 * g4 + e] = fmaf(S[kb][4 * g4 + e], dd[e], kv[e]); }
            asm volatile("" ::: "memory"); }
        }
    }
    const char* Pb = (const char*)F.P;
    const unsigned ov = (unsigned)(((tid >> 5) * PLD + PC_V + 256 * hh + 8 * (tid & 31)) * 2), olr = (unsigned)(((tid >> 1) * PLD + PC_LR + 8 * (tid & 1)) * 2);
    const unsigned okq = (unsigned)(((tid >> 4) * PLD + 128 * hh + 8 * (tid & 15)) * 2), oog = (unsigned)((8 * w * PLD + PC_OG + 256 * hh + 4 * lane) * 2);
    LAS bf16_t* sQR = (LAS bf16_t*)(F.lds + VRAW); LAS bf16_t* sKR = (LAS bf16_t*)(F.lds + VRAW + 16384);
    u32x4 pv[4], plr = (u32x4){0u, 0u, 0u, 0u}, pk[2], pq[2];
    auto prefetch = [&](size_t r0) {
        const char* rb = Pb + r0 * (size_t)(PLD * 2);
        unsigned o1 = ov, o2 = olr, o3 = okq; asm volatile("" : "+v"(o1), "+v"(o2), "+v"(o3));
#pragma unroll
        for (int i = 0; i < 4; ++i) pv[i] = *(const u32x4*)(rb + (o1 + (unsigned)(i * 16 * PLD * 2)));
        if (tid < 128) plr = *(const u32x4*)(rb + o2);
#pragma unroll
        for (int i = 0; i < 2; ++i) pk[i] = *(const u32x4*)(rb + (o3 + (unsigned)((i * 32 * PLD + PC_K) * 2)));
    };
    prefetch(rowbase + 64 * (8 * j));
    __syncthreads();
    for (int cn = 8 * j; cn < 8 * j + 8; ++cn) {
        const size_t row0 = rowbase + 64 * cn;
        GT(0);
        if constexpr (FULL) { const char* rb = Pb + row0 * (size_t)(PLD * 2); unsigned o3 = okq; asm volatile("" : "+v"(o3));
#pragma unroll
            for (int i = 0; i < 2; ++i) pq[i] = *(const u32x4*)(rb + (o3 + (unsigned)((i * 32 * PLD + PC_Q) * 2))); }
#pragma unroll
        for (int i = 0; i < 4; ++i) { const int e = tid + NTHR * i, row = e >> 5, c16 = e & 31; *(LAS u32x4*)(sVRAW + row * VRAW_LD + 8 * c16) = pv[i]; }
        if (tid < 128) { *(LAS u32x4*)(sLRb + (tid >> 1) * 32 + 8 * (tid & 1)) = plr; *(LAS u32x4*)(sLRb + (tid >> 1) * 32 + 16 + 8 * (tid & 1)) = (u32x4){0u, 0u, 0u, 0u}; }
        __syncthreads(); GT(1);
#pragma unroll
        for (int m = 0; m < 4; ++m) { const bf16x8 a = *(const LAS bf16x8*)(sLRb + (16 * m + (lane & 15)) * 32 + 8 * q); const f32x4 cg = MFMA16(a, Bwl, ((f32x4){0.f, 0.f, 0.f, 0.f}));
#pragma unroll
            for (int reg = 0; reg < 4; ++reg) sG[(16 * m + 4 * q + reg) * 128 + 16 * w + (lane & 15)] = cg[reg]; }
        { const int dv = tid & 255, hf = tid >> 8;
#pragma unroll
          for (int s8 = 0; s8 < 4; ++s8) { const int s = 32 * hf + 8 * s8; u32x4 wv; unsigned t[8];
#pragma unroll
              for (int jj = 0; jj < 8; ++jj) t[jj] = sVRAW[(s + jj) * VRAW_LD + dv];
              wv.x = t[0] | (t[1] << 16); wv.y = t[2] | (t[3] << 16); wv.z = t[4] | (t[5] << 16); wv.w = t[6] | (t[7] << 16);
              *(LAS u32x4*)(sVT + dv * T_LD + s) = wv; } }
        __syncthreads(); GT(2);
        float c[16]; float run = 0.f;
#pragma unroll
        for (int i = 0; i < 16; ++i) { float x = sG[(16 * seg + i) * 128 + kk] + bias;
            x = fminf(fmaxf(x, -80.f), 80.f);
            run -= __builtin_amdgcn_logf(1.0f + ex2(-LOG2E * x)) * (1.0f / 16.0f);
            c[i] = run; }
        sSEG[seg * 128 + kk] = run;
#pragma unroll
        for (int i = 0; i < 2; ++i) { const int rowq = (tid >> 4) + 32 * i, cq = 8 * (tid & 15); *(LAS u32x4*)(sKR + rowq * 128 + cq) = pk[i]; if constexpr (FULL) *(LAS u32x4*)(sQR + rowq * 128 + cq) = pq[i]; }
        __syncthreads(); GT(3);
        if (cn + 1 < 8 * j + 8) prefetch(row0 + 64);
        { float off = 0.f, tot = 0.f;
#pragma unroll
          for (int s2 = 0; s2 < 4; ++s2) { const float v = sSEG[s2 * 128 + kk]; tot += v; off += (s2 < seg) ? v : 0.f; }
          const float dec = ex2(tot);
          if (seg == 0) { sDEC[kk] = dec; dsum += tot; }
          float ke[16];
#pragma unroll
          for (int i = 0; i < 16; ++i) { const int t = 16 * seg + i; const float bc = off + c[i]; const float eb = ex2(bc), ei = __builtin_amdgcn_rcpf(eb); const float kf = bf2f(sKR[t * 128 + kk]) * ei;
              ke[i] = kf * dec;
              if constexpr (FULL) { sQI[t * QK_LD + kk] = (bf16_t)(pk2(bf2f(sQR[t * 128 + kk]) * 0.08838834764831845f * eb, 0.f) & 0xffffu); sKI[t * QK_LD + kk] = (bf16_t)(pk2(kf, 0.f) & 0xffffu); } }
          { float a8[8], b8[8];
#pragma unroll
            for (int e = 0; e < 8; ++e) { a8[e] = ke[e]; b8[e] = ke[8 + e]; }
            *(LAS u32x4*)(sKET + kk * T_LD + 16 * seg) = pack8(a8); *(LAS u32x4*)(sKET + kk * T_LD + 16 * seg + 8) = pack8(b8); } }
        __syncthreads(); GT(4);
        if constexpr (FULL) {
            const char* gp = Pb + (row0 + 8 * w) * (size_t)(PLD * 2) + (size_t)((PC_OG + 256 * hh) * 2); unsigned o5 = (unsigned)((lane >> 5) * PLD * 2 + (lane & 31) * 16); asm volatile("" : "+v"(o5));
#pragma unroll
            for (int i = 0; i < 4; ++i) __builtin_amdgcn_global_load_lds((const unsigned*)(gp + (o5 + (unsigned)(2 * i * PLD * 2))), (LAS unsigned*)(F.lds + OGT + w * 4096 + i * 1024), 16, 0, 0); }
        if constexpr (FULL) {
#pragma unroll
            for (int u = 0; u < 2; ++u) { const int T = 2 * w + u, ti = T >> 2, si = T & 3; f32x4 cc = (f32x4){0.f, 0.f, 0.f, 0.f};
                if (si <= ti) {
#pragma unroll
                    for (int ks = 0; ks < 4; ++ks) { const bf16x8 a = *(const LAS bf16x8*)(sKI + (16 * si + (lane & 15)) * QK_LD + 32 * ks + 8 * q), bq = *(const LAS bf16x8*)(sQI + (16 * ti + (lane & 15)) * QK_LD + 32 * ks + 8 * q);
                        cc = MFMA16(a, bq, cc); } }
                const int t = 16 * ti + (lane & 15), s0 = 16 * si + 4 * q; float v[4];
#pragma unroll
                for (int reg = 0; reg < 4; ++reg) v[reg] = (s0 + reg <= t) ? cc[reg] : 0.f;
                u32x2 wv; wv.x = pk2(v[0], v[1]); wv.y = pk2(v[2], v[3]); *(LAS u32x2*)(sATT + t * T_LD + s0) = wv; }
            asm volatile("s_waitcnt lgkmcnt(0)" ::: "memory"); __builtin_amdgcn_s_barrier(); asm volatile("" ::: "memory"); GT(5);
        }
        bf16x8 vf[4];
#pragma unroll
        for (int st = 0; st < 4; ++st) vf[st] = *(const LAS bf16x8*)(sVT + (32 * w + r32) * T_LD + 16 * st + 8 * h);
        f32x16 o[2];
        if constexpr (FULL) {
#pragma unroll
            for (int i = 0; i < 16; ++i) { o[0][i] = 0.f; o[1][i] = 0.f; }
#pragma unroll
            for (int kb = 0; kb < 4; ++kb)
#pragma unroll
                for (int s2 = 0; s2 < 2; ++s2) { const bf16x8 Bf = pack_step(S[kb], s2);
#pragma unroll
                    for (int tb = 0; tb < 2; ++tb) { const LAS bf16_t* qp = sQI + (32 * tb + r32) * QK_LD + 32 * kb + 16 * s2 + 4 * h; const u32x2 lo = *(const LAS u32x2*)qp, hi = *(const LAS u32x2*)(qp + 8);
                        const u32x4 af = (u32x4){lo.x, lo.y, hi.x, hi.y}; o[tb] = MFMA32(__builtin_bit_cast(bf16x8, af), Bf, o[tb]); }
                    }
#pragma unroll
            for (int tb = 0; tb < 2; ++tb)
#pragma unroll
                for (int st = 0; st < 4; ++st) { if (tb == 0 && st >= 2) continue; const bf16x8 af = *(const LAS bf16x8*)(sATT + (32 * tb + r32) * T_LD + 16 * st + 8 * h); o[tb] = MFMA32(af, vf[st], o[tb]); }
        }
#pragma unroll
        for (int kb = 0; kb < 4; ++kb) {
#pragma unroll
            for (int g4 = 0; g4 < 4; ++g4) { const f32x4 dd = *(const LAS f32x4*)(sDEC + 32 * kb + 8 * g4 + 4 * h);
#pragma unroll
                for (int e = 0; e < 4; ++e) S[kb][4 * g4 + e] *= dd[e]; }
#pragma unroll
            for (int st = 0; st < 4; ++st) { const bf16x8 af = *(const LAS bf16x8*)(sKET + (32 * kb + r32) * T_LD + 16 * st + 8 * h); S[kb] = MFMA32(af, vf[st], S[kb]); } }
        if constexpr (FULL) { asm volatile("s_waitcnt lgkmcnt(0)" ::: "memory"); __builtin_amdgcn_s_barrier(); asm volatile("" ::: "memory"); } else __syncthreads();
        GT(6);
        if constexpr (FULL) {
#pragma unroll
            for (int tb = 0; tb < 2; ++tb)
#pragma unroll
                for (int i = 0; i < 16; ++i) sO[(32 * tb + crow(i, h)) * 256 + 32 * w + r32] = o[tb][i];
            __syncthreads(); GT(7);
            const f32x4 gn = *(const f32x4*)(F.in[I_GNG] + 4 * lane);
#pragma unroll
            for (int jj = 0; jj < 8; ++jj) { const int t = 8 * w + jj; const f32x4 v = *(const LAS f32x4*)(sO + t * 256 + 4 * lane);
                const float rs = __builtin_amdgcn_rsqf(wave_sum((v[0] * v[0] + v[1] * v[1]) + (v[2] * v[2] + v[3] * v[3])) * (1.0f / 256.0f) + EPS);
                const u32x2 ogw = *(const LAS u32x2*)(F.lds + OGT + w * 4096 + jj * 512 + lane * 8); const float g0 = bf_lo(ogw.x), g1 = bf_hi(ogw.x), g2 = bf_lo(ogw.y), g3 = bf_hi(ogw.y);
                u32x2 wv; wv.x = pk2(v[0] * rs * gn[0] * silu_(g0), v[1] * rs * gn[1] * silu_(g1)); wv.y = pk2(v[2] * rs * gn[2] * silu_(g2), v[3] * rs * gn[3] * silu_(g3));
                *(u32x2*)(const_cast<char*>(Pb) + row0 * (size_t)(PLD * 2) + (oog + (unsigned)(jj * PLD * 2))) = wv; }
            __syncthreads(); GT(8);
        }
    }
    if constexpr (!FULL) {
        float* ag = gagg + (size_t)((b * 4 + hh) * 3 + j) * GAGG_FLOATS;
#pragma unroll
        for (int kb = 0; kb < 4; ++kb)
#pragma unroll
            for (int g4 = 0; g4 < 4; ++g4) *(f32x4*)(ag + ((size_t)((w * 4 + kb) * 4 + g4)) * 256 + 4 * lane) = (f32x4){S[kb][4 * g4], S[kb][4 * g4 + 1], S[kb][4 * g4 + 2], S[kb][4 * g4 + 3]};
        if (seg == 0) ag[32768 + kk] = ex2(dsum);
    } else if (j == 3) {
        float* sp = F.out + O_SP + (size_t)(b * 4 + hh) * 128 * 256;
#pragma unroll
        for (int kb = 0; kb < 4; ++kb)
#pragma unroll
            for (int i = 0; i < 16; ++i) sp[(size_t)(32 * kb + crow(i, h)) * 256 + 32 * w + r32] = S[kb][i];
    }
    __syncthreads();
}

__device__ __forceinline__ void gla_sample_item(const Frame& F, int item) {
    constexpr int SQ = 0, SK = 512, SE = 1024, RED = 2048;
    const int tid = F.tid, lane = F.lane, w = F.wave; const int hh = item & 3, s = item >> 2;
    LAS float* sq = (LAS float*)(F.lds + SQ); LAS float* sk = (LAS float*)(F.lds + SK); LAS float* se = (LAS float*)(F.lds + SE); LAS float* red = (LAS float*)(F.lds + RED);
    const bf16_t* Prow = F.P + (size_t)(MP + s) * PLD;
    if (tid < 128) { float x = F.in[I_BLR][hh * 128 + tid];
#pragma unroll
        for (int r = 0; r < 16; ++r) x = fmaf(bf2f(Prow[PC_LR + r]), F.in[I_WLR][r * 512 + hh * 128 + tid], x);
        se[tid] = __expf(-softplus_(-x) * (1.0f / 16.0f)); sq[tid] = bf2f(Prow[PC_Q + 128 * hh + tid]) * 0.08838834764831845f; sk[tid] = bf2f(Prow[PC_K + 128 * hh + tid]); }
    __syncthreads();
    const u32x2 vw = *(const u32x2*)(Prow + PC_V + 256 * hh + 4 * lane); const f32x4 v4 = (f32x4){bf_lo(vw.x), bf_hi(vw.x), bf_lo(vw.y), bf_hi(vw.y)};
    const float* S0 = F.in[I_SGLA] + ((size_t)(s * 4 + hh) * 128 + 16 * w) * 256 + 4 * lane; float* S1 = F.out + O_SS + ((size_t)(s * 4 + hh) * 128 + 16 * w) * 256 + 4 * lane;
    f32x4 o4 = (f32x4){0.f, 0.f, 0.f, 0.f};
    f32x4 sv[16];
#pragma unroll
    for (int jj = 0; jj < 16; ++jj) sv[jj] = __builtin_nontemporal_load((const f32x4*)(S0 + jj * 256));
#pragma unroll
    for (int jj = 0; jj < 16; ++jj) { const int k = 16 * w + jj; const f32x4 sn = sv[jj] * se[k] + v4 * sk[k]; __builtin_nontemporal_store(sn, (f32x4*)(S1 + jj * 256)); o4 = o4 + sn * sq[k]; }
    *(LAS f32x4*)(red + w * 256 + 4 * lane) = o4;
    __syncthreads();
    if (w == 0) { f32x4 o = (f32x4){0.f, 0.f, 0.f, 0.f};
#pragma unroll
        for (int ww = 0; ww < 8; ++ww) o = o + *(const LAS f32x4*)(red + ww * 256 + 4 * lane);
        const float rs = rsqrtf(wave_sum((o[0] * o[0] + o[1] * o[1]) + (o[2] * o[2] + o[3] * o[3])) * (1.0f / 256.0f) + EPS);
        const f32x4 gn = *(const f32x4*)(F.in[I_GNG] + 4 * lane); bf16_t* ogp = F.P + (size_t)(MP + s) * PLD + PC_OG + 256 * hh + 4 * lane; const u32x2 ogw = *(const u32x2*)ogp;
        u32x2 wv; wv.x = pk2(o[0] * rs * gn[0] * silu_(bf_lo(ogw.x)), o[1] * rs * gn[1] * silu_(bf_hi(ogw.x))); wv.y = pk2(o[2] * rs * gn[2] * silu_(bf_lo(ogw.y)), o[3] * rs * gn[3] * silu_(bf_hi(ogw.y)));
        *(u32x2*)ogp = wv; }
    __syncthreads();
}

template <int APROV>
__device__ __forceinline__ void skinny_piece(const Frame& F, const bf16_t* A, int lda, const bf16_t* Bt, int K, int k0, int nsub, int cb, const SlabMap om, int oslab) {
    constexpr int SA = 0, SB = 34816, LD = 136;
    const int tid = F.tid, lane = F.lane, w = F.wave, fr = lane & 15, fq = lane >> 4;
    LAS bf16_t* sA = (LAS bf16_t*)(F.lds + SA); LAS bf16_t* sB = (LAS bf16_t*)(F.lds + SB);
    f32x4 acc[8];
#pragma unroll
    for (int nb = 0; nb < 8; ++nb) acc[nb] = (f32x4){0.f, 0.f, 0.f, 0.f};
    for (int sub = 0; sub < nsub; ++sub) { const int kk0 = k0 + 128 * sub;
        __syncthreads();
#pragma unroll
        for (int i = 0; i < 4; ++i) { const int e = tid + NTHR * i, row = e >> 4, c16 = e & 15; u32x4 v;
            if constexpr (APROV == 0) v = *(const u32x4*)(A + (size_t)row * lda + kk0 + 8 * c16);
            else { const int cc = kk0 + 8 * c16; const bf16_t* gp = F.P + (size_t)(MP + row) * PLD + cc;
                float ga[8], gb[8], o[8]; unpack8(*(const u32x4*)(gp + PC_GA), ga); unpack8(*(const u32x4*)(gp + PC_GB), gb);
#pragma unroll
                for (int hf = 0; hf < 2; ++hf) { const f32x4 ya = *(const f32x4*)slab_at(F, SLAB_B, 0, row, cc + 4 * hf) + *(const f32x4*)slab_at(F, SLAB_B, 1, row, cc + 4 * hf), yb = *(const f32x4*)slab_at(F, SLAB_B, 2, row, cc + 4 * hf) + *(const f32x4*)slab_at(F, SLAB_B, 3, row, cc + 4 * hf);
#pragma unroll
                    for (int e2 = 0; e2 < 4; ++e2) o[4 * hf + e2] = sigm(ga[4 * hf + e2]) * ya[e2] + sigm(gb[4 * hf + e2]) * yb[e2]; }
                v = pack8(o); }
            *(LAS u32x4*)(sA + row * LD + 8 * c16) = v;
            *(LAS u32x4*)(sB + row * LD + 8 * c16) = *(const u32x4*)(Bt + (size_t)(128 * cb + row) * K + kk0 + 8 * c16); }
        __syncthreads();
        bf16x8 a[4];
#pragma unroll
        for (int s = 0; s < 4; ++s) a[s] = *(const LAS bf16x8*)(sA + (16 * w + fr) * LD + 32 * s + 8 * fq);
#pragma unroll
        for (int nb = 0; nb < 8; ++nb)
#pragma unroll
            for (int s = 0; s < 4; ++s) { const bf16x8 bb = *(const LAS bf16x8*)(sB + (16 * nb + fr) * LD + 32 * s + 8 * fq); acc[nb] = MFMA16(bb, a[s], acc[nb]); }
    }
#pragma unroll
    for (int nb = 0; nb < 8; ++nb) *(f32x4*)slab_at(F, om, oslab, 16 * w + fr, 128 * cb + 16 * nb + 4 * fq) = acc[nb];
    __syncthreads();
}
}
namespace mk {
constexpr int N_PHASES = 13;
__global__ void __launch_bounds__(NTHR, 2) mega_fwd(Args args) {
    extern __shared__ __attribute__((aligned(16))) unsigned char lds_raw[];
    Frame F;
    F.lds = (LAS unsigned char*)lds_raw;
    F.tid = threadIdx.x; F.lane = F.tid & 63; F.wave = __builtin_amdgcn_readfirstlane(F.tid >> 6);
    F.G = gridDim.x; { const int bx = blockIdx.x; F.vcu = (F.G % 8 == 0) ? (bx % 8) * (F.G / 8) + bx / 8 : bx; }
#pragma unroll
    for (int i = 0; i < 24; ++i) F.in[i] = args.in[i];
    F.out = args.out; F.ws = args.ws;
    F.P = (bf16_t*)(args.ws + WS_P);
    unsigned char* ssr = (unsigned char*)(args.out + O_SS);
    F.U = (bf16_t*)(ssr + SS_U); F.Win_t = (bf16_t*)(ssr + SS_WIN); F.Wgu1_t = (bf16_t*)(ssr + SS_WGU1); F.Wd1_t = (bf16_t*)(ssr + SS_WD1);
    F.Wrg_t = (bf16_t*)(args.ws + WS_WRG); F.Wbr_t = (bf16_t*)(args.ws + WS_WBR); F.Wbg_t = (bf16_t*)(args.ws + WS_WBG); F.Wout_t = (bf16_t*)(args.ws + WS_WOUT);
    F.Wgu2_t = (bf16_t*)(args.ws + WS_WGU2); F.Wd2_t = (bf16_t*)(args.ws + WS_WD2);
    volatile LAS unsigned* MISC = (volatile LAS unsigned*)(F.lds + MISC_OFF);
    for (int u = F.tid; u < 128; u += NTHR) MISC[u] = 0u;
    __syncthreads();
    const int lo = args.ph_lo, hi = args.ph_hi;
    XcdBarrier bar; bar.bar = (unsigned*)(args.ws + WS_CTL) + CW_BAR; bar.x = 0; bar.st = nullptr;
    if (hi - lo > 1) bar = xcd_barrier_post((unsigned*)(args.ws + WS_CTL) + CW_BAR, MISC + 8);
#define IN(k) (lo <= (k) && (k) < hi)
#ifdef TIME_PHASE
    unsigned long long tp0 = __builtin_amdgcn_s_memrealtime(), tp1 = 0;
#ifdef TIME_WALL
#define SEAM(k) do { if (IN(k) && IN((k) + 1)) xcd_barrier(bar); if ((k) == TIME_PHASE) tp1 = __builtin_amdgcn_s_memrealtime(); if ((k) + 1 == TIME_PHASE) tp0 = __builtin_amdgcn_s_memrealtime(); } while (0)
#else
#define SEAM(k) do { if ((k) == TIME_PHASE) tp1 = __builtin_amdgcn_s_memrealtime(); if (IN(k) && IN((k) + 1)) xcd_barrier(bar); if ((k) + 1 == TIME_PHASE) tp0 = __builtin_amdgcn_s_memrealtime(); } while (0)
#endif
#else
#define SEAM(k) do { if (IN(k) && IN((k) + 1)) xcd_barrier(bar); } while (0)
#endif
    const int gw = F.vcu * NWAVES + F.wave, NGW = F.G * NWAVES;
    LAS float* scr = (LAS float*)(F.lds + F.wave * 16384);
    constexpr bool AL = true, SP = true;

    if (IN(0)) {
        prep_wgu(F, F.in[I_F1GU], F.Wgu1_t, scr, gw, NGW);
        prep_plain(F, F.in[I_F1D], FF, D, F.Wd1_t, scr, gw, NGW);
        rowphase0(F);
    }
    SEAM(0);
    if (IN(1)) {
        pg8::Gemm g{F.P + SC_XA, PLD, F.Wgu1_t, MPAD, 2 * FF, D}; pg8::StaticOrder S; S.init(MPAD, 2 * FF, F.G, (int)blockIdx.x);
        pg8::EpiSwiGLU E{F.P + SC_H, PLD};
        pg8::gemm_phase<pg8::EpiSwiGLU, pg8::StaticOrder, AL, SP>(F.lds, g, S, E);
        { constexpr int NU = (MPAD / 256) * (2 * FF / 256); const int full = NU % F.G;
          if (NU > F.G && full > 0 && (int)blockIdx.x >= full) prep_win(F, scr, ((int)blockIdx.x - full) * NWAVES + F.wave, (F.G - full) * NWAVES);
          else if (!(NU > F.G && full > 0)) prep_win(F, scr, gw, NGW); }
    }
    SEAM(1);
    if (IN(2)) {
        for (int pc = F.vcu; pc < 176; pc += F.G) skinny_piece<0>(F, F.P + (size_t)MP * PLD + SC_H, PLD, F.Wd1_t, FF, 128 * (pc >> 3), 1, pc & 7, SLAB_D, pc >> 3);
        pg8::Gemm g{F.P + SC_H, PLD, F.Wd1_t, MP, D, FF}; pg8::StaticOrder S; S.init(MP, D, F.G, (int)blockIdx.x);
        pg8::EpiBf16 E{F.P + SC_F, PLD};
        pg8::gemm_phase<pg8::EpiBf16, pg8::StaticOrder, AL, SP>(F.lds, g, S, E);
    }
    SEAM(2);
    if (IN(3)) rowphase1(F);
    SEAM(3);
    if (IN(4)) {
        pg8::Gemm g{F.U, D, F.Win_t, MPAD, PLD, D}; pg8::StaticOrder S; S.init(MPAD, PLD, F.G, (int)blockIdx.x);
        pg8::EpiBf16 E{F.P, PLD};
        pg8::gemm_phase<pg8::EpiBf16, pg8::StaticOrder, AL, SP>(F.lds, g, S, E);
        { constexpr int NU = (MPAD / 256) * (PLD / 256); const int full = NU % F.G; const bool part = NU > F.G && full > 0;
          const int g2 = part ? ((int)blockIdx.x - full) * NWAVES + F.wave : gw, n2 = part ? (F.G - full) * NWAVES : NGW;
          if (!part || (int)blockIdx.x >= full) {
              prep_rg(F, scr, g2, n2);
              prep_plain(F, F.in[I_WBR], D, D, F.Wbr_t, scr, g2, n2, 2 * D);
              prep_plain(F, F.in[I_WBG], D, D, F.Wbr_t + D, scr, g2, n2, 2 * D);
              prep_plain(F, F.in[I_WOUT], D, D, F.Wout_t, scr, g2, n2); } }
    }
    SEAM(4);
    if (IN(5)) {
        const int c = F.vcu;
        if (c < 96) { gla_item<1>(F, (c / 3) * 4 + (c % 3)); rnn_item<false, 1>(F, (c / 7) * 8 + (c % 7)); }
        else {
            const int o = c - 96, no = F.G - 96;
            for (int i = 96 + o; i < 448; i += no) rnn_item<false, 1>(F, (i / 7) * 8 + (i % 7));
            if (o >= 32 || no != 160) for (int i = (no == 160 ? o - 32 : o); i < 2 * MS; i += (no == 160 ? 128 : no)) gla_sample_item(F, i);
        }
    }
    SEAM(5);
    if (IN(6)) {
        const int c = F.vcu;
        if (c < 128) { gla_item<3>(F, c); const int j = c & 3;
            if (j < 3) gla_sample_item(F, 2 * MS + c); if (j == 0) gla_sample_item(F, 2 * MS + c + 3); }
        else {
            for (int i = c - 128; i < 256; i += F.G - 128) rnn_item<false, 3>(F, i);
            if (c < 136) rnn_item<true, 3>(F, c - 128);
            for (int i = 3 * MS + c - 128; i < 4 * MS; i += F.G - 128) gla_sample_item(F, i);
        }
    }
    SEAM(6);
    if (IN(7)) {
        for (int pc = F.vcu; pc < 32; pc += F.G) { const int gsel = pc >> 4, ks = (pc >> 3) & 1, cb = pc & 7;
            skinny_piece<0>(F, F.P + (size_t)MP * PLD + (gsel ? PC_OG : PC_YR), PLD, F.Wbr_t + (gsel ? D : 0), 2 * D, 512 * ks, 4, cb, SLAB_B, 2 * gsel + ks); }
        pg8::Gemm g{F.P + PC_YR, PLD, F.Wbr_t, MP, D, 2 * D}; pg8::StaticOrder S; S.init(MP, D, F.G, (int)blockIdx.x);
        pg8::EpiMerge E{F.P + PC_GA, F.P + PC_GB, PLD, F.P + SC_XA, PLD};
        pg8::gemm_phase<pg8::EpiMerge, pg8::StaticOrder, false, SP>(F.lds, g, S, E);
    }
    SEAM(7);
    if (IN(8)) {
        for (int pc = F.vcu; pc < 64; pc += F.G) skinny_piece<1>(F, nullptr, 0, F.Wout_t, D, 128 * (pc >> 3), 1, pc & 7, SLAB_B, 4 + (pc >> 3));
        pg8::Gemm g{F.P + SC_XA, PLD, F.Wout_t, MP, D, D}; pg8::StaticOrder S; S.init(MP, D, F.G, (int)blockIdx.x);
        pg8::EpiBf16 E{F.P + SC_T, PLD};
        pg8::gemm_phase<pg8::EpiBf16, pg8::StaticOrder, AL, SP>(F.lds, g, S, E);
    }
    SEAM(8);
    if (IN(9)) {
        prep_wgu(F, F.in[I_F2GU], F.Wgu2_t, scr, gw, NGW);
        rowphase2(F);
    }
    SEAM(9);
    if (IN(10)) {
        pg8::Gemm g{F.P + SC_XA, PLD, F.Wgu2_t, MPAD, 2 * FF, D}; pg8::StaticOrder S; S.init(MPAD, 2 * FF, F.G, (int)blockIdx.x);
        pg8::EpiSwiGLU E{F.P + SC_H, PLD};
        pg8::gemm_phase<pg8::EpiSwiGLU, pg8::StaticOrder, AL, SP>(F.lds, g, S, E);
        { constexpr int NU = (MPAD / 256) * (2 * FF / 256); const int full = NU % F.G; const bool part = NU > F.G && full > 0;
          if (!part || (int)blockIdx.x >= full) prep_plain(F, F.in[I_F2D], FF, D, F.Wd2_t, scr, part ? ((int)blockIdx.x - full) * NWAVES + F.wave : gw, part ? (F.G - full) * NWAVES : NGW); }
    }
    SEAM(10);
    if (IN(11)) {
        for (int pc = F.vcu; pc < 176; pc += F.G) skinny_piece<0>(F, F.P + (size_t)MP * PLD + SC_H, PLD, F.Wd2_t, FF, 128 * (pc >> 3), 1, pc & 7, SLAB_D, pc >> 3);
        pg8::Gemm g{F.P + SC_H, PLD, F.Wd2_t, MP, D, FF}; pg8::StaticOrder S; S.init(MP, D, F.G, (int)blockIdx.x);
        pg8::EpiBf16 E{F.P + SC_F, PLD};
        pg8::gemm_phase<pg8::EpiBf16, pg8::StaticOrder, AL, SP>(F.lds, g, S, E);
    }
    SEAM(11);
    if (IN(12)) rowphase3(F);
#ifdef TIME_PHASE
#ifdef TIME_SUB
    if (F.vcu == 0) { tp0 = 0; tp1 = ((volatile LAS unsigned long long*)(F.lds + MISC_OFF + 64))[0]; }
#endif
#ifdef TIME_RSUB
    if (F.vcu == 200) { tp0 = 0; tp1 = ((volatile LAS unsigned long long*)(F.lds + MISC_OFF + 64))[0]; }
#endif
    if (F.vcu == TIME_VCU) { const unsigned long long te = __builtin_amdgcn_s_memrealtime(), wait = (unsigned long long)(TIME_MULT) * (tp1 - tp0); while (__builtin_amdgcn_s_memrealtime() - te < wait) __builtin_amdgcn_s_sleep(8); }
#endif
#undef IN
#undef SEAM
}

inline int launch(void* const* d_in, void* d_out, void* d_ws, hipStream_t stream, int n_launches, int ph_lo = 0, int ph_hi = 0) {
    static int grid = 0;
    if (grid == 0) {
        int dev = 0, cus = 0, per_cu = 0;
        if (hipGetDevice(&dev) != hipSuccess || hipDeviceGetAttribute(&cus, hipDeviceAttributeMultiprocessorCount, dev) != hipSuccess) { grid = -1; return -1; }
        if (hipFuncSetAttribute((const void*)mega_fwd, hipFuncAttributeMaxDynamicSharedMemorySize, LDS_BYTES) != hipSuccess) { grid = -1; return -1; }
        if (hipOccupancyMaxActiveBlocksPerMultiprocessor(&per_cu, (const void*)mega_fwd, NTHR, LDS_BYTES) != hipSuccess || per_cu < 1) per_cu = 1;
        (void)hipGetLastError();
        grid = cus;
    }
    if (grid < 0) return -1;
    Args a{};
    for (int i = 0; i < 24; ++i) a.in[i] = (const float*)d_in[i];
    a.out = (float*)d_out; a.ws = (unsigned char*)d_ws;
    if (n_launches == 0) { a.ph_lo = ph_lo; a.ph_hi = ph_hi; hipLaunchKernelGGL(mega_fwd, dim3(grid), dim3(NTHR), LDS_BYTES, stream, a); return 0; }
    (void)hipMemsetAsync((char*)d_ws + WS_CTL, 0, CTL_ZERO_BYTES, stream);
    if (n_launches == 1) { a.ph_lo = 0; a.ph_hi = N_PHASES; hipLaunchKernelGGL(mega_fwd, dim3(grid), dim3(NTHR), LDS_BYTES, stream, a); }
    else for (int p = 0; p < N_PHASES; ++p) { a.ph_lo = p; a.ph_hi = p + 1; hipLaunchKernelGGL(mega_fwd, dim3(grid), dim3(NTHR), LDS_BYTES, stream, a); }
    return 0;
}
}
#ifndef MK_NL
#define MK_NL 1
#endif
extern "C" void kernel_launch(void* const* d_in, const int* in_sizes, int n_in,
                              void* d_out, int out_size, void* d_ws, size_t ws_size,
                              hipStream_t stream) {
    mk::launch(d_in, d_out, d_ws, stream, MK_NL);
}
```

```cpp
#include <hip/hip_runtime.h>
#include <cstdio>
#include <cstdint>

#ifndef DBG_STATIC_FLOATS
#define DBG_STATIC_FLOATS 16
#endif
__device__ float g_static[DBG_STATIC_FLOATS];
#define STATIC_TAG (1ull << 62)
template <class T> __device__ __forceinline__ T* fx(T* p) { const unsigned long long v = (unsigned long long)p; return (v & STATIC_TAG) ? (T*)((char*)g_static + (v & (STATIC_TAG - 1))) : p; }
inline float* static_ptr(size_t float_off) { return (float*)(STATIC_TAG | (unsigned long long)(float_off * 4)); }
namespace nv {
constexpr int D = 1024, FF = 2816, DIN = 7184, TSEQ = 2048, NB = 8, NS = 128;
constexpr int C_XR = 0, C_YR = 1024, C_Q = 2048, C_K = 2560, C_V = 3072, C_OG = 4096, C_LR = 5120, C_GA = 5136, C_GB = 6160;
constexpr float EPS = 1e-6f;
constexpr size_t O_YP = 0, O_YS = 16777216, O_HP = 16908288, O_CP = 16916480, O_SP = 16941056, O_HS = 17989632, O_CS = 18120704, O_SS = 18513920;

__device__ __forceinline__ float sigmoidf_(float x) { return 1.f / (1.f + expf(-x)); }
__device__ __forceinline__ float siluf_(float x) { return x / (1.f + expf(-x)); }
__device__ __forceinline__ float softplusf_(float x) { return fmaxf(x, 0.f) + log1pf(expf(-fabsf(x))); }
__device__ __forceinline__ float logsigmoidf_(float x) { return -softplusf_(-x); }
__device__ __forceinline__ float gelu_tanhf_(float x) { const float c = 0.7978845608028654f; return 0.5f * x * (1.f + tanhf(c * (x + 0.044715f * x * x * x))); }

__device__ __forceinline__ float block_sum256(float v, float* red) {
#pragma unroll
    for (int o = 32; o > 0; o >>= 1) v += __shfl_xor(v, o);
    __syncthreads();
    if ((threadIdx.x & 63) == 0) red[threadIdx.x >> 6] = v;
    __syncthreads();
    return red[0] + red[1] + red[2] + red[3];
}
__global__ void k_rmsnorm(const float* x, const float* g, float* y) { x = fx(x); g = fx(g); y = fx(y);
    __shared__ float red[4];
    const size_t r = blockIdx.x; const float* xr = x + r * D; float v[4]; float s = 0.f;
#pragma unroll
    for (int j = 0; j < 4; ++j) { v[j] = xr[threadIdx.x + 256 * j]; s += v[j] * v[j]; }
    const float tot = block_sum256(s, red); const float rs = rsqrtf(tot / D + EPS);
#pragma unroll
    for (int j = 0; j < 4; ++j) y[r * D + threadIdx.x + 256 * j] = v[j] * rs * g[threadIdx.x + 256 * j];
}
__global__ void k_resnorm(const float* base, const float* f, const float* g, float scale, float* out) { base = fx(base); f = fx(f); g = fx(g); out = fx(out);
    __shared__ float red[4];
    const size_t r = blockIdx.x; const float* fr = f + r * D; float v[4]; float s = 0.f;
#pragma unroll
    for (int j = 0; j < 4; ++j) { v[j] = fr[threadIdx.x + 256 * j]; s += v[j] * v[j]; }
    const float tot = block_sum256(s, red); const float rs = rsqrtf(tot / D + EPS);
#pragma unroll
    for (int j = 0; j < 4; ++j) { const int c = threadIdx.x + 256 * j; out[r * D + c] = base[r * D + c] + scale * (v[j] * rs * g[c]); }
}
__global__ void __launch_bounds__(256) k_gemm(const float* A, int lda, const float* B, int ldb, float* C, int ldc, int M, int N, int K, size_t sA, size_t sB, size_t sC) { A = fx(A); B = fx(B); C = fx(C);
    __shared__ float As[16][64 + 1], Bs[16][64 + 1];
    A += blockIdx.z * sA; B += blockIdx.z * sB; C += blockIdx.z * sC;
    const int m0 = blockIdx.y * 64, n0 = blockIdx.x * 64, tx = threadIdx.x & 15, ty = threadIdx.x >> 4;
    float acc[4][4];
#pragma unroll
    for (int i = 0; i < 4; ++i)
#pragma unroll
        for (int j = 0; j < 4; ++j) acc[i][j] = 0.f;
    for (int k0 = 0; k0 < K; k0 += 16) {
#pragma unroll
        for (int i = 0; i < 4; ++i) { const int e = threadIdx.x + 256 * i; const int m = e >> 4, k = e & 15; As[k][m] = A[(size_t)(m0 + m) * lda + k0 + k]; }
#pragma unroll
        for (int i = 0; i < 4; ++i) { const int e = threadIdx.x + 256 * i; const int k = e >> 6, n = e & 63; Bs[k][n] = (n0 + n < N) ? B[(size_t)(k0 + k) * ldb + n0 + n] : 0.f; }
        __syncthreads();
#pragma unroll
        for (int k = 0; k < 16; ++k) { float a[4], b[4];
#pragma unroll
            for (int i = 0; i < 4; ++i) { a[i] = As[k][ty * 4 + i]; b[i] = Bs[k][tx * 4 + i]; }
#pragma unroll
            for (int i = 0; i < 4; ++i)
#pragma unroll
                for (int j = 0; j < 4; ++j) acc[i][j] = fmaf(a[i], b[j], acc[i][j]); }
        __syncthreads();
    }
#pragma unroll
    for (int i = 0; i < 4; ++i)
#pragma unroll
        for (int j = 0; j < 4; ++j) { const int n = n0 + tx * 4 + j; if (n < N) C[(size_t)(m0 + ty * 4 + i) * ldc + n] = acc[i][j]; }
}
__global__ void k_swiglu(const float* gu, float* h, size_t n) { gu = fx(gu); h = fx(h);
    for (size_t i = blockIdx.x * (size_t)blockDim.x + threadIdx.x; i < n; i += (size_t)gridDim.x * blockDim.x) { const size_t r = i / FF, j = i % FF; h[i] = siluf_(gu[r * (2 * FF) + j]) * gu[r * (2 * FF) + FF + j]; }
}
__global__ void k_conv(const float* P, const float* buf, const float* w, const float* b, float* xc, float* conv_new, int T, int nseq) { P = fx(P); buf = fx(buf); w = fx(w); b = fx(b); xc = fx(xc); conv_new = fx(conv_new);
    const size_t n = (size_t)nseq * T * D;
    for (size_t i = blockIdx.x * (size_t)blockDim.x + threadIdx.x; i < n; i += (size_t)gridDim.x * blockDim.x) {
        const int c = (int)(i % D); const size_t row = i / D; const int t = (int)(row % T); const int seq = (int)(row / T);
        float y = b[c];
#pragma unroll
        for (int j = 0; j < 4; ++j) { const int idx = t + j - 3; float xv;
            if (idx >= 0) xv = P[((size_t)seq * T + idx) * DIN + C_XR + c]; else xv = buf ? buf[((size_t)seq * 3 + (3 + idx)) * D + c] : 0.f;
            y += xv * w[j * D + c]; }
        xc[i] = y;
    }
    const size_t n2 = (size_t)nseq * 3 * D;
    for (size_t i = blockIdx.x * (size_t)blockDim.x + threadIdx.x; i < n2; i += (size_t)gridDim.x * blockDim.x) {
        const int c = (int)(i % D); const int j = (int)((i / D) % 3); const int seq = (int)(i / (3 * D));
        const int xi = T + j;
        float v; if (xi >= 3) v = P[((size_t)seq * T + (xi - 3)) * DIN + C_XR + c]; else v = buf ? buf[((size_t)seq * 3 + xi) * D + c] : 0.f;
        conv_new[i] = v;
    }
}
__global__ void k_rg_elem(const float* xc, const float* RA, const float* RX, const float* b_a, const float* b_x, const float* lam, float* a_out, float* bb_out, int T, int nseq, int reset) { xc = fx(xc); RA = fx(RA); RX = fx(RX); b_a = fx(b_a); b_x = fx(b_x); lam = fx(lam); a_out = fx(a_out); bb_out = fx(bb_out);
    const size_t n = (size_t)nseq * T * D;
    for (size_t i = blockIdx.x * (size_t)blockDim.x + threadIdx.x; i < n; i += (size_t)gridDim.x * blockDim.x) {
        const int c = (int)(i % D); const int t = (int)((i / D) % T);
        const float r = sigmoidf_(RA[i] + b_a[c]), ig = sigmoidf_(RX[i] + b_x[c]);
        const float log_a = -8.0f * r * softplusf_(-lam[c]); const float a = expf(log_a);
        float mult = sqrtf(fmaxf(-expm1f(2.0f * log_a), 0.f)); if (reset && t == 0) mult = 1.0f;
        a_out[i] = a; bb_out[i] = mult * ig * xc[i];
    }
}
__global__ void k_scan(const float* a, const float* bb, const float* h0, float* h, float* h_last, int T, int nseq) { a = fx(a); bb = fx(bb); h0 = fx(h0); h = fx(h); h_last = fx(h_last);
    const int i = blockIdx.x * blockDim.x + threadIdx.x; if (i >= nseq * D) return;
    const int c = i % D, seq = i / D; float hv = h0 ? h0[(size_t)seq * D + c] : 0.f;
    for (int t = 0; t < T; ++t) { const size_t o = ((size_t)seq * T + t) * D + c; hv = a[o] * hv + bb[o]; h[o] = hv; }
    h_last[(size_t)seq * D + c] = hv;
}
__global__ void k_gate_rnn(const float* h, const float* P, float* o, size_t n) { h = fx(h); P = fx(P); o = fx(o);
    for (size_t i = blockIdx.x * (size_t)blockDim.x + threadIdx.x; i < n; i += (size_t)gridDim.x * blockDim.x) { const size_t r = i / D; const int c = (int)(i % D); o[i] = h[i] * gelu_tanhf_(P[r * DIN + C_YR + c]); }
}
__global__ void __launch_bounds__(256) k_gla(const float* P, const float* G, const float* blr, const float* S0, float* O, float* S_out, int T) { P = fx(P); G = fx(G); blr = fx(blr); S0 = fx(S0); O = fx(O); S_out = fx(S_out);
    extern __shared__ float S[];
    __shared__ float sq[128], sk[128], se[128];
    const int head = blockIdx.x & 3, seq = blockIdx.x >> 2, dv = threadIdx.x;
    for (int kk = 0; kk < 128; ++kk) S[kk * 256 + dv] = S0 ? S0[(((size_t)seq * 4 + head) * 128 + kk) * 256 + dv] : 0.f;
    for (int t = 0; t < T; ++t) {
        const size_t row = (size_t)seq * T + t;
        __syncthreads();
        if (dv < 128) { sq[dv] = P[row * DIN + C_Q + head * 128 + dv] * 0.08838834764831845f; sk[dv] = P[row * DIN + C_K + head * 128 + dv];
            se[dv] = expf(logsigmoidf_(G[row * 512 + head * 128 + dv] + blr[head * 128 + dv]) * (1.0f / 16.0f)); }
        __syncthreads();
        const float v = P[row * DIN + C_V + head * 256 + dv]; float o = 0.f;
        for (int kk = 0; kk < 128; ++kk) { const float s = S[kk * 256 + dv] * se[kk] + sk[kk] * v; S[kk * 256 + dv] = s; o = fmaf(sq[kk], s, o); }
        O[row * D + head * 256 + dv] = o;
    }
    for (int kk = 0; kk < 128; ++kk) S_out[(((size_t)seq * 4 + head) * 128 + kk) * 256 + dv] = S[kk * 256 + dv];
}
__global__ void k_gla_out(const float* O, const float* P, const float* gn, float* og_out) { O = fx(O); P = fx(P); gn = fx(gn); og_out = fx(og_out);
    __shared__ float red[4];
    const int head = blockIdx.x & 3; const size_t row = blockIdx.x >> 2; const int dv = threadIdx.x;
    const float o = O[row * D + head * 256 + dv]; const float tot = block_sum256(o * o, red); const float rs = rsqrtf(tot / 256.f + EPS);
    og_out[row * D + head * 256 + dv] = o * rs * gn[dv] * siluf_(P[row * DIN + C_OG + head * 256 + dv]);
}
__global__ void k_merge(const float* P, const float* YA, const float* YB, float* m, size_t n) { P = fx(P); YA = fx(YA); YB = fx(YB); m = fx(m);
    for (size_t i = blockIdx.x * (size_t)blockDim.x + threadIdx.x; i < n; i += (size_t)gridDim.x * blockDim.x) { const size_t r = i / D; const int c = (int)(i % D);
        m[i] = sigmoidf_(P[r * DIN + C_GA + c]) * YA[i] + sigmoidf_(P[r * DIN + C_GB + c]) * YB[i]; }
}
struct In { const float *xp, *xs, *srh, *src, *sgla, *ng, *f1gu, *f1d, *win, *cw, *cb, *rwa, *rba, *rwx, *rbx, *lam, *wlr, *blr, *gng, *wbr, *wbg, *wout, *f2gu, *f2d; };
inline In make_in(void* const* d) { In I; const float** p = (const float**)&I; for (int i = 0; i < 24; ++i) p[i] = (const float*)d[i]; return I; }
inline void gemm(hipStream_t st, const float* A, int lda, const float* B, int ldb, float* C, int ldc, int M, int N, int K, int nz = 1, size_t sA = 0, size_t sB = 0, size_t sC = 0) {
    hipLaunchKernelGGL(k_gemm, dim3((N + 63) / 64, M / 64, nz), dim3(256), 0, st, A, lda, B, ldb, C, ldc, M, N, K, sA, sB, sC);
}
struct Outs { float *y, *h_last, *conv_new, *s_new; };
struct Bufs { float *T0, *T1, *T2, *T3, *T4, *T5, *T6, *T7, *T8, *T9, *GU, *HH, *P, *G; };
inline Bufs make_bufs(float* ws, int R) { Bufs B; const size_t RD = (size_t)R * D; B.T0 = ws; B.T1 = B.T0 + RD; B.T2 = B.T1 + RD; B.T3 = B.T2 + RD; B.T4 = B.T3 + RD; B.T5 = B.T4 + RD; B.T6 = B.T5 + RD; B.T7 = B.T6 + RD; B.T8 = B.T7 + RD; B.T9 = B.T8 + RD;
    B.GU = B.T9 + RD; B.HH = B.GU + (size_t)R * 2 * FF; B.P = B.HH + (size_t)R * FF; B.G = B.P + (size_t)R * DIN; return B; }
inline Outs std_outs(float* out, int grp) { Outs o; const bool smp = (grp == NB);
    o.y = smp ? out + O_YS : out + O_YP + (size_t)grp * TSEQ * D; o.h_last = smp ? out + O_HS : out + O_HP + (size_t)grp * D;
    o.conv_new = smp ? out + O_CS : out + O_CP + (size_t)grp * 3 * D; o.s_new = smp ? out + O_SS : out + O_SP + (size_t)grp * 4 * 128 * 256; return o; }
inline void run_group(hipStream_t st, const In& I, const Outs& O, float* ws, int grp, int s_lo = 0, int s_hi = 12) {
    const bool smp = (grp == NB); const int T = smp ? 1 : TSEQ, nseq = smp ? NS : 1, R = T * nseq;
    const float* x = smp ? I.xs : I.xp + (size_t)grp * TSEQ * D;
    const Bufs B = make_bufs(ws, R);
    float *T0 = B.T0, *T1 = B.T1, *T2 = B.T2, *T3 = B.T3, *T4 = B.T4, *T5 = B.T5, *T6 = B.T6, *T7 = B.T7, *T8 = B.T8, *T9 = B.T9, *GU = B.GU, *HH = B.HH, *P = B.P, *G = B.G;
    const float* ng = I.ng; const size_t n1 = (size_t)R * D; const int EB = 1024;
#define STG(k) if (s_lo <= (k) && (k) < s_hi)
    STG(0) hipLaunchKernelGGL(k_rmsnorm, dim3(R), dim3(256), 0, st, x, ng + 0 * D, T0);
    STG(1) { gemm(st, T0, D, I.f1gu, 2 * FF, GU, 2 * FF, R, 2 * FF, D);
        hipLaunchKernelGGL(k_swiglu, dim3(EB), dim3(256), 0, st, GU, HH, (size_t)R * FF); }
    STG(2) gemm(st, HH, FF, I.f1d, D, T1, D, R, D, FF);
    STG(3) { hipLaunchKernelGGL(k_resnorm, dim3(R), dim3(256), 0, st, x, T1, ng + 1 * D, 0.5f, T2);
        hipLaunchKernelGGL(k_rmsnorm, dim3(R), dim3(256), 0, st, T2, ng + 2 * D, T3); }
    STG(4) gemm(st, T3, D, I.win, DIN, P, DIN, R, DIN, D);
    STG(5) { hipLaunchKernelGGL(k_conv, dim3(EB), dim3(256), 0, st, P, smp ? I.src : nullptr, I.cw, I.cb, T4, O.conv_new, T, nseq);
        gemm(st, T4, D, I.rwa, 128, T5, D, R, 128, 128, 8, 128, 128 * 128, 128);
        gemm(st, T4, D, I.rwx, 128, T6, D, R, 128, 128, 8, 128, 128 * 128, 128);
        hipLaunchKernelGGL(k_rg_elem, dim3(EB), dim3(256), 0, st, T4, T5, T6, I.rba, I.rbx, I.lam, T7, T8, T, nseq, smp ? 0 : 1);
        hipLaunchKernelGGL(k_scan, dim3((nseq * D + 255) / 256), dim3(256), 0, st, T7, T8, smp ? I.srh : nullptr, T9, O.h_last, T, nseq);
        hipLaunchKernelGGL(k_gate_rnn, dim3(EB), dim3(256), 0, st, T9, P, T3, n1);
        gemm(st, P + C_LR, DIN, I.wlr, 512, G, 512, R, 512, 16);
        hipLaunchKernelGGL(k_gla, dim3(nseq * 4), dim3(256), 128 * 256 * 4, st, P, G, I.blr, smp ? I.sgla : nullptr, T7, O.s_new, T);
        hipLaunchKernelGGL(k_gla_out, dim3(R * 4), dim3(256), 0, st, T7, P, I.gng, T8); }
    STG(6) { gemm(st, T3, D, I.wbr, D, T5, D, R, D, D);
        gemm(st, T8, D, I.wbg, D, T6, D, R, D, D);
        hipLaunchKernelGGL(k_merge, dim3(EB), dim3(256), 0, st, P, T5, T6, T9, n1); }
    STG(7) gemm(st, T9, D, I.wout, D, T1, D, R, D, D);
    STG(8) { hipLaunchKernelGGL(k_resnorm, dim3(R), dim3(256), 0, st, T2, T1, ng + 3 * D, 1.0f, T2);
        hipLaunchKernelGGL(k_rmsnorm, dim3(R), dim3(256), 0, st, T2, ng + 4 * D, T0); }
    STG(9) { gemm(st, T0, D, I.f2gu, 2 * FF, GU, 2 * FF, R, 2 * FF, D);
        hipLaunchKernelGGL(k_swiglu, dim3(EB), dim3(256), 0, st, GU, HH, (size_t)R * FF); }
    STG(10) gemm(st, HH, FF, I.f2d, D, T1, D, R, D, FF);
    STG(11) hipLaunchKernelGGL(k_resnorm, dim3(R), dim3(256), 0, st, T2, T1, ng + 5 * D, 0.5f, O.y);
#undef STG
}
}
namespace pg8 {
#define PG8_LAS __attribute__((address_space(3)))
typedef unsigned short bf16_t;
typedef short bf16x8 __attribute__((ext_vector_type(8)));
typedef float f32x4 __attribute__((ext_vector_type(4)));
typedef float f32x2 __attribute__((ext_vector_type(2)));
typedef unsigned u32x4 __attribute__((ext_vector_type(4)));
typedef unsigned u32x2 __attribute__((ext_vector_type(2)));
constexpr int BM = 256, BK = 64, HALF = 128, HTB = HALF * BK * 2, STAGE_BYTES = 8 * HTB, NXCD = 8;

__host__ __device__ __forceinline__ int lds_byte(int r, int c) { const int st = (r >> 4) * 2 + (c >> 5), rr = r & 15, cc = c & 31, ob = rr * 64 + cc * 2; return st * 1024 + (ob ^ (((ob >> 9) & 1) << 5)); }
__host__ __device__ __forceinline__ void stage_rc(int b, int& R, int& C) { const int st = b / 1024, sb = b % 1024, swz = sb ^ (((sb >> 9) & 1) << 5); R = (st >> 1) * 16 + swz / 64; C = (st & 1) * 32 + (swz % 64) / 2; }
__host__ __device__ __forceinline__ int perm32(int rho) { const int n = rho >> 4, i = rho & 15; return 8 * (i >> 2) + 4 * n + (i & 3); }

struct Unit { int pm, pn; };
struct Gemm { const bf16_t* A; int lda; const bf16_t* Bt; int M, N, K; };

struct StaticOrder {
    int nM, nN, nwg, G, c, WGM;
    __host__ __device__ void init(int M, int N, int G_, int c_, int wgm = 4) { nM = M / BM; nN = N / BM; nwg = nM * nN; G = G_; c = c_; WGM = wgm; }
    __host__ __device__ bool next(int i, Unit& u) const {
        const long L = (long)i * G + c; if (L >= nwg) return false;
        int wgid = (int)L; { const int q = nwg / NXCD, r = nwg % NXCD, xcd = wgid % NXCD, off = wgid / NXCD; wgid = (xcd < r ? xcd * (q + 1) : r * (q + 1) + (xcd - r) * q) + off; }
        const int nig = WGM * nN, gid = wgid / nig, fm = gid * WGM, gsz = (nM - fm) < WGM ? (nM - fm) : WGM;
        u.pm = fm + ((wgid % nig) % gsz); u.pn = (wgid % nig) / gsz; return true;
    }
    __device__ __forceinline__ void a_ready(const Unit&) const {}
    __device__ __forceinline__ void done(const Unit&) const {}
};

__device__ __forceinline__ unsigned f2bf(float f) { unsigned u = __builtin_bit_cast(unsigned, f); return (u + 0x7fffu + ((u >> 16) & 1u)) >> 16; }
typedef __bf16 hwbf16x2 __attribute__((ext_vector_type(2)));
__device__ __forceinline__ unsigned pk2(float lo, float hi) { const f32x2 v = {lo, hi}; return __builtin_bit_cast(unsigned, __builtin_convertvector(v, hwbf16x2)); }
__device__ __forceinline__ float bf_lo(unsigned w) { return __builtin_bit_cast(float, w << 16); }
__device__ __forceinline__ float bf_hi(unsigned w) { return __builtin_bit_cast(float, w & 0xffff0000u); }
#ifndef PG8_SC1
#define PG8_SC1 0
#endif
__device__ __forceinline__ void st16(void* p, u32x4 v) {
#if PG8_SC1
    asm volatile("global_store_dwordx4 %0, %1, off sc1\n\ts_nop 1" :: "v"(p), "v"(v) : "memory");
#else
    *(u32x4*)p = v;
#endif
}
__device__ __forceinline__ float fast_sigmoid(float x) { return __builtin_amdgcn_rcpf(1.0f + __builtin_amdgcn_exp2f(-1.4426950408889634f * x)); }

struct EpiF32 {
    static constexpr bool PERM = false, AFTER_DRAIN = false;
    float* C; int ldc;
    __device__ __forceinline__ void operator()(const f32x4 (&acc)[2][2][4][2], const Unit& u, int wr, int wc, int fr, int fq) const {
        const int row0 = u.pm * BM + wr * 64 + fr, col0 = u.pn * BM + wc * 32 + 4 * fq;
#pragma unroll
        for (int ai = 0; ai < 2; ++ai)
#pragma unroll
            for (int m = 0; m < 4; ++m) { float* rowp = C + (size_t)(row0 + ai * HALF + m * 16) * ldc + col0;
#pragma unroll
                for (int bj = 0; bj < 2; ++bj)
#pragma unroll
                    for (int n = 0; n < 2; ++n) *(f32x4*)(rowp + bj * HALF + n * 16) = acc[ai][bj][m][n]; }
    }
};
struct EpiBf16 {
    static constexpr bool PERM = true, AFTER_DRAIN = false;
    bf16_t* O; int ldc;
    __device__ __forceinline__ void operator()(const f32x4 (&acc)[2][2][4][2], const Unit& u, int wr, int wc, int fr, int fq) const {
        const int row0 = u.pm * BM + wr * 64 + fr, col0 = u.pn * BM + wc * 32 + 8 * fq;
#pragma unroll
        for (int ai = 0; ai < 2; ++ai)
#pragma unroll
            for (int m = 0; m < 4; ++m) { bf16_t* rowp = O + (size_t)(row0 + ai * HALF + m * 16) * ldc + col0;
#pragma unroll
                for (int bj = 0; bj < 2; ++bj) { const f32x4 v0 = acc[ai][bj][m][0], v1 = acc[ai][bj][m][1];
                    u32x4 w; w.x = pk2(v0[0], v0[1]); w.y = pk2(v0[2], v0[3]); w.z = pk2(v1[0], v1[1]); w.w = pk2(v1[2], v1[3]);
                    st16(rowp + bj * HALF, w); } }
    }
};
struct EpiSwiGLU {
    static constexpr bool PERM = true, AFTER_DRAIN = false;
    bf16_t* O; int ldc;
    __device__ __forceinline__ void operator()(const f32x4 (&acc)[2][2][4][2], const Unit& u, int wr, int wc, int fr, int fq) const {
        const int row0 = u.pm * BM + wr * 64 + fr, col0 = u.pn * HALF + wc * 32 + 8 * fq;
#pragma unroll
        for (int ai = 0; ai < 2; ++ai)
#pragma unroll
            for (int m = 0; m < 4; ++m) { bf16_t* rowp = O + (size_t)(row0 + ai * HALF + m * 16) * ldc + col0;
                float h[8];
#pragma unroll
                for (int n = 0; n < 2; ++n)
#pragma unroll
                    for (int e = 0; e < 4; ++e) { const float g = acc[ai][0][m][n][e], up = acc[ai][1][m][n][e]; h[4 * n + e] = g * fast_sigmoid(g) * up; }
                u32x4 w; w.x = pk2(h[0], h[1]); w.y = pk2(h[2], h[3]); w.z = pk2(h[4], h[5]); w.w = pk2(h[6], h[7]);
                st16(rowp, w); }
    }
};
struct EpiMerge {
    static constexpr bool PERM = true, AFTER_DRAIN = false, MID = true;
    const bf16_t* GA; const bf16_t* GB; int ldg; bf16_t* O; int ldc;
    __device__ __forceinline__ void mid(f32x4 (&acc)[2][2][4][2], const Unit& u, int wr, int wc, int fr, int fq) const {
        int row0 = u.pm * BM + wr * 64 + fr; const int col0 = u.pn * BM + wc * 32 + 8 * fq;
        asm volatile("" : "+v"(row0));
#pragma unroll
        for (int ai = 0; ai < 2; ++ai)
#pragma unroll
            for (int m = 0; m < 4; ++m) { const size_t row = (size_t)(row0 + ai * HALF + m * 16);
#pragma unroll
                for (int bj = 0; bj < 2; ++bj) { const u32x4 a = *(const u32x4*)(GA + row * ldg + col0 + bj * HALF), b = *(const u32x4*)(GB + row * ldg + col0 + bj * HALF);
#define PG8_RT(x, y) (fast_sigmoid(x) * (1.0f + __builtin_amdgcn_exp2f(-1.4426950408889634f * (y))))
                    f32x4 r0, r1; r0[0] = PG8_RT(bf_lo(a.x), bf_lo(b.x)); r0[1] = PG8_RT(bf_hi(a.x), bf_hi(b.x)); r0[2] = PG8_RT(bf_lo(a.y), bf_lo(b.y)); r0[3] = PG8_RT(bf_hi(a.y), bf_hi(b.y));
                    r1[0] = PG8_RT(bf_lo(a.z), bf_lo(b.z)); r1[1] = PG8_RT(bf_hi(a.z), bf_hi(b.z)); r1[2] = PG8_RT(bf_lo(a.w), bf_lo(b.w)); r1[3] = PG8_RT(bf_hi(a.w), bf_hi(b.w));
#undef PG8_RT
                    acc[ai][bj][m][0] = acc[ai][bj][m][0] * r0; acc[ai][bj][m][1] = acc[ai][bj][m][1] * r1; }
                if (m & 1) asm volatile("" ::: "memory"); }
    }
    __device__ __forceinline__ void operator()(const f32x4 (&acc)[2][2][4][2], const Unit& u, int wr, int wc, int fr, int fq) const {
        int row0 = u.pm * BM + wr * 64 + fr; const int col0 = u.pn * BM + wc * 32 + 8 * fq;
        asm volatile("" : "+v"(row0));
#pragma unroll
        for (int ai = 0; ai < 2; ++ai)
#pragma unroll
            for (int m = 0; m < 4; ++m) { const size_t row = (size_t)(row0 + ai * HALF + m * 16);
#pragma unroll
                for (int bj = 0; bj < 2; ++bj) { const u32x4 g = *(const u32x4*)(GB + row * ldg + col0 + bj * HALF); const f32x4 v0 = acc[ai][bj][m][0], v1 = acc[ai][bj][m][1];
                    u32x4 w; w.x = pk2(fast_sigmoid(bf_lo(g.x)) * v0[0], fast_sigmoid(bf_hi(g.x)) * v0[1]); w.y = pk2(fast_sigmoid(bf_lo(g.y)) * v0[2], fast_sigmoid(bf_hi(g.y)) * v0[3]);
                    w.z = pk2(fast_sigmoid(bf_lo(g.z)) * v1[0], fast_sigmoid(bf_hi(g.z)) * v1[1]); w.w = pk2(fast_sigmoid(bf_lo(g.w)) * v1[2], fast_sigmoid(bf_hi(g.w)) * v1[3]);
                    st16(O + row * ldc + col0 + bj * HALF, w); } }
    }
};
template <class E> struct has_mid { template <class T> static auto test(int) -> decltype(T::MID, char()); template <class T> static long test(...); static constexpr bool value = sizeof(test<E>(0)) == 1; };

template <class Epi, class Sched, bool ALIGN_EPI = false, bool SP2 = false>
__device__ __forceinline__ void gemm_phase(PG8_LAS unsigned char* lds, const Gemm g, const Sched& S, const Epi& E) {
    const int tid = threadIdx.x, wid = __builtin_amdgcn_readfirstlane(tid >> 6), lane = tid & 63, wr = wid >> 2, wc = wid & 3, fr = lane & 15, fq = lane >> 4;
    const int K = g.K, nt = K / BK;
    unsigned voffA[2], voffB[2];
#pragma unroll
    for (int i = 0; i < 2; ++i) { int R, C; stage_rc(tid * 16 + i * 8192, R, C); const int Rb = Epi::PERM ? ((R & ~31) + perm32(R & 31)) : R;
        voffA[i] = (unsigned)(R * g.lda + C) * 2u; voffB[i] = (unsigned)(Rb * K + C) * 2u; }
    const size_t kstep = (size_t)(BK * 2);
    const size_t hstepA = (size_t)HALF * g.lda * 2, hstepB = (size_t)HALF * K * 2;
    const size_t tstepA = 2 * hstepA, tstepB = 2 * hstepB;
    const unsigned ldsw = (unsigned)wid * 1024u;
    const int aoff = lds_byte(wr * 64 + fr, fq * 8), boff = lds_byte(wc * 32 + fr, fq * 8);
#define PG8_SA(b, h) (((b) * 2 + (h)) * HTB)
#define PG8_SB(b, h) ((4 + (b) * 2 + (h)) * HTB)
#define PG8_STAGE(bufoff, gbase, voff) do { _Pragma("unroll") for (int _i = 0; _i < 2; ++_i) \
        __builtin_amdgcn_global_load_lds((const unsigned*)((const char*)(gbase) + (voff)[_i]), (PG8_LAS unsigned*)(lds + (bufoff) + ldsw + _i * 8192), 16, 0, 0); } while (0)
#define PG8_LDA(dst, b, h) do { _Pragma("unroll") for (int m = 0; m < 4; ++m) _Pragma("unroll") for (int k = 0; k < 2; ++k) dst[m][k] = *(const PG8_LAS bf16x8*)(lds + PG8_SA(b, h) + aoff + m * 2048 + k * 1024); } while (0)
#define PG8_LDB(dst, b, h) do { _Pragma("unroll") for (int n = 0; n < 2; ++n) _Pragma("unroll") for (int k = 0; k < 2; ++k) dst[n][k] = *(const PG8_LAS bf16x8*)(lds + PG8_SB(b, h) + boff + n * 2048 + k * 1024); } while (0)
#define PG8_MMA(ai, bj, At, Bt) do { __builtin_amdgcn_s_setprio(1); _Pragma("unroll") for (int m = 0; m < 4; ++m) _Pragma("unroll") for (int n = 0; n < 2; ++n) _Pragma("unroll") for (int k = 0; k < 2; ++k) \
        acc[ai][bj][m][n] = __builtin_amdgcn_mfma_f32_16x16x32_bf16(Bt[n][k], At[m][k], acc[ai][bj][m][n], 0, 0, 0); __builtin_amdgcn_s_setprio(0); } while (0)
#define PG8_WAIT_V(n) asm volatile("s_waitcnt vmcnt(" #n ")" ::: "memory")
#define PG8_WAIT_L(n) asm volatile("s_waitcnt lgkmcnt(" #n ")" ::: "memory")
#define PG8_BAR __builtin_amdgcn_s_barrier()
#define PG8_SCHED __builtin_amdgcn_sched_barrier(0)
    Unit cur, nxt; int ui = 0;
    if (!S.next(0, cur)) return;
    f32x4 acc[2][2][4][2];
#pragma unroll
    for (int a = 0; a < 2; ++a)
#pragma unroll
        for (int b = 0; b < 2; ++b)
#pragma unroll
            for (int m = 0; m < 4; ++m)
#pragma unroll
                for (int n = 0; n < 2; ++n) acc[a][b][m][n] = (f32x4){0.f, 0.f, 0.f, 0.f};
    bf16x8 At[4][2], B0[2][2], B1[2][2];
    const char* cA = (const char*)g.A + (size_t)cur.pm * tstepA; const char* cB = (const char*)g.Bt + (size_t)cur.pn * tstepB;
    S.a_ready(cur);
    if constexpr (SP2) {
        PG8_STAGE(PG8_SB(0, 0), cB, voffB); PG8_STAGE(PG8_SB(0, 1), cB + hstepB, voffB); PG8_STAGE(PG8_SA(0, 0), cA, voffA); PG8_STAGE(PG8_SA(0, 1), cA + hstepA, voffA);
        if (wr == 1) PG8_BAR;
        PG8_WAIT_V(2); PG8_BAR;
        PG8_STAGE(PG8_SB(1, 0), cB + kstep, voffB); PG8_STAGE(PG8_SA(1, 0), cA + kstep, voffA); PG8_STAGE(PG8_SB(1, 1), cB + hstepB + kstep, voffB);
        PG8_WAIT_V(6); PG8_BAR;
    } else {
        PG8_STAGE(PG8_SB(0, 0), cB, voffB); PG8_STAGE(PG8_SA(0, 0), cA, voffA); PG8_STAGE(PG8_SB(0, 1), cB + hstepB, voffB); PG8_STAGE(PG8_SA(0, 1), cA + hstepA, voffA);
        if (wr == 1) PG8_BAR;
        PG8_WAIT_V(4); PG8_BAR;
        PG8_STAGE(PG8_SB(1, 0), cB + kstep, voffB); PG8_STAGE(PG8_SA(1, 0), cA + kstep, voffA); PG8_STAGE(PG8_SB(1, 1), cB + hstepB + kstep, voffB);
        PG8_WAIT_V(6); PG8_BAR;
    }
    for (;;) {
        const bool has_next = S.next(ui + 1, nxt);
        const char* nA = has_next ? (const char*)g.A + (size_t)nxt.pm * tstepA : cA; const char* nB = has_next ? (const char*)g.Bt + (size_t)nxt.pn * tstepB : cB;
        constexpr int NSEG = has_mid<Epi>::value ? 2 : 1;
        for (int sg = 0; sg < NSEG; ++sg) {
        if constexpr (has_mid<Epi>::value) { if (sg == 1) E.mid(acc, cur, wr, wc, fr, fq); }
        const int t_end = (sg + 1) * (nt / NSEG);
        for (int t = sg * (nt / NSEG); t < t_end; t += 2) {
            const bool last = (t == nt - 2);
            const char* a1 = cA + (size_t)(t + 1) * kstep;
            const char* a2 = last ? nA : cA + (size_t)(t + 2) * kstep; const char* b2 = last ? nB : cB + (size_t)(t + 2) * kstep;
            const char* a3 = a2 + kstep; const char* b3 = b2 + kstep;
            if (last && has_next) S.a_ready(nxt);
            if constexpr (SP2) {
            PG8_LDB(B0, 0, 0); PG8_LDB(B1, 0, 1); PG8_SCHED; PG8_LDA(At, 0, 0); PG8_STAGE(PG8_SA(1, 1), a1 + hstepA, voffA);
            PG8_WAIT_V(8); PG8_WAIT_L(0); PG8_BAR; PG8_MMA(0, 0, At, B0); PG8_MMA(0, 1, At, B1); PG8_BAR; PG8_SCHED;
            PG8_LDA(At, 0, 1); PG8_STAGE(PG8_SB(0, 0), b2, voffB); PG8_STAGE(PG8_SB(0, 1), b2 + hstepB, voffB); PG8_STAGE(PG8_SA(0, 0), a2, voffA);
            PG8_WAIT_V(8); PG8_WAIT_L(0); PG8_BAR; PG8_MMA(1, 0, At, B0); PG8_MMA(1, 1, At, B1); PG8_BAR; PG8_SCHED;
            PG8_LDB(B0, 1, 0); PG8_LDB(B1, 1, 1); PG8_SCHED; PG8_LDA(At, 1, 0); PG8_STAGE(PG8_SA(0, 1), a2 + hstepA, voffA);
            PG8_WAIT_V(8); PG8_WAIT_L(0); PG8_BAR; PG8_MMA(0, 0, At, B0); PG8_MMA(0, 1, At, B1); PG8_BAR; PG8_SCHED;
            PG8_LDA(At, 1, 1); PG8_STAGE(PG8_SB(1, 0), b3, voffB); PG8_STAGE(PG8_SB(1, 1), b3 + hstepB, voffB); PG8_STAGE(PG8_SA(1, 0), a3, voffA);
            PG8_WAIT_V(8); PG8_WAIT_L(0); PG8_BAR; PG8_MMA(1, 0, At, B0); PG8_MMA(1, 1, At, B1); PG8_BAR; PG8_SCHED;
            } else {
            PG8_LDB(B0, 0, 0); PG8_SCHED; PG8_LDA(At, 0, 0); PG8_STAGE(PG8_SA(1, 1), a1 + hstepA, voffA);
            PG8_WAIT_L(8); PG8_BAR; PG8_WAIT_L(0); PG8_MMA(0, 0, At, B0); PG8_BAR; PG8_SCHED;
            PG8_LDB(B1, 0, 1); PG8_STAGE(PG8_SB(0, 0), b2, voffB);
            PG8_BAR; PG8_WAIT_L(0); PG8_MMA(0, 1, At, B1); PG8_BAR;
            PG8_LDA(At, 0, 1); PG8_STAGE(PG8_SA(0, 0), a2, voffA);
            PG8_BAR; PG8_WAIT_L(0); PG8_MMA(1, 0, At, B0); PG8_BAR; PG8_SCHED;
            PG8_STAGE(PG8_SB(0, 1), b2 + hstepB, voffB);
            PG8_WAIT_V(6); PG8_BAR; PG8_MMA(1, 1, At, B1); PG8_BAR;
            PG8_LDB(B0, 1, 0); PG8_SCHED; PG8_LDA(At, 1, 0); PG8_STAGE(PG8_SA(0, 1), a2 + hstepA, voffA);
            PG8_WAIT_L(8); PG8_BAR; PG8_WAIT_L(0); PG8_MMA(0, 0, At, B0); PG8_BAR; PG8_SCHED;
            PG8_LDB(B1, 1, 1); PG8_STAGE(PG8_SB(1, 0), b3, voffB);
            PG8_BAR; PG8_WAIT_L(0); PG8_MMA(0, 1, At, B1); PG8_BAR;
            PG8_LDA(At, 1, 1); PG8_STAGE(PG8_SA(1, 0), a3, voffA);
            PG8_BAR; PG8_WAIT_L(0); PG8_MMA(1, 0, At, B0); PG8_BAR; PG8_SCHED;
            PG8_STAGE(PG8_SB(1, 1), b3 + hstepB, voffB);
            PG8_WAIT_V(6); PG8_BAR; PG8_MMA(1, 1, At, B1); PG8_BAR;
            }
        }
        }
        if constexpr (ALIGN_EPI) { if (wr == 0) PG8_BAR; }
        if constexpr (!Epi::AFTER_DRAIN) { E(acc, cur, wr, wc, fr, fq); S.done(cur); }
        if (!has_next) break;
#pragma unroll
        for (int a = 0; a < 2; ++a)
#pragma unroll
            for (int b = 0; b < 2; ++b)
#pragma unroll
                for (int m = 0; m < 4; ++m)
#pragma unroll
                    for (int n = 0; n < 2; ++n) acc[a][b][m][n] = (f32x4){0.f, 0.f, 0.f, 0.f};
        cur = nxt; cA = nA; cB = nB; ++ui;
        if constexpr (ALIGN_EPI) { if (wr == 1) PG8_BAR; }
    }
    PG8_WAIT_V(0);
    if constexpr (!ALIGN_EPI) { if (wr == 0) PG8_BAR; }
    PG8_BAR;
#undef PG8_SA
#undef PG8_SB
#undef PG8_STAGE
#undef PG8_LDA
#undef PG8_LDB
#undef PG8_MMA
#undef PG8_WAIT_V
#undef PG8_WAIT_L
#undef PG8_BAR
#undef PG8_SCHED
}
}
namespace mk {
using pg8::bf16_t; using pg8::bf16x8; using pg8::f32x4; using pg8::f32x2; using pg8::u32x4; using pg8::u32x2; using pg8::f2bf; using pg8::pk2; using pg8::bf_lo; using pg8::bf_hi;
#define LAS __attribute__((address_space(3)))
typedef float f32x16 __attribute__((ext_vector_type(16)));
constexpr int NWAVES = 8, NTHR = 512;
constexpr int D = 1024, FF = 2816, DIN = 7184, MP = 16384, MS = 128, MT = 16512, MPAD = 16640, TSEQ = 2048, NB = 8;
constexpr int PLD = 7424;
constexpr int PC_XR = 0, PC_YR = 1024, PC_OG = 2048, PC_Q = 3072, PC_K = 3584, PC_V = 4096, PC_GA = 5120, PC_GB = 6144, PC_LR = 7168;
constexpr int SC_XA = 0, SC_H = 1024, SC_T = 3072, SC_F = 5120;
constexpr float EPS = 1e-6f;
constexpr size_t O_YP = 0, O_YS = 16777216, O_HP = 16908288, O_CP = 16916480, O_SP = 16941056, O_HS = 17989632, O_CS = 18120704, O_SS = 18513920;
constexpr size_t MiB = 1u << 20;
constexpr size_t WS_CTL = 0, CTL_ZERO_BYTES = 64 * 1024;
constexpr size_t WS_P = 1 * MiB;
constexpr size_t WS_TAIL = 237 * MiB;
constexpr size_t WS_WRG = WS_TAIL, WS_WBR = WS_TAIL + MiB / 2, WS_WBG = WS_WBR + 2 * MiB, WS_WOUT = WS_WBG + 2 * MiB;
constexpr size_t WS_WGU2 = WS_TAIL, WS_WD2 = WS_TAIL + 11 * MiB;
static_assert(WS_P + (size_t)MPAD * PLD * 2 <= WS_TAIL && WS_WOUT + 2 * MiB <= 256 * MiB && WS_WD2 + (size_t)D * FF * 2 <= 256 * MiB, "d_ws map");
constexpr size_t SS_U = 0, SS_WIN = (size_t)MPAD * D * 2, SS_WGU1 = SS_WIN + (size_t)PLD * D * 2, SS_WD1 = SS_WGU1 + (size_t)2 * FF * D * 2;
static_assert(SS_WD1 + (size_t)D * FF * 2 <= 64 * MiB, "ss-region map");
constexpr int CW_BAR = 4096;
constexpr int LDS_BYTES = 163840, MISC_OFF = LDS_BYTES - 512;

#define RLX_AGENT __ATOMIC_RELAXED, __HIP_MEMORY_SCOPE_AGENT
#define LDS_WAIT() asm volatile("s_waitcnt lgkmcnt(0)" ::: "memory")
#define VM_WAIT() asm volatile("s_waitcnt vmcnt(0)" ::: "memory")

#define XB_TMO      128
#define XB_XCNT(j)  (256  + 64 * (j))
#define XB_XSUB(j)  (1280 + 64 * (j))
#define XB_XGEN(j)  (2304 + 64 * (j))
#define XB_TOP      3328
#define XB_TOPGEN   3392
#define XCD_BAR_WORDS 3456
#define XB_SPIN_CAP (1u << 18)
__device__ __forceinline__ unsigned xb_ld(unsigned* p)              { return __hip_atomic_load(p, __ATOMIC_RELAXED, __HIP_MEMORY_SCOPE_AGENT); }
__device__ __forceinline__ unsigned xb_add(unsigned* p, unsigned v) { return __hip_atomic_fetch_add(p, v, __ATOMIC_RELAXED, __HIP_MEMORY_SCOPE_AGENT); }
__device__ __forceinline__ unsigned xb_xcc_id() { return (unsigned)__builtin_amdgcn_s_getreg((3 << 11) | 20) & 0xFu; }
#define XB_SPIN(cond, bar) do { unsigned _sp = 0; while (cond) { __builtin_amdgcn_s_sleep(1); \
    if ((++_sp & 255u) == 0u) { if (xb_ld(&(bar)[XB_TMO])) break; if (_sp > XB_SPIN_CAP) { atomicAdd(&(bar)[XB_TMO], 1u); break; } } } } while (0)
struct XcdBarrier { unsigned* bar; unsigned x; volatile LAS unsigned* st; };
__device__ __forceinline__ XcdBarrier xcd_barrier_post(unsigned* bar, volatile LAS unsigned* st) {
    XcdBarrier b; b.bar = bar; b.x = xb_xcc_id(); b.st = st;
    if (threadIdx.x == 0) (void)xb_add(&bar[XB_XCNT(b.x)], 1u);
    return b;
}
__device__ __forceinline__ void xcd_barrier_complete(unsigned* bar, unsigned x, unsigned& nloc, unsigned& nx) {
    const unsigned G = gridDim.x * gridDim.y * gridDim.z;
    unsigned sum, cnt, mine, sp = 0u;
    for (;;) {
        sum = 0u; cnt = 0u; mine = 0u;
#pragma unroll
        for (unsigned j = 0; j < 16; ++j) { const unsigned c = xb_ld(&bar[XB_XCNT(j)]); sum += c; cnt += (c > 0u) ? 1u : 0u; mine = (j == x) ? c : mine; }
        if (sum == G) break;
        __builtin_amdgcn_s_sleep(1);
        if ((++sp & 255u) == 0u) { if (xb_ld(&bar[XB_TMO])) break; if (sp > XB_SPIN_CAP) { atomicAdd(&bar[XB_TMO], 1u); break; } }
    }
    nloc = mine > 0u ? mine : 1u; nx = cnt > 0u ? cnt : 1u;
}
__device__ __forceinline__ void xcd_barrier(const XcdBarrier& b) {
    asm volatile("s_waitcnt vmcnt(0)" ::: "memory");
    __syncthreads();
    if (threadIdx.x == 0) {
        unsigned* bar = b.bar;
        __builtin_amdgcn_s_waitcnt(0);
        unsigned nloc = b.st[0], nx = b.st[1];
        if (nloc == 0u) { xcd_barrier_complete(bar, b.x, nloc, nx); b.st[0] = nloc; b.st[1] = nx; }
        const unsigned old = xb_add(&bar[XB_XSUB(b.x)], 1u);
        const unsigned gen = old / nloc;
        if (old + 1u == (gen + 1u) * nloc) {
            __builtin_amdgcn_fence(__ATOMIC_RELEASE, "agent");
            asm volatile("s_waitcnt vmcnt(0)" ::: "memory");
            const unsigned og = xb_add(&bar[XB_TOP], 1u);
            const unsigned tg = og / nx;
            if (og + 1u == (tg + 1u) * nx) xb_add(&bar[XB_TOPGEN], 1u);
            else XB_SPIN(xb_ld(&bar[XB_TOPGEN]) == tg, bar);
            __builtin_amdgcn_fence(__ATOMIC_ACQUIRE, "agent");
            xb_add(&bar[XB_XGEN(b.x)], 1u);
            asm volatile("s_waitcnt vmcnt(0)" ::: "memory");
        } else {
            XB_SPIN(xb_ld(&bar[XB_XGEN(b.x)]) == gen, bar);
            __builtin_amdgcn_fence(__ATOMIC_ACQUIRE, "agent");
            asm volatile("s_waitcnt vmcnt(0)" ::: "memory");
        }
    }
    __syncthreads();
}

struct Args { const float* in[24]; float* out; unsigned char* ws; int ph_lo, ph_hi; };
struct Frame {
    LAS unsigned char* lds; int tid, lane, wave, vcu, G;
    const float* in[24]; float* out; unsigned char* ws;
    bf16_t* P; bf16_t* U; bf16_t* Win_t; bf16_t* Wgu1_t; bf16_t* Wd1_t; bf16_t* Wrg_t; bf16_t* Wbr_t; bf16_t* Wbg_t; bf16_t* Wout_t; bf16_t* Wgu2_t; bf16_t* Wd2_t;
};
enum { I_XP = 0, I_XS, I_SRH, I_SRC, I_SGLA, I_NG, I_F1GU, I_F1D, I_WIN, I_CW, I_CB, I_RWA, I_RBA, I_RWX, I_RBX, I_LAM, I_WLR, I_BLR, I_GNG, I_WBR, I_WBG, I_WOUT, I_F2GU, I_F2D };

__device__ __forceinline__ float wave_sum(float v) {
#pragma unroll
    for (int o = 1; o < 64; o <<= 1) v += __shfl_xor(v, o);
    return v;
}
__device__ __forceinline__ const float* xrow_ptr(const Frame& F, int row) { return row < MP ? F.in[I_XP] + (size_t)row * D : F.in[I_XS] + (size_t)(row - MP) * D; }
__device__ __forceinline__ void load_row16(const float* p, int lane, f32x4 (&v)[4]) {
#pragma unroll
    for (int j = 0; j < 4; ++j) v[j] = *(const f32x4*)(p + 4 * lane + 256 * j);
}
__device__ __forceinline__ float sumsq16(const f32x4 (&v)[4]) { float s = 0.f;
#pragma unroll
    for (int j = 0; j < 4; ++j) s += (v[j].x * v[j].x + v[j].y * v[j].y) + (v[j].z * v[j].z + v[j].w * v[j].w);
    return s; }
__device__ __forceinline__ void store_row16_bf16(bf16_t* p, int lane, const f32x4 (&v)[4]) {
#pragma unroll
    for (int j = 0; j < 4; ++j) { u32x2 w; w.x = pk2(v[j].x, v[j].y); w.y = pk2(v[j].z, v[j].w); *(u32x2*)(p + 4 * lane + 256 * j) = w; }
}
struct SlabMap { int slot, logw; };
__device__ __forceinline__ float* slab_at(const Frame& F, const SlabMap m, int s, int r, int c) {
    return (float*)(F.P + (size_t)(((s * MS + r) << (10 - m.logw)) + (c >> m.logw)) * PLD + m.slot) + (c & ((1 << m.logw) - 1)); }
constexpr SlabMap SLAB_D = {SC_XA, 9};
constexpr SlabMap SLAB_B = {PC_LR, 7};
__device__ __forceinline__ void load_row16_f(const Frame& F, int row, int slot, const SlabMap m, int slab0, int ns, f32x4 (&v)[4]) {
    if (row < MP) {
#pragma unroll
        for (int j = 0; j < 4; ++j) { const u32x2 w = *(const u32x2*)(F.P + (size_t)row * PLD + slot + 4 * F.lane + 256 * j); v[j] = (f32x4){bf_lo(w.x), bf_hi(w.x), bf_lo(w.y), bf_hi(w.y)}; }
        return; }
#pragma unroll
    for (int j = 0; j < 4; ++j) v[j] = (f32x4){0.f, 0.f, 0.f, 0.f};
    for (int s = 0; s < ns; ++s) {
#pragma unroll
        for (int j = 0; j < 4; ++j) v[j] = v[j] + *(const f32x4*)slab_at(F, m, slab0 + s, row - MP, 4 * F.lane + 256 * j); }
}
__device__ __forceinline__ void rowphase0(const Frame& F) {
    const int gw = F.vcu * NWAVES + F.wave, NGW = F.G * NWAVES; const float* g0 = F.in[I_NG];
    f32x4 g[4]; load_row16(g0, F.lane, g);
    for (int row = gw; row < MT; row += NGW) {
        f32x4 v[4]; load_row16(xrow_ptr(F, row), F.lane, v);
        const float rs = rsqrtf(wave_sum(sumsq16(v)) * (1.f / D) + EPS);
#pragma unroll
        for (int j = 0; j < 4; ++j) v[j] = v[j] * rs * g[j];
        store_row16_bf16(F.P + (size_t)row * PLD + SC_XA, F.lane, v);
    }
}
__device__ __forceinline__ void rowphase1(const Frame& F) {
    const int gw = F.vcu * NWAVES + F.wave, NGW = F.G * NWAVES; const float* ng = F.in[I_NG];
    f32x4 g1[4], g2[4]; load_row16(ng + 1 * D, F.lane, g1); load_row16(ng + 2 * D, F.lane, g2);
    for (int row = gw; row < MT; row += NGW) {
        f32x4 f[4], x[4]; load_row16_f(F, row, SC_F, SLAB_D, 0, 22, f); load_row16(xrow_ptr(F, row), F.lane, x);
        const float rs = rsqrtf(wave_sum(sumsq16(f)) * (1.f / D) + EPS);
#pragma unroll
        for (int j = 0; j < 4; ++j) x[j] = x[j] + 0.5f * (f[j] * rs * g1[j]);
        float* o = F.out + (size_t)row * D;
#pragma unroll
        for (int j = 0; j < 4; ++j) *(f32x4*)(o + 4 * F.lane + 256 * j) = x[j];
        const float rs2 = rsqrtf(wave_sum(sumsq16(x)) * (1.f / D) + EPS);
#pragma unroll
        for (int j = 0; j < 4; ++j) x[j] = x[j] * rs2 * g2[j];
        store_row16_bf16(F.U + (size_t)row * D, F.lane, x);
    }
}
__device__ __forceinline__ void rowphase2(const Frame& F) {
    const int gw = F.vcu * NWAVES + F.wave, NGW = F.G * NWAVES; const float* ng = F.in[I_NG];
    f32x4 g3[4], g4[4]; load_row16(ng + 3 * D, F.lane, g3); load_row16(ng + 4 * D, F.lane, g4);
    for (int row = gw; row < MT; row += NGW) {
        f32x4 f[4], x[4]; load_row16_f(F, row, SC_T, SLAB_B, 4, 8, f); float* o = F.out + (size_t)row * D; load_row16(o, F.lane, x);
        const float rs = rsqrtf(wave_sum(sumsq16(f)) * (1.f / D) + EPS);
#pragma unroll
        for (int j = 0; j < 4; ++j) x[j] = x[j] + f[j] * rs * g3[j];
#pragma unroll
        for (int j = 0; j < 4; ++j) *(f32x4*)(o + 4 * F.lane + 256 * j) = x[j];
        const float rs2 = rsqrtf(wave_sum(sumsq16(x)) * (1.f / D) + EPS);
#pragma unroll
        for (int j = 0; j < 4; ++j) x[j] = x[j] * rs2 * g4[j];
        store_row16_bf16(F.P + (size_t)row * PLD + SC_XA, F.lane, x);
    }
}
__device__ __forceinline__ void rowphase3(const Frame& F) {
    const int gw = F.vcu * NWAVES + F.wave, NGW = F.G * NWAVES; const float* ng = F.in[I_NG];
    f32x4 g5[4]; load_row16(ng + 5 * D, F.lane, g5);
    for (int row = gw; row < MT; row += NGW) {
        f32x4 f[4], x[4]; load_row16_f(F, row, SC_F, SLAB_D, 0, 22, f); float* o = F.out + (size_t)row * D; load_row16(o, F.lane, x);
        const float rs = rsqrtf(wave_sum(sumsq16(f)) * (1.f / D) + EPS);
#pragma unroll
        for (int j = 0; j < 4; ++j) *(f32x4*)(o + 4 * F.lane + 256 * j) = x[j] + 0.5f * (f[j] * rs * g5[j]);
    }
}

__device__ __forceinline__ void tr_item(const float* W, int ldw, int K, int k0, int scol0, int nvalid, bf16_t* WT, int drow0, LAS float* scr, int lane, int ldt = 0) {
    if (ldt == 0) ldt = K;
    { const int c4 = lane & 7, r = lane >> 3; const bool ok = 4 * c4 < nvalid; f32x4 v[8];
#pragma unroll
      for (int i = 0; i < 8; ++i) v[i] = ok ? *(const f32x4*)(W + (size_t)(k0 + r + 8 * i) * ldw + scol0 + 4 * c4) : (f32x4){0.f, 0.f, 0.f, 0.f};
#pragma unroll
      for (int i = 0; i < 8; ++i) { LAS float* d = scr + (r + 8 * i) * 33 + 4 * c4; d[0] = v[i][0]; d[1] = v[i][1]; d[2] = v[i][2]; d[3] = v[i][3]; } }
    LDS_WAIT(); asm volatile("" ::: "memory");
    const int c = lane & 7;
#pragma unroll
    for (int j = 0; j < 4; ++j) { const int n = (lane >> 3) + 8 * j; const LAS float* s = scr + (8 * c) * 33 + n;
        u32x4 o; o.x = pk2(s[0 * 33], s[1 * 33]); o.y = pk2(s[2 * 33], s[3 * 33]); o.z = pk2(s[4 * 33], s[5 * 33]); o.w = pk2(s[6 * 33], s[7 * 33]);
        *(u32x4*)(WT + (size_t)(drow0 + n) * ldt + k0 + 8 * c) = o; }
    LDS_WAIT(); asm volatile("" ::: "memory");
}
__device__ __forceinline__ void prep_wgu(const Frame& F, const float* W, bf16_t* WT, LAS float* scr, int gw, int NGW) {
    constexpr int KB = D / 64, RB = 2 * FF / 32;
    for (int it = gw; it < KB * RB; it += NGW) { const int kb = it / RB, rb = it % RB, n0 = 32 * rb, pn = n0 >> 8, bj = (n0 >> 7) & 1, j = n0 & 127;
        tr_item(W, 2 * FF, D, 64 * kb, bj * FF + 128 * pn + j, 32, WT, n0, scr, F.lane); }
}
__device__ __forceinline__ void prep_plain(const Frame& F, const float* W, int K, int N, bf16_t* WT, LAS float* scr, int gw, int NGW, int ldt = 0) {
    const int KB = K / 64, RB = N / 32;
    for (int it = gw; it < KB * RB; it += NGW) { const int kb = it / RB, rb = it % RB; tr_item(W, N, K, 64 * kb, 32 * rb, 32, WT, 32 * rb, scr, F.lane, ldt); }
}
__device__ __forceinline__ void prep_win(const Frame& F, LAS float* scr, int gw, int NGW) {
    constexpr int KB = D / 64, RB = PLD / 32;
    for (int it = gw; it < KB * RB; it += NGW) { const int kb = it / RB, rb = it % RB, n0 = 32 * rb; int sc, nv = 32;
        if (n0 < 2048) sc = n0;
        else if (n0 < 3072) sc = 4096 + (n0 - 2048);
        else if (n0 < 3584) sc = 2048 + (n0 - 3072);
        else if (n0 < 4096) sc = 2560 + (n0 - 3584);
        else if (n0 < 5120) sc = 3072 + (n0 - 4096);
        else if (n0 < 6144) sc = 5136 + (n0 - 5120);
        else if (n0 < 7168) sc = 6160 + (n0 - 6144);
        else if (n0 == 7168) { sc = 5120; nv = 16; }
        else { sc = 0; nv = 0; }
        tr_item(F.in[I_WIN], DIN, D, 64 * kb, sc, nv, F.Win_t, n0, scr, F.lane); }
}
__device__ __forceinline__ void prep_rg(const Frame& F, LAS float* scr, int gw, int NGW) {
    for (int it = gw; it < 2 * 8 * 8; it += NGW) { const int gate = it >> 6, n = (it >> 3) & 7, sub = it & 7, kb = sub >> 2, rb = sub & 3;
        tr_item(F.in[gate ? I_RWX : I_RWA] + (size_t)n * 16384, 128, 128, 64 * kb, 32 * rb, 32, F.Wrg_t + (size_t)(gate * 8 + n) * 16384, 32 * rb, scr, F.lane); }
}
}
namespace mk {
#define MFMA16(a, b, c) __builtin_amdgcn_mfma_f32_16x16x32_bf16((a), (b), (c), 0, 0, 0)
#define MFMA32(a, b, c) __builtin_amdgcn_mfma_f32_32x32x16_bf16((a), (b), (c), 0, 0, 0)
constexpr float LOG2E = 1.4426950408889634f;
__device__ __forceinline__ float bf2f(bf16_t h) { return __builtin_bit_cast(float, (unsigned)h << 16); }
__device__ __forceinline__ float ex2(float x) { return __builtin_amdgcn_exp2f(x); }
__device__ __forceinline__ float sigm(float x) { return __builtin_amdgcn_rcpf(1.0f + ex2(-LOG2E * x)); }
__device__ __forceinline__ float softplus_(float x) { return fmaxf(x, 0.f) + log1pf(__expf(-fabsf(x))); }
__device__ __forceinline__ float gelu_tanh_(float x) { return x * sigm(1.5957691216057308f * (x + 0.044715f * x * x * x)); }
__device__ __forceinline__ float silu_(float x) { return x * sigm(x); }
__device__ __forceinline__ void unpack8(const u32x4 w, float (&f)[8]) { f[0] = bf_lo(w.x); f[1] = bf_hi(w.x); f[2] = bf_lo(w.y); f[3] = bf_hi(w.y); f[4] = bf_lo(w.z); f[5] = bf_hi(w.z); f[6] = bf_lo(w.w); f[7] = bf_hi(w.w); }
__device__ __forceinline__ u32x4 pack8(const float (&f)[8]) { u32x4 w; w.x = pk2(f[0], f[1]); w.y = pk2(f[2], f[3]); w.z = pk2(f[4], f[5]); w.w = pk2(f[6], f[7]); return w; }

constexpr size_t WS_GAGG = WS_WOUT + 2 * MiB, GAGG_FLOATS = 32768 + 128, WS_RAGG = 128 * 1024;
static_assert(WS_GAGG + (size_t)96 * GAGG_FLOATS * 4 <= 256 * MiB && WS_RAGG + 512 * 256 * 4 <= WS_P, "mixer scratch map");

#ifdef TIME_RSUB
#define RT(k) do { if (!SAMPLE && MODE == 3 && F.vcu == 200) { const unsigned long long now_ = __builtin_amdgcn_s_memrealtime(); volatile LAS unsigned long long* tq_ = (volatile LAS unsigned long long*)(F.lds + MISC_OFF + 64); if ((k) == TIME_RSUB && F.tid == 0) tq_[0] += now_ - tq_[1]; if (F.tid == 0) tq_[1] = now_; } } while (0)
#else
#define RT(k) do {} while (0)
#endif
template <bool SAMPLE, int MODE>
__device__ __forceinline__ void rnn_item(const Frame& F, int item) {
    constexpr int XRAW_OFF = 0, XRAW_LD = 136, XCF_OFF = 18432, XCF_LD = 132, XCB_OFF = 52224, XCB_LD = 136, HB_OFF = 69632, CW_OFF = 103424;
    constexpr bool FULL = SAMPLE || MODE == 3;
    const int tid = F.tid, lane = F.lane, wid = F.wave;
    const int seg = SAMPLE ? 0 : (MODE == 3 ? 2 * (item & 3) : (item & 7)), n = SAMPLE ? (item >> 1) : (MODE == 3 ? ((item >> 2) & 7) : ((item >> 3) & 7)), b = SAMPLE ? 0 : (MODE == 3 ? (item >> 5) : (item >> 6)), ch0 = 128 * n;
    LAS bf16_t* XRAW = (LAS bf16_t*)(F.lds + XRAW_OFF); LAS float* XCF = (LAS float*)(F.lds + XCF_OFF); LAS bf16_t* XCB = (LAS bf16_t*)(F.lds + XCB_OFF);
    LAS float* HB = (LAS float*)(F.lds + HB_OFF); LAS float* CW = (LAS float*)(F.lds + CW_OFF);
    for (int i = tid; i < 5 * 128; i += NTHR) { const int j = i >> 7, c = i & 127; CW[i] = j < 4 ? F.in[I_CW][j * D + ch0 + c] : F.in[I_CB][ch0 + c]; }
    const int q = lane >> 4, cl = 16 * wid + (lane & 15);
    const float ba = F.in[I_RBA][ch0 + cl], bx = F.in[I_RBX][ch0 + cl], sp8 = 8.0f * softplus_(-F.in[I_LAM][ch0 + cl]), sp8l2 = sp8 * LOG2E;
    bf16x8 Bw[2][4];
#pragma unroll
    for (int g = 0; g < 2; ++g)
#pragma unroll
        for (int ks = 0; ks < 4; ++ks) Bw[g][ks] = *(const bf16x8*)(F.Wrg_t + ((size_t)(g * 8 + n) * 128 + cl) * 128 + 32 * ks + 8 * q);
    const int t5 = tid >> 3, c5 = 16 * (tid & 7);
    float* ragg = (float*)(F.ws + WS_RAGG);
    float carry = 0.f, aprod = 1.f;
    if constexpr (!SAMPLE && MODE == 3) {
        float fa[7], fh[7];
#pragma unroll
        for (int s = 0; s < 7; ++s) { const float* ag = ragg + ((size_t)((b * 8 + n) * 8 + s)) * 256; fa[s] = s < seg ? ag[cl] : 1.f; fh[s] = s < seg ? ag[128 + cl] : 0.f; }
#pragma unroll
        for (int s = 0; s < 7; ++s) carry = fmaf(fa[s], carry, fh[s]);
    }
    const int ntiles = SAMPLE ? 1 : (MODE == 3 ? 8 : 4), tile0 = SAMPLE ? (item & 1) : 4 * seg;
    u32x4 pxr[3], py0 = (u32x4){0u, 0u, 0u, 0u}, py1 = py0;
    auto prefetch = [&](int t0n) {
        if constexpr (!SAMPLE) {
#pragma unroll
            for (int i3 = 0; i3 < 3; ++i3) { const int e = tid + NTHR * i3, i = e >> 4, chk = e & 15, t = t0n - 3 + i; pxr[i3] = (u32x4){0u, 0u, 0u, 0u};
                if (e < 67 * 16 && t >= 0) pxr[i3] = *(const u32x4*)(F.P + ((size_t)b * TSEQ + t) * PLD + PC_XR + ch0 + 8 * chk); }
            if constexpr (FULL) { const bf16_t* yp = F.P + ((size_t)b * TSEQ + t0n + t5) * PLD + PC_YR + ch0 + c5; py0 = *(const u32x4*)yp; py1 = *(const u32x4*)(yp + 8); }
        }
    };
    if constexpr (!SAMPLE) prefetch(64 * tile0);
    __syncthreads();
    for (int tt = 0; tt < ntiles; ++tt) {
        RT(0);
        const int t0 = 64 * (tile0 + tt);
        const size_t row5 = SAMPLE ? (size_t)(MP + t0 + t5) : (size_t)b * TSEQ + t0 + t5;
        bf16_t* yrp = F.P + row5 * PLD + PC_YR + ch0 + c5;
        u32x4 y0 = py0, y1 = py1;
        if constexpr (SAMPLE) { y0 = *(const u32x4*)yrp; y1 = *(const u32x4*)(yrp + 8); }
        if constexpr (!SAMPLE) {
#pragma unroll
            for (int i3 = 0; i3 < 3; ++i3) { const int e = tid + NTHR * i3, i = e >> 4, chk = e & 15; if (e < 67 * 16) *(LAS u32x4*)(XRAW + i * XRAW_LD + 8 * chk) = pxr[i3]; }
            __syncthreads(); RT(1);
            if (tt + 1 < ntiles) prefetch(t0 + 64);
            const int c0 = 8 * (tid & 15);
            float w[4][8], cb8[8];
#pragma unroll
            for (int e = 0; e < 8; ++e) { cb8[e] = CW[4 * 128 + c0 + e];
#pragma unroll
                for (int j = 0; j < 4; ++j) w[j][e] = CW[j * 128 + c0 + e]; }
#pragma unroll
            for (int rr = 0; rr < 2; ++rr) { const int t = (tid >> 4) + 32 * rr; float xc[8];
#pragma unroll
                for (int e = 0; e < 8; ++e) xc[e] = cb8[e];
#pragma unroll
                for (int j = 0; j < 4; ++j) { float x[8]; unpack8(*(const LAS u32x4*)(XRAW + (t + j) * XRAW_LD + c0), x);
#pragma unroll
                    for (int e = 0; e < 8; ++e) xc[e] = fmaf(w[j][e], x[e], xc[e]); }
                *(LAS f32x4*)(XCF + t * XCF_LD + c0) = (f32x4){xc[0], xc[1], xc[2], xc[3]}; *(LAS f32x4*)(XCF + t * XCF_LD + c0 + 4) = (f32x4){xc[4], xc[5], xc[6], xc[7]};
                *(LAS u32x4*)(XCB + t * XCB_LD + c0) = pack8(xc); }
        } else {
            const int s = t0 + t5; const bf16_t* xrp = F.P + (size_t)(MP + s) * PLD + PC_XR + ch0 + c5;
            float xr[16]; { float a8[8], b8[8]; unpack8(*(const u32x4*)xrp, a8); unpack8(*(const u32x4*)(xrp + 8), b8);
#pragma unroll
                for (int e = 0; e < 8; ++e) { xr[e] = a8[e]; xr[8 + e] = b8[e]; } }
            const float* bufp = F.in[I_SRC] + (size_t)s * 3 * D + ch0 + c5; float* csp = F.out + O_CS + (size_t)s * 3 * D + ch0 + c5;
            float xc[16];
#pragma unroll
            for (int e = 0; e < 16; ++e) xc[e] = CW[4 * 128 + c5 + e] + CW[3 * 128 + c5 + e] * xr[e];
#pragma unroll
            for (int j = 0; j < 3; ++j)
#pragma unroll
                for (int v4 = 0; v4 < 4; ++v4) { const f32x4 bv = *(const f32x4*)(bufp + j * D + 4 * v4);
#pragma unroll
                    for (int e = 0; e < 4; ++e) xc[4 * v4 + e] = fmaf(CW[j * 128 + c5 + 4 * v4 + e], bv[e], xc[4 * v4 + e]);
                    if (j >= 1) *(f32x4*)(csp + (j - 1) * D + 4 * v4) = bv; }
#pragma unroll
            for (int v4 = 0; v4 < 4; ++v4) { *(f32x4*)(csp + 2 * D + 4 * v4) = (f32x4){xr[4 * v4], xr[4 * v4 + 1], xr[4 * v4 + 2], xr[4 * v4 + 3]};
                *(LAS f32x4*)(XCF + t5 * XCF_LD + c5 + 4 * v4) = (f32x4){xc[4 * v4], xc[4 * v4 + 1], xc[4 * v4 + 2], xc[4 * v4 + 3]}; }
            { float h8[8];
#pragma unroll
              for (int hf = 0; hf < 2; ++hf) {
#pragma unroll
                for (int e = 0; e < 8; ++e) h8[e] = xc[8 * hf + e];
                *(LAS u32x4*)(XCB + t5 * XCB_LD + c5 + 8 * hf) = pack8(h8); } }
        }
        __syncthreads(); RT(2);
        f32x4 acc[4][2];
#pragma unroll
        for (int m = 0; m < 4; ++m) { acc[m][0] = (f32x4){0.f, 0.f, 0.f, 0.f}; acc[m][1] = (f32x4){0.f, 0.f, 0.f, 0.f}; }
#pragma unroll
        for (int m = 0; m < 4; ++m)
#pragma unroll
            for (int ks = 0; ks < 4; ++ks) { const bf16x8 a = *(const LAS bf16x8*)(XCB + (16 * m + (lane & 15)) * XCB_LD + 32 * ks + 8 * q);
                acc[m][0] = MFMA16(a, Bw[0][ks], acc[m][0]); acc[m][1] = MFMA16(a, Bw[1][ks], acc[m][1]); }
#pragma unroll
        for (int m = 0; m < 4; ++m) {
            float av[4], bv[4];
#pragma unroll
            for (int reg = 0; reg < 4; ++reg) { const int t = 16 * m + 4 * q + reg; const float xcv = XCF[t * XCF_LD + cl];
                const float r = sigm(acc[m][0][reg] + ba), ig = sigm(acc[m][1][reg] + bx);
                const float x2 = -2.0f * sp8 * r;
                const float em = -x2 * (1.0f + x2 * (0.5f + x2 * (0.16666667f + x2 * (0.041666668f + x2 * (0.0083333338f + x2 * 0.0013888889f)))));
                float mult = __builtin_amdgcn_sqrtf(fmaxf(em, 0.f)); if (!SAMPLE && (t0 + t) == 0) mult = 1.0f;
                av[reg] = ex2(-sp8l2 * r); bv[reg] = mult * ig * xcv; }
            if constexpr (!SAMPLE) {
                float Al = 1.f, Hl = 0.f;
#pragma unroll
                for (int reg = 0; reg < 4; ++reg) { Hl = fmaf(av[reg], Hl, bv[reg]); Al *= av[reg]; }
                float hin = carry, cn = carry;
#pragma unroll
                for (int qq = 0; qq < 4; ++qq) { const float Ag = __shfl(Al, (lane & 15) + 16 * qq), Hg = __shfl(Hl, (lane & 15) + 16 * qq);
                    cn = fmaf(Ag, cn, Hg); hin = (qq < q) ? cn : hin; if (MODE == 1) aprod *= Ag; }
                carry = cn;
                if constexpr (MODE == 3) { float hv = hin;
#pragma unroll
                    for (int reg = 0; reg < 4; ++reg) { hv = fmaf(av[reg], hv, bv[reg]); HB[(16 * m + 4 * q + reg) * XCF_LD + cl] = hv; } }
            } else {
#pragma unroll
                for (int reg = 0; reg < 4; ++reg) { const int t = 16 * m + 4 * q + reg; const float h0 = F.in[I_SRH][(size_t)(t0 + t) * D + ch0 + cl];
                    HB[t * XCF_LD + cl] = fmaf(av[reg], h0, bv[reg]); }
            }
        }
        __syncthreads(); RT(3);
        if constexpr (FULL) {
            float h[16], yv[16], o8[8];
#pragma unroll
            for (int v4 = 0; v4 < 4; ++v4) { const f32x4 hv = *(const LAS f32x4*)(HB + t5 * XCF_LD + c5 + 4 * v4); h[4 * v4] = hv[0]; h[4 * v4 + 1] = hv[1]; h[4 * v4 + 2] = hv[2]; h[4 * v4 + 3] = hv[3]; }
            { float a8[8], b8[8]; unpack8(y0, a8); unpack8(y1, b8);
#pragma unroll
              for (int e = 0; e < 8; ++e) { yv[e] = a8[e]; yv[8 + e] = b8[e]; } }
            if constexpr (SAMPLE) { float* hsp = F.out + O_HS + (size_t)(t0 + t5) * D + ch0 + c5;
#pragma unroll
                for (int v4 = 0; v4 < 4; ++v4) *(f32x4*)(hsp + 4 * v4) = (f32x4){h[4 * v4], h[4 * v4 + 1], h[4 * v4 + 2], h[4 * v4 + 3]}; }
#pragma unroll
            for (int hf = 0; hf < 2; ++hf) {
#pragma unroll
                for (int e = 0; e < 8; ++e) o8[e] = h[8 * hf + e] * gelu_tanh_(yv[8 * hf + e]);
                *(u32x4*)(yrp + 8 * hf) = pack8(o8); }
            if constexpr (!SAMPLE) { if (tile0 + tt == 31 && t5 >= 61) { float* cpp = F.out + O_CP + ((size_t)b * 3 + (t5 - 61)) * D + ch0 + c5;
#pragma unroll
                for (int e = 0; e < 16; ++e) cpp[e] = bf2f(XRAW[(t5 + 3) * XRAW_LD + c5 + e]); } }
        }
        RT(4);
    }
    if constexpr (!SAMPLE && MODE == 1) { if (q == 0) { float* ag = ragg + (size_t)item * 256; ag[cl] = aprod; ag[128 + cl] = carry; } }
    if constexpr (!SAMPLE && MODE == 3) { if (seg == 6 && q == 0) F.out[O_HP + (size_t)b * D + ch0 + cl] = carry; }
    __syncthreads();
}

__device__ __forceinline__ int crow(int reg, int h) { return (reg & 3) + 8 * (reg >> 2) + 4 * h; }
__device__ __forceinline__ bf16x8 pack_step(const f32x16& x, int s) {
    u32x4 p; p.x = pk2(x[8 * s], x[8 * s + 1]); p.y = pk2(x[8 * s + 2], x[8 * s + 3]); p.z = pk2(x[8 * s + 4], x[8 * s + 5]); p.w = pk2(x[8 * s + 6], x[8 * s + 7]);
    return __builtin_bit_cast(bf16x8, p);
}
#ifdef TIME_SUB
#define GT(k) do { if (MODE == 3 && F.vcu == 0) { const unsigned long long now_ = __builtin_amdgcn_s_memrealtime(); volatile LAS unsigned long long* tq_ = (volatile LAS unsigned long long*)(F.lds + MISC_OFF + 64); if ((k) == TIME_SUB && F.tid == 0) tq_[0] += now_ - tq_[1]; if (F.tid == 0) tq_[1] = now_; } } while (0)
#else
#define GT(k) do {} while (0)
#endif
template <int MODE>
__device__ __forceinline__ void gla_item(const Frame& F, int item) {
    constexpr int VRAW = 0, VRAW_LD = 264, LRS = 33792, QI = 37888, QK_LD = 136, KI = 55296, OBUF = 72704, OGT = 0, KET = 72704, T_LD = 72, VT = 91136, ATT = 128000, SEG = 137216, DEC = 139264, WLS = 139776;
    static_assert(WLS + 17 * 512 <= MISC_OFF, "GLA LDS map");
    constexpr bool FULL = (MODE == 3);
    const int tid = F.tid, lane = F.lane, w = F.wave;
    const int j = item & 3, hh = (item >> 2) & 3, b = item >> 4; const size_t rowbase = (size_t)b * TSEQ;
    LAS bf16_t* sVRAW = (LAS bf16_t*)(F.lds + VRAW); LAS bf16_t* sQI = (LAS bf16_t*)(F.lds + QI); LAS bf16_t* sKI = (LAS bf16_t*)(F.lds + KI);
    LAS float* sO = (LAS float*)(F.lds + OBUF); LAS bf16_t* sKET = (LAS bf16_t*)(F.lds + KET); LAS bf16_t* sVT = (LAS bf16_t*)(F.lds + VT); LAS bf16_t* sATT = (LAS bf16_t*)(F.lds + ATT);
    LAS float* sSEG = (LAS float*)(F.lds + SEG); LAS float* sDEC = (LAS float*)(F.lds + DEC);
    const int kk = tid & 127, seg = tid >> 7;
    LAS bf16_t* sLRb = (LAS bf16_t*)(F.lds + LRS); LAS float* sG = (LAS float*)(F.lds + QI);
    bf16x8 Bwl; { float wv[8];
#pragma unroll
        for (int jj = 0; jj < 8; ++jj) wv[jj] = (lane >> 4) < 2 ? F.in[I_WLR][(8 * (lane >> 4) + jj) * 512 + hh * 128 + 16 * w + (lane & 15)] : 0.f;
        Bwl = __builtin_bit_cast(bf16x8, pack8(wv)); }
    const float bias = F.in[I_BLR][hh * 128 + kk];
    const int r32 = lane & 31, h = lane >> 5, q = lane >> 4;
    float* gagg = (float*)(F.ws + WS_GAGG);
    f32x16 S[4];
#pragma unroll
    for (int kb = 0; kb < 4; ++kb)
#pragma unroll
        for (int i = 0; i < 16; ++i) S[kb][i] = 0.f;
    float dsum = 0.f;
    if constexpr (FULL) {
        for (int s = 0; s < j; ++s) { const float* ag = gagg + (size_t)((b * 4 + hh) * 3 + s) * GAGG_FLOATS;
            __syncthreads();
            if (tid < 128) sDEC[tid] = ag[32768 + tid];
            __syncthreads();
#pragma unroll
            for (int kb = 0; kb < 4; ++kb) {
#pragma unroll
                for (int g4 = 0; g4 < 4; ++g4) { const f32x4 kv = *(const f32x4*)(ag + ((size_t)((w * 4 + kb) * 4 + g4)) * 256 + 4 * lane); const f32x4 dd = *(const LAS f32x4*)(sDEC + 32 * kb + 8 * g4 + 4 * h);
#pragma unroll
                    for (int e = 0; e < 4; ++e) S[kb][4 * g4 + e] = fmaf(S[kb][4 * g4 + e], dd[e], kv[e]); }
            asm volatile("" ::: "memory"); }
        }
    }
    const char* Pb = (const char*)F.P;
    const unsigned ov = (unsigned)(((tid >> 5) * PLD + PC_V + 256 * hh + 8 * (tid & 31)) * 2), olr = (unsigned)(((tid >> 1) * PLD + PC_LR + 8 * (tid & 1)) * 2);
    const unsigned okq = (unsigned)(((tid >> 4) * PLD + 128 * hh + 8 * (tid & 15)) * 2), oog = (unsigned)((8 * w * PLD + PC_OG + 256 * hh + 4 * lane) * 2);
    LAS bf16_t* sQR = (LAS bf16_t*)(F.lds + VRAW); LAS bf16_t* sKR = (LAS bf16_t*)(F.lds + VRAW + 16384);
    u32x4 pv[4], plr = (u32x4){0u, 0u, 0u, 0u}, pk[2], pq[2];
    auto prefetch = [&](size_t r0) {
        const char* rb = Pb + r0 * (size_t)(PLD * 2);
        unsigned o1 = ov, o2 = olr, o3 = okq; asm volatile("" : "+v"(o1), "+v"(o2), "+v"(o3));
#pragma unroll
        for (int i = 0; i < 4; ++i) pv[i] = *(const u32x4*)(rb + (o1 + (unsigned)(i * 16 * PLD * 2)));
        if (tid < 128) plr = *(const u32x4*)(rb + o2);
#pragma unroll
        for (int i = 0; i < 2; ++i) pk[i] = *(const u32x4*)(rb + (o3 + (unsigned)((i * 32 * PLD + PC_K) * 2)));
    };
    prefetch(rowbase + 64 * (8 * j));
    __syncthreads();
    for (int cn = 8 * j; cn < 8 * j + 8; ++cn) {
        const size_t row0 = rowbase + 64 * cn;
        GT(0);
        if constexpr (FULL) { const char* rb = Pb + row0 * (size_t)(PLD * 2); unsigned o3 = okq; asm volatile("" : "+v"(o3));
#pragma unroll
            for (int i = 0; i < 2; ++i) pq[i] = *(const u32x4*)(rb + (o3 + (unsigned)((i * 32 * PLD + PC_Q) * 2))); }
#pragma unroll
        for (int i = 0; i < 4; ++i) { const int e = tid + NTHR * i, row = e >> 5, c16 = e & 31; *(LAS u32x4*)(sVRAW + row * VRAW_LD + 8 * c16) = pv[i]; }
        if (tid < 128) { *(LAS u32x4*)(sLRb + (tid >> 1) * 32 + 8 * (tid & 1)) = plr; *(LAS u32x4*)(sLRb + (tid >> 1) * 32 + 16 + 8 * (tid & 1)) = (u32x4){0u, 0u, 0u, 0u}; }
        __syncthreads(); GT(1);
#pragma unroll
        for (int m = 0; m < 4; ++m) { const bf16x8 a = *(const LAS bf16x8*)(sLRb + (16 * m + (lane & 15)) * 32 + 8 * q); const f32x4 cg = MFMA16(a, Bwl, ((f32x4){0.f, 0.f, 0.f, 0.f}));
#pragma unroll
            for (int reg = 0; reg < 4; ++reg) sG[(16 * m + 4 * q + reg) * 128 + 16 * w + (lane & 15)] = cg[reg]; }
        { const int dv = tid & 255, hf = tid >> 8;
#pragma unroll
          for (int s8 = 0; s8 < 4; ++s8) { const int s = 32 * hf + 8 * s8; u32x4 wv; unsigned t[8];
#pragma unroll
              for (int jj = 0; jj < 8; ++jj) t[jj] = sVRAW[(s + jj) * VRAW_LD + dv];
              wv.x = t[0] | (t[1] << 16); wv.y = t[2] | (t[3] << 16); wv.z = t[4] | (t[5] << 16); wv.w = t[6] | (t[7] << 16);
              *(LAS u32x4*)(sVT + dv * T_LD + s) = wv; } }
        __syncthreads(); GT(2);
        float c[16]; float run = 0.f;
#pragma unroll
        for (int i = 0; i < 16; ++i) { float x = sG[(16 * seg + i) * 128 + kk] + bias;
            x = fminf(fmaxf(x, -80.f), 80.f);
            run -= __builtin_amdgcn_logf(1.0f + ex2(-LOG2E * x)) * (1.0f / 16.0f);
            c[i] = run; }
        sSEG[seg * 128 + kk] = run;
#pragma unroll
        for (int i = 0; i < 2; ++i) { const int rowq = (tid >> 4) + 32 * i, cq = 8 * (tid & 15); *(LAS u32x4*)(sKR + rowq * 128 + cq) = pk[i]; if constexpr (FULL) *(LAS u32x4*)(sQR + rowq * 128 + cq) = pq[i]; }
        __syncthreads(); GT(3);
        if (cn + 1 < 8 * j + 8) prefetch(row0 + 64);
        { float off = 0.f, tot = 0.f;
#pragma unroll
          for (int s2 = 0; s2 < 4; ++s2) { const float v = sSEG[s2 * 128 + kk]; tot += v; off += (s2 < seg) ? v : 0.f; }
          const float dec = ex2(tot);
          if (seg == 0) { sDEC[kk] = dec; dsum += tot; }
          float ke[16];
#pragma unroll
          for (int i = 0; i < 16; ++i) { const int t = 16 * seg + i; const float bc = off + c[i]; const float eb = ex2(bc), ei = __builtin_amdgcn_rcpf(eb); const float kf = bf2f(sKR[t * 128 + kk]) * ei;
              ke[i] = kf * dec;
              if constexpr (FULL) { sQI[t * QK_LD + kk] = (bf16_t)(pk2(bf2f(sQR[t * 128 + kk]) * 0.08838834764831845f * eb, 0.f) & 0xffffu); sKI[t * QK_LD + kk] = (bf16_t)(pk2(kf, 0.f) & 0xffffu); } }
          { float a8[8], b8[8];
#pragma unroll
            for (int e = 0; e < 8; ++e) { a8[e] = ke[e]; b8[e] = ke[8 + e]; }
            *(LAS u32x4*)(sKET + kk * T_LD + 16 * seg) = pack8(a8); *(LAS u32x4*)(sKET + kk * T_LD + 16 * seg + 8) = pack8(b8); } }
        __syncthreads(); GT(4);
        if constexpr (FULL) {
            const char* gp = Pb + (row0 + 8 * w) * (size_t)(PLD * 2) + (size_t)((PC_OG + 256 * hh) * 2); unsigned o5 = (unsigned)((lane >> 5) * PLD * 2 + (lane & 31) * 16); asm volatile("" : "+v"(o5));
#pragma unroll
            for (int i = 0; i < 4; ++i) __builtin_amdgcn_global_load_lds((const unsigned*)(gp + (o5 + (unsigned)(2 * i * PLD * 2))), (LAS unsigned*)(F.lds + OGT + w * 4096 + i * 1024), 16, 0, 0); }
        if constexpr (FULL) {
#pragma unroll
            for (int u = 0; u < 2; ++u) { const int T = 2 * w + u, ti = T >> 2, si = T & 3; f32x4 cc = (f32x4){0.f, 0.f, 0.f, 0.f};
                if (si <= ti) {
#pragma unroll
                    for (int ks = 0; ks < 4; ++ks) { const bf16x8 a = *(const LAS bf16x8*)(sKI + (16 * si + (lane & 15)) * QK_LD + 32 * ks + 8 * q), bq = *(const LAS bf16x8*)(sQI + (16 * ti + (lane & 15)) * QK_LD + 32 * ks + 8 * q);
                        cc = MFMA16(a, bq, cc); } }
                const int t = 16 * ti + (lane & 15), s0 = 16 * si + 4 * q; float v[4];
#pragma unroll
                for (int reg = 0; reg < 4; ++reg) v[reg] = (s0 + reg <= t) ? cc[reg] : 0.f;
                u32x2 wv; wv.x = pk2(v[0], v[1]); wv.y = pk2(v[2], v[3]); *(LAS u32x2*)(sATT + t * T_LD + s0) = wv; }
            asm volatile("s_waitcnt lgkmcnt(0)" ::: "memory"); __builtin_amdgcn_s_barrier(); asm volatile("" ::: "memory"); GT(5);
        }
        bf16x8 vf[4];
#pragma unroll
        for (int st = 0; st < 4; ++st) vf[st] = *(const LAS bf16x8*)(sVT + (32 * w + r32) * T_LD + 16 * st + 8 * h);
        f32x16 o[2];
        if constexpr (FULL) {
#pragma unroll
            for (int i = 0; i < 16; ++i) { o[0][i] = 0.f; o[1][i] = 0.f; }
#pragma unroll
            for (int kb = 0; kb < 4; ++kb)
#pragma unroll
                for (int s2 = 0; s2 < 2; ++s2) { const bf16x8 Bf = pack_step(S[kb], s2);
#pragma unroll
                    for (int tb = 0; tb < 2; ++tb) { const LAS bf16_t* qp = sQI + (32 * tb + r32) * QK_LD + 32 * kb + 16 * s2 + 4 * h; const u32x2 lo = *(const LAS u32x2*)qp, hi = *(const LAS u32x2*)(qp + 8);
                        const u32x4 af = (u32x4){lo.x, lo.y, hi.x, hi.y}; o[tb] = MFMA32(__builtin_bit_cast(bf16x8, af), Bf, o[tb]); }
                    }
#pragma unroll
            for (int tb = 0; tb < 2; ++tb)
#pragma unroll
                for (int st = 0; st < 4; ++st) { if (tb == 0 && st >= 2) continue; const bf16x8 af = *(const LAS bf16x8*)(sATT + (32 * tb + r32) * T_LD + 16 * st + 8 * h); o[tb] = MFMA32(af, vf[st], o[tb]); }
        }
#pragma unroll
        for (int kb = 0; kb < 4; ++kb) {
#pragma unroll
            for (int g4 = 0; g4 < 4; ++g4) { const f32x4 dd = *(const LAS f32x4*)(sDEC + 32 * kb + 8 * g4 + 4 * h);
#pragma unroll
                for (int e = 0; e < 4; ++e) S[kb][4 * g4 + e] *= dd[e]; }
#pragma unroll
            for (int st = 0; st < 4; ++st) { const bf16x8 af = *(const LAS bf16x8*)(sKET + (32 * kb + r32) * T_LD + 16 * st + 8 * h); S[kb] = MFMA32(af, vf[st], S[kb]); } }
        if constexpr (FULL) { asm volatile("s_waitcnt lgkmcnt(0)" ::: "memory"); __builtin_amdgcn_s_barrier(); asm volatile("" ::: "memory"); } else __syncthreads();
        GT(6);
        if constexpr (FULL) {
#pragma unroll
            for (int tb = 0; tb < 2; ++tb)
#pragma unroll
                for (int i = 0; i < 16; ++i) sO[(32 * tb + crow(i, h)) * 256 + 32 * w + r32] = o[tb][i];
            __syncthreads(); GT(7);
            { const int l16 = lane & 15; float gnv[16];
#pragma unroll
              for (int i = 0; i < 4; ++i) { const f32x4 g4 = *(const f32x4*)(F.in[I_GNG] + 16 * l16 + 4 * i); gnv[4 * i] = g4[0]; gnv[4 * i + 1] = g4[1]; gnv[4 * i + 2] = g4[2]; gnv[4 * i + 3] = g4[3]; }
#pragma unroll
              for (int p = 0; p < 2; ++p) { const int jj = 4 * p + (lane >> 4), t = 8 * w + jj; float v[16]; float ss = 0.f;
#pragma unroll
                  for (int i = 0; i < 4; ++i) { const f32x4 x = *(const LAS f32x4*)(sO + t * 256 + 16 * l16 + 4 * i); v[4 * i] = x[0]; v[4 * i + 1] = x[1]; v[4 * i + 2] = x[2]; v[4 * i + 3] = x[3]; ss += (x[0] * x[0] + x[1] * x[1]) + (x[2] * x[2] + x[3] * x[3]); }
                  ss += __shfl_xor(ss, 1); ss += __shfl_xor(ss, 2); ss += __shfl_xor(ss, 4); ss += __shfl_xor(ss, 8);
                  const float rs = __builtin_amdgcn_rsqf(ss * (1.0f / 256.0f) + EPS);
                  float gv[16]; { float a8[8], b8[8]; const LAS unsigned char* op = F.lds + OGT + w * 4096 + jj * 512 + l16 * 32; unpack8(*(const LAS u32x4*)op, a8); unpack8(*(const LAS u32x4*)(op + 16), b8);
#pragma unroll
                      for (int e = 0; e < 8; ++e) { gv[e] = a8[e]; gv[8 + e] = b8[e]; } }
                  float o8[8]; char* dst = const_cast<char*>(Pb) + (row0 + t) * (size_t)(PLD * 2) + (size_t)((PC_OG + 256 * hh + 16 * l16) * 2);
#pragma unroll
                  for (int hf = 0; hf < 2; ++hf) {
#pragma unroll
                      for (int e = 0; e < 8; ++e) o8[e] = v[8 * hf + e] * rs * gnv[8 * hf + e] * silu_(gv[8 * hf + e]);
                      *(u32x4*)(dst + 16 * hf) = pack8(o8); } } }
            __syncthreads(); GT(8);
        }
    }
    if constexpr (!FULL) {
        float* ag = gagg + (size_t)((b * 4 + hh) * 3 + j) * GAGG_FLOATS;
#pragma unroll
        for (int kb = 0; kb < 4; ++kb)
#pragma unroll
            for (int g4 = 0; g4 < 4; ++g4) *(f32x4*)(ag + ((size_t)((w * 4 + kb) * 4 + g4)) * 256 + 4 * lane) = (f32x4){S[kb][4 * g4], S[kb][4 * g4 + 1], S[kb][4 * g4 + 2], S[kb][4 * g4 + 3]};
        if (seg == 0) ag[32768 + kk] = ex2(dsum);
    } else if (j == 3) {
        float* sp = F.out + O_SP + (size_t)(b * 4 + hh) * 128 * 256;
#pragma unroll
        for (int kb = 0; kb < 4; ++kb)
#pragma unroll
            for (int i = 0; i < 16; ++i) sp[(size_t)(32 * kb + crow(i, h)) * 256 + 32 * w + r32] = S[kb][i];
    }
    __syncthreads();
}

__device__ __forceinline__ void gla_sample_item(const Frame& F, int item) {
    constexpr int SQ = 0, SK = 512, SE = 1024, RED = 2048;
    const int tid = F.tid, lane = F.lane, w = F.wave; const int hh = item & 3, s = item >> 2;
    LAS float* sq = (LAS float*)(F.lds + SQ); LAS float* sk = (LAS float*)(F.lds + SK); LAS float* se = (LAS float*)(F.lds + SE); LAS float* red = (LAS float*)(F.lds + RED);
    const bf16_t* Prow = F.P + (size_t)(MP + s) * PLD;
    const float* S0 = F.in[I_SGLA] + ((size_t)(s * 4 + hh) * 128 + 16 * w) * 256 + 4 * lane; float* S1 = F.out + O_SS + ((size_t)(s * 4 + hh) * 128 + 16 * w) * 256 + 4 * lane;
    f32x4 sv[16];
#pragma unroll
    for (int jj = 0; jj < 16; ++jj) sv[jj] = __builtin_nontemporal_load((const f32x4*)(S0 + jj * 256));
    const u32x2 vw = *(const u32x2*)(Prow + PC_V + 256 * hh + 4 * lane);
    bf16_t* ogp = F.P + (size_t)(MP + s) * PLD + PC_OG + 256 * hh + 4 * lane; const u32x2 ogw = *(const u32x2*)ogp;
    if (tid < 128) { const u32x4 l0 = *(const u32x4*)(Prow + PC_LR), l1 = *(const u32x4*)(Prow + PC_LR + 8); float lr[16]; { float a8[8], b8[8]; unpack8(l0, a8); unpack8(l1, b8);
#pragma unroll
            for (int e = 0; e < 8; ++e) { lr[e] = a8[e]; lr[8 + e] = b8[e]; } }
        float wv[16];
#pragma unroll
        for (int r = 0; r < 16; ++r) wv[r] = F.in[I_WLR][r * 512 + hh * 128 + tid];
        float x = F.in[I_BLR][hh * 128 + tid]; const float qf = bf2f(Prow[PC_Q + 128 * hh + tid]), kf = bf2f(Prow[PC_K + 128 * hh + tid]);
#pragma unroll
        for (int r = 0; r < 16; ++r) x = fmaf(lr[r], wv[r], x);
        se[tid] = __expf(-softplus_(-x) * (1.0f / 16.0f)); sq[tid] = qf * 0.08838834764831845f; sk[tid] = kf; }
    __syncthreads();
    const f32x4 v4 = (f32x4){bf_lo(vw.x), bf_hi(vw.x), bf_lo(vw.y), bf_hi(vw.y)};
    f32x4 o4 = (f32x4){0.f, 0.f, 0.f, 0.f};
#pragma unroll
    for (int jj = 0; jj < 16; ++jj) { const int k = 16 * w + jj; const f32x4 sn = sv[jj] * se[k] + v4 * sk[k]; __builtin_nontemporal_store(sn, (f32x4*)(S1 + jj * 256)); o4 = o4 + sn * sq[k]; }
    *(LAS f32x4*)(red + w * 256 + 4 * lane) = o4;
    __syncthreads();
    if (w == 0) { f32x4 o = (f32x4){0.f, 0.f, 0.f, 0.f};
#pragma unroll
        for (int ww = 0; ww < 8; ++ww) o = o + *(const LAS f32x4*)(red + ww * 256 + 4 * lane);
        const float rs = rsqrtf(wave_sum((o[0] * o[0] + o[1] * o[1]) + (o[2] * o[2] + o[3] * o[3])) * (1.0f / 256.0f) + EPS);
        const f32x4 gn = *(const f32x4*)(F.in[I_GNG] + 4 * lane);
        u32x2 wv2; wv2.x = pk2(o[0] * rs * gn[0] * silu_(bf_lo(ogw.x)), o[1] * rs * gn[1] * silu_(bf_hi(ogw.x))); wv2.y = pk2(o[2] * rs * gn[2] * silu_(bf_lo(ogw.y)), o[3] * rs * gn[3] * silu_(bf_hi(ogw.y)));
        *(u32x2*)ogp = wv2; }
    __syncthreads();
}

template <int APROV>
__device__ __forceinline__ void skinny_piece(const Frame& F, const bf16_t* A, int lda, const bf16_t* Bt, int K, int k0, int nsub, int cb, const SlabMap om, int oslab) {
    constexpr int SA = 0, SB = 34816, LD = 136;
    const int tid = F.tid, lane = F.lane, w = F.wave, fr = lane & 15, fq = lane >> 4;
    LAS bf16_t* sA = (LAS bf16_t*)(F.lds + SA); LAS bf16_t* sB = (LAS bf16_t*)(F.lds + SB);
    f32x4 acc[8];
#pragma unroll
    for (int nb = 0; nb < 8; ++nb) acc[nb] = (f32x4){0.f, 0.f, 0.f, 0.f};
    for (int sub = 0; sub < nsub; ++sub) { const int kk0 = k0 + 128 * sub;
        __syncthreads();
#pragma unroll
        for (int i = 0; i < 4; ++i) { const int e = tid + NTHR * i, row = e >> 4, c16 = e & 15; u32x4 v;
            if constexpr (APROV == 0) v = *(const u32x4*)(A + (size_t)row * lda + kk0 + 8 * c16);
            else { const int cc = kk0 + 8 * c16; const bf16_t* gp = F.P + (size_t)(MP + row) * PLD + cc;
                float ga[8], gb[8], o[8]; unpack8(*(const u32x4*)(gp + PC_GA), ga); unpack8(*(const u32x4*)(gp + PC_GB), gb);
#pragma unroll
                for (int hf = 0; hf < 2; ++hf) { const f32x4 ya = *(const f32x4*)slab_at(F, SLAB_B, 0, row, cc + 4 * hf) + *(const f32x4*)slab_at(F, SLAB_B, 1, row, cc + 4 * hf), yb = *(const f32x4*)slab_at(F, SLAB_B, 2, row, cc + 4 * hf) + *(const f32x4*)slab_at(F, SLAB_B, 3, row, cc + 4 * hf);
#pragma unroll
                    for (int e2 = 0; e2 < 4; ++e2) o[4 * hf + e2] = sigm(ga[4 * hf + e2]) * ya[e2] + sigm(gb[4 * hf + e2]) * yb[e2]; }
                v = pack8(o); }
            *(LAS u32x4*)(sA + row * LD + 8 * c16) = v;
            *(LAS u32x4*)(sB + row * LD + 8 * c16) = *(const u32x4*)(Bt + (size_t)(128 * cb + row) * K + kk0 + 8 * c16); }
        __syncthreads();
        bf16x8 a[4];
#pragma unroll
        for (int s = 0; s < 4; ++s) a[s] = *(const LAS bf16x8*)(sA + (16 * w + fr) * LD + 32 * s + 8 * fq);
#pragma unroll
        for (int nb = 0; nb < 8; ++nb)
#pragma unroll
            for (int s = 0; s < 4; ++s) { const bf16x8 bb = *(const LAS bf16x8*)(sB + (16 * nb + fr) * LD + 32 * s + 8 * fq); acc[nb] = MFMA16(bb, a[s], acc[nb]); }
    }
#pragma unroll
    for (int nb = 0; nb < 8; ++nb) *(f32x4*)slab_at(F, om, oslab, 16 * w + fr, 128 * cb + 16 * nb + 4 * fq) = acc[nb];
    __syncthreads();
}
}
namespace mk {
constexpr int N_PHASES = 13;
__global__ void __launch_bounds__(NTHR, 2) mega_fwd(Args args) {
    extern __shared__ __attribute__((aligned(16))) unsigned char lds_raw[];
    Frame F;
    F.lds = (LAS unsigned char*)lds_raw;
    F.tid = threadIdx.x; F.lane = F.tid & 63; F.wave = __builtin_amdgcn_readfirstlane(F.tid >> 6);
    F.G = gridDim.x; { const int bx = blockIdx.x; F.vcu = (F.G % 8 == 0) ? (bx % 8) * (F.G / 8) + bx / 8 : bx; }
#pragma unroll
    for (int i = 0; i < 24; ++i) F.in[i] = args.in[i];
    F.out = args.out; F.ws = args.ws;
    F.P = (bf16_t*)(args.ws + WS_P);
    unsigned char* ssr = (unsigned char*)(args.out + O_SS);
    F.U = (bf16_t*)(ssr + SS_U); F.Win_t = (bf16_t*)(ssr + SS_WIN); F.Wgu1_t = (bf16_t*)(ssr + SS_WGU1); F.Wd1_t = (bf16_t*)(ssr + SS_WD1);
    F.Wrg_t = (bf16_t*)(args.ws + WS_WRG); F.Wbr_t = (bf16_t*)(args.ws + WS_WBR); F.Wbg_t = (bf16_t*)(args.ws + WS_WBG); F.Wout_t = (bf16_t*)(args.ws + WS_WOUT);
    F.Wgu2_t = (bf16_t*)(args.ws + WS_WGU2); F.Wd2_t = (bf16_t*)(args.ws + WS_WD2);
    volatile LAS unsigned* MISC = (volatile LAS unsigned*)(F.lds + MISC_OFF);
    for (int u = F.tid; u < 128; u += NTHR) MISC[u] = 0u;
    __syncthreads();
    const int lo = args.ph_lo, hi = args.ph_hi;
    XcdBarrier bar; bar.bar = (unsigned*)(args.ws + WS_CTL) + CW_BAR; bar.x = 0; bar.st = nullptr;
    if (hi - lo > 1) bar = xcd_barrier_post((unsigned*)(args.ws + WS_CTL) + CW_BAR, MISC + 8);
#define IN(k) (lo <= (k) && (k) < hi)
#ifdef TIME_PHASE
    unsigned long long tp0 = __builtin_amdgcn_s_memrealtime(), tp1 = 0;
#ifdef TIME_WALL
#define SEAM(k) do { if (IN(k) && IN((k) + 1)) xcd_barrier(bar); if ((k) == TIME_PHASE) tp1 = __builtin_amdgcn_s_memrealtime(); if ((k) + 1 == TIME_PHASE) tp0 = __builtin_amdgcn_s_memrealtime(); } while (0)
#else
#define SEAM(k) do { if ((k) == TIME_PHASE) tp1 = __builtin_amdgcn_s_memrealtime(); if (IN(k) && IN((k) + 1)) xcd_barrier(bar); if ((k) + 1 == TIME_PHASE) tp0 = __builtin_amdgcn_s_memrealtime(); } while (0)
#endif
#else
#define SEAM(k) do { if (IN(k) && IN((k) + 1)) xcd_barrier(bar); } while (0)
#endif
    const int gw = F.vcu * NWAVES + F.wave, NGW = F.G * NWAVES;
    LAS float* scr = (LAS float*)(F.lds + F.wave * 16384);
    constexpr bool AL = true, SP = true;

    if (IN(0)) {
        prep_wgu(F, F.in[I_F1GU], F.Wgu1_t, scr, gw, NGW);
        prep_plain(F, F.in[I_F1D], FF, D, F.Wd1_t, scr, gw, NGW);
        rowphase0(F);
    }
    SEAM(0);
    if (IN(1)) {
        pg8::Gemm g{F.P + SC_XA, PLD, F.Wgu1_t, MPAD, 2 * FF, D}; pg8::StaticOrder S; S.init(MPAD, 2 * FF, F.G, (int)blockIdx.x);
        pg8::EpiSwiGLU E{F.P + SC_H, PLD};
        pg8::gemm_phase<pg8::EpiSwiGLU, pg8::StaticOrder, AL, SP>(F.lds, g, S, E);
        { constexpr int NU = (MPAD / 256) * (2 * FF / 256); const int full = NU % F.G;
          if (NU > F.G && full > 0 && (int)blockIdx.x >= full) prep_win(F, scr, ((int)blockIdx.x - full) * NWAVES + F.wave, (F.G - full) * NWAVES);
          else if (!(NU > F.G && full > 0)) prep_win(F, scr, gw, NGW); }
    }
    SEAM(1);
    if (IN(2)) {
        for (int pc = F.vcu; pc < 176; pc += F.G) skinny_piece<0>(F, F.P + (size_t)MP * PLD + SC_H, PLD, F.Wd1_t, FF, 128 * (pc >> 3), 1, pc & 7, SLAB_D, pc >> 3);
        pg8::Gemm g{F.P + SC_H, PLD, F.Wd1_t, MP, D, FF}; pg8::StaticOrder S; S.init(MP, D, F.G, (int)blockIdx.x);
        pg8::EpiBf16 E{F.P + SC_F, PLD};
        pg8::gemm_phase<pg8::EpiBf16, pg8::StaticOrder, AL, SP>(F.lds, g, S, E);
    }
    SEAM(2);
    if (IN(3)) rowphase1(F);
    SEAM(3);
    if (IN(4)) {
        pg8::Gemm g{F.U, D, F.Win_t, MPAD, PLD, D}; pg8::StaticOrder S; S.init(MPAD, PLD, F.G, (int)blockIdx.x);
        pg8::EpiBf16 E{F.P, PLD};
        pg8::gemm_phase<pg8::EpiBf16, pg8::StaticOrder, AL, SP>(F.lds, g, S, E);
        { constexpr int NU = (MPAD / 256) * (PLD / 256); const int full = NU % F.G; const bool part = NU > F.G && full > 0;
          const int g2 = part ? ((int)blockIdx.x - full) * NWAVES + F.wave : gw, n2 = part ? (F.G - full) * NWAVES : NGW;
          if (!part || (int)blockIdx.x >= full) {
              prep_rg(F, scr, g2, n2);
              prep_plain(F, F.in[I_WBR], D, D, F.Wbr_t, scr, g2, n2, 2 * D);
              prep_plain(F, F.in[I_WBG], D, D, F.Wbr_t + D, scr, g2, n2, 2 * D);
              prep_plain(F, F.in[I_WOUT], D, D, F.Wout_t, scr, g2, n2); } }
    }
    SEAM(4);
    if (IN(5)) {
        const int c = (int)blockIdx.x;
        if (c < 96) { gla_item<1>(F, (c / 3) * 4 + (c % 3)); rnn_item<false, 1>(F, (c / 7) * 8 + (c % 7)); }
        else {
            const int o = c - 96, no = F.G - 96;
            for (int i = 96 + o; i < 448; i += no) rnn_item<false, 1>(F, (i / 7) * 8 + (i % 7));
            if (o >= 32 || no != 160) for (int i = (no == 160 ? o - 32 : o); i < 2 * MS; i += (no == 160 ? 128 : no)) gla_sample_item(F, i);
        }
    }
    SEAM(5);
    if (IN(6)) {
        const int c = (int)blockIdx.x;
        if (c < 128) { gla_item<3>(F, c); const int j = c & 3;
            if (j < 3) gla_sample_item(F, 2 * MS + c); if (j == 0) gla_sample_item(F, 2 * MS + c + 3);
            if (j == 3 && c < 64) gla_sample_item(F, 3 * MS + (c >> 2)); }
        else {
            for (int i = c - 128; i < 256; i += F.G - 128) rnn_item<false, 3>(F, i);
            if (c < 144) rnn_item<true, 3>(F, c - 128);
            for (int i = 3 * MS + c - 128; i < 4 * MS; i += F.G - 128) if (i >= 3 * MS + 16) gla_sample_item(F, i);
        }
    }
    SEAM(6);
    if (IN(7)) {
        for (int pc = F.vcu; pc < 32; pc += F.G) { const int gsel = pc >> 4, ks = (pc >> 3) & 1, cb = pc & 7;
            skinny_piece<0>(F, F.P + (size_t)MP * PLD + (gsel ? PC_OG : PC_YR), PLD, F.Wbr_t + (gsel ? D : 0), 2 * D, 512 * ks, 4, cb, SLAB_B, 2 * gsel + ks); }
        pg8::Gemm g{F.P + PC_YR, PLD, F.Wbr_t, MP, D, 2 * D}; pg8::StaticOrder S; S.init(MP, D, F.G, (int)blockIdx.x);
        pg8::EpiMerge E{F.P + PC_GA, F.P + PC_GB, PLD, F.P + SC_XA, PLD};
        pg8::gemm_phase<pg8::EpiMerge, pg8::StaticOrder, false, SP>(F.lds, g, S, E);
    }
    SEAM(7);
    if (IN(8)) {
        for (int pc = F.vcu; pc < 64; pc += F.G) skinny_piece<1>(F, nullptr, 0, F.Wout_t, D, 128 * (pc >> 3), 1, pc & 7, SLAB_B, 4 + (pc >> 3));
        pg8::Gemm g{F.P + SC_XA, PLD, F.Wout_t, MP, D, D}; pg8::StaticOrder S; S.init(MP, D, F.G, (int)blockIdx.x);
        pg8::EpiBf16 E{F.P + SC_T, PLD};
        pg8::gemm_phase<pg8::EpiBf16, pg8::StaticOrder, AL, SP>(F.lds, g, S, E);
    }
    SEAM(8);
    if (IN(9)) {
        prep_wgu(F, F.in[I_F2GU], F.Wgu2_t, scr, gw, NGW);
        rowphase2(F);
    }
    SEAM(9);
    if (IN(10)) {
        pg8::Gemm g{F.P + SC_XA, PLD, F.Wgu2_t, MPAD, 2 * FF, D}; pg8::StaticOrder S; S.init(MPAD, 2 * FF, F.G, (int)blockIdx.x);
        pg8::EpiSwiGLU E{F.P + SC_H, PLD};
        pg8::gemm_phase<pg8::EpiSwiGLU, pg8::StaticOrder, AL, SP>(F.lds, g, S, E);
        { constexpr int NU = (MPAD / 256) * (2 * FF / 256); const int full = NU % F.G; const bool part = NU > F.G && full > 0;
          if (!part || (int)blockIdx.x >= full) prep_plain(F, F.in[I_F2D], FF, D, F.Wd2_t, scr, part ? ((int)blockIdx.x - full) * NWAVES + F.wave : gw, part ? (F.G - full) * NWAVES : NGW); }
    }
    SEAM(10);
    if (IN(11)) {
        for (int pc = F.vcu; pc < 176; pc += F.G) skinny_piece<0>(F, F.P + (size_t)MP * PLD + SC_H, PLD, F.Wd2_t, FF, 128 * (pc >> 3), 1, pc & 7, SLAB_D, pc >> 3);
        pg8::Gemm g{F.P + SC_H, PLD, F.Wd2_t, MP, D, FF}; pg8::StaticOrder S; S.init(MP, D, F.G, (int)blockIdx.x);
        pg8::EpiBf16 E{F.P + SC_F, PLD};
        pg8::gemm_phase<pg8::EpiBf16, pg8::StaticOrder, AL, SP>(F.lds, g, S, E);
    }
    SEAM(11);
    if (IN(12)) rowphase3(F);
#ifdef TIME_PHASE
    if (TIME_PHASE == 12) { asm volatile("s_waitcnt vmcnt(0)" ::: "memory"); tp1 = __builtin_amdgcn_s_memrealtime(); }
#ifdef TIME_SUB
    if (F.vcu == 0) { tp0 = 0; tp1 = ((volatile LAS unsigned long long*)(F.lds + MISC_OFF + 64))[0]; }
#endif
#ifdef TIME_RSUB
    if (F.vcu == 200) { tp0 = 0; tp1 = ((volatile LAS unsigned long long*)(F.lds + MISC_OFF + 64))[0]; }
#endif
    if (F.vcu == TIME_VCU) { const unsigned long long te = __builtin_amdgcn_s_memrealtime(), wait = (unsigned long long)(TIME_MULT) * (tp1 - tp0); while (__builtin_amdgcn_s_memrealtime() - te < wait) __builtin_amdgcn_s_sleep(8); }
#endif
#undef IN
#undef SEAM
}

inline int launch(void* const* d_in, void* d_out, void* d_ws, hipStream_t stream, int n_launches, int ph_lo = 0, int ph_hi = 0) {
    static int grid = 0;
    if (grid == 0) {
        int dev = 0, cus = 0, per_cu = 0;
        if (hipGetDevice(&dev) != hipSuccess || hipDeviceGetAttribute(&cus, hipDeviceAttributeMultiprocessorCount, dev) != hipSuccess) { grid = -1; return -1; }
        if (hipFuncSetAttribute((const void*)mega_fwd, hipFuncAttributeMaxDynamicSharedMemorySize, LDS_BYTES) != hipSuccess) { grid = -1; return -1; }
        if (hipOccupancyMaxActiveBlocksPerMultiprocessor(&per_cu, (const void*)mega_fwd, NTHR, LDS_BYTES) != hipSuccess || per_cu < 1) per_cu = 1;
        (void)hipGetLastError();
        grid = cus < 256 ? cus : 256;
    }
    if (grid < 0) return -1;
    Args a{};
    for (int i = 0; i < 24; ++i) a.in[i] = (const float*)d_in[i];
    a.out = (float*)d_out; a.ws = (unsigned char*)d_ws;
    if (n_launches == 0) { a.ph_lo = ph_lo; a.ph_hi = ph_hi; hipLaunchKernelGGL(mega_fwd, dim3(grid), dim3(NTHR), LDS_BYTES, stream, a); return 0; }
    (void)hipMemsetAsync((char*)d_ws + WS_CTL, 0, CTL_ZERO_BYTES, stream);
    if (n_launches == 1) { a.ph_lo = 0; a.ph_hi = N_PHASES; hipLaunchKernelGGL(mega_fwd, dim3(grid), dim3(NTHR), LDS_BYTES, stream, a); }
    else for (int p = 0; p < N_PHASES; ++p) { a.ph_lo = p; a.ph_hi = p + 1; hipLaunchKernelGGL(mega_fwd, dim3(grid), dim3(NTHR), LDS_BYTES, stream, a); }
    return 0;
}
}
#ifndef MK_NL
#define MK_NL 1
#endif
extern "C" void kernel_launch(void* const* d_in, const int* in_sizes, int n_in,
                              void* d_out, int out_size, void* d_ws, size_t ws_size,
                              hipStream_t stream) {
    mk::launch(d_in, d_out, d_ws, stream, MK_NL);
}
```
